# Optimizing an MI355X kernel written in HIP

```python
import jax, jax.numpy as jnp
from jax import lax
import numpy as np

D_MODEL = 1024
BATCH = 4
SEQ = 8192
DEPTH = 2

GRID_W = 64
CTX_LEN = 256
HEAD_DIM = 64
EPS = 1e-6
A_HEADS = 4
A_WIDTH = A_HEADS * HEAD_DIM
CHUNK = 128
B_GROUPS = 4
B_WIDTH = B_GROUPS * HEAD_DIM
C_Q_HEADS = 8
C_KV_HEADS = 2
C_GROUP = C_Q_HEADS // C_KV_HEADS
C_WIDTH = C_Q_HEADS * HEAD_DIM
KV_WIDTH = C_KV_HEADS * HEAD_DIM
WINDOW = 128
BLOCK = 128
ROPE_BASE = 10000.0
D_MIX = A_WIDTH + B_WIDTH + C_WIDTH
OFF_B = 2 * A_WIDTH
OFF_Q = OFF_B + B_WIDTH
OFF_K = OFF_Q + C_WIDTH
OFF_V = OFF_K + KV_WIDTH
N_IN = OFF_V + KV_WIDTH
D_FF = 3584
N_EXPERTS = 8
TOP_K = 2
N_DENSE = (DEPTH + 1) // 2
N_MOE = DEPTH // 2

kernel_name = "hybrid_parallel_mixer_diffusion_block"


def rmsnorm(x, g):
    xf = x.astype(jnp.float32)
    y = xf * lax.rsqrt(jnp.mean(xf * xf, axis=-1, keepdims=True) + EPS)
    return (y * g.astype(jnp.float32)).astype(x.dtype)


def adaln(cond, w, b):
    m = jax.nn.silu(cond) @ w + b
    return jnp.split(m[..., None, :], 6, axis=-1)


def modulate(y, shift, scale):
    return y * (1 + scale) + shift


def axial_rope(n_tok):
    rows = n_tok // GRID_W
    row = jnp.broadcast_to(jnp.arange(rows)[:, None], (rows, GRID_W)).reshape(-1)
    col = jnp.broadcast_to(jnp.arange(GRID_W)[None, :], (rows, GRID_W)).reshape(-1)
    half = HEAD_DIM // 2
    inv = ROPE_BASE ** (-jnp.arange(0, half, 2, dtype=jnp.float32) / half)
    ang = jnp.stack([row.astype(jnp.float32)[:, None] * inv,
                     col.astype(jnp.float32)[:, None] * inv], axis=1)
    return jnp.cos(ang), jnp.sin(ang)


def apply_rope(x, cos, sin):
    xf = x.astype(jnp.float32).reshape(x.shape[:-1] + (2, 2, HEAD_DIM // 4))
    x1, x2 = xf[..., 0, :], xf[..., 1, :]
    cs, sn = cos[:, None], sin[:, None]
    out = jnp.stack([x1 * cs - x2 * sn, x2 * cs + x1 * sn], axis=-2)
    return out.reshape(x.shape).astype(x.dtype)


def chunk_sgu(uv, w_s, b_s, g_v):
    bsz, n, _ = uv.shape
    u, v = jnp.split(uv, 2, axis=-1)
    v = rmsnorm(v.reshape(bsz, n, A_HEADS, HEAD_DIM), g_v)
    v = v.reshape(bsz, n // CHUNK, CHUNK, A_HEADS, HEAD_DIM)
    sv = jnp.einsum('hpq,bcqhd->bcphd', w_s, v) + b_s.T[None, None, :, :, None]
    return u * sv.reshape(bsz, n, A_WIDTH)


def fourier_mix(xb, w_f):
    bsz, n, _ = xb.shape
    xg = xb.astype(jnp.float32).reshape(bsz, n, B_GROUPS, HEAD_DIM)
    y = jnp.fft.fft2(xg, axes=(1, 3), norm='ortho').real.astype(xb.dtype)
    y = jnp.einsum('bngd,gde->bnge', y, w_f)
    return y.reshape(bsz, n, B_WIDTH)


def window_attention(q, k, v, kc, vc, sink):
    bsz, n = q.shape[:2]
    nb = n // BLOCK
    scale = HEAD_DIM ** -0.5
    qb = q.reshape(bsz, nb, BLOCK, C_KV_HEADS, C_GROUP, HEAD_DIM)

    def band(t):
        tb = jnp.pad(t, ((0, 0), (BLOCK, BLOCK), (0, 0), (0, 0)))
        tb = tb.reshape(bsz, nb + 2, BLOCK, C_KV_HEADS, HEAD_DIM)
        return jnp.concatenate([tb[:, :-2], tb[:, 1:-1], tb[:, 2:]], axis=2)

    kb, vb = band(k), band(v)
    s_loc = jnp.einsum('bnqkgd,bnskd->bnkgqs', qb, kb,
                       preferred_element_type=jnp.float32) * scale
    s_ctx = jnp.einsum('bnqkgd,bckd->bnkgqc', qb, kc,
                       preferred_element_type=jnp.float32) * scale
    kpos = jnp.arange(3 * BLOCK) - BLOCK
    rel = kpos[None, :] - jnp.arange(BLOCK)[:, None]
    gpos = jnp.arange(nb)[:, None, None] * BLOCK + kpos[None, None, :]
    valid = (jnp.abs(rel) <= WINDOW)[None] & (gpos >= 0) & (gpos < n)
    s_loc = jnp.where(valid[None, :, None, None], s_loc, -jnp.inf)
    sink_col = jnp.broadcast_to(
        sink.astype(jnp.float32).reshape(C_KV_HEADS, C_GROUP, 1, 1), s_loc.shape[:-1] + (1,))
    p = jax.nn.softmax(jnp.concatenate([s_loc, s_ctx, sink_col], axis=-1), axis=-1)
    n_loc = 3 * BLOCK
    n_ctx = kc.shape[1]
    p_loc = p[..., :n_loc].astype(v.dtype)
    p_ctx = p[..., n_loc:n_loc + n_ctx].astype(v.dtype)
    o = (jnp.einsum('bnkgqs,bnskd->bnqkgd', p_loc, vb)
         + jnp.einsum('bnkgqc,bckd->bnqkgd', p_ctx, vc))
    return o.reshape(bsz, n, C_WIDTH)


def context_attention(qc, kc, vc, sink):
    bsz, m = qc.shape[:2]
    qg = qc.reshape(bsz, m, C_KV_HEADS, C_GROUP, HEAD_DIM)
    s = jnp.einsum('bqkgd,bckd->bkgqc', qg, kc,
                   preferred_element_type=jnp.float32) * HEAD_DIM ** -0.5
    sink_col = jnp.broadcast_to(
        sink.astype(jnp.float32).reshape(C_KV_HEADS, C_GROUP, 1, 1), s.shape[:-1] + (1,))
    p = jax.nn.softmax(jnp.concatenate([s, sink_col], axis=-1), axis=-1)
    o = jnp.einsum('bkgqc,bckd->bqkgd', p[..., :-1].astype(vc.dtype), vc)
    return o.reshape(bsz, m, C_WIDTH)


def swiglu(y, wg, wu, wd):
    return (jax.nn.silu(y @ wg) * (y @ wu)) @ wd


def moe_swiglu(y, w_r, b_r, wg, wu, wd):
    logits = (y @ w_r).astype(jnp.float32) + b_r.astype(jnp.float32)
    top_val, top_idx = lax.top_k(logits, TOP_K)
    gates = jax.nn.softmax(top_val, axis=-1)
    combine = jnp.sum(jax.nn.one_hot(top_idx, N_EXPERTS, dtype=jnp.float32)
                      * gates[..., None], axis=-2).astype(y.dtype)
    out = jnp.zeros_like(y)
    for e in range(N_EXPERTS):
        out = out + combine[..., e:e + 1] * swiglu(y, wg[e], wu[e], wd[e])
    return out


def setup_inputs(seed: int = 0) -> dict:
    key = jax.random.key(seed)
    ks = jax.random.split(key, 25)

    def nrm(k, shape, s):
        return jax.random.normal(k, shape, jnp.float32) * s

    return {
        "x": nrm(ks[0], (BATCH, SEQ, D_MODEL), 1.0),
        "c": nrm(ks[1], (BATCH, D_MODEL), 1.0),
        "ctx": nrm(ks[2], (BATCH, CTX_LEN, D_MODEL), 1.0),
        "c_ctx": nrm(ks[3], (D_MODEL,), 1.0),
        "w_ada": nrm(ks[4], (DEPTH, D_MODEL, 6 * D_MODEL), 0.5 * D_MODEL ** -0.5),
        "b_ada": nrm(ks[5], (DEPTH, 6 * D_MODEL), 0.02),
        "g_mix_pre": 1.0 + nrm(ks[6], (DEPTH, D_MODEL), 0.1),
        "g_mix_post": 1.0 + nrm(ks[7], (DEPTH, D_MODEL), 0.1),
        "g_ffn_pre": 1.0 + nrm(ks[8], (DEPTH, D_MODEL), 0.1),
        "g_ffn_post": 1.0 + nrm(ks[9], (DEPTH, D_MODEL), 0.1),
        "w_in": nrm(ks[10], (DEPTH, D_MODEL, N_IN), D_MODEL ** -0.5),
        "w_s": nrm(ks[11], (DEPTH, A_HEADS, CHUNK, CHUNK), CHUNK ** -0.5),
        "b_s": 1.0 + nrm(ks[12], (DEPTH, A_HEADS, CHUNK), 0.1),
        "g_v": 1.0 + nrm(ks[13], (DEPTH, A_HEADS, HEAD_DIM), 0.1),
        "w_f": nrm(ks[14], (DEPTH, B_GROUPS, HEAD_DIM, HEAD_DIM), HEAD_DIM ** -0.5),
        "sink": nrm(ks[15], (DEPTH, C_Q_HEADS), 0.5),
        "w_out": nrm(ks[16], (DEPTH, D_MIX, D_MODEL), D_MIX ** -0.5),
        "w_gate_d": nrm(ks[17], (N_DENSE, D_MODEL, D_FF), D_MODEL ** -0.5),
        "w_up_d": nrm(ks[18], (N_DENSE, D_MODEL, D_FF), D_MODEL ** -0.5),
        "w_down_d": nrm(ks[19], (N_DENSE, D_FF, D_MODEL), D_FF ** -0.5),
        "w_router": nrm(ks[20], (N_MOE, D_MODEL, N_EXPERTS), D_MODEL ** -0.5),
        "b_router": nrm(ks[21], (N_MOE, N_EXPERTS), 0.01),
        "w_gate_e": nrm(ks[22], (N_MOE, N_EXPERTS, D_MODEL, D_FF), D_MODEL ** -0.5),
        "w_up_e": nrm(ks[23], (N_MOE, N_EXPERTS, D_MODEL, D_FF), D_MODEL ** -0.5),
        "w_down_e": nrm(ks[24], (N_MOE, N_EXPERTS, D_FF, D_MODEL), D_FF ** -0.5),
    }


def reference(x, c, ctx, c_ctx, w_ada, b_ada, g_mix_pre, g_mix_post, g_ffn_pre, g_ffn_post,
              w_in, w_s, b_s, g_v, w_f, sink, w_out, w_gate_d, w_up_d, w_down_d,
              w_router, b_router, w_gate_e, w_up_e, w_down_e):
    bsz, n_lat = x.shape[:2]
    n_ctx = ctx.shape[1]
    cos, sin = axial_rope(n_lat)
    h, hc = x, ctx
    for i in range(DEPTH):
        last = i == DEPTH - 1
        sh_m, sc_m, gt_m, sh_f, sc_f, gt_f = adaln(c, w_ada[i], b_ada[i])
        csh_m, csc_m, cgt_m, csh_f, csc_f, cgt_f = adaln(c_ctx[None, :], w_ada[i], b_ada[i])

        z = modulate(rmsnorm(h, g_mix_pre[i]), sh_m, sc_m) @ w_in[i]
        a, fb, q, k, v = jnp.split(z, [OFF_B, OFF_Q, OFF_K, OFF_V], axis=-1)
        q = apply_rope(q.reshape(bsz, n_lat, C_Q_HEADS, HEAD_DIM), cos, sin)
        k = apply_rope(k.reshape(bsz, n_lat, C_KV_HEADS, HEAD_DIM), cos, sin)
        v = v.reshape(bsz, n_lat, C_KV_HEADS, HEAD_DIM)
        zc_in = modulate(rmsnorm(hc, g_mix_pre[i]), csh_m, csc_m)
        kc, vc = jnp.split(zc_in @ w_in[i][:, OFF_K:], 2, axis=-1)
        kc = kc.reshape(bsz, n_ctx, C_KV_HEADS, HEAD_DIM)
        vc = vc.reshape(bsz, n_ctx, C_KV_HEADS, HEAD_DIM)
        o = jnp.concatenate([
            chunk_sgu(jax.nn.gelu(a), w_s[i], b_s[i], g_v[i]),
            fourier_mix(fb, w_f[i]),
            window_attention(q, k, v, kc, vc, sink[i]),
        ], axis=-1) @ w_out[i]
        h = h + gt_m * rmsnorm(o, g_mix_post[i])
        if not last:
            ac, fbc, qc = jnp.split(zc_in @ w_in[i][:, :OFF_K], [OFF_B, OFF_Q], axis=-1)
            oc = jnp.concatenate([
                chunk_sgu(jax.nn.gelu(ac), w_s[i], b_s[i], g_v[i]),
                fourier_mix(fbc, w_f[i]),
                context_attention(qc.reshape(bsz, n_ctx, C_Q_HEADS, HEAD_DIM), kc, vc, sink[i]),
            ], axis=-1) @ w_out[i]
            hc = hc + cgt_m * rmsnorm(oc, g_mix_post[i])

        j = i // 2
        if i % 2 == 0:
            def ffn(y):
                return swiglu(y, w_gate_d[j], w_up_d[j], w_down_d[j])
        else:
            def ffn(y):
                return moe_swiglu(y, w_router[j], b_router[j], w_gate_e[j], w_up_e[j], w_down_e[j])
        f = ffn(modulate(rmsnorm(h, g_ffn_pre[i]), sh_f, sc_f))
        h = h + gt_f * rmsnorm(f, g_ffn_post[i])
        if not last:
            fc = ffn(modulate(rmsnorm(hc, g_ffn_pre[i]), csh_f, csc_f))
            hc = hc + cgt_f * rmsnorm(fc, g_ffn_post[i])
    return h
```

```cpp
#include <hip/hip_runtime.h>
#include <cstdio>
#include <cstdint>

#ifndef MK_MULTI
#define MK_MULTI 0
#endif
#define SPLITK (!MK_MULTI)
#ifndef MK_EN
#define MK_EN 0xFFFF
#endif
#define EN(b) (((MK_EN) >> (b)) & 1)
#ifndef MK_PROBE
#define MK_PROBE 0
#endif
#define KDUP_IN (MK_PROBE == 20)
#define KDUP_GRP (MK_PROBE >= 21 && MK_PROBE <= 24)
#define REP(k) ((MK_PROBE == (k)) ? 2 : 1)
#ifndef FILL
#define FILL 1
#endif

#define GAS __attribute__((address_space(1)))
#define LAS __attribute__((address_space(3)))
typedef unsigned short bf16;
typedef short bf16x8 __attribute__((ext_vector_type(8)));
typedef float f32x4 __attribute__((ext_vector_type(4)));
typedef float f32x2 __attribute__((ext_vector_type(2)));
typedef unsigned u32x4 __attribute__((ext_vector_type(4)));
typedef unsigned u32x2 __attribute__((ext_vector_type(2)));
typedef int i32x8 __attribute__((ext_vector_type(8)));
typedef GAS unsigned gu32;
#define RLX_AGENT __ATOMIC_RELAXED, __HIP_MEMORY_SCOPE_AGENT
#define LDS_WAIT() asm volatile("s_waitcnt lgkmcnt(0)" ::: "memory")
#define VM_WAIT() asm volatile("s_waitcnt vmcnt(0)" ::: "memory")
#define DI __device__ __forceinline__

constexpr int NB = 4, NLAT = 8192, NCTX = 256, DM = 1024;
constexpr int MLAT = NB * NLAT, MCTX = NB * NCTX, MALL = MLAT + MCTX;
constexpr int NZ = 1792;
constexpr int ZU = 0, ZV = 256, ZP = 512, ZQI = 768, ZQ = 1024, ZK = 1536, ZVV = 1664;
constexpr int DFF = 3584, NE = 8;
constexpr float EPS = 1e-6f, LOG2E = 1.4426950408889634f, QSCALE = 0.125f * 1.4426950408889634f;
constexpr int NWAVES = 8, NTHR = 512;
#ifndef FP8_DGU
#define FP8_DGU 1
#endif
#ifndef FP8_DDN
#define FP8_DDN 0
#endif
constexpr int CHUNK_TILES = 64;

constexpr size_t MiB = 1u << 20;
constexpr size_t WS_CTL = 0, CTL_ZERO_BYTES = 1 * MiB;
constexpr size_t WS_MOD = 6 * MiB;
constexpr size_t WS_TAB = 2 * MiB;
constexpr size_t T_G1 = 0, T_G3 = 32768, T_GC = 98304, T_WS = 360448, T_ROPE = 622592;
constexpr size_t WS_RT = 3 * MiB;
constexpr size_t RT_TOK = 0, RT_DST = 327680, RT_GATE = 655360, RT_TILE = 983040, RT_WGCNT = 985088, RT_ROW = 1 * MiB;
constexpr size_t WS_W = 8 * MiB;
constexpr size_t W_IN = 0, W_OUT = 7 * MiB, W_GUD = 11 * MiB, W_DD = 25 * MiB, W_GUE = 32 * MiB, W_DE = 88 * MiB;
constexpr size_t WS_H3 = 8 * MiB + 120 * MiB;
constexpr size_t WS_HCTX = 208 * MiB;
constexpr size_t WS_Y = 212 * MiB;
constexpr size_t WS_R = 278 * MiB;
constexpr size_t R_Z = 0, R_O = 0, R_OC = 116 * MiB, R_T = 182 * MiB, R_ACT = 0, R_F = 116 * MiB;
constexpr size_t ACT0_BACK = 8 * MiB;
constexpr size_t ACT1_BACK = 16 * MiB;
constexpr size_t R_PART0 = 182 * MiB;
constexpr size_t R_PART = 8 * MiB;
static_assert((size_t)MCTX * DFF * 2 <= 8 * MiB && R_PART + (size_t)14 * MCTX * DM * 4 <= 116 * MiB, "partials fit the activation region");
constexpr size_t WS_RT1 = 278 * MiB + 248 * MiB;
constexpr int CAP = 32768;
constexpr size_t RT1_TOK = 0, RT1_DST = 1 * MiB, RT1_GATE = 2 * MiB;
constexpr size_t WS_END = WS_RT1 + 3 * MiB;
static_assert((size_t)MALL * NZ * 2 <= 116 * MiB && (size_t)(CHUNK_TILES * 256) * DFF * 2 <= 116 * MiB && (size_t)(132 * 256) * DFF <= 116 * MiB && (size_t)2 * MALL * DM * 2 <= 132 * MiB, "ws map");
constexpr int CW_TMO = 0, CW_NTILES = 16, CW_CVT = 32, CW_GCNT = 48, CW_DONE = 64, CW_BAR = 4096;

constexpr int RING_BYTES = 131072, LDSCTL_OFF = RING_BYTES, LDS_BYTES = 163840;
constexpr int LC_ROPE = 16384;
constexpr int LC_BAR = 0;
constexpr int LC_TILE = 64;
constexpr int LC_CNT = 64 + 2048;
constexpr int LC_FILL = 64 + 2048 + 128;

DI unsigned cvt_pk_bf16(float lo, float hi) { unsigned r; asm volatile("v_cvt_pk_bf16_f32 %0, %1, %2" : "=v"(r) : "v"(lo), "v"(hi)); return r; }
DI unsigned short f2bf(float f) { return (unsigned short)(cvt_pk_bf16(f, 0.f) & 0xffffu); }
DI float bflo(unsigned w) { return __uint_as_float(w << 16); }
DI float bfhi(unsigned w) { return __uint_as_float(w & 0xffff0000u); }
DI float shx(float v, int mask, int lane) { return __builtin_bit_cast(float, __builtin_amdgcn_ds_bpermute((lane ^ mask) << 2, __builtin_bit_cast(int, v))); }
template <int CTRL> DI float dppx(float x) { return __builtin_bit_cast(float, __builtin_amdgcn_mov_dpp(__builtin_bit_cast(int, x), CTRL, 0xf, 0xf, true)); }
DI float xrow16_sum(float x) {
    auto s = __builtin_amdgcn_permlane16_swap(__float_as_uint(x), __float_as_uint(x), false, false);
    x = __uint_as_float(s[0]) + __uint_as_float(s[1]);
    auto t = __builtin_amdgcn_permlane32_swap(__float_as_uint(x), __float_as_uint(x), false, false);
    return __uint_as_float(t[0]) + __uint_as_float(t[1]);
}
DI float xrow16_max(float x) {
    auto s = __builtin_amdgcn_permlane16_swap(__float_as_uint(x), __float_as_uint(x), false, false);
    x = fmaxf(__uint_as_float(s[0]), __uint_as_float(s[1]));
    auto t = __builtin_amdgcn_permlane32_swap(__float_as_uint(x), __float_as_uint(x), false, false);
    return fmaxf(__uint_as_float(t[0]), __uint_as_float(t[1]));
}
DI float wave_sum(float v, int) {
    v += dppx<0xB1>(v);
    v += dppx<0x4E>(v);
    v += dppx<0x141>(v);
    v += dppx<0x128>(v);
    return xrow16_sum(v);
}
DI float fexp2(float x) { return __builtin_amdgcn_exp2f(x); }
DI float vmax3(float a, float b, float c) { float r; asm("v_max3_f32 %0, %1, %2, %3" : "=v"(r) : "v"(a), "v"(b), "v"(c)); return r; }
DI float frcp(float x) { return __builtin_amdgcn_rcpf(x); }
DI float gelu_tanh(float x) { const float u = 0.7978845608028654f * (x + 0.044715f * x * x * x); return x * frcp(1.0f + fexp2(-2.0f * LOG2E * u)); }
DI float silu_f(float x) { return x * frcp(1.0f + fexp2(-LOG2E * x)); }
DI f32x4 mfma16(bf16x8 a, bf16x8 b, f32x4 c) { return __builtin_amdgcn_mfma_f32_16x16x32_bf16(a, b, c, 0, 0, 0); }
typedef short v4i16_t __attribute__((ext_vector_type(4)));
DI bf16x8 trfrag(const LAS unsigned char* p, int pitch, int lane) {
    const LAS unsigned char* q = p + (8 * (lane >> 4) + ((lane & 15) >> 2)) * pitch + 8 * (lane & 3);
    const v4i16_t lo = __builtin_amdgcn_ds_read_tr16_b64_v4i16((LAS v4i16_t*)q), hi = __builtin_amdgcn_ds_read_tr16_b64_v4i16((LAS v4i16_t*)(q + 4 * pitch));
    return __builtin_shufflevector(lo, hi, 0, 1, 2, 3, 4, 5, 6, 7);
}

#define XB_TMO      128
#define XB_XCNT(j)  (256  + 64 * (j))
#define XB_XSUB(j)  (1280 + 64 * (j))
#define XB_XGEN(j)  (2304 + 64 * (j))
#define XB_TOP      3328
#define XB_TOPGEN   3392
#define XCD_BAR_WORDS 3456
#define XB_SPIN_CAP (1u << 18)
DI unsigned xb_ld(unsigned* p)              { return __hip_atomic_load(p, __ATOMIC_RELAXED, __HIP_MEMORY_SCOPE_AGENT); }
DI unsigned xb_add(unsigned* p, unsigned v) { return __hip_atomic_fetch_add(p, v, __ATOMIC_RELAXED, __HIP_MEMORY_SCOPE_AGENT); }
DI unsigned xb_xcc_id() { return (unsigned)__builtin_amdgcn_s_getreg((3 << 11) | 20) & 0xFu; }
#define XB_SPIN(cond, bar) do { unsigned _sp = 0; while (cond) { __builtin_amdgcn_s_sleep(1); \
    if ((++_sp & 255u) == 0u) { if (xb_ld(&(bar)[XB_TMO])) break; if (_sp > XB_SPIN_CAP) { atomicAdd(&(bar)[XB_TMO], 1u); break; } } } } while (0)
struct XcdBarrier { unsigned* bar; unsigned x; volatile LAS unsigned* st; };
DI XcdBarrier xcd_barrier_post(unsigned* bar, volatile LAS unsigned* st) {
    XcdBarrier b; b.bar = bar; b.x = xb_xcc_id(); b.st = st;
    if (threadIdx.x == 0) (void)xb_add(&bar[XB_XCNT(b.x)], 1u);
    return b;
}
DI void xcd_barrier_complete(unsigned* bar, unsigned x, unsigned& nloc, unsigned& nx) {
    const unsigned G = gridDim.x * gridDim.y * gridDim.z;
    unsigned sum, cnt, mine, sp = 0u;
    for (;;) {
        sum = 0u; cnt = 0u; mine = 0u;
#pragma unroll
        for (unsigned j = 0; j < 16; ++j) { const unsigned c = xb_ld(&bar[XB_XCNT(j)]); sum += c; cnt += (c > 0u) ? 1u : 0u; mine = (j == x) ? c : mine; }
        if (sum == G) break;
        __builtin_amdgcn_s_sleep(1);
        if ((++sp & 255u) == 0u) { if (xb_ld(&bar[XB_TMO])) break; if (sp > XB_SPIN_CAP) { atomicAdd(&bar[XB_TMO], 1u); break; } }
    }
    nloc = mine > 0u ? mine : 1u; nx = cnt > 0u ? cnt : 1u;
}
DI void xcd_barrier(const XcdBarrier& b, const bool leader) {
    asm volatile("s_waitcnt vmcnt(0)" ::: "memory");
    __syncthreads();
    if (leader) {
        unsigned* bar = b.bar;
        __builtin_amdgcn_s_waitcnt(0);
        unsigned nloc = b.st[0], nx = b.st[1];
        if (nloc == 0u) { xcd_barrier_complete(bar, b.x, nloc, nx); b.st[0] = nloc; b.st[1] = nx; }
        const unsigned old = xb_add(&bar[XB_XSUB(b.x)], 1u);
        const unsigned gen = old / nloc;
        if (old + 1u == (gen + 1u) * nloc) {
            __builtin_amdgcn_fence(__ATOMIC_RELEASE, "agent");
            asm volatile("s_waitcnt vmcnt(0)" ::: "memory");
            const unsigned og = xb_add(&bar[XB_TOP], 1u);
            const unsigned tg = og / nx;
            if (og + 1u == (tg + 1u) * nx) xb_add(&bar[XB_TOPGEN], 1u);
            else XB_SPIN(xb_ld(&bar[XB_TOPGEN]) == tg, bar);
            __builtin_amdgcn_fence(__ATOMIC_ACQUIRE, "agent");
            xb_add(&bar[XB_XGEN(b.x)], 1u);
            asm volatile("s_waitcnt vmcnt(0)" ::: "memory");
        } else {
            XB_SPIN(xb_ld(&bar[XB_XGEN(b.x)]) == gen, bar);
            __builtin_amdgcn_fence(__ATOMIC_ACQUIRE, "agent");
            asm volatile("s_waitcnt vmcnt(0)" ::: "memory");
        }
    }
    __syncthreads();
}

namespace pg8 {
typedef unsigned short bf16_t;
constexpr int BM = 256, BK = 64, HALF = 128, HTB = HALF * BK * 2, STAGE_BYTES = 8 * HTB;
DI int lds_byte(int r, int c) { const int st = (r >> 4) * 2 + (c >> 5), rr = r & 15, cc = c & 31, ob = rr * 64 + cc * 2; return st * 1024 + (ob ^ (((ob >> 9) & 1) << 5)); }
DI void stage_rc(int b, int& R, int& C) { const int st = b / 1024, sb = b % 1024, swz = sb ^ (((sb >> 9) & 1) << 5); R = (st >> 1) * 16 + swz / 64; C = (st & 1) * 32 + (swz % 64) / 2; }
DI int perm32(int rho) { const int n = rho >> 4, i = rho & 15; return 8 * (i >> 2) + 4 * n + (i & 3); }

struct Unit { int pm, pn; int arow; unsigned boff; int dup; int slot0; unsigned kofs; int ks; };

DI void static_map(int wgid, int nM, int nN, int& pm, int& pn) {
    const int nwg = nM * nN; const int q = nwg / 8, r = nwg % 8, xcd = wgid % 8, off = wgid / 8;
    wgid = (xcd < r ? xcd * (q + 1) : r * (q + 1) + (xcd - r) * q) + off;
    const int nig = 8 * nN, gid = wgid / nig, fm = gid * 8, gsz = (nM - fm) < 8 ? (nM - fm) : 8;
    pm = fm + ((wgid % nig) % gsz); pn = (wgid % nig) / gsz;
}

template <class Epi, class Sched, bool GATHER, bool FP8>
DI void gemm_phase(LAS unsigned char* lds, const unsigned char* Abase, const int rowbytes, const Sched& S, const Epi& E, const int tid, const int ntk = 0) {
    const int wid = __builtin_amdgcn_readfirstlane(tid >> 6), lane = tid & 63, wr = wid >> 2, wc = wid & 3, fr = lane & 15, fq = lane >> 4;
    const int nt = ntk ? ntk : rowbytes / 128;
    unsigned voffA, voffB, cofs; int Rr[2];
    { int R, C; stage_rc(tid * 16, R, C); const int Rb = (R & ~31) + perm32(R & 31);
      voffA = (unsigned)(R * rowbytes + C * 2); voffB = (unsigned)(Rb * rowbytes + C * 2); cofs = (unsigned)C * 2u; Rr[0] = R; Rr[1] = R + 64; }
    const unsigned kstep = (unsigned)(BK * 2);
    const unsigned hstep = (unsigned)HALF * (unsigned)rowbytes;
    const unsigned istep = 64u * (unsigned)rowbytes;
    const unsigned rowb = (unsigned)rowbytes;
    const unsigned ldsw = (unsigned)wid * 1024u;
    const int aoff = lds_byte(wr * 64 + fr, fq * 8), boff = lds_byte(wc * 32 + fr, fq * 8);
    const __amdgpu_buffer_rsrc_t rA = __builtin_amdgcn_make_buffer_rsrc((void*)Abase, (short)0, 0x7fffffff, 0x00020000);
    const __amdgpu_buffer_rsrc_t rB = __builtin_amdgcn_make_buffer_rsrc((void*)S.wbase(), (short)0, 0x7fffffff, 0x00020000);
#define PG8_SA(b, h) (((b) * 2 + (h)) * HTB)
#define PG8_SB(b, h) ((4 + (b) * 2 + (h)) * HTB)
#define PG8_DMA(rs, ldsoff, vo, so) __builtin_amdgcn_raw_ptr_buffer_load_lds(rs, (LAS void*)(lds + (ldsoff)), 16, (int)(vo), (int)(so), 0, 0)
#define PG8_STAGE(bufoff, so) do { PG8_DMA(rB, (bufoff) + ldsw, voffB, (so)); PG8_DMA(rB, (bufoff) + ldsw + 8192, voffB, (so) + istep); } while (0)
#define PG8_STAGE_A(bufoff, h, kb, nx) do { if constexpr (GATHER) { PG8_DMA(rA, (bufoff) + ldsw, aoC[h][0], (kb)); PG8_DMA(rA, (bufoff) + ldsw + 8192, aoC[h][1], (kb)); } \
        else { const unsigned so_ = ((nx) ? nA : cA) + (unsigned)(h) * hstep + (kb); PG8_DMA(rA, (bufoff) + ldsw, voffA, so_); PG8_DMA(rA, (bufoff) + ldsw + 8192, voffA, so_ + istep); } } while (0)
#define PG8_LDA(dst, b, h) do { _Pragma("unroll") for (int m = 0; m < 4; ++m) { const u32x4 lo_ = *(const LAS u32x4*)(lds + PG8_SA(b, h) + aoff + m * 2048), hi_ = *(const LAS u32x4*)(lds + PG8_SA(b, h) + aoff + m * 2048 + 1024); \
        dst[m] = (i32x8){(int)lo_.x, (int)lo_.y, (int)lo_.z, (int)lo_.w, (int)hi_.x, (int)hi_.y, (int)hi_.z, (int)hi_.w}; } } while (0)
#define PG8_LDB(dst, b, h) do { _Pragma("unroll") for (int n = 0; n < 2; ++n) { const u32x4 lo_ = *(const LAS u32x4*)(lds + PG8_SB(b, h) + boff + n * 2048), hi_ = *(const LAS u32x4*)(lds + PG8_SB(b, h) + boff + n * 2048 + 1024); \
        dst[n] = (i32x8){(int)lo_.x, (int)lo_.y, (int)lo_.z, (int)lo_.w, (int)hi_.x, (int)hi_.y, (int)hi_.z, (int)hi_.w}; } } while (0)
#define PG8_HALF(v, k) __builtin_bit_cast(bf16x8, __builtin_shufflevector(v, v, 4 * (k), 4 * (k) + 1, 4 * (k) + 2, 4 * (k) + 3))
#define PG8_MMA(ai, bj, At, Bt) do { __builtin_amdgcn_s_setprio(1); if constexpr (FP8) { _Pragma("unroll") for (int m = 0; m < 4; ++m) _Pragma("unroll") for (int n = 0; n < 2; ++n) \
        acc[ai][bj][m][n] = __builtin_amdgcn_mfma_scale_f32_16x16x128_f8f6f4(Bt[n], At[m], acc[ai][bj][m][n], 0, 0, 0, 0, 0, 0); } \
    else { _Pragma("unroll") for (int m = 0; m < 4; ++m) _Pragma("unroll") for (int n = 0; n < 2; ++n) { \
        acc[ai][bj][m][n] = __builtin_amdgcn_mfma_f32_16x16x32_bf16(PG8_HALF(Bt[n], 0), PG8_HALF(At[m], 0), acc[ai][bj][m][n], 0, 0, 0); \
        acc[ai][bj][m][n] = __builtin_amdgcn_mfma_f32_16x16x32_bf16(PG8_HALF(Bt[n], 1), PG8_HALF(At[m], 1), acc[ai][bj][m][n], 0, 0, 0); } } __builtin_amdgcn_s_setprio(0); } while (0)
#define PG8_WAIT_V(n) asm volatile("s_waitcnt vmcnt(" #n ")" ::: "memory")
#define PG8_WAIT_L(n) asm volatile("s_waitcnt lgkmcnt(" #n ")" ::: "memory")
#define PG8_BAR __builtin_amdgcn_s_barrier()
#define PG8_SCHED __builtin_amdgcn_sched_barrier(0)
    Unit cur, nxt; int ui = 0;
    if (!S.next(0, cur)) return;
    f32x4 acc[2][2][4][2];
#pragma unroll
    for (int a = 0; a < 2; ++a)
#pragma unroll
        for (int b = 0; b < 2; ++b)
#pragma unroll
            for (int m = 0; m < 4; ++m)
#pragma unroll
                for (int n = 0; n < 2; ++n) acc[a][b][m][n] = (f32x4){0.f, 0.f, 0.f, 0.f};
    i32x8 At[4], B0[2], B1[2];
    unsigned aoC[2][2];
    LAS unsigned short* gidx = (LAS unsigned short*)(lds + 131072 + 4096);
    unsigned cA = (unsigned)cur.arow * rowb + cur.kofs, cB = cur.boff + cur.kofs;
    if constexpr (GATHER) {
        Unit pu;
        for (int i = 0; i < 16 && S.next(i, pu); ++i) if (tid < 256) gidx[i * 256 + tid] = (unsigned short)S.rowidx(pu.arow + tid);
        __syncthreads();
    }
#pragma unroll
    for (int h = 0; h < 2; ++h)
#pragma unroll
        for (int i = 0; i < 2; ++i) aoC[h][i] = GATHER ? (unsigned)gidx[128 * h + Rr[i]] * rowb + cofs : 0u;
    unsigned nA = cA, nB = cB;
    PG8_STAGE(PG8_SB(0, 0), cB); PG8_STAGE(PG8_SB(0, 1), cB + hstep); PG8_STAGE_A(PG8_SA(0, 0), 0, 0u, false); PG8_STAGE_A(PG8_SA(0, 1), 1, 0u, false);
    if (wr == 1) PG8_BAR;
    PG8_WAIT_V(2); PG8_BAR;
    PG8_STAGE(PG8_SB(1, 0), cB + kstep); PG8_STAGE_A(PG8_SA(1, 0), 0, kstep, false); PG8_STAGE(PG8_SB(1, 1), cB + hstep + kstep);
    PG8_WAIT_V(6); PG8_BAR;
    for (;;) {
        const bool has_next = S.next(ui + 1, nxt);
        nA = has_next ? (unsigned)nxt.arow * rowb + nxt.kofs : cA; nB = has_next ? nxt.boff + nxt.kofs : cB;
#pragma unroll 1
        for (int t = 0; t < nt; t += 2) {
            const bool last = (t == nt - 2);
            const unsigned kb1 = (unsigned)(t + 1) * kstep, kb2 = last ? 0u : (unsigned)(t + 2) * kstep, kb3 = kb2 + kstep;
            const unsigned b2 = (last ? nB : cB) + kb2, b3 = b2 + kstep;
            PG8_LDB(B0, 0, 0); PG8_LDB(B1, 0, 1); PG8_SCHED; PG8_LDA(At, 0, 0); PG8_STAGE_A(PG8_SA(1, 1), 1, kb1, false);
            PG8_WAIT_V(8); PG8_WAIT_L(0); PG8_BAR; PG8_MMA(0, 0, At, B0); PG8_MMA(0, 1, At, B1); PG8_BAR; PG8_SCHED;
            if constexpr (GATHER) { if (last && has_next) { const LAS unsigned short* gi = gidx + (ui + 1) * 256;
                aoC[0][0] = (unsigned)gi[Rr[0]] * rowb + cofs; aoC[0][1] = (unsigned)gi[Rr[1]] * rowb + cofs; aoC[1][0] = (unsigned)gi[128 + Rr[0]] * rowb + cofs; aoC[1][1] = (unsigned)gi[128 + Rr[1]] * rowb + cofs; } }
            PG8_LDA(At, 0, 1); PG8_STAGE(PG8_SB(0, 0), b2); PG8_STAGE(PG8_SB(0, 1), b2 + hstep); PG8_STAGE_A(PG8_SA(0, 0), 0, kb2, last);
            PG8_WAIT_V(8); PG8_WAIT_L(0); PG8_BAR; PG8_MMA(1, 0, At, B0); PG8_MMA(1, 1, At, B1); PG8_BAR; PG8_SCHED;
            PG8_LDB(B0, 1, 0); PG8_LDB(B1, 1, 1); PG8_SCHED; PG8_LDA(At, 1, 0); PG8_STAGE_A(PG8_SA(0, 1), 1, kb2, last);
            PG8_WAIT_V(8); PG8_WAIT_L(0); PG8_BAR; PG8_MMA(0, 0, At, B0); PG8_MMA(0, 1, At, B1); PG8_BAR; PG8_SCHED;
            PG8_LDA(At, 1, 1); PG8_STAGE(PG8_SB(1, 0), b3); PG8_STAGE(PG8_SB(1, 1), b3 + hstep); PG8_STAGE_A(PG8_SA(1, 0), 0, kb3, last);
            PG8_WAIT_V(8); PG8_WAIT_L(0); PG8_BAR; PG8_MMA(1, 0, At, B0); PG8_MMA(1, 1, At, B1); PG8_BAR; PG8_SCHED;
        }
        if (wr == 0) PG8_BAR;
        if (!cur.dup) { int te; asm volatile("v_mbcnt_lo_u32_b32 %0, -1, 0\n\tv_mbcnt_hi_u32_b32 %0, -1, %0" : "=v"(te));
          for (int rep = 0; rep < REP(30); ++rep) E(acc, cur, wr, wc, te & 15, (te & 63) >> 4); }
        if (!has_next) break;
#pragma unroll
        for (int a = 0; a < 2; ++a)
#pragma unroll
            for (int b = 0; b < 2; ++b)
#pragma unroll
                for (int m = 0; m < 4; ++m)
#pragma unroll
                    for (int n = 0; n < 2; ++n) acc[a][b][m][n] = (f32x4){0.f, 0.f, 0.f, 0.f};
        cur = nxt; cA = nA; cB = nB; ++ui;
        if (wr == 1) PG8_BAR;
    }
    PG8_WAIT_V(0);
    PG8_BAR;
#undef PG8_SA
#undef PG8_SB
#undef PG8_STAGE
#undef PG8_DMA
#undef PG8_STAGE_A
#undef PG8_LDA
#undef PG8_LDB
#undef PG8_MMA
#undef PG8_HALF
#undef PG8_WAIT_V
#undef PG8_WAIT_L
#undef PG8_BAR
#undef PG8_SCHED
}

struct SchedIn {
    int G, c, nctx; bool ctx_all; const char* Bt; int rb;
    DI bool next(int i0, Unit& u) const {
        const int i = KDUP_IN ? (i0 >> 1) : i0; u.dup = KDUP_IN ? !(i0 & 1) : 0;
        const long Lx = (long)i * G + c; int pm, pn;
        if (Lx < 896) static_map((int)Lx, 128, 7, pm, pn);
        else { const int j = (int)(Lx - 896); if (j >= nctx) return false; if (ctx_all) { pm = 128 + j / 7; pn = j % 7; } else { pm = 128 + j; pn = 6; } }
        u.pm = pm; u.pn = pn; u.arow = pm * 256; u.boff = (unsigned)(pn * 256 * rb); u.kofs = 0u; u.ks = 0; return true;
    }
    DI int rowidx(int) const { return 0; }
    DI const void* wbase() const { return Bt; }
};
struct SchedPlain {
    int G, c, nM, nN; const char* Bt; int rb;
    DI bool next(int i, Unit& u) const {
        u.dup = 0; const long Lx = (long)i * G + c; if (Lx >= (long)nM * nN) return false; int pm, pn; static_map((int)Lx, nM, nN, pm, pn);
        u.pm = pm; u.pn = pn; u.arow = pm * 256; u.boff = (unsigned)(pn * 256 * rb); u.kofs = 0u; u.ks = 0; return true;
    }
    DI int rowidx(int) const { return 0; }
    DI const void* wbase() const { return Bt; }
};
struct SchedGrp {
    int G, c, t0, nM, nN; const char* W; size_t wstride; int rb; const LAS int* tile_e; const int* tokmap; bool gather; bool kdup;
    DI bool next(int i0, Unit& u) const {
        const int i = (KDUP_GRP && kdup) ? (i0 >> 1) : i0; u.dup = (KDUP_GRP && kdup) ? !(i0 & 1) : 0;
        const long Lx = (long)i * G + c; if (Lx >= (long)nM * nN) return false; int pm, pn; static_map((int)Lx, nM, nN, pm, pn);
        const int te = __builtin_amdgcn_readfirstlane(tile_e[t0 + pm]);
        const int e = te >> 24; u.slot0 = te & 0xffffff;
        u.pm = t0 + pm; u.pn = pn; u.arow = gather ? u.slot0 : pm * 256; u.boff = (unsigned)e * (unsigned)wstride + (unsigned)(pn * 256 * rb); u.kofs = 0u; u.ks = 0; return true;
    }
    DI int rowidx(int slot) const { return tokmap[slot]; }
    DI const void* wbase() const { return W; }
};

struct SchedSplit {
    int G, c, nM, nN, S, ntk; const char* Bt; int rb;
    DI bool next(int i, Unit& u) const {
        const long Lx = (long)i * G + c; if (Lx >= (long)nM * nN * S) return false;
        const int ks = (int)(Lx % S), rest = (int)(Lx / S), pn = rest % nN, pm = rest / nN;
        u.pm = pm; u.pn = pn; u.arow = pm * 256; u.boff = (unsigned)(pn * 256 * rb); u.kofs = (unsigned)(ks * ntk * 128); u.ks = ks; u.dup = 0; u.slot0 = 0; return true;
    }
    DI int rowidx(int) const { return 0; }
    DI const void* wbase() const { return Bt; }
};
#ifndef EPI_NT
#define EPI_NT 0
#endif
#if EPI_NT
#define EPI_ST(p, v) __builtin_nontemporal_store((v), (p))
#else
#define EPI_ST(p, v) (*(p) = (v))
#endif
typedef f32x4 Acc[2][2][4][2];
DI u32x4 tr4(u32x4 w, int te) { const int src = (((te & 3) << 4) | (te >> 2)) << 2; u32x4 r;
    r.x = (unsigned)__builtin_amdgcn_ds_bpermute(src, (int)w.x); r.y = (unsigned)__builtin_amdgcn_ds_bpermute(src, (int)w.y); r.z = (unsigned)__builtin_amdgcn_ds_bpermute(src, (int)w.z); r.w = (unsigned)__builtin_amdgcn_ds_bpermute(src, (int)w.w); return r; }
struct EpiZ {
    bf16_t* Z; const LAS float* rc; const LAS float* rs;
    DI void operator()(const Acc& acc, const Unit& u, int wr, int wc, int fr, int fq) const {
        const int pn = u.pn, row0 = u.pm * 256 + wr * 64 + fr, te = fq * 16 + fr;
        const bool lat = u.pm < 128;
        bf16_t* rowp0 = Z + (size_t)(u.pm * 256 + wr * 64 + (te >> 2)) * NZ + pn * 256 + wc * 32 + 8 * (te & 3);
#pragma unroll
        for (int ai = 0; ai < 2; ++ai)
#pragma unroll
            for (int m = 0; m < 4; ++m) {
                const int row = row0 + ai * 128 + m * 16; bf16_t* rowp = rowp0 + (size_t)(ai * 128 + m * 16) * NZ;
#pragma unroll
                for (int bj = 0; bj < 2; ++bj) {
                    f32x4 v0 = acc[ai][bj][m][0], v1 = acc[ai][bj][m][1];
                    if (pn < 2) {
#pragma unroll
                        for (int j = 0; j < 4; ++j) { v0[j] = gelu_tanh(v0[j]); v1[j] = gelu_tanh(v1[j]); }
                    } else if (pn >= 4 && !(pn == 6 && bj == 1)) {
                        if (lat) {
                            const int n = row & (NLAT - 1); const int pos = (wc & 1) ? (n & 63) : (n >> 6); const int fb = 8 * (fq & 1);
                            const f32x4 c0 = *(const LAS f32x4*)(rc + pos * 16 + fb), c1 = *(const LAS f32x4*)(rc + pos * 16 + fb + 4);
                            const f32x4 s0 = *(const LAS f32x4*)(rs + pos * 16 + fb), s1 = *(const LAS f32x4*)(rs + pos * 16 + fb + 4);
                            const float sg = (fq >> 1) ? 1.f : -1.f;
                            f32x4 p0, p1;
#pragma unroll
                            for (int j = 0; j < 4; ++j) { p0[j] = shx(v0[j], 32, fq * 16 + fr); p1[j] = shx(v1[j], 32, fq * 16 + fr); }
                            v0 = v0 * c0 + sg * p0 * s0; v1 = v1 * c1 + sg * p1 * s1;
                        }
                        if (pn < 6) { v0 = v0 * QSCALE; v1 = v1 * QSCALE; }
                    }
                    u32x4 w; w.x = cvt_pk_bf16(v0[0], v0[1]); w.y = cvt_pk_bf16(v0[2], v0[3]); w.z = cvt_pk_bf16(v1[0], v1[1]); w.w = cvt_pk_bf16(v1[2], v1[3]);
                    EPI_ST((u32x4*)(rowp + bj * 128), tr4(w, te));
                }
            }
    }
};
struct EpiO {
    bf16_t* O; int ldc;
    DI void operator()(const Acc& acc, const Unit& u, int wr, int wc, int fr, int fq) const {
        const int te = fq * 16 + fr, row0 = u.pm * 256 + wr * 64 + (te >> 2), colb = u.pn * 256 + wc * 32 + 8 * (te & 3);
#pragma unroll
        for (int ai = 0; ai < 2; ++ai)
#pragma unroll
            for (int m = 0; m < 4; ++m) { bf16_t* rowp = O + (size_t)(row0 + ai * 128 + m * 16) * ldc + colb;
#pragma unroll
                for (int bj = 0; bj < 2; ++bj) { const f32x4 v0 = acc[ai][bj][m][0], v1 = acc[ai][bj][m][1];
                    u32x4 w; w.x = cvt_pk_bf16(v0[0], v0[1]); w.y = cvt_pk_bf16(v0[2], v0[3]); w.z = cvt_pk_bf16(v1[0], v1[1]); w.w = cvt_pk_bf16(v1[2], v1[3]);
                    EPI_ST((u32x4*)(rowp + bj * 128), tr4(w, te)); } }
    }
};
DI f32x2 swiglu2(f32x2 g, f32x2 u, float c1, float c0, float k0) {
    const f32x2 t = g * c1 + c0; f32x2 e; e.x = fexp2(t.x); e.y = fexp2(t.y);
    const f32x2 d = e + k0; f32x2 r; r.x = frcp(d.x); r.y = frcp(d.y);
    return (g * u) * r;
}
DI f32x2 swiglu2d(f32x2 g, f32x2 u) {
    f32x2 e; e.x = fexp2(-g.x); e.y = fexp2(-g.y);
    const f32x2 d = e * LOG2E + LOG2E; f32x2 r; r.x = frcp(d.x); r.y = frcp(d.y);
    return (g * u) * r;
}
struct EpiGU {
    bf16_t* ACT; int t0;
    DI void operator()(const Acc& acc, const Unit& u, int wr, int wc, int fr, int fq) const {
        const int row0 = (u.pm - t0) * 256 + wr * 64 + fr, colb = u.pn * 128 + wc * 32 + 8 * fq;
#pragma unroll
        for (int ai = 0; ai < 2; ++ai)
#pragma unroll
            for (int m = 0; m < 4; ++m) { bf16_t* rowp = ACT + (size_t)(row0 + ai * 128 + m * 16) * DFF + colb;
                const f32x4 g0 = acc[ai][0][m][0], g1 = acc[ai][0][m][1], u0 = acc[ai][1][m][0], u1 = acc[ai][1][m][1];
                const f32x2 a = swiglu2d((f32x2){g0[0], g0[1]}, (f32x2){u0[0], u0[1]}), b = swiglu2d((f32x2){g0[2], g0[3]}, (f32x2){u0[2], u0[3]});
                const f32x2 c = swiglu2d((f32x2){g1[0], g1[1]}, (f32x2){u1[0], u1[1]}), d = swiglu2d((f32x2){g1[2], g1[3]}, (f32x2){u1[2], u1[3]});
                u32x4 w; w.x = cvt_pk_bf16(a.x, a.y); w.y = cvt_pk_bf16(b.x, b.y); w.z = cvt_pk_bf16(c.x, c.y); w.w = cvt_pk_bf16(d.x, d.y);
                EPI_ST((u32x4*)rowp, w); }
    }
};
struct EpiPart {
    float* P; int rows, ldc;
    DI void operator()(const Acc& acc, const Unit& u, int wr, int wc, int fr, int fq) const {
        const int te = fq * 16 + fr, row0 = u.pm * 256 + wr * 64 + (te >> 2), colb = u.pn * 256 + wc * 32 + 8 * (te & 3);
        float* base = P + (size_t)u.ks * rows * ldc;
#pragma unroll
        for (int ai = 0; ai < 2; ++ai)
#pragma unroll
            for (int m = 0; m < 4; ++m) { float* rowp = base + (size_t)(row0 + ai * 128 + m * 16) * ldc + colb;
#pragma unroll
                for (int bj = 0; bj < 2; ++bj) { *(u32x4*)(rowp + bj * 128) = tr4(__builtin_bit_cast(u32x4, acc[ai][bj][m][0]), te); *(u32x4*)(rowp + bj * 128 + 4) = tr4(__builtin_bit_cast(u32x4, acc[ai][bj][m][1]), te); } }
    }
};
struct EpiDown {
    bf16_t* F; const int* dstmap; const float* gate;
    DI void operator()(const Acc& acc, const Unit& u, int wr, int wc, int fr, int fq) const {
        const int te = fq * 16 + fr, slot0 = u.slot0 + wr * 64 + fr, slot0s = u.slot0 + wr * 64 + (te >> 2), colb = u.pn * 256 + wc * 32 + 8 * (te & 3);
        int dstv[2][4]; float gtv[2][4];
#pragma unroll
        for (int ai = 0; ai < 2; ++ai)
#pragma unroll
            for (int m = 0; m < 4; ++m) { dstv[ai][m] = dstmap[slot0s + ai * 128 + m * 16]; gtv[ai][m] = gate[slot0 + ai * 128 + m * 16]; }
#pragma unroll
        for (int ai = 0; ai < 2; ++ai)
#pragma unroll
            for (int m = 0; m < 4; ++m) { const int dst = dstv[ai][m]; const float gt = gtv[ai][m];
                bf16_t* rowp = F + (size_t)dst * DM + colb;
#pragma unroll
                for (int bj = 0; bj < 2; ++bj) { const f32x4 v0 = acc[ai][bj][m][0] * gt, v1 = acc[ai][bj][m][1] * gt;
                    u32x4 w; w.x = cvt_pk_bf16(v0[0], v0[1]); w.y = cvt_pk_bf16(v0[2], v0[3]); w.z = cvt_pk_bf16(v1[0], v1[1]); w.w = cvt_pk_bf16(v1[2], v1[3]);
                    const u32x4 wt = tr4(w, te);
                    if (dst >= 0) EPI_ST((u32x4*)(rowp + bj * 128), wt); } }
    }
};

constexpr float S8_Y = 16.0f, S8_W = 256.0f, S8_ACT = 8.0f, S8_F = 16.0f;
DI float clamp8(float v) { return __builtin_amdgcn_fmed3f(v, -448.0f, 448.0f); }
DI unsigned pk_fp8x4(float a, float b, float c, float d) { int w0; asm volatile("" : "=v"(w0));
    int w = __builtin_amdgcn_cvt_pk_fp8_f32(clamp8(a), clamp8(b), w0, false); w = __builtin_amdgcn_cvt_pk_fp8_f32(clamp8(c), clamp8(d), w, true); return (unsigned)w; }
struct EpiGU8 {
    unsigned char* ACT; int t0;
    DI void operator()(const Acc& acc, const Unit& u, int wr, int wc, int fr, int fq) const {
        constexpr float us = 1.0f / (S8_Y * S8_W), c1 = -us * LOG2E, c0 = 21.0f, k0 = 2097152.0f;
        static_assert(us * us * S8_ACT * k0 == 1.0f, "k0 = 1 / c2, c0 = log2 k0");
        const int te = fq * 16 + fr, rho = te >> 1, hf = te & 1, srcl = (((2 * hf + (rho >> 4)) << 4) | (rho & 15)) << 2;
        unsigned char* base = ACT + (size_t)((u.pm - t0) * 256 + wr * 64 + rho) * DFF + u.pn * 128 + wc * 32 + 16 * hf;
#pragma unroll
        for (int ai = 0; ai < 2; ++ai)
#pragma unroll
            for (int mp = 0; mp < 4; mp += 2) { u32x2 w[2];
#pragma unroll
                for (int k = 0; k < 2; ++k) { const int m = mp + k;
                    const f32x4 g0 = acc[ai][0][m][0], g1 = acc[ai][0][m][1], u0 = acc[ai][1][m][0], u1 = acc[ai][1][m][1];
                    const f32x2 a = swiglu2((f32x2){g0[0], g0[1]}, (f32x2){u0[0], u0[1]}, c1, c0, k0), b = swiglu2((f32x2){g0[2], g0[3]}, (f32x2){u0[2], u0[3]}, c1, c0, k0);
                    const f32x2 c = swiglu2((f32x2){g1[0], g1[1]}, (f32x2){u1[0], u1[1]}, c1, c0, k0), d = swiglu2((f32x2){g1[2], g1[3]}, (f32x2){u1[2], u1[3]}, c1, c0, k0);
                    w[k].x = pk_fp8x4(a.x, a.y, b.x, b.y); w[k].y = pk_fp8x4(c.x, c.y, d.x, d.y); }
                const auto rx = __builtin_amdgcn_permlane16_swap(w[0].x, w[1].x, false, false), ry = __builtin_amdgcn_permlane16_swap(w[0].y, w[1].y, false, false);
                u32x4 o; o.x = (unsigned)__builtin_amdgcn_ds_bpermute(srcl, (int)rx[0]); o.y = (unsigned)__builtin_amdgcn_ds_bpermute(srcl, (int)ry[0]); o.z = (unsigned)__builtin_amdgcn_ds_bpermute(srcl, (int)rx[1]); o.w = (unsigned)__builtin_amdgcn_ds_bpermute(srcl, (int)ry[1]);
                EPI_ST((u32x4*)(base + (size_t)(ai * 128 + mp * 16) * DFF), o); }
    }
};
struct EpiGUm {
    bf16_t* ACT; int t0;
    DI void operator()(const Acc& acc, const Unit& u, int wr, int wc, int fr, int fq) const {
        const int te = fq * 16 + fr, row0 = (u.pm - t0) * 256 + wr * 64 + (te >> 2), colb = u.pn * 128 + wc * 32 + 8 * (te & 3);
        constexpr float us = 1.0f / (S8_Y * S8_W), c1 = -us * LOG2E, c0 = 24.0f, k0 = 16777216.0f;
        static_assert(us * us * k0 == 1.0f, "k0 = 1 / us^2, c0 = log2 k0");
#pragma unroll
        for (int ai = 0; ai < 2; ++ai)
#pragma unroll
            for (int m = 0; m < 4; ++m) { bf16_t* rowp = ACT + (size_t)(row0 + ai * 128 + m * 16) * DFF + colb;
                const f32x4 g0 = acc[ai][0][m][0], g1 = acc[ai][0][m][1], u0 = acc[ai][1][m][0], u1 = acc[ai][1][m][1];
                const f32x2 a = swiglu2((f32x2){g0[0], g0[1]}, (f32x2){u0[0], u0[1]}, c1, c0, k0), b = swiglu2((f32x2){g0[2], g0[3]}, (f32x2){u0[2], u0[3]}, c1, c0, k0);
                const f32x2 c = swiglu2((f32x2){g1[0], g1[1]}, (f32x2){u1[0], u1[1]}, c1, c0, k0), d = swiglu2((f32x2){g1[2], g1[3]}, (f32x2){u1[2], u1[3]}, c1, c0, k0);
                u32x4 w; w.x = cvt_pk_bf16(a.x, a.y); w.y = cvt_pk_bf16(b.x, b.y); w.z = cvt_pk_bf16(c.x, c.y); w.w = cvt_pk_bf16(d.x, d.y);
                EPI_ST((u32x4*)rowp, tr4(w, te)); }
    }
};
struct EpiDown8 {
    bf16_t* F; const int* dstmap; const float* gate;
    DI void operator()(const Acc& acc, const Unit& u, int wr, int wc, int fr, int fq) const {
        static_assert(!FP8_DDN, "the dense layer's norm_end reads bf16 F rows");
        const int te = fq * 16 + fr, slot0 = u.slot0 + wr * 64 + fr, slot0s = u.slot0 + wr * 64 + (te >> 2), colb = u.pn * 256 + wc * 32 + 8 * (te & 3);
        constexpr float us = S8_F / (S8_ACT * S8_W);
        const int trs = (((te & 3) << 4) | (te >> 2)) << 2;
        int dstv[2][4]; float gtv[2][4];
#pragma unroll
        for (int ai = 0; ai < 2; ++ai)
#pragma unroll
            for (int m = 0; m < 4; ++m) { dstv[ai][m] = dstmap[slot0s + ai * 128 + m * 16]; gtv[ai][m] = gate[slot0 + ai * 128 + m * 16] * us; }
#pragma unroll
        for (int ai = 0; ai < 2; ++ai)
#pragma unroll
            for (int m = 0; m < 4; ++m) { const int dst = dstv[ai][m]; const float gt = gtv[ai][m];
                unsigned char* rowp = (unsigned char*)F + (size_t)dst * DM + colb;
#pragma unroll
                for (int bj = 0; bj < 2; ++bj) { const f32x4 v0 = acc[ai][bj][m][0] * gt, v1 = acc[ai][bj][m][1] * gt;
                    u32x2 w; w.x = (unsigned)__builtin_amdgcn_ds_bpermute(trs, (int)pk_fp8x4(v0[0], v0[1], v0[2], v0[3])); w.y = (unsigned)__builtin_amdgcn_ds_bpermute(trs, (int)pk_fp8x4(v1[0], v1[1], v1[2], v1[3]));
                    if (dst >= 0) *(u32x2*)(rowp + bj * 128) = w; } }
    }
};
}

struct Args { const float* in[25]; float* out; unsigned char* ws; int ph_lo, ph_hi; };
enum { I_X = 0, I_C, I_CTX, I_CCTX, I_WADA, I_BADA, I_GMPRE, I_GMPOST, I_GFPRE, I_GFPOST, I_WIN, I_WS, I_BS, I_GV, I_WF, I_SINK, I_WOUT, I_WGD, I_WUD, I_WDD, I_WR, I_BR, I_WGE, I_WUE, I_WDE };

struct TJob { const float* src; bf16* dst; int K, Nsrc, ncol0, drow0, kb, f8; float sc; };
constexpr int TJ_IN_A = 256, TJ_IN_B = 384, TJ_OUT = 512, TJ_D = 896, TJ_E = 7168;
constexpr int TJ_TOTAL = TJ_IN_A + TJ_IN_B + TJ_OUT + 3 * TJ_D + 3 * TJ_E;
constexpr int TJ_NOW = TJ_IN_A + TJ_IN_B + TJ_OUT + 3 * TJ_D;
constexpr int TJ_DEF = TJ_TOTAL - TJ_NOW, TJ_BATCH = 16;
static_assert(TJ_DEF % TJ_BATCH == 0, "deferred queue is dealt in whole batches");
DI TJob tj_decode(const Args& a, bf16* WB, int it) {
    TJob J; J.f8 = 0; J.sc = 1.0f;
    if (it < TJ_IN_A) { const int L = it / 128, r = it % 128; J.kb = r / 8; const int nb = r % 8;
        J.src = a.in[I_WIN] + (size_t)L * 1024 * 1536; J.K = 1024; J.Nsrc = 1536; J.ncol0 = 64 * nb; J.dst = WB + W_IN / 2 + (size_t)L * NZ * 1024; J.drow0 = 64 * nb; return J; }
    it -= TJ_IN_A;
    if (it < TJ_IN_B) { const int L = it / 192, r = it % 192; J.kb = r / 12; const int nb = r % 12;
        J.src = a.in[I_WIN] + (size_t)L * 1024 * 1536; J.K = 1024; J.Nsrc = 1536; J.ncol0 = 768 + 64 * nb; J.dst = WB + W_IN / 2 + (size_t)L * NZ * 1024; J.drow0 = 1024 + 64 * nb; return J; }
    it -= TJ_IN_B;
    if (it < TJ_OUT) { const int L = it / 256, r = it % 256; J.kb = r / 16; const int nb = r % 16;
        J.src = a.in[I_WOUT] + (size_t)L * 1024 * 1024; J.K = 1024; J.Nsrc = 1024; J.ncol0 = 64 * nb; J.dst = WB + W_OUT / 2 + (size_t)L * 1024 * 1024; J.drow0 = 64 * nb; return J; }
    it -= TJ_OUT;
    if (it < 2 * TJ_D) { const int up = it / TJ_D, r = it % TJ_D; J.kb = r / 56; const int nb = r % 56, f0 = 64 * nb;
        J.src = a.in[up ? I_WUD : I_WGD]; J.K = 1024; J.Nsrc = DFF; J.ncol0 = f0; J.dst = WB + W_GUD / 2; J.drow0 = (f0 / 128) * 256 + (f0 % 128) + 128 * up; J.sc = FP8_DGU ? pg8::S8_W : (up ? 1.0f : LOG2E); J.f8 = FP8_DGU; return J; }
    it -= 2 * TJ_D;
    if (it < TJ_D) { J.kb = it / 16; const int nb = it % 16;
        J.src = a.in[I_WDD]; J.K = DFF; J.Nsrc = 1024; J.ncol0 = 64 * nb; J.dst = WB + W_DD / 2; J.drow0 = 64 * nb; if (FP8_DDN) { J.f8 = 1; J.sc = pg8::S8_W; } return J; }
    it -= TJ_D;
    if (it < 2 * TJ_E) { const int up = it / TJ_E, r0 = it % TJ_E, e = r0 / TJ_D, r = r0 % TJ_D; J.kb = r / 56; const int nb = r % 56, f0 = 64 * nb;
        J.src = a.in[up ? I_WUE : I_WGE] + (size_t)e * 1024 * DFF; J.K = 1024; J.Nsrc = DFF; J.ncol0 = f0; J.dst = (bf16*)((unsigned char*)WB + W_GUE + (size_t)e * 7168 * 1024); J.drow0 = (f0 / 128) * 256 + (f0 % 128) + 128 * up; J.f8 = 1; J.sc = pg8::S8_W; return J; }
    it -= 2 * TJ_E;
    { const int e = it / TJ_D, r = it % TJ_D; J.kb = r / 16; const int nb = r % 16;
        J.src = a.in[I_WDE] + (size_t)e * DFF * 1024; J.K = DFF; J.Nsrc = 1024; J.ncol0 = 64 * nb; J.dst = (bf16*)((unsigned char*)WB + W_DE + (size_t)e * 1024 * DFF); J.drow0 = 64 * nb; J.f8 = 1; J.sc = pg8::S8_W; return J; }
}
DI void tj_load(const TJob& J, int lane, f32x4 (&v)[16]) {
    const float* p = J.src + (size_t)(64 * J.kb + (lane >> 4)) * J.Nsrc + J.ncol0 + 4 * (lane & 15);
#pragma unroll
    for (int i = 0; i < 16; ++i) v[i] = *(const f32x4*)(p + (size_t)(4 * i) * J.Nsrc);
}
DI void tj_store(const TJob& J, LAS float* scr, int lane, const f32x4 (&v)[16]) {
#pragma unroll
    for (int i = 0; i < 16; ++i) { const int k = 4 * i + (lane >> 4); *(LAS f32x4*)(scr + k * 64 + ((4 * (lane & 15)) ^ (4 * ((k >> 3) & 7)))) = v[i]; }
    LDS_WAIT();
    const int c = lane & 7, k0 = 64 * J.kb;
#pragma unroll
    for (int j = 0; j < 8; ++j) { const int n = (lane >> 3) + 8 * j; const LAS float* s = scr + (8 * c) * 64 + (((n & ~3) ^ (4 * c)) + (n & 3));
        const float x0 = s[0 * 64], x1 = s[1 * 64], x2 = s[2 * 64], x3 = s[3 * 64], x4 = s[4 * 64], x5 = s[5 * 64], x6 = s[6 * 64], x7 = s[7 * 64];
        const float sw = J.sc;
        if (J.f8) { u32x2 o; o.x = pg8::pk_fp8x4(x0 * sw, x1 * sw, x2 * sw, x3 * sw); o.y = pg8::pk_fp8x4(x4 * sw, x5 * sw, x6 * sw, x7 * sw);
            *(u32x2*)((unsigned char*)J.dst + (size_t)(J.drow0 + n) * J.K + k0 + 8 * c) = o; }
        else { u32x4 o; o.x = cvt_pk_bf16(x0 * sw, x1 * sw); o.y = cvt_pk_bf16(x2 * sw, x3 * sw); o.z = cvt_pk_bf16(x4 * sw, x5 * sw); o.w = cvt_pk_bf16(x6 * sw, x7 * sw);
            *(u32x4*)(J.dst + (size_t)(J.drow0 + n) * J.K + k0 + 8 * c) = o; } }
    LDS_WAIT();
}

DI void prologue_a(const Args& a, unsigned char* ws, LAS unsigned char* lds, int tid, int wave, int lane) {
    const int G = gridDim.x, bx = blockIdx.x;
    {
        const int gw = bx * NWAVES + wave, NGW = G * NWAVES;
        float* mp = (float*)(ws + WS_MOD);
        for (int it = gw; it < 2 * 96 * 8; it += NGW) {
            const int ks = it & 7, jg = (it >> 3) % 96, L = it / 768, j0 = 64 * jg;
            float sil[5][2];
#pragma unroll
            for (int s = 0; s < 5; ++s)
#pragma unroll
                for (int hf = 0; hf < 2; ++hf) { const int k = 128 * ks + 64 * hf + lane; sil[s][hf] = silu_f(s < 4 ? a.in[I_C][s * 1024 + k] : a.in[I_CCTX][k]); }
            float acc[5] = {0.f, 0.f, 0.f, 0.f, 0.f};
            const float* wp = a.in[I_WADA] + (size_t)L * 1024 * 6144 + (size_t)(128 * ks) * 6144 + j0 + lane;
#pragma unroll
            for (int hf = 0; hf < 2; ++hf)
#pragma unroll 16
                for (int kk = 0; kk < 64; ++kk) { const float w = wp[(size_t)(64 * hf + kk) * 6144];
#pragma unroll
                    for (int s = 0; s < 5; ++s) acc[s] += __builtin_bit_cast(float, __builtin_amdgcn_readlane(__builtin_bit_cast(int, sil[s][hf]), kk)) * w; }
#pragma unroll
            for (int s = 0; s < 5; ++s) mp[((size_t)(L * 8 + ks) * 5 + s) * 6144 + j0 + lane] = acc[s];
        }
    }
    for (int it = bx; it < 256; it += G) {
        const int L = it >> 7, g = (it >> 5) & 3, kblk = it & 31;
        LAS float* Mt = (LAS float*)lds; LAS float* Wl = (LAS float*)(lds + 32768);
        __syncthreads();
        const float* wf = a.in[I_WF] + (size_t)(L * 4 + g) * 4096;
        LAS float* trg = (LAS float*)(lds + 49152); LAS float* wfl = (LAS float*)(lds + 49152 + 512);
        if (tid < 128) { const float fr = (float)(tid & 63) * (1.0f / 64.0f); trg[tid] = tid < 64 ? __builtin_amdgcn_cosf(fr) : __builtin_amdgcn_sinf(fr); }
        { float t8[8];
#pragma unroll
          for (int k = 0; k < 8; ++k) t8[k] = wf[tid + k * NTHR];
#pragma unroll
          for (int k = 0; k < 8; ++k) wfl[tid + k * NTHR] = t8[k]; }
        const float* wi = a.in[I_WIN] + (size_t)L * 1024 * 1536;
        { float t4[4];
#pragma unroll
          for (int k = 0; k < 4; ++k) { const int idx = tid + k * NTHR, kl = idx >> 6, d = idx & 63; t4[k] = wi[(size_t)(32 * kblk + kl) * 1536 + 512 + 64 * g + d]; }
#pragma unroll
          for (int k = 0; k < 4; ++k) { const int idx = tid + k * NTHR, kl = idx >> 6, d = idx & 63; Wl[kl * 65 + d] = t4[k]; } }
        __syncthreads();
        { const int rg = tid >> 4, cg = tid & 15, pq = rg >> 4, d0 = 4 * (rg & 15);
          f32x4 acc4[4];
#pragma unroll
          for (int i = 0; i < 4; ++i) acc4[i] = (f32x4){0.f, 0.f, 0.f, 0.f};
#pragma unroll 4
          for (int e = 0; e < 64; ++e) { const f32x4 w4 = *(const LAS f32x4*)(wfl + e * 64 + 4 * cg);
#pragma unroll
              for (int i = 0; i < 4; ++i) { const float tv = trg[64 * pq + (((d0 + i) * e) & 63)]; acc4[i] = acc4[i] + w4 * tv; } }
#pragma unroll
          for (int i = 0; i < 4; ++i) *(LAS f32x4*)(Mt + (pq * 64 + d0 + i) * 64 + 4 * cg) = acc4[i]; }
        __syncthreads();
        { const int klp = tid & 15, cgrp = tid >> 4, pq = cgrp >> 4, e20 = 4 * (cgrp & 15);
          bf16* WIN = (bf16*)(ws + WS_W + W_IN) + (size_t)L * NZ * 1024;
          f32x4 s0 = (f32x4){0.f, 0.f, 0.f, 0.f}, s1 = (f32x4){0.f, 0.f, 0.f, 0.f};
#pragma unroll 8
          for (int d = 0; d < 64; ++d) { const f32x4 m4 = *(const LAS f32x4*)(Mt + (pq * 64 + d) * 64 + e20); const float w0 = Wl[(2 * klp) * 65 + d], w1 = Wl[(2 * klp + 1) * 65 + d];
              s0 = s0 + m4 * w0; s1 = s1 + m4 * w1; }
#pragma unroll
          for (int i = 0; i < 4; ++i) *(unsigned*)(WIN + (size_t)(512 + 256 * pq + 64 * g + e20 + i) * 1024 + 32 * kblk + 2 * klp) = cvt_pk_bf16(s0[i], s1[i]); }
    }
    __syncthreads();
    {
        const int gt = bx * NTHR + tid, GT = G * NTHR;
        bf16* G1 = (bf16*)(ws + WS_TAB + T_G1); bf16* G3 = (bf16*)(ws + WS_TAB + T_G3); bf16* GC = (bf16*)(ws + WS_TAB + T_GC); bf16* WSB = (bf16*)(ws + WS_TAB + T_WS);
        float* RC = (float*)(ws + WS_TAB + T_ROPE); float* RS = RC + 2048;
        for (int idx = gt; idx < 128 * 128; idx += GT) { const int m = idx >> 7, kk = idx & 127; const int w = m >> 4, x = m & 15, k1 = 8 * w + 2 * (x >> 2) + ((x & 3) >> 1), ri = x & 1, pq = kk >> 6, n1 = kk & 63;
            const float fr = (float)((k1 * n1) & 63) * (1.0f / 64.0f), c = __builtin_amdgcn_cosf(fr), s = __builtin_amdgcn_sinf(fr);
            G1[idx] = f2bf(ri == 0 ? (pq == 0 ? c : -s) : (pq == 0 ? s : c)); }
        for (int idx = gt; idx < 128 * 256; idx += GT) { const int k2 = idx >> 8, kk = idx & 255, ri = kk >> 7, n2 = kk & 127; const float fr = (float)((k2 * n2) & 127) * (1.0f / 128.0f);
            G3[idx] = f2bf(ri == 0 ? __builtin_amdgcn_cosf(fr) : __builtin_amdgcn_sinf(fr)); }
        for (int idx = gt; idx < 256 * 512; idx += GT) { const int k = idx >> 9, kk = idx & 511, pq = kk >> 8, n = kk & 255; const float fr = (float)((k * n) & 255) * (1.0f / 256.0f);
            GC[idx] = f2bf(pq == 0 ? __builtin_amdgcn_cosf(fr) : -__builtin_amdgcn_sinf(fr)); }
        for (int idx = gt; idx < 2 * 4 * 128 * 128; idx += GT) WSB[idx] = f2bf(a.in[I_WS][idx]);
        { int* t0 = (int*)(ws + WS_RT + RT_TOK); int* d0 = (int*)(ws + WS_RT + RT_DST); float* g0 = (float*)(ws + WS_RT + RT_GATE);
          for (int idx = gt; idx < MALL; idx += GT) { t0[idx] = idx; d0[idx] = idx; g0[idx] = 1.0f; }
          int* t1 = (int*)(ws + WS_RT1 + RT1_TOK); int* d1 = (int*)(ws + WS_RT1 + RT1_DST); float* g1 = (float*)(ws + WS_RT1 + RT1_GATE);
          for (int idx = gt; idx < NE * CAP; idx += GT) { t1[idx] = 0; d1[idx] = -1; g1[idx] = 0.f; } }
        for (int idx = gt; idx < 2048; idx += GT) { const int pos = idx >> 4, f = idx & 15; const float inv = powf(10000.0f, -(float)f / 16.0f); const float ang = (float)pos * inv; RC[idx] = cosf(ang); RS[idx] = sinf(ang); }
    }
    {
        LAS float* scr = (LAS float*)(lds + wave * 16384);
        bf16* WB = (bf16*)(ws + WS_W);
        const int gw = bx * NWAVES + wave, NGW = G * NWAVES;
        f32x4 va[16], vb[16]; TJob Ja, Jb;
        int ia = gw;
        if (ia < TJ_NOW) { Ja = tj_decode(a, WB, ia); tj_load(Ja, lane, va); }
        for (;;) {
            if (ia >= TJ_NOW) break;
            const int ib = ia + NGW;
            if (ib < TJ_NOW) { Jb = tj_decode(a, WB, ib); tj_load(Jb, lane, vb); }
            tj_store(Ja, scr, lane, va);
            if (ib >= TJ_NOW) break;
            ia = ib + NGW;
            if (ia < TJ_NOW) { Ja = tj_decode(a, WB, ia); tj_load(Ja, lane, va); }
            tj_store(Jb, scr, lane, vb);
        }
    }
}

DI void cvt_filler(const Args& a, unsigned char* ws, LAS unsigned char* lds, int tid, int wave, int lane, int* done, int need) {
    LAS int* sh = (LAS int*)(lds + LDSCTL_OFF + LC_FILL);
    int* cur = (int*)(ws + WS_CTL) + CW_CVT;
    LAS float* scr = (LAS float*)(lds + wave * 16384);
    bf16* WB = (bf16*)(ws + WS_W);
    __syncthreads();
    if (done) {
#define CF_FETCH(slot_, out_) do { if (tid == 0) { int b_ = -1; \
            if (__hip_atomic_load(done, __ATOMIC_RELAXED, __HIP_MEMORY_SCOPE_AGENT) < need) { b_ = __hip_atomic_fetch_add(cur, TJ_BATCH / 2, __ATOMIC_RELAXED, __HIP_MEMORY_SCOPE_AGENT); if (b_ >= TJ_DEF) b_ = -1; } \
            sh[slot_] = b_; } __syncthreads(); out_ = __builtin_amdgcn_readfirstlane(sh[slot_]); } while (0)
        f32x4 va[16], vb[16]; TJob Ja, Jb; int bc, bn;
        CF_FETCH(0, bc);
        if (bc >= 0 && bc + wave < TJ_DEF) { Ja = tj_decode(a, WB, TJ_NOW + bc + wave); tj_load(Ja, lane, va); }
        while (bc >= 0) {
            CF_FETCH(1, bn);
            if (bn >= 0 && bn + wave < TJ_DEF) { Jb = tj_decode(a, WB, TJ_NOW + bn + wave); tj_load(Jb, lane, vb); }
            if (bc + wave < TJ_DEF) tj_store(Ja, scr, lane, va);
            if (bn < 0) break;
            CF_FETCH(0, bc);
            if (bc >= 0 && bc + wave < TJ_DEF) { Ja = tj_decode(a, WB, TJ_NOW + bc + wave); tj_load(Ja, lane, va); }
            if (bn + wave < TJ_DEF) tj_store(Jb, scr, lane, vb);
        }
#undef CF_FETCH
        __syncthreads();
        return;
    }
    for (int it = 0;; ++it) {
        if (tid == 0) { int b = -1;
            const bool stop = done && __hip_atomic_load(done, __ATOMIC_RELAXED, __HIP_MEMORY_SCOPE_AGENT) >= need;
            if (!stop) { b = __hip_atomic_fetch_add(cur, done ? TJ_BATCH / 2 : TJ_BATCH, __ATOMIC_RELAXED, __HIP_MEMORY_SCOPE_AGENT); if (b >= TJ_DEF) b = -1; }
            sh[it & 1] = b; }
        __syncthreads();
        const int b = __builtin_amdgcn_readfirstlane(sh[it & 1]);
        if (b < 0) break;
        f32x4 va[16], vb[16];
        const int ia = b + (done ? wave : 2 * wave), ib = done ? TJ_DEF : ia + 1;
        if (ia < TJ_DEF) { const TJob Ja = tj_decode(a, WB, TJ_NOW + ia); tj_load(Ja, lane, va);
            if (ib < TJ_DEF) { const TJob Jb = tj_decode(a, WB, TJ_NOW + ib); tj_load(Jb, lane, vb); tj_store(Ja, scr, lane, va); tj_store(Jb, scr, lane, vb); }
            else tj_store(Ja, scr, lane, va); }
    }
    __syncthreads();
}

DI void ld_row_f32(const float* row, int lane, f32x4 (&v)[4]) { const f32x4* p = (const f32x4*)row + lane;
#pragma unroll
    for (int j = 0; j < 4; ++j) v[j] = p[64 * j]; }
DI void st_row_f32(float* row, int lane, const f32x4 (&v)[4]) { f32x4* p = (f32x4*)row + lane;
#pragma unroll
    for (int j = 0; j < 4; ++j) p[64 * j] = v[j]; }
DI void ld_row_bf16(const bf16* row, int lane, f32x4 (&v)[4]) { const u32x2* p = (const u32x2*)row + lane;
#pragma unroll
    for (int j = 0; j < 4; ++j) { const u32x2 w = p[64 * j]; v[j] = (f32x4){bflo(w.x), bfhi(w.x), bflo(w.y), bfhi(w.y)}; } }
DI void st_row_bf16(bf16* row, int lane, const f32x4 (&v)[4]) { u32x2* p = (u32x2*)row + lane;
#pragma unroll
    for (int j = 0; j < 4; ++j) { u32x2 w; w.x = cvt_pk_bf16(v[j][0], v[j][1]); w.y = cvt_pk_bf16(v[j][2], v[j][3]); p[64 * j] = w; } }
DI float row_rstd(const f32x4 (&v)[4], int lane) { float s = 0.f;
#pragma unroll
    for (int j = 0; j < 4; ++j) s += (v[j][0] * v[j][0] + v[j][1] * v[j][1]) + (v[j][2] * v[j][2] + v[j][3] * v[j][3]);
    return 1.0f / sqrtf(wave_sum(s, lane) * (1.0f / 1024.0f) + EPS); }
DI void modulate_row(const f32x4 (&h)[4], float rstd, const float* g, const float* sh, const float* sc, int lane, f32x4 (&y)[4]) {
#pragma unroll
    for (int j = 0; j < 4; ++j) { const f32x4 gv = ((const f32x4*)g + lane)[64 * j], shv = ((const f32x4*)sh + lane)[64 * j], scv = ((const f32x4*)sc + lane)[64 * j];
        y[j] = h[j] * rstd * gv * (1.0f + scv) + shv; } }
DI int mod_set(int r) { return r < MLAT ? (r >> 13) : 4; }

DI void ldraw_f32(const float* row, int lane, f32x4 (&v)[4]) { const f32x4* p = (const f32x4*)row + lane;
#pragma unroll
    for (int j = 0; j < 4; ++j) v[j] = p[64 * j]; }
DI void ldraw_bf16(const bf16* row, int lane, u32x2 (&v)[4]) { const u32x2* p = (const u32x2*)row + lane;
#pragma unroll
    for (int j = 0; j < 4; ++j) v[j] = p[64 * j]; }
DI void unpack_bf16(const u32x2 (&w)[4], f32x4 (&v)[4]) {
#pragma unroll
    for (int j = 0; j < 4; ++j) v[j] = (f32x4){bflo(w[j].x), bfhi(w[j].x), bflo(w[j].y), bfhi(w[j].y)}; }
DI void ldvec(const float* p, int lane, f32x4 (&v)[4]) { ldraw_f32(p, lane, v); }
DI void ldmod(const Args& a, const unsigned char* ws, int L, int s, int j, int lane, f32x4 (&v)[4]) {
    ldraw_f32(a.in[I_BADA] + L * 6144 + j * 1024, lane, v);
#pragma unroll 1
    for (int ks = 0; ks < 8; ++ks) { f32x4 t[4]; ldraw_f32((const float*)(ws + WS_MOD) + ((size_t)(L * 8 + ks) * 5 + s) * 6144 + j * 1024, lane, t);
#pragma unroll
        for (int q = 0; q < 4; ++q) v[q] = v[q] + t[q]; }
}

DI void norm0_phase(const Args& a, unsigned char* ws, int wave, int lane) {
    constexpr int RPW = MALL / 256; const int bx = blockIdx.x;
    bf16* Y = (bf16*)(ws + WS_Y);
    if (bx >= 256) return;
    f32x4 g[4], sh[4], sc[4], hn[4]; int cs = -1;
    ldvec(a.in[I_GMPRE], lane, g);
    { const int r = bx * RPW + wave; ldraw_f32(r < MLAT ? a.in[I_X] + (size_t)r * DM : a.in[I_CTX] + (size_t)(r - MLAT) * DM, lane, hn); }
    for (int rr = wave; rr < RPW; rr += NWAVES) {
        const int r = bx * RPW + rr, s = mod_set(r);
        f32x4 h[4], y[4];
#pragma unroll
        for (int j = 0; j < 4; ++j) h[j] = hn[j];
        if (rr + NWAVES < RPW) { const int rn = r + NWAVES; ldraw_f32(rn < MLAT ? a.in[I_X] + (size_t)rn * DM : a.in[I_CTX] + (size_t)(rn - MLAT) * DM, lane, hn); }
        if (s != cs) { ldmod(a, ws, 0, s, 0, lane, sh); ldmod(a, ws, 0, s, 1, lane, sc); cs = s; }
        const float rs = row_rstd(h, lane);
#pragma unroll
        for (int j = 0; j < 4; ++j) y[j] = h[j] * rs * g[j] * (1.0f + sc[j]) + sh[j];
        st_row_bf16(Y + (size_t)r * DM, lane, y);
    }
}

DI void norm_mid_phase(const Args& a, unsigned char* ws, LAS unsigned char* lds, int L, int tid, int wave, int lane) {
    const int M = L == 0 ? MALL : MLAT, RPW = M / 256, bx = blockIdx.x;
    const bool moe = (L == 1);
    LAS int* cnt = (LAS int*)(lds + LDSCTL_OFF + LC_CNT);
    __syncthreads();
    if (tid < 8) cnt[tid] = 0;
    LAS float* wrl = (LAS float*)(lds + 4096);
    if (moe) { f32x4 w4[2048 / NTHR];
#pragma unroll
        for (int k = 0; k < 2048 / NTHR; ++k) w4[k] = ((const f32x4*)a.in[I_WR])[tid + k * NTHR];
#pragma unroll
        for (int k = 0; k < 2048 / NTHR; ++k) { const int i = tid + k * NTHR, c = i >> 1, e0 = 4 * (i & 1);
#pragma unroll
            for (int q = 0; q < 4; ++q) wrl[(e0 + q) * 1024 + c] = w4[k][q]; } }
    __syncthreads();
    const bf16* O = (const bf16*)(ws + WS_R + R_O); bf16* Y = (bf16*)(ws + WS_Y);
    bf16* hctx1 = (bf16*)(ws + WS_HCTX); const bf16* h2lat = (const bf16*)a.out + (size_t)MLAT * DM; bf16* h3 = (bf16*)(ws + WS_H3);
    LAS int* rec = (LAS int*)lds;
    if (bx < 256) {
        f32x4 gpost[4], gpre[4], gtm[4], shf[4], scf[4]; u32x4 hr[4], hr2[4]; u32x2 hb[4], hb2[4]; u32x2 on[4], on2[4]; int cs = -1;
        ldvec(a.in[I_GMPOST] + L * DM, lane, gpost); ldvec(a.in[I_GFPRE] + L * DM, lane, gpre);
#define NM_LOAD(rq_, o_, h_, hb_) do { const int rq = (rq_); ldraw_bf16(O + (size_t)rq * DM, lane, o_); \
            if (L == 0) { const u32x4* p_ = (const u32x4*)(rq < MLAT ? a.in[I_X] + (size_t)rq * DM : a.in[I_CTX] + (size_t)(rq - MLAT) * DM) + lane; _Pragma("unroll") for (int j = 0; j < 4; ++j) h_[j] = p_[64 * j]; } \
            else ldraw_bf16(h2lat + (size_t)rq * DM, lane, hb_); } while (0)
#define NM_ROW(rr_) ((L == 0 && SPLITK) ? ((rr_) < 4 ? MLAT + 4 * bx + (rr_) : 128 * bx + ((rr_) - 4)) : bx * RPW + (rr_))
        NM_LOAD(NM_ROW(wave), on, hr, hb);
        if (wave + NWAVES < RPW) NM_LOAD(NM_ROW(wave + NWAVES), on2, hr2, hb2);
        for (int rr = wave; rr < RPW; rr += NWAVES) {
            const int r = NM_ROW(rr), s = mod_set(r);
            bf16* hout = L == 0 ? (r < MLAT ? (bf16*)a.out + (size_t)r * DM : hctx1 + (size_t)(r - MLAT) * DM) : h3 + (size_t)r * DM;
            f32x4 o[4], h[4], y[4]; unpack_bf16(on, o);
#pragma unroll
            for (int j = 0; j < 4; ++j) h[j] = L == 0 ? __builtin_bit_cast(f32x4, hr[j]) : (f32x4){bflo(hb[j].x), bfhi(hb[j].x), bflo(hb[j].y), bfhi(hb[j].y)};
#pragma unroll
            for (int j = 0; j < 4; ++j) { on[j] = on2[j]; hr[j] = hr2[j]; hb[j] = hb2[j]; }
            if (rr + 2 * NWAVES < RPW) NM_LOAD(NM_ROW(rr + 2 * NWAVES), on2, hr2, hb2);
            if (SPLITK && L == 0 && r >= MLAT) {
#pragma unroll
                for (int j = 0; j < 4; ++j) o[j] = (f32x4){0.f, 0.f, 0.f, 0.f};
#pragma unroll 2
                for (int ks = 0; ks < 4; ++ks) { f32x4 t4[4]; ldraw_f32((const float*)(ws + WS_R + R_T) + ((size_t)ks * MCTX + (r - MLAT)) * DM, lane, t4);
#pragma unroll
                    for (int j = 0; j < 4; ++j) o[j] = o[j] + t4[j]; }
            }
            if (s != cs) { ldmod(a, ws, L, s, 2, lane, gtm); ldmod(a, ws, L, s, 3, lane, shf); ldmod(a, ws, L, s, 4, lane, scf); cs = s; }
            const float ro = row_rstd(o, lane);
#pragma unroll
            for (int j = 0; j < 4; ++j) h[j] = h[j] + gtm[j] * (o[j] * ro * gpost[j]);
            st_row_bf16(hout, lane, h);
            const float rh = row_rstd(h, lane);
#pragma unroll
            for (int j = 0; j < 4; ++j) y[j] = h[j] * rh * gpre[j] * (1.0f + scf[j]) + shf[j];
            if (moe || FP8_DGU) { unsigned* y8 = (unsigned*)((unsigned char*)Y + (size_t)r * DM) + lane;
#pragma unroll
                for (int j = 0; j < 4; ++j) y8[64 * j] = pg8::pk_fp8x4(y[j][0] * pg8::S8_Y, y[j][1] * pg8::S8_Y, y[j][2] * pg8::S8_Y, y[j][3] * pg8::S8_Y); }
            else st_row_bf16(Y + (size_t)r * DM, lane, y);
            if (moe) {
                float lg[8];
#pragma unroll
                for (int e = 0; e < 8; ++e) { float acc = 0.f;
#pragma unroll
                    for (int j = 0; j < 4; ++j) { const f32x4 w4 = *(const LAS f32x4*)(wrl + e * 1024 + 4 * lane + 256 * j); acc += (y[j][0] * w4[0] + y[j][1] * w4[1]) + (y[j][2] * w4[2] + y[j][3] * w4[3]); }
                    lg[e] = acc; }
#pragma unroll
                for (int e = 0; e < 8; ++e) lg[e] = wave_sum(lg[e], lane) + a.in[I_BR][e];
                int i0 = 0; float v0 = lg[0];
#pragma unroll
                for (int e = 1; e < 8; ++e) if (lg[e] > v0) { v0 = lg[e]; i0 = e; }
                int i1 = -1; float v1 = -3.0e38f;
#pragma unroll
                for (int e = 0; e < 8; ++e) if (e != i0 && lg[e] > v1) { v1 = lg[e]; i1 = e; }
                const float g0 = 1.0f / (1.0f + expf(v1 - v0)), g1 = 1.0f - g0;
                if (lane == 0) { const int p0 = __hip_atomic_fetch_add(&cnt[i0], 1, __ATOMIC_RELAXED, __HIP_MEMORY_SCOPE_WORKGROUP), p1 = __hip_atomic_fetch_add(&cnt[i1], 1, __ATOMIC_RELAXED, __HIP_MEMORY_SCOPE_WORKGROUP);
                    rec[rr * 4 + 0] = (i0 << 16) | p0; rec[rr * 4 + 1] = __float_as_int(g0); rec[rr * 4 + 2] = (i1 << 16) | p1; rec[rr * 4 + 3] = __float_as_int(g1); }
            }
        }
    }
    if (moe) {
        __syncthreads();
        if (bx < 256 && tid < 8) cnt[8 + tid] = __hip_atomic_fetch_add((int*)(ws + WS_CTL) + CW_GCNT + tid, cnt[tid], __ATOMIC_RELAXED, __HIP_MEMORY_SCOPE_AGENT);
        __syncthreads();
        if (bx < 256 && tid < 2 * RPW) { const int rr = tid >> 1, k = tid & 1, r = bx * RPW + rr; const int info = rec[rr * 4 + 2 * k], e = info >> 16, slot = e * CAP + cnt[8 + e] + (info & 0xffff);
            ((int*)(ws + WS_RT1 + RT1_TOK))[slot] = r; ((int*)(ws + WS_RT1 + RT1_DST))[slot] = k * MALL + r; ((int*)(ws + WS_RT1 + RT1_GATE))[slot] = rec[rr * 4 + 2 * k + 1]; }
    }
}

#undef NM_LOAD
#undef NM_ROW
DI void norm_end_phase(const Args& a, unsigned char* ws, int L, int wave, int lane) {
    const int M = L == 0 ? MALL : MLAT, RPW = M / 256, bx = blockIdx.x; const bool moe = (L == 1);
    const bf16* F = (const bf16*)(ws + WS_R + R_F); bf16* Y = (bf16*)(ws + WS_Y);
    const bf16* hctx1 = (const bf16*)(ws + WS_HCTX); bf16* hctx2 = (bf16*)(ws + WS_HCTX) + (size_t)MCTX * DM; bf16* h2lat = (bf16*)a.out + (size_t)MLAT * DM; const bf16* h3 = (const bf16*)(ws + WS_H3);
    if (bx >= 256) return;
    f32x4 gpost[4], gnx[4], gtf[4], shn[4], scn[4]; u32x2 f0n[4], hbn[4]; unsigned q0[4], q1[4], q02[4], q12[4]; int cs = -1;
    ldvec(a.in[I_GFPOST] + L * DM, lane, gpost); ldvec(a.in[I_GMPRE] + DM, lane, gnx);
#define NE_HIN(r_) (L == 0 ? ((r_) < MLAT ? (const bf16*)a.out + (size_t)(r_) * DM : hctx1 + (size_t)((r_) - MLAT) * DM) : h3 + (size_t)(r_) * DM)
#define NE_ROW(rr_) (L == 0 ? ((rr_) < 4 ? MLAT + 4 * bx + (rr_) : 128 * bx + ((rr_) - 4)) : bx * RPW + (rr_))
    u32x2 f0n2[4], hbn2[4];
#define NE_LOAD(rq_, f0_, q0_, q1_, hb_) do { const int rq = (rq_); \
        if (moe) { const unsigned* p0_ = (const unsigned*)((const unsigned char*)F + (size_t)rq * DM) + lane; const unsigned* p1_ = (const unsigned*)((const unsigned char*)F + (size_t)(MALL + rq) * DM) + lane; \
            _Pragma("unroll") for (int j = 0; j < 4; ++j) { q0_[j] = p0_[64 * j]; q1_[j] = p1_[64 * j]; } } \
        else ldraw_bf16(F + (size_t)rq * DM, lane, f0_); \
        ldraw_bf16(NE_HIN(rq), lane, hb_); } while (0)
    NE_LOAD(NE_ROW(wave), f0n, q0, q1, hbn);
    if (wave + NWAVES < RPW) NE_LOAD(NE_ROW(wave + NWAVES), f0n2, q02, q12, hbn2);
    for (int rr = wave; rr < RPW; rr += NWAVES) {
        const int r = NE_ROW(rr), s = mod_set(r);
        f32x4 f[4], h[4]; unpack_bf16(hbn, h);
        if (moe) {
#pragma unroll
            for (int j = 0; j < 4; ++j) { const int a0 = (int)q0[j], a1 = (int)q1[j];
                f[j] = (f32x4){__builtin_amdgcn_cvt_f32_fp8(a0, 0) + __builtin_amdgcn_cvt_f32_fp8(a1, 0), __builtin_amdgcn_cvt_f32_fp8(a0, 1) + __builtin_amdgcn_cvt_f32_fp8(a1, 1),
                               __builtin_amdgcn_cvt_f32_fp8(a0, 2) + __builtin_amdgcn_cvt_f32_fp8(a1, 2), __builtin_amdgcn_cvt_f32_fp8(a0, 3) + __builtin_amdgcn_cvt_f32_fp8(a1, 3)} * (1.0f / pg8::S8_F); }
        } else unpack_bf16(f0n, f);
#pragma unroll
        for (int j = 0; j < 4; ++j) { f0n[j] = f0n2[j]; q0[j] = q02[j]; q1[j] = q12[j]; hbn[j] = hbn2[j]; }
        if (rr + 2 * NWAVES < RPW) NE_LOAD(NE_ROW(rr + 2 * NWAVES), f0n2, q02, q12, hbn2);
        if (SPLITK && L == 0 && r >= MLAT) {
#pragma unroll
            for (int j = 0; j < 4; ++j) f[j] = (f32x4){0.f, 0.f, 0.f, 0.f};
#pragma unroll 2
            for (int ks = 0; ks < (FP8_DDN ? 7 : 14); ++ks) { f32x4 t[4]; ldraw_f32((const float*)(ws + WS_R + (FP8_DDN ? R_PART : R_PART0)) + ((size_t)ks * MCTX + (r - MLAT)) * DM, lane, t);
#pragma unroll
                for (int j = 0; j < 4; ++j) f[j] = f[j] + t[j]; }
            if (FP8_DDN) {
#pragma unroll
                for (int j = 0; j < 4; ++j) f[j] = f[j] * (1.0f / (pg8::S8_ACT * pg8::S8_W)); }
        }
        if (s != cs) { ldmod(a, ws, L, s, 5, lane, gtf); if (L == 0) { ldmod(a, ws, 1, s, 0, lane, shn); ldmod(a, ws, 1, s, 1, lane, scn); } cs = s; }
        const float rf = row_rstd(f, lane);
#pragma unroll
        for (int j = 0; j < 4; ++j) h[j] = h[j] + gtf[j] * (f[j] * rf * gpost[j]);
        if (L == 0) st_row_bf16(r < MLAT ? h2lat + (size_t)r * DM : hctx2 + (size_t)(r - MLAT) * DM, lane, h);
        else st_row_f32(a.out + (size_t)r * DM, lane, h);
        if (L == 0) { f32x4 y[4]; const float rh = row_rstd(h, lane);
#pragma unroll
            for (int j = 0; j < 4; ++j) y[j] = h[j] * rh * gnx[j] * (1.0f + scn[j]) + shn[j];
            st_row_bf16(Y + (size_t)r * DM, lane, y); }
    }
#undef NE_HIN
#undef NE_ROW
#undef NE_LOAD
}

constexpr int AT_KS = 0, AT_VT = 9216, AT_BUF = 19456;
DI void attn_unit(LAS unsigned char* lds, const bf16* Z, bf16* OC, const float* sinkL, int u, int tid, int wave, int lane) {
    int b, blk, kh; bool isctx;
    if (u < 512) { kh = u & 1; blk = (u >> 1) & 63; b = u >> 7; isctx = false; } else { const int j = u - 512; kh = j & 1; blk = (j >> 1) & 1; b = j >> 2; isctx = true; }
    const int qrowbase = isctx ? (MLAT + b * NCTX + 128 * blk) : (b * NLAT + 128 * blk);
    const int hq = 4 * kh + (wave & 3), qrow0 = (wave >> 2) * 64, i16 = lane & 15, h4 = lane >> 4;
    bf16x8 Qf[4][2];
#pragma unroll
    for (int qt = 0; qt < 4; ++qt)
#pragma unroll
        for (int ks = 0; ks < 2; ++ks) Qf[qt][ks] = *(const bf16x8*)(Z + (size_t)(qrowbase + qrow0 + 16 * qt + i16) * NZ + ZQ + 64 * hq + 32 * ks + 8 * h4);
    float mrun[4], lrun[4]; f32x4 o[4][4];
    const float sk = sinkL[hq] * LOG2E;
#pragma unroll
    for (int qt = 0; qt < 4; ++qt) { mrun[qt] = sk; lrun[qt] = (h4 == 0) ? 1.f : 0.f;
#pragma unroll
        for (int dt = 0; dt < 4; ++dt) o[dt][qt] = (f32x4){0.f, 0.f, 0.f, 0.f}; }
    const int ntl = isctx ? 0 : 6, ntt = ntl + 4;
#define AT_TILE(t, kr, mt, k0) (((t) < ntl) ? ((kr) = b * NLAT + 128 * (blk - 1 + ((t) >> 1)) + 64 * ((t) & 1), (mt) = ((t) >> 1) == 0 ? 1 : (((t) >> 1) == 2 ? 2 : 0), (k0) = 64 * ((t) & 1), (blk - 1 + ((t) >> 1)) >= 0 && (blk - 1 + ((t) >> 1)) <= 63) \
                                            : ((kr) = MLAT + b * NCTX + 64 * ((t) - ntl), (mt) = 0, (k0) = 0, true))
    const int skey = tid >> 3, sch = tid & 7;
#define AT_LOAD(kr) do { const bf16* src = Z + (size_t)((kr) + skey) * NZ; kvr = *(const u32x4*)(src + ZK + 64 * kh + 8 * sch); vvr = *(const u32x4*)(src + ZVV + 64 * kh + 8 * sch); } while (0)
#define AT_STORE(pb_) do { *(LAS u32x4*)(lds + (pb_) * AT_BUF + AT_KS + skey * 144 + sch * 16) = kvr; *(LAS u32x4*)(lds + (pb_) * AT_BUF + AT_VT + skey * 160 + sch * 16) = vvr; } while (0)
    u32x4 kvr, vvr;
    int tix = 0, krow0 = 0, cmtype = 0, ckb0 = 0, nmtype = 0, nkb0 = 0, pb = 0;
    while (tix < ntt && !AT_TILE(tix, krow0, cmtype, ckb0)) ++tix;
    AT_LOAD(krow0);
    __syncthreads();
    AT_STORE(0);
#pragma unroll
    for (int qt = 0; qt < 4; ++qt)
#pragma unroll
        for (int ks = 0; ks < 2; ++ks) asm volatile("" : "+v"(Qf[qt][ks]));
    ++tix; while (tix < ntt && !AT_TILE(tix, krow0, nmtype, nkb0)) ++tix;
    bool nvalid = tix < ntt;
    if (nvalid) AT_LOAD(krow0);
    __syncthreads();
    for (;;) {
        int n2mtype = 0, n2kb0 = 0; bool n2valid = false;
        if (nvalid) { AT_STORE(pb ^ 1);
            ++tix; while (tix < ntt && !AT_TILE(tix, krow0, n2mtype, n2kb0)) ++tix;
            n2valid = tix < ntt; if (n2valid) AT_LOAD(krow0); }
        const LAS unsigned char* ldt = lds + pb * AT_BUF;
        const bool skipw = (cmtype == 1 && ckb0 < qrow0) || (cmtype == 2 && ckb0 > qrow0);
        if (!skipw) {
        f32x4 sa[4][4];
#pragma unroll
        for (int kt = 0; kt < 4; ++kt)
#pragma unroll
            for (int qt = 0; qt < 4; ++qt) { const float nm = -mrun[qt]; sa[kt][qt] = (f32x4){nm, nm, nm, nm}; }
#pragma unroll
        for (int ks = 0; ks < 2; ++ks)
#pragma unroll
            for (int kt = 0; kt < 4; ++kt) { const bf16x8 ak = *(const LAS bf16x8*)(ldt + AT_KS + (16 * kt + i16) * 144 + (32 * ks + 8 * h4) * 2);
#pragma unroll
                for (int qt = 0; qt < 4; ++qt) sa[kt][qt] = mfma16(ak, Qf[qt][ks], sa[kt][qt]); }
        if (cmtype && ckb0 == qrow0) {
            int ln; asm volatile("v_mbcnt_lo_u32_b32 %0, -1, 0\n\tv_mbcnt_hi_u32_b32 %0, -1, %0" : "=v"(ln));
            const int dl = 4 * (ln >> 4) - (ln & 15);
            if (cmtype == 1) {
#pragma unroll
                for (int kt = 0; kt < 4; ++kt)
#pragma unroll
                    for (int qt = 0; qt < 4; ++qt) {
                        if (kt < qt) sa[kt][qt] = (f32x4){-1.0e30f, -1.0e30f, -1.0e30f, -1.0e30f};
                        else if (kt == qt) {
#pragma unroll
                            for (int r = 0; r < 4; ++r) if (dl + r < 0) sa[kt][qt][r] = -1.0e30f; } }
            } else {
#pragma unroll
                for (int kt = 0; kt < 4; ++kt)
#pragma unroll
                    for (int qt = 0; qt < 4; ++qt) {
                        if (kt > qt) sa[kt][qt] = (f32x4){-1.0e30f, -1.0e30f, -1.0e30f, -1.0e30f};
                        else if (kt == qt) {
#pragma unroll
                            for (int r = 0; r < 4; ++r) if (dl + r > 0) sa[kt][qt][r] = -1.0e30f; } }
            }
        }
#pragma unroll
        for (int qt = 0; qt < 4; ++qt) {
            float mx = vmax3(vmax3(vmax3(sa[0][qt][0], sa[0][qt][1], sa[0][qt][2]), vmax3(sa[0][qt][3], sa[1][qt][0], sa[1][qt][1]), sa[1][qt][2]),
                             vmax3(sa[1][qt][3], sa[2][qt][0], sa[2][qt][1]), vmax3(vmax3(sa[2][qt][2], sa[2][qt][3], sa[3][qt][0]), vmax3(sa[3][qt][1], sa[3][qt][2], sa[3][qt][3]), sa[3][qt][3]));
            if (__builtin_amdgcn_ballot_w64(mx > 6.0f) != 0ull) {
                mx = xrow16_max(mx);
                const float dl = fmaxf(mx, 0.f), alpha = fexp2(-dl); mrun[qt] += dl; lrun[qt] *= alpha;
#pragma unroll
                for (int kt = 0; kt < 4; ++kt) sa[kt][qt] = sa[kt][qt] - dl;
#pragma unroll
                for (int dt = 0; dt < 4; ++dt) o[dt][qt] = o[dt][qt] * alpha;
            }
            f32x2 ps = (f32x2){0.f, 0.f};
#pragma unroll
            for (int kt = 0; kt < 4; ++kt) { f32x4 p; p[0] = fexp2(sa[kt][qt][0]); p[1] = fexp2(sa[kt][qt][1]); p[2] = fexp2(sa[kt][qt][2]); p[3] = fexp2(sa[kt][qt][3]); sa[kt][qt] = p;
                ps = ps + (f32x2){p[0], p[1]} + (f32x2){p[2], p[3]}; }
            lrun[qt] += ps.x + ps.y;
        }
#pragma unroll
        for (int s = 0; s < 2; ++s) {
            bf16x8 pf[4];
#pragma unroll
            for (int qt = 0; qt < 4; ++qt) { u32x4 w; const f32x4 p0 = sa[2 * s][qt], p1 = sa[2 * s + 1][qt];
                w.x = cvt_pk_bf16(p0[0], p0[1]); w.y = cvt_pk_bf16(p0[2], p0[3]); w.z = cvt_pk_bf16(p1[0], p1[1]); w.w = cvt_pk_bf16(p1[2], p1[3]); pf[qt] = __builtin_bit_cast(bf16x8, w); }
#pragma unroll
            for (int dt = 0; dt < 4; ++dt) {
                const LAS unsigned char* vp = ldt + AT_VT + (32 * s + 4 * h4 + (i16 >> 2)) * 160 + (16 * dt + 4 * (i16 & 3)) * 2;
                const v4i16_t lo = __builtin_amdgcn_ds_read_tr16_b64_v4i16((LAS v4i16_t*)vp), hi = __builtin_amdgcn_ds_read_tr16_b64_v4i16((LAS v4i16_t*)(vp + 16 * 160)); const bf16x8 av = __builtin_shufflevector(lo, hi, 0, 1, 2, 3, 4, 5, 6, 7);
#pragma unroll
                for (int qt = 0; qt < 4; ++qt) o[dt][qt] = mfma16(av, pf[qt], o[dt][qt]); }
        }
        }
        if (!nvalid) break;
        __syncthreads();
        pb ^= 1; cmtype = nmtype; ckb0 = nkb0; nvalid = n2valid; nmtype = n2mtype; nkb0 = n2kb0;
    }
#undef AT_LOAD
#undef AT_STORE
    const int trs = (((lane & 3) << 4) | (lane >> 2)) << 2;
#pragma unroll
    for (int qt = 0; qt < 4; ++qt) { const float lt = xrow16_sum(lrun[qt]); const float inv = 1.0f / lt;
        bf16* orow = OC + (size_t)(qrowbase + qrow0 + 16 * qt + (lane >> 2)) * DM + 512 + 64 * hq + 4 * (lane & 3);
#pragma unroll
        for (int dt = 0; dt < 4; ++dt) { const f32x4 v = o[dt][qt] * inv; u32x2 w; w.x = (unsigned)__builtin_amdgcn_ds_bpermute(trs, (int)cvt_pk_bf16(v[0], v[1])); w.y = (unsigned)__builtin_amdgcn_ds_bpermute(trs, (int)cvt_pk_bf16(v[2], v[3])); *(u32x2*)(orow + 16 * dt) = w; } }
#undef AT_TILE
}

DI void sgu_unit(LAS unsigned char* lds, const bf16* Z, bf16* OC, const bf16* wsb, const float* bs, const float* gv, int c, int tid, int wave, int lane) {
    const int rowbase = 128 * c, i16 = lane & 15, h4 = lane >> 4;
    __syncthreads();
    { const int q = tid >> 2, hh = tid & 3; const u32x4* src = (const u32x4*)(Z + (size_t)(rowbase + q) * NZ + ZV + 64 * hh);
      u32x4 v[8]; float ss = 0.f;
#pragma unroll
      for (int j = 0; j < 8; ++j) { v[j] = src[j];
#pragma unroll
          for (int q2 = 0; q2 < 4; ++q2) { const float x0 = bflo(v[j][q2]), x1 = bfhi(v[j][q2]); ss += x0 * x0 + x1 * x1; } }
      const float rstd = 1.0f / sqrtf(ss * (1.0f / 64.0f) + EPS);
      const f32x4* gp = (const f32x4*)(gv + hh * 64);
#pragma unroll
      for (int j = 0; j < 8; ++j) { const f32x4 ga = gp[2 * j], gb = gp[2 * j + 1]; u32x4 w;
          w.x = cvt_pk_bf16(bflo(v[j].x) * rstd * ga[0], bfhi(v[j].x) * rstd * ga[1]); w.y = cvt_pk_bf16(bflo(v[j].y) * rstd * ga[2], bfhi(v[j].y) * rstd * ga[3]);
          w.z = cvt_pk_bf16(bflo(v[j].z) * rstd * gb[0], bfhi(v[j].z) * rstd * gb[1]); w.w = cvt_pk_bf16(bflo(v[j].w) * rstd * gb[2], bfhi(v[j].w) * rstd * gb[3]);
          *(LAS u32x4*)(lds + q * 544 + (hh * 64 + 8 * j) * 2) = w; } }
    __syncthreads();
    const int p = 16 * wave + i16;
#pragma unroll 1
    for (int hh = 0; hh < 4; ++hh) {
        f32x4 acc[4];
#pragma unroll
        for (int ct = 0; ct < 4; ++ct) acc[ct] = (f32x4){0.f, 0.f, 0.f, 0.f};
#pragma unroll
        for (int ks = 0; ks < 4; ++ks) { const bf16x8 bw = *(const bf16x8*)(wsb + ((size_t)hh * 128 + p) * 128 + 32 * ks + 8 * h4);
#pragma unroll
            for (int ct = 0; ct < 4; ++ct) { const bf16x8 av = trfrag(lds + 32 * ks * 544 + (hh * 64 + 16 * ct) * 2, 544, lane); acc[ct] = mfma16(av, bw, acc[ct]); } }
        const float bias = bs[hh * 128 + p];
#pragma unroll
        for (int ct = 0; ct < 4; ++ct) { const u32x2 uu = *(const u32x2*)(Z + (size_t)(rowbase + p) * NZ + ZU + 64 * hh + 16 * ct + 4 * h4);
            u32x2 w; w.x = cvt_pk_bf16(bflo(uu.x) * (acc[ct][0] + bias), bfhi(uu.x) * (acc[ct][1] + bias)); w.y = cvt_pk_bf16(bflo(uu.y) * (acc[ct][2] + bias), bfhi(uu.y) * (acc[ct][3] + bias));
            const int trs = (((lane & 3) << 4) | (lane >> 2)) << 2;
            w.x = (unsigned)__builtin_amdgcn_ds_bpermute(trs, (int)w.x); w.y = (unsigned)__builtin_amdgcn_ds_bpermute(trs, (int)w.y);
            *(u32x2*)(OC + (size_t)(rowbase + 16 * wave + (lane >> 2)) * DM + 64 * hh + 16 * ct + 4 * (lane & 3)) = w; }
    }
}

DI void fft1_unit(LAS unsigned char* lds, const bf16* Z, bf16* T, const bf16* G1, int u, int tid, int wave, int lane) {
    const int n2g = u & 31, g = (u >> 5) & 3, b = u >> 7, i16 = lane & 15, h4 = lane >> 4;
    __syncthreads();
    constexpr int PB = 544;
    { const int ch = tid & 7, n2l = (tid >> 3) & 3, k0 = tid >> 5;
      u32x4 v[8];
#pragma unroll
      for (int it = 0; it < 8; ++it) { const int k = k0 + 16 * it, pq = k >> 6, n1 = k & 63;
          v[it] = *(const u32x4*)(Z + (size_t)(b * NLAT + 128 * n1 + 4 * n2g + n2l) * NZ + ZP + 256 * pq + 64 * g + 8 * ch); }
#pragma unroll
      for (int it = 0; it < 8; ++it) { const int k = k0 + 16 * it;
          *(LAS u32x4*)(lds + k * PB + (n2l * 64 + 8 * ch) * 2) = v[it]; } }
    __syncthreads();
    bf16x8 ga[4];
#pragma unroll
    for (int ks = 0; ks < 4; ++ks) ga[ks] = *(const bf16x8*)(G1 + (16 * wave + i16) * 128 + 32 * ks + 8 * h4);
    const int k1a = 8 * wave + 2 * h4;
#pragma unroll 4
    for (int ct = 0; ct < 16; ++ct) {
        f32x4 acc = (f32x4){0.f, 0.f, 0.f, 0.f};
#pragma unroll
        for (int ks = 0; ks < 4; ++ks) { const bf16x8 bd = trfrag(lds + 32 * ks * PB + 32 * ct, PB, lane); acc = mfma16(ga[ks], bd, acc); }
        const int n2 = 4 * n2g + (ct >> 2), e2 = 16 * (ct & 3) + i16;
#pragma unroll
        for (int hf = 0; hf < 2; ++hf) { const int k1 = k1a + hf; const float ar = acc[2 * hf], mai = acc[2 * hf + 1];
            const float fr = (float)((k1 * n2) & 8191) * (1.0f / 8192.0f), c = __builtin_amdgcn_cosf(fr), s = __builtin_amdgcn_sinf(fr);
            const float apr = ar * c - mai * s, api = -mai * c - ar * s;
            const size_t base = ((((size_t)(b * 4 + g) * 64 + k1) * 2) * 128 + n2) * 64 + e2;
            T[base] = f2bf(apr); T[base + 128 * 64] = f2bf(api); }
    }
}

template <int KD> DI void dft_unit(LAS unsigned char* lds, const bf16* Gt, const bf16* P0, const bf16* P1, int pitch, bf16* outp, int rstride, float scale, int tid, int wave, int lane) {
    constexpr int PB = 160; const int i16 = lane & 15, h4 = lane >> 4;
    __syncthreads();
    { const int ch = tid & 7, r0 = tid >> 3;
      u32x4 v[KD / 64];
#pragma unroll
      for (int it = 0; it < KD / 64; ++it) { const int k = r0 + 64 * it, pl = k / (KD / 2), rr = k % (KD / 2);
          v[it] = *(const u32x4*)((pl ? P1 : P0) + (size_t)rr * pitch + 8 * ch); }
#pragma unroll
      for (int it = 0; it < KD / 64; ++it) { const int k = r0 + 64 * it;
          *(LAS u32x4*)(lds + k * PB + 16 * ch) = v[it]; } }
    __syncthreads();
    f32x4 acc[4];
#pragma unroll
    for (int ct = 0; ct < 4; ++ct) acc[ct] = (f32x4){0.f, 0.f, 0.f, 0.f};
#pragma unroll 4
    for (int ks = 0; ks < KD / 32; ++ks) { const bf16x8 gb = *(const bf16x8*)(Gt + (size_t)(16 * wave + i16) * KD + 32 * ks + 8 * h4);
#pragma unroll
        for (int ct = 0; ct < 4; ++ct) { const bf16x8 ad = trfrag(lds + 32 * ks * PB + 32 * ct, PB, lane); acc[ct] = mfma16(ad, gb, acc[ct]); } }
    bf16* orow = outp + (size_t)rstride * (16 * wave + i16) * DM + 4 * h4;
#pragma unroll
    for (int ct = 0; ct < 4; ++ct) { const f32x4 v = acc[ct] * scale; u32x2 w; w.x = cvt_pk_bf16(v[0], v[1]); w.y = cvt_pk_bf16(v[2], v[3]); *(u32x2*)(orow + 16 * ct) = w; }
}

DI void fft3_phase(LAS unsigned char* lds, const bf16* T, const bf16* G3, bf16* OC, int bx, int G, int tid, int wave, int lane) {
    constexpr int PB = 160, BUF = 256 * PB; const int i16 = lane & 15, h4 = lane >> 4, ch = tid & 7, r0 = tid >> 3;
    int u = bx; if (u >= 1024) return;
    bf16x8 gb[8];
#pragma unroll
    for (int ks = 0; ks < 8; ++ks) gb[ks] = *(const bf16x8*)(G3 + (size_t)(16 * wave + i16) * 256 + 32 * ks + 8 * h4);
    u32x4 v[4];
#define F3_LOAD(uu) do { const bf16* p_ = T + (size_t)(uu) * 2 * 8192 + (size_t)r0 * 64 + 8 * ch; _Pragma("unroll") for (int it = 0; it < 4; ++it) v[it] = *(const u32x4*)(p_ + (size_t)it * 64 * 64); } while (0)
#define F3_STORE(pb_) do { _Pragma("unroll") for (int it = 0; it < 4; ++it) *(LAS u32x4*)(lds + (pb_) * BUF + (r0 + 64 * it) * PB + 16 * ch) = v[it]; } while (0)
    F3_LOAD(u);
    __syncthreads();
    F3_STORE(0);
    int un = u + G; bool nvalid = un < 1024;
    if (nvalid) F3_LOAD(un);
    __syncthreads();
    int pb = 0;
    for (;;) {
        int u2 = un + G; bool n2valid = false;
        if (nvalid) { F3_STORE(pb ^ 1); n2valid = u2 < 1024; if (n2valid) F3_LOAD(u2); }
        const LAS unsigned char* ldt = lds + pb * BUF;
        f32x4 acc[4];
#pragma unroll
        for (int ct = 0; ct < 4; ++ct) acc[ct] = (f32x4){0.f, 0.f, 0.f, 0.f};
#pragma unroll
        for (int ks = 0; ks < 8; ++ks)
#pragma unroll
            for (int ct = 0; ct < 4; ++ct) { const bf16x8 ad = trfrag(ldt + 32 * ks * PB + 32 * ct, PB, lane); acc[ct] = mfma16(ad, gb[ks], acc[ct]); }
        const int k1 = u & 63, g = (u >> 6) & 3, b = u >> 8;
        bf16* orow = OC + (size_t)(b * NLAT + k1 + 64 * (16 * wave + (lane >> 2))) * DM + 256 + 64 * g + 4 * (lane & 3);
        const int trs = (((lane & 3) << 4) | (lane >> 2)) << 2;
#pragma unroll
        for (int ct = 0; ct < 4; ++ct) { const f32x4 w4 = acc[ct] * (1.0f / 724.0773439350247f); u32x2 w; w.x = (unsigned)__builtin_amdgcn_ds_bpermute(trs, (int)cvt_pk_bf16(w4[0], w4[1])); w.y = (unsigned)__builtin_amdgcn_ds_bpermute(trs, (int)cvt_pk_bf16(w4[2], w4[3])); *(u32x2*)(orow + 16 * ct) = w; }
        if (!nvalid) break;
        __syncthreads();
        pb ^= 1; u = un; un = u2; nvalid = n2valid;
    }
#undef F3_LOAD
#undef F3_STORE
}

constexpr int PH_L = 20, PH_END = 2 + 2 * PH_L;
__global__ void __launch_bounds__(NTHR, 2) fwd_kernel(Args args) {
    extern __shared__ __attribute__((aligned(16))) unsigned char lds_raw[];
    LAS unsigned char* const lds0 = (LAS unsigned char*)lds_raw;
    const int tid0 = threadIdx.x; const int wave0 = __builtin_amdgcn_readfirstlane(tid0 >> 6);
    const int G0 = gridDim.x, bx0 = blockIdx.x;
    unsigned char* ws0 = args.ws;
#define PHASE_REGS() int bx = bx0, G = G0; asm volatile("" : "+s"(bx), "+s"(G)); LAS unsigned char* lds = lds0; asm volatile("" : "+s"(lds)); int tid; asm volatile("v_mbcnt_lo_u32_b32 %0, -1, 0\n\tv_mbcnt_hi_u32_b32 %0, -1, %0" : "=v"(tid)); tid += wave0 * 64; GAS unsigned char* wsg_ = (GAS unsigned char*)ws0; asm volatile("" : "+s"(wsg_)); unsigned char* ws = (unsigned char*)wsg_; const int lane = tid & 63, wave = __builtin_amdgcn_readfirstlane(tid >> 6); (void)lane; (void)wave; \
    bf16* Z = (bf16*)(ws + WS_R + R_Z); bf16* OC = (bf16*)(ws + WS_R + R_OC); bf16* TT = (bf16*)(ws + WS_R + R_T); bf16* Y = (bf16*)(ws + WS_Y); (void)Z; (void)OC; (void)TT; (void)Y
    for (int u = tid0; u < (LDS_BYTES - LDSCTL_OFF) / 4; u += NTHR) ((LAS unsigned*)(lds0 + LDSCTL_OFF))[u] = 0u;
    __syncthreads();
#if MK_MULTI
#define GRID_BAR() do { } while (0)
#else
    XcdBarrier bar = xcd_barrier_post((unsigned*)(ws0 + WS_CTL) + CW_BAR, (volatile LAS unsigned*)(lds0 + LDSCTL_OFF + LC_BAR));
#define GRID_BAR() do { XcdBarrier b_ = bar; { GAS unsigned* bp_ = (GAS unsigned*)bar.bar; asm volatile("" : "+s"(bp_)); b_.bar = (unsigned*)bp_; } int l_; asm volatile("v_mbcnt_lo_u32_b32 %0, -1, 0\n\tv_mbcnt_hi_u32_b32 %0, -1, %0" : "=v"(l_)); xcd_barrier(b_, wave0 == 0 && l_ == 0); if (MK_PROBE == 40) xcd_barrier(b_, wave0 == 0 && l_ == 0); } while (0)
#endif
    const int lo = args.ph_lo, hi = args.ph_hi;
#define IN(k) (lo <= (k) && (k) < hi)
#define TAIL_FILL(id, nunits) do { if (FILL) { PHASE_REGS(); const int nu_ = (nunits), last_ = nu_ - ((nu_ + G - 1) / G - 1) * G; int* dn_ = (int*)(ws + WS_CTL) + CW_DONE + 64 * (L * 16 + (id)); \
        if (last_ < G) { if (bx < last_) { if (tid == 0) __hip_atomic_fetch_add(dn_, 1, __ATOMIC_RELAXED, __HIP_MEMORY_SCOPE_AGENT); } else cvt_filler(args, ws, lds, tid, wave, lane, dn_, 1); } } } while (0)
#define SEAM(k) do { if (IN(k) && IN((k) + 1)) GRID_BAR(); } while (0)

    if (EN(0) && IN(0)) { PHASE_REGS(); for (int rep = 0; rep < REP(1); ++rep) prologue_a(args, ws, lds, tid, wave, lane); }
    SEAM(0);
    if (EN(1) && IN(1)) { PHASE_REGS(); for (int rep = 0; rep < REP(2); ++rep) norm0_phase(args, ws, wave, lane); }
    SEAM(1);

#pragma unroll 1
    for (int L = 0; L < 2; ++L) {
        const int pb = 2 + PH_L * L;
        if (EN(2) && IN(pb + 0)) { PHASE_REGS();
            pg8::SchedIn S{G, bx, L == 0 ? 28 : 4, L == 0, (const char*)(ws + WS_W + W_IN) + (size_t)L * NZ * 1024 * 2, 2048};
            { LAS f32x4* rl = (LAS f32x4*)(lds + LDSCTL_OFF + LC_ROPE); const f32x4* src = (const f32x4*)(ws + WS_TAB + T_ROPE); const f32x4 r0_ = src[tid], r1_ = src[tid + NTHR]; rl[tid] = r0_; rl[tid + NTHR] = r1_; __syncthreads(); }
            pg8::EpiZ E{Z, (const LAS float*)(lds + LDSCTL_OFF + LC_ROPE), (const LAS float*)(lds + LDSCTL_OFF + LC_ROPE) + 2048};
            pg8::gemm_phase<pg8::EpiZ, pg8::SchedIn, false, false>(lds, (const unsigned char*)Y, 2048, S, E, tid);
        }
        if (IN(pb + 0)) TAIL_FILL(0, 896 + (L == 0 ? 28 : 4));
        SEAM(pb + 0);
        if (IN(pb + 1)) {
            const int nattn = L == 0 ? 528 : 512, nsgu = L == 0 ? 264 : 256;
            if (EN(3)) { PHASE_REGS(); for (int rep = 0; rep < REP(3); ++rep) { for (int u = bx; u < 512; u += G) attn_unit(lds, Z, OC, args.in[I_SINK] + L * 8, u, tid, wave, lane);
                { PHASE_REGS(); for (int u = 512 + ((bx + 16) % G); u < nattn; u += G) attn_unit(lds, Z, OC, args.in[I_SINK] + L * 8, u, tid, wave, lane); } } }
            if (EN(4)) { PHASE_REGS(); for (int rep = 0; rep < REP(4); ++rep) { for (int u = bx; u < 256; u += G) sgu_unit(lds, Z, OC, (const bf16*)(ws + WS_TAB + T_WS) + (size_t)L * 4 * 128 * 128, args.in[I_BS] + L * 512, args.in[I_GV] + L * 256, u, tid, wave, lane);
                for (int u = 256 + ((bx + 32) % G); u < nsgu; u += G) sgu_unit(lds, Z, OC, (const bf16*)(ws + WS_TAB + T_WS) + (size_t)L * 4 * 128 * 128, args.in[I_BS] + L * 512, args.in[I_GV] + L * 256, u, tid, wave, lane); } }
            if (EN(5)) { PHASE_REGS(); for (int rep = 0; rep < REP(5); ++rep) for (int u = bx; u < 512; u += G) fft1_unit(lds, Z, TT, (const bf16*)(ws + WS_TAB + T_G1), u, tid, wave, lane); }
            if (L == 0) { PHASE_REGS(); for (int u = (bx + 96) % G; u < 32; u += G) {     const int mh = u & 1, g = (u >> 1) & 3, b = u >> 3; const bf16* zr = Z + (size_t)(MLAT + b * NCTX) * NZ;
                dft_unit<512>(lds, (const bf16*)(ws + WS_TAB + T_GC) + (size_t)128 * mh * 512, zr + ZP + 64 * g, zr + ZQI + 64 * g, NZ, OC + (size_t)(MLAT + b * NCTX + 128 * mh) * DM + 256 + 64 * g, 1, 1.0f / 128.0f, tid, wave, lane); } }
            __syncthreads();
        }
        SEAM(pb + 1);
        if (EN(6) && IN(pb + 2)) { PHASE_REGS();
            for (int rep = 0; rep < REP(6); ++rep) fft3_phase(lds, TT, (const bf16*)(ws + WS_TAB + T_G3), OC, bx, G, tid, wave, lane);
            __syncthreads();
        }
        SEAM(pb + 2);
        if (EN(7) && IN(pb + 3)) { PHASE_REGS();
            pg8::SchedPlain S{G, bx, (L == 0 && !SPLITK) ? 132 : 128, 4, (const char*)(ws + WS_W + W_OUT) + (size_t)L * 1024 * 1024 * 2, 2048};
            pg8::EpiO E{(bf16*)(ws + WS_R + R_O), DM};
            pg8::gemm_phase<pg8::EpiO, pg8::SchedPlain, false, false>(lds, (const unsigned char*)OC, 2048, S, E, tid);
        }
        if (EN(7) && IN(pb + 3) && L == 0 && SPLITK) { PHASE_REGS();
            pg8::SchedSplit S{G, bx, 4, 4, 4, 4, (const char*)(ws + WS_W + W_OUT), 2048};
            pg8::EpiPart E{(float*)(ws + WS_R + R_T), MCTX, DM};
            pg8::gemm_phase<pg8::EpiPart, pg8::SchedSplit, false, false>(lds, (const unsigned char*)(OC + (size_t)MLAT * DM), 2048, S, E, tid, 4);
        }
        if (IN(pb + 3)) TAIL_FILL(3, (L == 0 ? 132 : 128) * 4);
        SEAM(pb + 3);
        if (EN(8) && IN(pb + 4)) { PHASE_REGS(); for (int rep = 0; rep < (L == 0 ? REP(7) : 1); ++rep) norm_mid_phase(args, ws, lds, L, tid, wave, lane); }
        if (IN(pb + 4) && L == 1) { PHASE_REGS(); cvt_filler(args, ws, lds, tid, wave, lane, nullptr, 0); }
        SEAM(pb + 4);
#pragma unroll 1
        for (int c = 0; c < 5; ++c) {
            const bool any = IN(pb + 6 + 2 * c) || IN(pb + 7 + 2 * c);
            int ntiles = 0;
            PHASE_REGS();
            if (any) {
                LAS int* tlw = (LAS int*)(lds + LDSCTL_OFF + LC_TILE);
                int pre[9]; pre[0] = 0;
#pragma unroll
                for (int e = 0; e < 8; ++e) { const int ce = L == 0 ? (e == 0 ? MALL : 0) : __builtin_amdgcn_readfirstlane(__hip_atomic_load((int*)(ws + WS_CTL) + CW_GCNT + e, RLX_AGENT)); pre[e + 1] = pre[e] + ((ce + 255) >> 8); }
                ntiles = pre[8];
                __syncthreads();
                for (int t = tid; t < ntiles && t < 512; t += NTHR) { int e = 0;
#pragma unroll
                    for (int q = 1; q < 8; ++q) if (pre[q] <= t) e = q;
                    int pe = 0;
#pragma unroll
                    for (int q = 0; q < 8; ++q) if (q == e) pe = pre[q];
                    tlw[t] = (e << 24) | ((L == 0 ? 0 : e * CAP) + 256 * (t - pe)); }
                __syncthreads(); }
            const int CT = L == 0 ? CHUNK_TILES : 128;
            const int t0 = c * CT; int nM = ntiles - t0;
            if (L == 0 && SPLITK && !FP8_DDN) { if (c == 0) nM = nM > CT ? CT : nM; else if (c > 1) nM = 0; }
            else if (L == 1 && !MK_MULTI) { if (c == 0) nM = nM > CT ? CT : nM; else if (c > 1) nM = 0; }
            else nM = nM > CT ? CT : nM;
            unsigned char* const actb = (L == 0 && SPLITK && !FP8_DDN) ? ws + WS_R - ACT0_BACK : (L == 1 && !MK_MULTI) ? ws + WS_R - ACT1_BACK : ws + WS_R + R_ACT;
            if (!MK_MULTI && nM <= 0) break;
            const LAS int* tl = (const LAS int*)(lds + LDSCTL_OFF + LC_TILE);
            const int* tokmap = L == 0 ? (const int*)(ws + WS_RT + RT_TOK) : (const int*)(ws + WS_RT1 + RT1_TOK);
            const int* dstmap = L == 0 ? (const int*)(ws + WS_RT + RT_DST) : (const int*)(ws + WS_RT1 + RT1_DST);
            const float* gatemap = L == 0 ? (const float*)(ws + WS_RT + RT_GATE) : (const float*)(ws + WS_RT1 + RT1_GATE);
            if (EN(10) && IN(pb + 6 + 2 * c) && nM > 0) {
                if (L == 0 && FP8_DGU && !FP8_DDN) { PHASE_REGS();
                    pg8::SchedGrp S{G, bx, t0, nM, 28, (const char*)(ws + WS_W + W_GUD), (size_t)0, 1024, tl, tokmap, true, MK_PROBE == 21};
                    pg8::EpiGUm E{(bf16*)actb, t0};
                    pg8::gemm_phase<pg8::EpiGUm, pg8::SchedGrp, true, true>(lds, (const unsigned char*)Y, 1024, S, E, tid);
                    TAIL_FILL(4 + 2 * c, nM * 28);
                } else if (L == 0 && !FP8_DGU) { PHASE_REGS();
                    pg8::SchedGrp S{G, bx, t0, nM, 28, (const char*)(ws + WS_W + W_GUD), (size_t)0, 2048, tl, tokmap, true, MK_PROBE == 21};
                    pg8::EpiGU E{(bf16*)(ws + WS_R + R_ACT), t0};
                    pg8::gemm_phase<pg8::EpiGU, pg8::SchedGrp, true, false>(lds, (const unsigned char*)Y, 2048, S, E, tid);
                    TAIL_FILL(4 + 2 * c, nM * 28);
                } else { PHASE_REGS();
                    pg8::SchedGrp S{G, bx, t0, nM, 28, (const char*)(ws + WS_W + (L == 0 ? W_GUD : W_GUE)), L == 0 ? (size_t)0 : (size_t)7168 * 1024, 1024, tl, tokmap, true, MK_PROBE == 23};
                    pg8::EpiGU8 E{(unsigned char*)actb, t0};
                    pg8::gemm_phase<pg8::EpiGU8, pg8::SchedGrp, true, true>(lds, (const unsigned char*)Y, 1024, S, E, tid);
                }
            }
            SEAM(pb + 6 + 2 * c);
            if (EN(11) && IN(pb + 7 + 2 * c) && nM > 0) {
                if (L == 0 && SPLITK && c == 2 && FP8_DDN) { PHASE_REGS();
                    pg8::SchedSplit S{G, bx, nM, 4, 7, 4, (const char*)(ws + WS_W + W_DD), DFF};
                    pg8::EpiPart E{(float*)(ws + WS_R + R_PART), nM * 256, DM};
                    pg8::gemm_phase<pg8::EpiPart, pg8::SchedSplit, false, true>(lds, (const unsigned char*)(ws + WS_R + R_ACT), DFF, S, E, tid, 4);
                } else if (L == 0 && !FP8_DDN) {
                    const int ng = (SPLITK && nM > CHUNK_TILES) ? CHUNK_TILES : nM;
                    { PHASE_REGS();
                      pg8::SchedGrp S{G, bx, t0, ng, 4, (const char*)(ws + WS_W + W_DD), (size_t)0, 2 * DFF, tl, tokmap, false, MK_PROBE == 22};
                      pg8::EpiDown E{(bf16*)(ws + WS_R + R_F), dstmap, gatemap};
                      pg8::gemm_phase<pg8::EpiDown, pg8::SchedGrp, false, false>(lds, (const unsigned char*)actb, 2 * DFF, S, E, tid); }
                    if (nM > ng) { PHASE_REGS();
                      pg8::SchedSplit S{G, bx, nM - ng, 4, 14, 4, (const char*)(ws + WS_W + W_DD), 2 * DFF};
                      pg8::EpiPart E{(float*)(ws + WS_R + R_PART0), (nM - ng) * 256, DM};
                      pg8::gemm_phase<pg8::EpiPart, pg8::SchedSplit, false, false>(lds, (const unsigned char*)actb + (size_t)ng * 256 * 2 * DFF, 2 * DFF, S, E, tid, 4); }
                } else { PHASE_REGS();
                    pg8::SchedGrp S{G, bx, t0, nM, 4, (const char*)(ws + WS_W + (L == 0 ? W_DD : W_DE)), L == 0 ? (size_t)0 : (size_t)1024 * DFF, DFF, tl, tokmap, false, MK_PROBE == 24};
                    pg8::EpiDown8 E{(bf16*)(ws + WS_R + R_F), dstmap, gatemap};
                    pg8::gemm_phase<pg8::EpiDown8, pg8::SchedGrp, false, true>(lds, (const unsigned char*)actb, DFF, S, E, tid);
                }
            }
            SEAM(pb + 7 + 2 * c);
        }
        if (EN(12) && IN(pb + 16)) { PHASE_REGS(); norm_end_phase(args, ws, L, wave, lane); }
        if (L == 0) SEAM(pb + 16);
    }
#undef IN
#undef SEAM
}

extern "C" void kernel_launch(void* const* d_in, const int* in_sizes, int n_in, void* d_out, int out_size, void* d_ws, size_t ws_size, hipStream_t stream) {
    static int grid = 0;
    if (grid == 0) {
        if (n_in != 25 || out_size != MLAT * DM || ws_size < WS_END) { fprintf(stderr, "kernel_launch: unexpected shapes (n_in %d out %d ws %zu, need %zu)\n", n_in, out_size, ws_size, (size_t)WS_END); grid = -1; return; }
        int dev = 0, cus = 0, per_cu = 0;
        if (hipGetDevice(&dev) != hipSuccess || hipDeviceGetAttribute(&cus, hipDeviceAttributeMultiprocessorCount, dev) != hipSuccess) { grid = -1; return; }
        if (hipFuncSetAttribute((const void*)fwd_kernel, hipFuncAttributeMaxDynamicSharedMemorySize, LDS_BYTES) != hipSuccess) { fprintf(stderr, "kernel_launch: hipFuncSetAttribute failed\n"); grid = -1; return; }
        if (hipOccupancyMaxActiveBlocksPerMultiprocessor(&per_cu, (const void*)fwd_kernel, NTHR, LDS_BYTES) != hipSuccess || per_cu < 1) fprintf(stderr, "kernel_launch: occupancy query says %d\n", per_cu);
        (void)hipGetLastError();
        grid = cus > 256 ? 256 : cus;
    }
    if (grid < 0) return;
    (void)hipMemsetAsync((char*)d_ws + WS_CTL, 0, CTL_ZERO_BYTES, stream);
    Args a{};
    for (int i = 0; i < 25; ++i) a.in[i] = (const float*)d_in[i];
    a.out = (float*)d_out; a.ws = (unsigned char*)d_ws;
#if MK_MULTI
    for (int p = 0; p < PH_END; ++p) {
        const int k = p < 2 ? -1 : (p - 2) % PH_L;
        if (k > 16 || k == 5) continue;
        a.ph_lo = p; a.ph_hi = p + 1;
        hipLaunchKernelGGL(fwd_kernel, dim3(grid), dim3(NTHR), LDS_BYTES, stream, a);
    }
#else
    a.ph_lo = 0; a.ph_hi = PH_END;
    hipLaunchKernelGGL(fwd_kernel, dim3(grid), dim3(NTHR), LDS_BYTES, stream, a);
#endif
}
```

```cpp
#include <hip/hip_runtime.h>
#include <cstdio>
#include <cstdint>

#ifndef MK_MULTI
#define MK_MULTI 0
#endif
#define SPLITK (!MK_MULTI)
#ifndef MK_EN
#define MK_EN 0xFFFF
#endif
#define EN(b) (((MK_EN) >> (b)) & 1)
#ifndef MK_PROBE
#define MK_PROBE 0
#endif
#define KDUP_IN (MK_PROBE == 20)
#define KDUP_GRP (MK_PROBE >= 21 && MK_PROBE <= 24)
#define REP(k) ((MK_PROBE == (k)) ? 2 : 1)
#ifndef FILL
#define FILL 1
#endif

#define GAS __attribute__((address_space(1)))
#define LAS __attribute__((address_space(3)))
typedef unsigned short bf16;
typedef short bf16x8 __attribute__((ext_vector_type(8)));
typedef float f32x4 __attribute__((ext_vector_type(4)));
typedef float f32x2 __attribute__((ext_vector_type(2)));
typedef unsigned u32x4 __attribute__((ext_vector_type(4)));
typedef unsigned u32x2 __attribute__((ext_vector_type(2)));
typedef int i32x8 __attribute__((ext_vector_type(8)));
typedef GAS unsigned gu32;
#define RLX_AGENT __ATOMIC_RELAXED, __HIP_MEMORY_SCOPE_AGENT
#define LDS_WAIT() asm volatile("s_waitcnt lgkmcnt(0)" ::: "memory")
#define VM_WAIT() asm volatile("s_waitcnt vmcnt(0)" ::: "memory")
#define DI __device__ __forceinline__

constexpr int NB = 4, NLAT = 8192, NCTX = 256, DM = 1024;
constexpr int MLAT = NB * NLAT, MCTX = NB * NCTX, MALL = MLAT + MCTX;
constexpr int NZ = 1792;
constexpr int ZU = 0, ZV = 256, ZP = 512, ZQI = 768, ZQ = 1024, ZK = 1536, ZVV = 1664;
constexpr int DFF = 3584, NE = 8;
constexpr float EPS = 1e-6f, LOG2E = 1.4426950408889634f, QSCALE = 0.125f * 1.4426950408889634f;
constexpr int NWAVES = 8, NTHR = 512;
#ifndef FP8_DGU
#define FP8_DGU 1
#endif
#ifndef FP8_DDN
#define FP8_DDN 0
#endif
constexpr int CHUNK_TILES = 64;

constexpr size_t MiB = 1u << 20;
constexpr size_t WS_CTL = 0, CTL_ZERO_BYTES = 1 * MiB;
constexpr size_t WS_MOD = 6 * MiB;
constexpr size_t WS_TAB = 2 * MiB;
constexpr size_t T_G1 = 0, T_G3 = 32768, T_GC = 98304, T_WS = 360448, T_ROPE = 622592;
constexpr size_t WS_RT = 3 * MiB;
constexpr size_t RT_TOK = 0, RT_DST = 327680, RT_GATE = 655360, RT_TILE = 983040, RT_WGCNT = 985088, RT_ROW = 1 * MiB;
constexpr size_t WS_W = 8 * MiB;
constexpr size_t W_IN = 0, W_OUT = 7 * MiB, W_GUD = 11 * MiB, W_DD = 25 * MiB, W_GUE = 32 * MiB, W_DE = 88 * MiB;
constexpr size_t WS_H3 = 8 * MiB + 120 * MiB;
constexpr size_t WS_HCTX = 208 * MiB;
constexpr size_t WS_Y = 212 * MiB;
constexpr size_t WS_R = 278 * MiB;
constexpr size_t R_Z = 0, R_O = 0, R_OC = 116 * MiB, R_T = 182 * MiB, R_ACT = 0, R_F = 116 * MiB;
constexpr size_t ACT0_BACK = 8 * MiB;
constexpr size_t ACT1_BACK = 16 * MiB;
constexpr size_t R_PART0 = 182 * MiB;
constexpr size_t R_PART = 8 * MiB;
static_assert((size_t)MCTX * DFF * 2 <= 8 * MiB && R_PART + (size_t)14 * MCTX * DM * 4 <= 116 * MiB, "partials fit the activation region");
constexpr size_t WS_RT1 = 278 * MiB + 248 * MiB;
constexpr int CAP = 32768;
constexpr size_t RT1_TOK = 0, RT1_DST = 1 * MiB, RT1_GATE = 2 * MiB;
constexpr size_t WS_END = WS_RT1 + 3 * MiB;
static_assert((size_t)MALL * NZ * 2 <= 116 * MiB && (size_t)(CHUNK_TILES * 256) * DFF * 2 <= 116 * MiB && (size_t)(132 * 256) * DFF <= 116 * MiB && (size_t)2 * MALL * DM * 2 <= 132 * MiB, "ws map");
constexpr int CW_TMO = 0, CW_NTILES = 16, CW_CVT = 32, CW_GCNT = 48, CW_DONE = 64, CW_BAR = 4096;

constexpr int RING_BYTES = 131072, LDSCTL_OFF = RING_BYTES, LDS_BYTES = 163840;
constexpr int LC_ROPE = 16384;
constexpr int LC_BAR = 0;
constexpr int LC_TILE = 64;
constexpr int LC_CNT = 64 + 2048;
constexpr int LC_FILL = 64 + 2048 + 128;

DI unsigned cvt_pk_bf16(float lo, float hi) { unsigned r; asm volatile("v_cvt_pk_bf16_f32 %0, %1, %2" : "=v"(r) : "v"(lo), "v"(hi)); return r; }
DI unsigned short f2bf(float f) { return (unsigned short)(cvt_pk_bf16(f, 0.f) & 0xffffu); }
DI float bflo(unsigned w) { return __uint_as_float(w << 16); }
DI float bfhi(unsigned w) { return __uint_as_float(w & 0xffff0000u); }
DI float shx(float v, int mask, int lane) { return __builtin_bit_cast(float, __builtin_amdgcn_ds_bpermute((lane ^ mask) << 2, __builtin_bit_cast(int, v))); }
template <int CTRL> DI float dppx(float x) { return __builtin_bit_cast(float, __builtin_amdgcn_mov_dpp(__builtin_bit_cast(int, x), CTRL, 0xf, 0xf, true)); }
DI float xrow16_sum(float x) {
    auto s = __builtin_amdgcn_permlane16_swap(__float_as_uint(x), __float_as_uint(x), false, false);
    x = __uint_as_float(s[0]) + __uint_as_float(s[1]);
    auto t = __builtin_amdgcn_permlane32_swap(__float_as_uint(x), __float_as_uint(x), false, false);
    return __uint_as_float(t[0]) + __uint_as_float(t[1]);
}
DI float xrow16_max(float x) {
    auto s = __builtin_amdgcn_permlane16_swap(__float_as_uint(x), __float_as_uint(x), false, false);
    x = fmaxf(__uint_as_float(s[0]), __uint_as_float(s[1]));
    auto t = __builtin_amdgcn_permlane32_swap(__float_as_uint(x), __float_as_uint(x), false, false);
    return fmaxf(__uint_as_float(t[0]), __uint_as_float(t[1]));
}
DI float wave_sum(float v, int) {
    v += dppx<0xB1>(v);
    v += dppx<0x4E>(v);
    v += dppx<0x141>(v);
    v += dppx<0x128>(v);
    return xrow16_sum(v);
}
DI float fexp2(float x) { return __builtin_amdgcn_exp2f(x); }
DI float vmax3(float a, float b, float c) { float r; asm("v_max3_f32 %0, %1, %2, %3" : "=v"(r) : "v"(a), "v"(b), "v"(c)); return r; }
DI float frcp(float x) { return __builtin_amdgcn_rcpf(x); }
DI float gelu_tanh(float x) { const float u = 0.7978845608028654f * (x + 0.044715f * x * x * x); return x * frcp(1.0f + fexp2(-2.0f * LOG2E * u)); }
DI float silu_f(float x) { return x * frcp(1.0f + fexp2(-LOG2E * x)); }
DI f32x4 mfma16(bf16x8 a, bf16x8 b, f32x4 c) { return __builtin_amdgcn_mfma_f32_16x16x32_bf16(a, b, c, 0, 0, 0); }
typedef short v4i16_t __attribute__((ext_vector_type(4)));
DI bf16x8 trfrag(const LAS unsigned char* p, int pitch, int lane) {
    const LAS unsigned char* q = p + (8 * (lane >> 4) + ((lane & 15) >> 2)) * pitch + 8 * (lane & 3);
    const v4i16_t lo = __builtin_amdgcn_ds_read_tr16_b64_v4i16((LAS v4i16_t*)q), hi = __builtin_amdgcn_ds_read_tr16_b64_v4i16((LAS v4i16_t*)(q + 4 * pitch));
    return __builtin_shufflevector(lo, hi, 0, 1, 2, 3, 4, 5, 6, 7);
}

#define XB_TMO      128
#define XB_XCNT(j)  (256  + 64 * (j))
#define XB_XSUB(j)  (1280 + 64 * (j))
#define XB_XGEN(j)  (2304 + 64 * (j))
#define XB_TOP      3328
#define XB_TOPGEN   3392
#define XCD_BAR_WORDS 3456
#define XB_SPIN_CAP (1u << 18)
DI unsigned xb_ld(unsigned* p)              { return __hip_atomic_load(p, __ATOMIC_RELAXED, __HIP_MEMORY_SCOPE_AGENT); }
DI unsigned xb_add(unsigned* p, unsigned v) { return __hip_atomic_fetch_add(p, v, __ATOMIC_RELAXED, __HIP_MEMORY_SCOPE_AGENT); }
DI unsigned xb_xcc_id() { return (unsigned)__builtin_amdgcn_s_getreg((3 << 11) | 20) & 0xFu; }
#define XB_SPIN(cond, bar) do { unsigned _sp = 0; while (cond) { __builtin_amdgcn_s_sleep(1); \
    if ((++_sp & 255u) == 0u) { if (xb_ld(&(bar)[XB_TMO])) break; if (_sp > XB_SPIN_CAP) { atomicAdd(&(bar)[XB_TMO], 1u); break; } } } } while (0)
struct XcdBarrier { unsigned* bar; unsigned x; volatile LAS unsigned* st; };
DI XcdBarrier xcd_barrier_post(unsigned* bar, volatile LAS unsigned* st) {
    XcdBarrier b; b.bar = bar; b.x = xb_xcc_id(); b.st = st;
    if (threadIdx.x == 0) (void)xb_add(&bar[XB_XCNT(b.x)], 1u);
    return b;
}
DI void xcd_barrier_complete(unsigned* bar, unsigned x, unsigned& nloc, unsigned& nx) {
    const unsigned G = gridDim.x * gridDim.y * gridDim.z;
    unsigned sum, cnt, mine, sp = 0u;
    for (;;) {
        sum = 0u; cnt = 0u; mine = 0u;
#pragma unroll
        for (unsigned j = 0; j < 16; ++j) { const unsigned c = xb_ld(&bar[XB_XCNT(j)]); sum += c; cnt += (c > 0u) ? 1u : 0u; mine = (j == x) ? c : mine; }
        if (sum == G) break;
        __builtin_amdgcn_s_sleep(1);
        if ((++sp & 255u) == 0u) { if (xb_ld(&bar[XB_TMO])) break; if (sp > XB_SPIN_CAP) { atomicAdd(&bar[XB_TMO], 1u); break; } }
    }
    nloc = mine > 0u ? mine : 1u; nx = cnt > 0u ? cnt : 1u;
}
DI void xcd_barrier(const XcdBarrier& b, const bool leader) {
    asm volatile("s_waitcnt vmcnt(0)" ::: "memory");
    __syncthreads();
    if (leader) {
        unsigned* bar = b.bar;
        __builtin_amdgcn_s_waitcnt(0);
        unsigned nloc = b.st[0], nx = b.st[1];
        if (nloc == 0u) { xcd_barrier_complete(bar, b.x, nloc, nx); b.st[0] = nloc; b.st[1] = nx; }
        const unsigned old = xb_add(&bar[XB_XSUB(b.x)], 1u);
        const unsigned gen = old / nloc;
        if (old + 1u == (gen + 1u) * nloc) {
            __builtin_amdgcn_fence(__ATOMIC_RELEASE, "agent");
            asm volatile("s_waitcnt vmcnt(0)" ::: "memory");
            const unsigned og = xb_add(&bar[XB_TOP], 1u);
            const unsigned tg = og / nx;
            if (og + 1u == (tg + 1u) * nx) xb_add(&bar[XB_TOPGEN], 1u);
            else XB_SPIN(xb_ld(&bar[XB_TOPGEN]) == tg, bar);
            __builtin_amdgcn_fence(__ATOMIC_ACQUIRE, "agent");
            xb_add(&bar[XB_XGEN(b.x)], 1u);
            asm volatile("s_waitcnt vmcnt(0)" ::: "memory");
        } else {
            XB_SPIN(xb_ld(&bar[XB_XGEN(b.x)]) == gen, bar);
            __builtin_amdgcn_fence(__ATOMIC_ACQUIRE, "agent");
            asm volatile("s_waitcnt vmcnt(0)" ::: "memory");
        }
    }
    __syncthreads();
}

namespace pg8 {
typedef unsigned short bf16_t;
constexpr int BM = 256, BK = 64, HALF = 128, HTB = HALF * BK * 2, STAGE_BYTES = 8 * HTB;
DI int lds_byte(int r, int c) { const int st = (r >> 4) * 2 + (c >> 5), rr = r & 15, cc = c & 31, ob = rr * 64 + cc * 2; return st * 1024 + (ob ^ (((ob >> 9) & 1) << 5)); }
DI void stage_rc(int b, int& R, int& C) { const int st = b / 1024, sb = b % 1024, swz = sb ^ (((sb >> 9) & 1) << 5); R = (st >> 1) * 16 + swz / 64; C = (st & 1) * 32 + (swz % 64) / 2; }
DI int perm32(int rho) { const int n = rho >> 4, i = rho & 15; return 8 * (i >> 2) + 4 * n + (i & 3); }

struct Unit { int pm, pn; int arow; unsigned boff; int dup; int slot0; unsigned kofs; int ks; };

DI void static_map(int wgid, int nM, int nN, int& pm, int& pn) {
    const int nwg = nM * nN; const int q = nwg / 8, r = nwg % 8, xcd = wgid % 8, off = wgid / 8;
    wgid = (xcd < r ? xcd * (q + 1) : r * (q + 1) + (xcd - r) * q) + off;
    const int nig = 8 * nN, gid = wgid / nig, fm = gid * 8, gsz = (nM - fm) < 8 ? (nM - fm) : 8;
    pm = fm + ((wgid % nig) % gsz); pn = (wgid % nig) / gsz;
}

template <class Epi, class Sched, bool GATHER, bool FP8>
DI void gemm_phase(LAS unsigned char* lds, const unsigned char* Abase, const int rowbytes, const Sched& S, const Epi& E, const int tid, const int ntk = 0) {
    const int wid = __builtin_amdgcn_readfirstlane(tid >> 6), lane = tid & 63, wr = wid >> 2, wc = wid & 3, fr = lane & 15, fq = lane >> 4;
    const int nt = ntk ? ntk : rowbytes / 128;
    unsigned voffA, voffB, cofs; int Rr[2];
    { int R, C; stage_rc(tid * 16, R, C); const int Rb = (R & ~31) + perm32(R & 31);
      voffA = (unsigned)(R * rowbytes + C * 2); voffB = (unsigned)(Rb * rowbytes + C * 2); cofs = (unsigned)C * 2u; Rr[0] = R; Rr[1] = R + 64; }
    const unsigned kstep = (unsigned)(BK * 2);
    const unsigned hstep = (unsigned)HALF * (unsigned)rowbytes;
    const unsigned istep = 64u * (unsigned)rowbytes;
    const unsigned rowb = (unsigned)rowbytes;
    const unsigned ldsw = (unsigned)wid * 1024u;
    const int aoff = lds_byte(wr * 64 + fr, fq * 8), boff = lds_byte(wc * 32 + fr, fq * 8);
    const __amdgpu_buffer_rsrc_t rA = __builtin_amdgcn_make_buffer_rsrc((void*)Abase, (short)0, 0x7fffffff, 0x00020000);
    const __amdgpu_buffer_rsrc_t rB = __builtin_amdgcn_make_buffer_rsrc((void*)S.wbase(), (short)0, 0x7fffffff, 0x00020000);
#define PG8_SA(b, h) (((b) * 2 + (h)) * HTB)
#define PG8_SB(b, h) ((4 + (b) * 2 + (h)) * HTB)
#define PG8_DMA(rs, ldsoff, vo, so) __builtin_amdgcn_raw_ptr_buffer_load_lds(rs, (LAS void*)(lds + (ldsoff)), 16, (int)(vo), (int)(so), 0, 0)
#define PG8_STAGE(bufoff, so) do { PG8_DMA(rB, (bufoff) + ldsw, voffB, (so)); PG8_DMA(rB, (bufoff) + ldsw + 8192, voffB, (so) + istep); } while (0)
#define PG8_STAGE_A(bufoff, h, kb, nx) do { if constexpr (GATHER) { PG8_DMA(rA, (bufoff) + ldsw, aoC[h][0], (kb)); PG8_DMA(rA, (bufoff) + ldsw + 8192, aoC[h][1], (kb)); } \
        else { const unsigned so_ = ((nx) ? nA : cA) + (unsigned)(h) * hstep + (kb); PG8_DMA(rA, (bufoff) + ldsw, voffA, so_); PG8_DMA(rA, (bufoff) + ldsw + 8192, voffA, so_ + istep); } } while (0)
#define PG8_LDA(dst, b, h) do { _Pragma("unroll") for (int m = 0; m < 4; ++m) { const u32x4 lo_ = *(const LAS u32x4*)(lds + PG8_SA(b, h) + aoff + m * 2048), hi_ = *(const LAS u32x4*)(lds + PG8_SA(b, h) + aoff + m * 2048 + 1024); \
        dst[m] = (i32x8){(int)lo_.x, (int)lo_.y, (int)lo_.z, (int)lo_.w, (int)hi_.x, (int)hi_.y, (int)hi_.z, (int)hi_.w}; } } while (0)
#define PG8_LDB(dst, b, h) do { _Pragma("unroll") for (int n = 0; n < 2; ++n) { const u32x4 lo_ = *(const LAS u32x4*)(lds + PG8_SB(b, h) + boff + n * 2048), hi_ = *(const LAS u32x4*)(lds + PG8_SB(b, h) + boff + n * 2048 + 1024); \
        dst[n] = (i32x8){(int)lo_.x, (int)lo_.y, (int)lo_.z, (int)lo_.w, (int)hi_.x, (int)hi_.y, (int)hi_.z, (int)hi_.w}; } } while (0)
#define PG8_HALF(v, k) __builtin_bit_cast(bf16x8, __builtin_shufflevector(v, v, 4 * (k), 4 * (k) + 1, 4 * (k) + 2, 4 * (k) + 3))
#define PG8_MMA(ai, bj, At, Bt) do { __builtin_amdgcn_s_setprio(1); if constexpr (FP8) { _Pragma("unroll") for (int m = 0; m < 4; ++m) _Pragma("unroll") for (int n = 0; n < 2; ++n) \
        acc[ai][bj][m][n] = __builtin_amdgcn_mfma_scale_f32_16x16x128_f8f6f4(Bt[n], At[m], acc[ai][bj][m][n], 0, 0, 0, 0, 0, 0); } \
    else { _Pragma("unroll") for (int m = 0; m < 4; ++m) _Pragma("unroll") for (int n = 0; n < 2; ++n) { \
        acc[ai][bj][m][n] = __builtin_amdgcn_mfma_f32_16x16x32_bf16(PG8_HALF(Bt[n], 0), PG8_HALF(At[m], 0), acc[ai][bj][m][n], 0, 0, 0); \
        acc[ai][bj][m][n] = __builtin_amdgcn_mfma_f32_16x16x32_bf16(PG8_HALF(Bt[n], 1), PG8_HALF(At[m], 1), acc[ai][bj][m][n], 0, 0, 0); } } __builtin_amdgcn_s_setprio(0); } while (0)
#define PG8_WAIT_V(n) asm volatile("s_waitcnt vmcnt(" #n ")" ::: "memory")
#define PG8_WAIT_L(n) asm volatile("s_waitcnt lgkmcnt(" #n ")" ::: "memory")
#define PG8_BAR __builtin_amdgcn_s_barrier()
#define PG8_SCHED __builtin_amdgcn_sched_barrier(0)
    Unit cur, nxt; int ui = 0;
    if (!S.next(0, cur)) return;
    f32x4 acc[2][2][4][2];
#pragma unroll
    for (int a = 0; a < 2; ++a)
#pragma unroll
        for (int b = 0; b < 2; ++b)
#pragma unroll
            for (int m = 0; m < 4; ++m)
#pragma unroll
                for (int n = 0; n < 2; ++n) acc[a][b][m][n] = (f32x4){0.f, 0.f, 0.f, 0.f};
    i32x8 At[4], B0[2], B1[2];
    unsigned aoC[2][2];
    LAS unsigned short* gidx = (LAS unsigned short*)(lds + 131072 + 4096);
    unsigned cA = (unsigned)cur.arow * rowb + cur.kofs, cB = cur.boff + cur.kofs;
    if constexpr (GATHER) {
        Unit pu;
        for (int i = 0; i < 16 && S.next(i, pu); ++i) if (tid < 256) gidx[i * 256 + tid] = (unsigned short)S.rowidx(pu.arow + tid);
        __syncthreads();
    }
#pragma unroll
    for (int h = 0; h < 2; ++h)
#pragma unroll
        for (int i = 0; i < 2; ++i) aoC[h][i] = GATHER ? (unsigned)gidx[128 * h + Rr[i]] * rowb + cofs : 0u;
    unsigned nA = cA, nB = cB;
    PG8_STAGE(PG8_SB(0, 0), cB); PG8_STAGE(PG8_SB(0, 1), cB + hstep); PG8_STAGE_A(PG8_SA(0, 0), 0, 0u, false); PG8_STAGE_A(PG8_SA(0, 1), 1, 0u, false);
    if (wr == 1) PG8_BAR;
    PG8_WAIT_V(2); PG8_BAR;
    PG8_STAGE(PG8_SB(1, 0), cB + kstep); PG8_STAGE_A(PG8_SA(1, 0), 0, kstep, false); PG8_STAGE(PG8_SB(1, 1), cB + hstep + kstep);
    PG8_WAIT_V(6); PG8_BAR;
    for (;;) {
        const bool has_next = S.next(ui + 1, nxt);
        nA = has_next ? (unsigned)nxt.arow * rowb + nxt.kofs : cA; nB = has_next ? nxt.boff + nxt.kofs : cB;
#pragma unroll 1
        for (int t = 0; t < nt; t += 2) {
            const bool last = (t == nt - 2);
            const unsigned kb1 = (unsigned)(t + 1) * kstep, kb2 = last ? 0u : (unsigned)(t + 2) * kstep, kb3 = kb2 + kstep;
            const unsigned b2 = (last ? nB : cB) + kb2, b3 = b2 + kstep;
            PG8_LDB(B0, 0, 0); PG8_LDB(B1, 0, 1); PG8_SCHED; PG8_LDA(At, 0, 0); PG8_STAGE_A(PG8_SA(1, 1), 1, kb1, false);
            PG8_WAIT_V(8); PG8_WAIT_L(0); PG8_BAR; PG8_MMA(0, 0, At, B0); PG8_MMA(0, 1, At, B1); PG8_BAR; PG8_SCHED;
            if constexpr (GATHER) { if (last && has_next) { const LAS unsigned short* gi = gidx + (ui + 1) * 256;
                aoC[0][0] = (unsigned)gi[Rr[0]] * rowb + cofs; aoC[0][1] = (unsigned)gi[Rr[1]] * rowb + cofs; aoC[1][0] = (unsigned)gi[128 + Rr[0]] * rowb + cofs; aoC[1][1] = (unsigned)gi[128 + Rr[1]] * rowb + cofs; } }
            PG8_LDA(At, 0, 1); PG8_STAGE(PG8_SB(0, 0), b2); PG8_STAGE(PG8_SB(0, 1), b2 + hstep); PG8_STAGE_A(PG8_SA(0, 0), 0, kb2, last);
            PG8_WAIT_V(8); PG8_WAIT_L(0); PG8_BAR; PG8_MMA(1, 0, At, B0); PG8_MMA(1, 1, At, B1); PG8_BAR; PG8_SCHED;
            PG8_LDB(B0, 1, 0); PG8_LDB(B1, 1, 1); PG8_SCHED; PG8_LDA(At, 1, 0); PG8_STAGE_A(PG8_SA(0, 1), 1, kb2, last);
            PG8_WAIT_V(8); PG8_WAIT_L(0); PG8_BAR; PG8_MMA(0, 0, At, B0); PG8_MMA(0, 1, At, B1); PG8_BAR; PG8_SCHED;
            PG8_LDA(At, 1, 1); PG8_STAGE(PG8_SB(1, 0), b3); PG8_STAGE(PG8_SB(1, 1), b3 + hstep); PG8_STAGE_A(PG8_SA(1, 0), 0, kb3, last);
            PG8_WAIT_V(8); PG8_WAIT_L(0); PG8_BAR; PG8_MMA(1, 0, At, B0); PG8_MMA(1, 1, At, B1); PG8_BAR; PG8_SCHED;
        }
        if (wr == 0) PG8_BAR;
        if (!cur.dup) { int te; asm volatile("v_mbcnt_lo_u32_b32 %0, -1, 0\n\tv_mbcnt_hi_u32_b32 %0, -1, %0" : "=v"(te));
          for (int rep = 0; rep < REP(30); ++rep) E(acc, cur, wr, wc, te & 15, (te & 63) >> 4); }
        if (!has_next) break;
#pragma unroll
        for (int a = 0; a < 2; ++a)
#pragma unroll
            for (int b = 0; b < 2; ++b)
#pragma unroll
                for (int m = 0; m < 4; ++m)
#pragma unroll
                    for (int n = 0; n < 2; ++n) acc[a][b][m][n] = (f32x4){0.f, 0.f, 0.f, 0.f};
        cur = nxt; cA = nA; cB = nB; ++ui;
        if (wr == 1) PG8_BAR;
    }
    PG8_WAIT_V(0);
    PG8_BAR;
#undef PG8_SA
#undef PG8_SB
#undef PG8_STAGE
#undef PG8_DMA
#undef PG8_STAGE_A
#undef PG8_LDA
#undef PG8_LDB
#undef PG8_MMA
#undef PG8_HALF
#undef PG8_WAIT_V
#undef PG8_WAIT_L
#undef PG8_BAR
#undef PG8_SCHED
}

struct SchedIn {
    int G, c, nctx; bool ctx_all; const char* Bt; int rb;
    DI bool next(int i0, Unit& u) const {
        const int i = KDUP_IN ? (i0 >> 1) : i0; u.dup = KDUP_IN ? !(i0 & 1) : 0;
        const long Lx = (long)i * G + c; int pm, pn;
        if (Lx < 896) static_map((int)Lx, 128, 7, pm, pn);
        else { const int j = (int)(Lx - 896); if (j >= nctx) return false; if (ctx_all) { pm = 128 + j / 7; pn = j % 7; } else { pm = 128 + j; pn = 6; } }
        u.pm = pm; u.pn = pn; u.arow = pm * 256; u.boff = (unsigned)(pn * 256 * rb); u.kofs = 0u; u.ks = 0; return true;
    }
    DI int rowidx(int) const { return 0; }
    DI const void* wbase() const { return Bt; }
};
struct SchedPlain {
    int G, c, nM, nN; const char* Bt; int rb;
    DI bool next(int i, Unit& u) const {
        u.dup = 0; const long Lx = (long)i * G + c; if (Lx >= (long)nM * nN) return false; int pm, pn; static_map((int)Lx, nM, nN, pm, pn);
        u.pm = pm; u.pn = pn; u.arow = pm * 256; u.boff = (unsigned)(pn * 256 * rb); u.kofs = 0u; u.ks = 0; return true;
    }
    DI int rowidx(int) const { return 0; }
    DI const void* wbase() const { return Bt; }
};
struct SchedGrp {
    int G, c, t0, nM, nN; const char* W; size_t wstride; int rb; const LAS int* tile_e; const int* tokmap; bool gather; bool kdup;
    DI bool next(int i0, Unit& u) const {
        const int i = (KDUP_GRP && kdup) ? (i0 >> 1) : i0; u.dup = (KDUP_GRP && kdup) ? !(i0 & 1) : 0;
        const long Lx = (long)i * G + c; if (Lx >= (long)nM * nN) return false; int pm, pn; static_map((int)Lx, nM, nN, pm, pn);
        const int te = __builtin_amdgcn_readfirstlane(tile_e[t0 + pm]);
        const int e = te >> 24; u.slot0 = te & 0xffffff;
        u.pm = t0 + pm; u.pn = pn; u.arow = gather ? u.slot0 : pm * 256; u.boff = (unsigned)e * (unsigned)wstride + (unsigned)(pn * 256 * rb); u.kofs = 0u; u.ks = 0; return true;
    }
    DI int rowidx(int slot) const { return tokmap[slot]; }
    DI const void* wbase() const { return W; }
};

struct SchedSplit {
    int G, c, nM, nN, S, ntk; const char* Bt; int rb;
    DI bool next(int i, Unit& u) const {
        const long Lx = (long)i * G + c; if (Lx >= (long)nM * nN * S) return false;
        const int ks = (int)(Lx % S), rest = (int)(Lx / S), pn = rest % nN, pm = rest / nN;
        u.pm = pm; u.pn = pn; u.arow = pm * 256; u.boff = (unsigned)(pn * 256 * rb); u.kofs = (unsigned)(ks * ntk * 128); u.ks = ks; u.dup = 0; u.slot0 = 0; return true;
    }
    DI int rowidx(int) const { return 0; }
    DI const void* wbase() const { return Bt; }
};
#ifndef EPI_NT
#define EPI_NT 0
#endif
#if EPI_NT
#define EPI_ST(p, v) __builtin_nontemporal_store((v), (p))
#else
#define EPI_ST(p, v) (*(p) = (v))
#endif
typedef f32x4 Acc[2][2][4][2];
DI u32x4 tr4(u32x4 w, int te) { const int src = (((te & 3) << 4) | (te >> 2)) << 2; u32x4 r;
    r.x = (unsigned)__builtin_amdgcn_ds_bpermute(src, (int)w.x); r.y = (unsigned)__builtin_amdgcn_ds_bpermute(src, (int)w.y); r.z = (unsigned)__builtin_amdgcn_ds_bpermute(src, (int)w.z); r.w = (unsigned)__builtin_amdgcn_ds_bpermute(src, (int)w.w); return r; }
struct EpiZ {
    bf16_t* Z; const LAS float* rc; const LAS float* rs;
    DI void operator()(const Acc& acc, const Unit& u, int wr, int wc, int fr, int fq) const {
        const int pn = u.pn, row0 = u.pm * 256 + wr * 64 + fr, te = fq * 16 + fr;
        const bool lat = u.pm < 128;
        bf16_t* rowp0 = Z + (size_t)(u.pm * 256 + wr * 64 + (te >> 2)) * NZ + pn * 256 + wc * 32 + 8 * (te & 3);
#pragma unroll
        for (int ai = 0; ai < 2; ++ai)
#pragma unroll
            for (int m = 0; m < 4; ++m) {
                const int row = row0 + ai * 128 + m * 16; bf16_t* rowp = rowp0 + (size_t)(ai * 128 + m * 16) * NZ;
#pragma unroll
                for (int bj = 0; bj < 2; ++bj) {
                    f32x4 v0 = acc[ai][bj][m][0], v1 = acc[ai][bj][m][1];
                    if (pn < 2) {
#pragma unroll
                        for (int j = 0; j < 4; ++j) { v0[j] = gelu_tanh(v0[j]); v1[j] = gelu_tanh(v1[j]); }
                    } else if (pn >= 4 && !(pn == 6 && bj == 1)) {
                        if (lat) {
                            const int n = row & (NLAT - 1); const int pos = (wc & 1) ? (n & 63) : (n >> 6); const int fb = 8 * (fq & 1);
                            const f32x4 c0 = *(const LAS f32x4*)(rc + pos * 16 + fb), c1 = *(const LAS f32x4*)(rc + pos * 16 + fb + 4);
                            const f32x4 s0 = *(const LAS f32x4*)(rs + pos * 16 + fb), s1 = *(const LAS f32x4*)(rs + pos * 16 + fb + 4);
                            const float sg = (fq >> 1) ? 1.f : -1.f;
                            f32x4 p0, p1;
#pragma unroll
                            for (int j = 0; j < 4; ++j) { p0[j] = shx(v0[j], 32, fq * 16 + fr); p1[j] = shx(v1[j], 32, fq * 16 + fr); }
                            v0 = v0 * c0 + sg * p0 * s0; v1 = v1 * c1 + sg * p1 * s1;
                        }
                        if (pn < 6) { v0 = v0 * QSCALE; v1 = v1 * QSCALE; }
                    }
                    u32x4 w; w.x = cvt_pk_bf16(v0[0], v0[1]); w.y = cvt_pk_bf16(v0[2], v0[3]); w.z = cvt_pk_bf16(v1[0], v1[1]); w.w = cvt_pk_bf16(v1[2], v1[3]);
                    EPI_ST((u32x4*)(rowp + bj * 128), tr4(w, te));
                }
            }
    }
};
struct EpiO {
    bf16_t* O; int ldc;
    DI void operator()(const Acc& acc, const Unit& u, int wr, int wc, int fr, int fq) const {
        const int te = fq * 16 + fr, row0 = u.pm * 256 + wr * 64 + (te >> 2), colb = u.pn * 256 + wc * 32 + 8 * (te & 3);
#pragma unroll
        for (int ai = 0; ai < 2; ++ai)
#pragma unroll
            for (int m = 0; m < 4; ++m) { bf16_t* rowp = O + (size_t)(row0 + ai * 128 + m * 16) * ldc + colb;
#pragma unroll
                for (int bj = 0; bj < 2; ++bj) { const f32x4 v0 = acc[ai][bj][m][0], v1 = acc[ai][bj][m][1];
                    u32x4 w; w.x = cvt_pk_bf16(v0[0], v0[1]); w.y = cvt_pk_bf16(v0[2], v0[3]); w.z = cvt_pk_bf16(v1[0], v1[1]); w.w = cvt_pk_bf16(v1[2], v1[3]);
                    EPI_ST((u32x4*)(rowp + bj * 128), tr4(w, te)); } }
    }
};
DI f32x2 swiglu2(f32x2 g, f32x2 u, float c1, float c0, float k0) {
    const f32x2 t = g * c1 + c0; f32x2 e; e.x = fexp2(t.x); e.y = fexp2(t.y);
    const f32x2 d = e + k0; f32x2 r; r.x = frcp(d.x); r.y = frcp(d.y);
    return (g * u) * r;
}
DI f32x2 swiglu2d(f32x2 g, f32x2 u) {
    f32x2 e; e.x = fexp2(-g.x); e.y = fexp2(-g.y);
    const f32x2 d = e * LOG2E + LOG2E; f32x2 r; r.x = frcp(d.x); r.y = frcp(d.y);
    return (g * u) * r;
}
struct EpiGU {
    bf16_t* ACT; int t0;
    DI void operator()(const Acc& acc, const Unit& u, int wr, int wc, int fr, int fq) const {
        const int row0 = (u.pm - t0) * 256 + wr * 64 + fr, colb = u.pn * 128 + wc * 32 + 8 * fq;
#pragma unroll
        for (int ai = 0; ai < 2; ++ai)
#pragma unroll
            for (int m = 0; m < 4; ++m) { bf16_t* rowp = ACT + (size_t)(row0 + ai * 128 + m * 16) * DFF + colb;
                const f32x4 g0 = acc[ai][0][m][0], g1 = acc[ai][0][m][1], u0 = acc[ai][1][m][0], u1 = acc[ai][1][m][1];
                const f32x2 a = swiglu2d((f32x2){g0[0], g0[1]}, (f32x2){u0[0], u0[1]}), b = swiglu2d((f32x2){g0[2], g0[3]}, (f32x2){u0[2], u0[3]});
                const f32x2 c = swiglu2d((f32x2){g1[0], g1[1]}, (f32x2){u1[0], u1[1]}), d = swiglu2d((f32x2){g1[2], g1[3]}, (f32x2){u1[2], u1[3]});
                u32x4 w; w.x = cvt_pk_bf16(a.x, a.y); w.y = cvt_pk_bf16(b.x, b.y); w.z = cvt_pk_bf16(c.x, c.y); w.w = cvt_pk_bf16(d.x, d.y);
                EPI_ST((u32x4*)rowp, w); }
    }
};
struct EpiPart {
    float* P; int rows, ldc;
    DI void operator()(const Acc& acc, const Unit& u, int wr, int wc, int fr, int fq) const {
        const int te = fq * 16 + fr, row0 = u.pm * 256 + wr * 64 + (te >> 2), colb = u.pn * 256 + wc * 32 + 8 * (te & 3);
        float* base = P + (size_t)u.ks * rows * ldc;
#pragma unroll
        for (int ai = 0; ai < 2; ++ai)
#pragma unroll
            for (int m = 0; m < 4; ++m) { float* rowp = base + (size_t)(row0 + ai * 128 + m * 16) * ldc + colb;
#pragma unroll
                for (int bj = 0; bj < 2; ++bj) { *(u32x4*)(rowp + bj * 128) = tr4(__builtin_bit_cast(u32x4, acc[ai][bj][m][0]), te); *(u32x4*)(rowp + bj * 128 + 4) = tr4(__builtin_bit_cast(u32x4, acc[ai][bj][m][1]), te); } }
    }
};
struct EpiDown {
    bf16_t* F; const int* dstmap; const float* gate;
    DI void operator()(const Acc& acc, const Unit& u, int wr, int wc, int fr, int fq) const {
        const int te = fq * 16 + fr, slot0 = u.slot0 + wr * 64 + fr, slot0s = u.slot0 + wr * 64 + (te >> 2), colb = u.pn * 256 + wc * 32 + 8 * (te & 3);
        int dstv[2][4]; float gtv[2][4];
#pragma unroll
        for (int ai = 0; ai < 2; ++ai)
#pragma unroll
            for (int m = 0; m < 4; ++m) { dstv[ai][m] = dstmap[slot0s + ai * 128 + m * 16]; gtv[ai][m] = gate[slot0 + ai * 128 + m * 16]; }
#pragma unroll
        for (int ai = 0; ai < 2; ++ai)
#pragma unroll
            for (int m = 0; m < 4; ++m) { const int dst = dstv[ai][m]; const float gt = gtv[ai][m];
                bf16_t* rowp = F + (size_t)dst * DM + colb;
#pragma unroll
                for (int bj = 0; bj < 2; ++bj) { const f32x4 v0 = acc[ai][bj][m][0] * gt, v1 = acc[ai][bj][m][1] * gt;
                    u32x4 w; w.x = cvt_pk_bf16(v0[0], v0[1]); w.y = cvt_pk_bf16(v0[2], v0[3]); w.z = cvt_pk_bf16(v1[0], v1[1]); w.w = cvt_pk_bf16(v1[2], v1[3]);
                    const u32x4 wt = tr4(w, te);
                    if (dst >= 0) EPI_ST((u32x4*)(rowp + bj * 128), wt); } }
    }
};

constexpr float S8_Y = 16.0f, S8_W = 256.0f, S8_ACT = 8.0f, S8_F = 16.0f;
DI float clamp8(float v) { return __builtin_amdgcn_fmed3f(v, -448.0f, 448.0f); }
DI unsigned pk_fp8x4(float a, float b, float c, float d) { int w0; asm volatile("" : "=v"(w0));
    int w = __builtin_amdgcn_cvt_pk_fp8_f32(clamp8(a), clamp8(b), w0, false); w = __builtin_amdgcn_cvt_pk_fp8_f32(clamp8(c), clamp8(d), w, true); return (unsigned)w; }
struct EpiGU8 {
    unsigned char* ACT; int t0;
    DI void operator()(const Acc& acc, const Unit& u, int wr, int wc, int fr, int fq) const {
        constexpr float us = 1.0f / (S8_Y * S8_W), c1 = -us * LOG2E, c0 = 21.0f, k0 = 2097152.0f;
        static_assert(us * us * S8_ACT * k0 == 1.0f, "k0 = 1 / c2, c0 = log2 k0");
        const int te = fq * 16 + fr, rho = te >> 1, hf = te & 1, srcl = (((2 * hf + (rho >> 4)) << 4) | (rho & 15)) << 2;
        unsigned char* base = ACT + (size_t)((u.pm - t0) * 256 + wr * 64 + rho) * DFF + u.pn * 128 + wc * 32 + 16 * hf;
#pragma unroll
        for (int ai = 0; ai < 2; ++ai)
#pragma unroll
            for (int mp = 0; mp < 4; mp += 2) { u32x2 w[2];
#pragma unroll
                for (int k = 0; k < 2; ++k) { const int m = mp + k;
                    const f32x4 g0 = acc[ai][0][m][0], g1 = acc[ai][0][m][1], u0 = acc[ai][1][m][0], u1 = acc[ai][1][m][1];
                    const f32x2 a = swiglu2((f32x2){g0[0], g0[1]}, (f32x2){u0[0], u0[1]}, c1, c0, k0), b = swiglu2((f32x2){g0[2], g0[3]}, (f32x2){u0[2], u0[3]}, c1, c0, k0);
                    const f32x2 c = swiglu2((f32x2){g1[0], g1[1]}, (f32x2){u1[0], u1[1]}, c1, c0, k0), d = swiglu2((f32x2){g1[2], g1[3]}, (f32x2){u1[2], u1[3]}, c1, c0, k0);
                    w[k].x = pk_fp8x4(a.x, a.y, b.x, b.y); w[k].y = pk_fp8x4(c.x, c.y, d.x, d.y); }
                const auto rx = __builtin_amdgcn_permlane16_swap(w[0].x, w[1].x, false, false), ry = __builtin_amdgcn_permlane16_swap(w[0].y, w[1].y, false, false);
                u32x4 o; o.x = (unsigned)__builtin_amdgcn_ds_bpermute(srcl, (int)rx[0]); o.y = (unsigned)__builtin_amdgcn_ds_bpermute(srcl, (int)ry[0]); o.z = (unsigned)__builtin_amdgcn_ds_bpermute(srcl, (int)rx[1]); o.w = (unsigned)__builtin_amdgcn_ds_bpermute(srcl, (int)ry[1]);
                EPI_ST((u32x4*)(base + (size_t)(ai * 128 + mp * 16) * DFF), o); }
    }
};
struct EpiGUm {
    bf16_t* ACT; int t0;
    DI void operator()(const Acc& acc, const Unit& u, int wr, int wc, int fr, int fq) const {
        const int te = fq * 16 + fr, row0 = (u.pm - t0) * 256 + wr * 64 + (te >> 2), colb = u.pn * 128 + wc * 32 + 8 * (te & 3);
        constexpr float us = 1.0f / (S8_Y * S8_W), c1 = -us * LOG2E, c0 = 24.0f, k0 = 16777216.0f;
        static_assert(us * us * k0 == 1.0f, "k0 = 1 / us^2, c0 = log2 k0");
#pragma unroll
        for (int ai = 0; ai < 2; ++ai)
#pragma unroll
            for (int m = 0; m < 4; ++m) { bf16_t* rowp = ACT + (size_t)(row0 + ai * 128 + m * 16) * DFF + colb;
                const f32x4 g0 = acc[ai][0][m][0], g1 = acc[ai][0][m][1], u0 = acc[ai][1][m][0], u1 = acc[ai][1][m][1];
                const f32x2 a = swiglu2((f32x2){g0[0], g0[1]}, (f32x2){u0[0], u0[1]}, c1, c0, k0), b = swiglu2((f32x2){g0[2], g0[3]}, (f32x2){u0[2], u0[3]}, c1, c0, k0);
                const f32x2 c = swiglu2((f32x2){g1[0], g1[1]}, (f32x2){u1[0], u1[1]}, c1, c0, k0), d = swiglu2((f32x2){g1[2], g1[3]}, (f32x2){u1[2], u1[3]}, c1, c0, k0);
                u32x4 w; w.x = cvt_pk_bf16(a.x, a.y); w.y = cvt_pk_bf16(b.x, b.y); w.z = cvt_pk_bf16(c.x, c.y); w.w = cvt_pk_bf16(d.x, d.y);
                EPI_ST((u32x4*)rowp, tr4(w, te)); }
    }
};
struct EpiDown8 {
    bf16_t* F; const int* dstmap; const float* gate;
    DI void operator()(const Acc& acc, const Unit& u, int wr, int wc, int fr, int fq) const {
        static_assert(!FP8_DDN, "the dense layer's norm_end reads bf16 F rows");
        const int te = fq * 16 + fr, slot0 = u.slot0 + wr * 64 + fr, slot0s = u.slot0 + wr * 64 + (te >> 2), colb = u.pn * 256 + wc * 32 + 8 * (te & 3);
        constexpr float us = S8_F / (S8_ACT * S8_W);
        const int trs = (((te & 3) << 4) | (te >> 2)) << 2;
        int dstv[2][4]; float gtv[2][4];
#pragma unroll
        for (int ai = 0; ai < 2; ++ai)
#pragma unroll
            for (int m = 0; m < 4; ++m) { dstv[ai][m] = dstmap[slot0s + ai * 128 + m * 16]; gtv[ai][m] = gate[slot0 + ai * 128 + m * 16] * us; }
#pragma unroll
        for (int ai = 0; ai < 2; ++ai)
#pragma unroll
            for (int m = 0; m < 4; ++m) { const int dst = dstv[ai][m]; const float gt = gtv[ai][m];
                unsigned char* rowp = (unsigned char*)F + (size_t)dst * DM + colb;
#pragma unroll
                for (int bj = 0; bj < 2; ++bj) { const f32x4 v0 = acc[ai][bj][m][0] * gt, v1 = acc[ai][bj][m][1] * gt;
                    u32x2 w; w.x = (unsigned)__builtin_amdgcn_ds_bpermute(trs, (int)pk_fp8x4(v0[0], v0[1], v0[2], v0[3])); w.y = (unsigned)__builtin_amdgcn_ds_bpermute(trs, (int)pk_fp8x4(v1[0], v1[1], v1[2], v1[3]));
                    if (dst >= 0) *(u32x2*)(rowp + bj * 128) = w; } }
    }
};
}

struct Args { const float* in[25]; float* out; unsigned char* ws; int ph_lo, ph_hi; };
enum { I_X = 0, I_C, I_CTX, I_CCTX, I_WADA, I_BADA, I_GMPRE, I_GMPOST, I_GFPRE, I_GFPOST, I_WIN, I_WS, I_BS, I_GV, I_WF, I_SINK, I_WOUT, I_WGD, I_WUD, I_WDD, I_WR, I_BR, I_WGE, I_WUE, I_WDE };

struct TJob { const float* src; bf16* dst; int K, Nsrc, ncol0, drow0, kb, f8; float sc; };
constexpr int TJ_IN_A = 256, TJ_IN_B = 384, TJ_OUT = 512, TJ_D = 896, TJ_E = 7168;
constexpr int TJ_TOTAL = TJ_IN_A + TJ_IN_B + TJ_OUT + 3 * TJ_D + 3 * TJ_E;
constexpr int TJ_NOW = TJ_IN_A + TJ_IN_B + TJ_OUT + 3 * TJ_D;
constexpr int TJ_DEF = TJ_TOTAL - TJ_NOW, TJ_BATCH = 16;
static_assert(TJ_DEF % TJ_BATCH == 0, "deferred queue is dealt in whole batches");
DI TJob tj_decode(const Args& a, bf16* WB, int it) {
    TJob J; J.f8 = 0; J.sc = 1.0f;
    if (it < TJ_IN_A) { const int L = it / 128, r = it % 128; J.kb = r / 8; const int nb = r % 8;
        J.src = a.in[I_WIN] + (size_t)L * 1024 * 1536; J.K = 1024; J.Nsrc = 1536; J.ncol0 = 64 * nb; J.dst = WB + W_IN / 2 + (size_t)L * NZ * 1024; J.drow0 = 64 * nb; return J; }
    it -= TJ_IN_A;
    if (it < TJ_IN_B) { const int L = it / 192, r = it % 192; J.kb = r / 12; const int nb = r % 12;
        J.src = a.in[I_WIN] + (size_t)L * 1024 * 1536; J.K = 1024; J.Nsrc = 1536; J.ncol0 = 768 + 64 * nb; J.dst = WB + W_IN / 2 + (size_t)L * NZ * 1024; J.drow0 = 1024 + 64 * nb; return J; }
    it -= TJ_IN_B;
    if (it < TJ_OUT) { const int L = it / 256, r = it % 256; J.kb = r / 16; const int nb = r % 16;
        J.src = a.in[I_WOUT] + (size_t)L * 1024 * 1024; J.K = 1024; J.Nsrc = 1024; J.ncol0 = 64 * nb; J.dst = WB + W_OUT / 2 + (size_t)L * 1024 * 1024; J.drow0 = 64 * nb; return J; }
    it -= TJ_OUT;
    if (it < 2 * TJ_D) { const int up = it / TJ_D, r = it % TJ_D; J.kb = r / 56; const int nb = r % 56, f0 = 64 * nb;
        J.src = a.in[up ? I_WUD : I_WGD]; J.K = 1024; J.Nsrc = DFF; J.ncol0 = f0; J.dst = WB + W_GUD / 2; J.drow0 = (f0 / 128) * 256 + (f0 % 128) + 128 * up; J.sc = FP8_DGU ? pg8::S8_W : (up ? 1.0f : LOG2E); J.f8 = FP8_DGU; return J; }
    it -= 2 * TJ_D;
    if (it < TJ_D) { J.kb = it / 16; const int nb = it % 16;
        J.src = a.in[I_WDD]; J.K = DFF; J.Nsrc = 1024; J.ncol0 = 64 * nb; J.dst = WB + W_DD / 2; J.drow0 = 64 * nb; if (FP8_DDN) { J.f8 = 1; J.sc = pg8::S8_W; } return J; }
    it -= TJ_D;
    if (it < 2 * TJ_E) { const int up = it / TJ_E, r0 = it % TJ_E, e = r0 / TJ_D, r = r0 % TJ_D; J.kb = r / 56; const int nb = r % 56, f0 = 64 * nb;
        J.src = a.in[up ? I_WUE : I_WGE] + (size_t)e * 1024 * DFF; J.K = 1024; J.Nsrc = DFF; J.ncol0 = f0; J.dst = (bf16*)((unsigned char*)WB + W_GUE + (size_t)e * 7168 * 1024); J.drow0 = (f0 / 128) * 256 + (f0 % 128) + 128 * up; J.f8 = 1; J.sc = pg8::S8_W; return J; }
    it -= 2 * TJ_E;
    { const int e = it / TJ_D, r = it % TJ_D; J.kb = r / 16; const int nb = r % 16;
        J.src = a.in[I_WDE] + (size_t)e * DFF * 1024; J.K = DFF; J.Nsrc = 1024; J.ncol0 = 64 * nb; J.dst = (bf16*)((unsigned char*)WB + W_DE + (size_t)e * 1024 * DFF); J.drow0 = 64 * nb; J.f8 = 1; J.sc = pg8::S8_W; return J; }
}
DI void tj_load(const TJob& J, int lane, f32x4 (&v)[16]) {
    const float* p = J.src + (size_t)(64 * J.kb + (lane >> 4)) * J.Nsrc + J.ncol0 + 4 * (lane & 15);
#pragma unroll
    for (int i = 0; i < 16; ++i) v[i] = *(const f32x4*)(p + (size_t)(4 * i) * J.Nsrc);
}
DI void tj_store(const TJob& J, LAS float* scr, int lane, const f32x4 (&v)[16]) {
#pragma unroll
    for (int i = 0; i < 16; ++i) { const int k = 4 * i + (lane >> 4); *(LAS f32x4*)(scr + k * 64 + ((4 * (lane & 15)) ^ (4 * ((k >> 3) & 7)))) = v[i]; }
    LDS_WAIT();
    const int c = lane & 7, k0 = 64 * J.kb;
#pragma unroll
    for (int j = 0; j < 8; ++j) { const int n = (lane >> 3) + 8 * j; const LAS float* s = scr + (8 * c) * 64 + (((n & ~3) ^ (4 * c)) + (n & 3));
        const float x0 = s[0 * 64], x1 = s[1 * 64], x2 = s[2 * 64], x3 = s[3 * 64], x4 = s[4 * 64], x5 = s[5 * 64], x6 = s[6 * 64], x7 = s[7 * 64];
        const float sw = J.sc;
        if (J.f8) { u32x2 o; o.x = pg8::pk_fp8x4(x0 * sw, x1 * sw, x2 * sw, x3 * sw); o.y = pg8::pk_fp8x4(x4 * sw, x5 * sw, x6 * sw, x7 * sw);
            *(u32x2*)((unsigned char*)J.dst + (size_t)(J.drow0 + n) * J.K + k0 + 8 * c) = o; }
        else { u32x4 o; o.x = cvt_pk_bf16(x0 * sw, x1 * sw); o.y = cvt_pk_bf16(x2 * sw, x3 * sw); o.z = cvt_pk_bf16(x4 * sw, x5 * sw); o.w = cvt_pk_bf16(x6 * sw, x7 * sw);
            *(u32x4*)(J.dst + (size_t)(J.drow0 + n) * J.K + k0 + 8 * c) = o; } }
    LDS_WAIT();
}

DI void prologue_a(const Args& a, unsigned char* ws, LAS unsigned char* lds, int tid, int wave, int lane) {
    const int G = gridDim.x, bx = blockIdx.x;
    {
        const int gw = bx * NWAVES + wave, NGW = G * NWAVES;
        float* mp = (float*)(ws + WS_MOD);
        for (int it = gw; it < 2 * 96 * 8; it += NGW) {
            const int ks = it & 7, jg = (it >> 3) % 96, L = it / 768, j0 = 64 * jg;
            float sil[5][2];
#pragma unroll
            for (int s = 0; s < 5; ++s)
#pragma unroll
                for (int hf = 0; hf < 2; ++hf) { const int k = 128 * ks + 64 * hf + lane; sil[s][hf] = silu_f(s < 4 ? a.in[I_C][s * 1024 + k] : a.in[I_CCTX][k]); }
            float acc[5] = {0.f, 0.f, 0.f, 0.f, 0.f};
            const float* wp = a.in[I_WADA] + (size_t)L * 1024 * 6144 + (size_t)(128 * ks) * 6144 + j0 + lane;
#pragma unroll
            for (int hf = 0; hf < 2; ++hf)
#pragma unroll 16
                for (int kk = 0; kk < 64; ++kk) { const float w = wp[(size_t)(64 * hf + kk) * 6144];
#pragma unroll
                    for (int s = 0; s < 5; ++s) acc[s] += __builtin_bit_cast(float, __builtin_amdgcn_readlane(__builtin_bit_cast(int, sil[s][hf]), kk)) * w; }
#pragma unroll
            for (int s = 0; s < 5; ++s) mp[((size_t)(L * 8 + ks) * 5 + s) * 6144 + j0 + lane] = acc[s];
        }
    }
    for (int it = bx; it < 256; it += G) {
        const int L = it >> 7, g = (it >> 5) & 3, kblk = it & 31;
        LAS float* Mt = (LAS float*)lds; LAS float* Wl = (LAS float*)(lds + 32768);
        __syncthreads();
        const float* wf = a.in[I_WF] + (size_t)(L * 4 + g) * 4096;
        LAS float* trg = (LAS float*)(lds + 49152); LAS float* wfl = (LAS float*)(lds + 49152 + 512);
        if (tid < 128) { const float fr = (float)(tid & 63) * (1.0f / 64.0f); trg[tid] = tid < 64 ? __builtin_amdgcn_cosf(fr) : __builtin_amdgcn_sinf(fr); }
        { float t8[8];
#pragma unroll
          for (int k = 0; k < 8; ++k) t8[k] = wf[tid + k * NTHR];
#pragma unroll
          for (int k = 0; k < 8; ++k) wfl[tid + k * NTHR] = t8[k]; }
        const float* wi = a.in[I_WIN] + (size_t)L * 1024 * 1536;
        { float t4[4];
#pragma unroll
          for (int k = 0; k < 4; ++k) { const int idx = tid + k * NTHR, kl = idx >> 6, d = idx & 63; t4[k] = wi[(size_t)(32 * kblk + kl) * 1536 + 512 + 64 * g + d]; }
#pragma unroll
          for (int k = 0; k < 4; ++k) { const int idx = tid + k * NTHR, kl = idx >> 6, d = idx & 63; Wl[kl * 65 + d] = t4[k]; } }
        __syncthreads();
        { const int rg = tid >> 4, cg = tid & 15, pq = rg >> 4, d0 = 4 * (rg & 15);
          f32x4 acc4[4];
#pragma unroll
          for (int i = 0; i < 4; ++i) acc4[i] = (f32x4){0.f, 0.f, 0.f, 0.f};
#pragma unroll 4
          for (int e = 0; e < 64; ++e) { const f32x4 w4 = *(const LAS f32x4*)(wfl + e * 64 + 4 * cg);
#pragma unroll
              for (int i = 0; i < 4; ++i) { const float tv = trg[64 * pq + (((d0 + i) * e) & 63)]; acc4[i] = acc4[i] + w4 * tv; } }
#pragma unroll
          for (int i = 0; i < 4; ++i) *(LAS f32x4*)(Mt + (pq * 64 + d0 + i) * 64 + 4 * cg) = acc4[i]; }
        __syncthreads();
        { const int klp = tid & 15, cgrp = tid >> 4, pq = cgrp >> 4, e20 = 4 * (cgrp & 15);
          bf16* WIN = (bf16*)(ws + WS_W + W_IN) + (size_t)L * NZ * 1024;
          f32x4 s0 = (f32x4){0.f, 0.f, 0.f, 0.f}, s1 = (f32x4){0.f, 0.f, 0.f, 0.f};
#pragma unroll 8
          for (int d = 0; d < 64; ++d) { const f32x4 m4 = *(const LAS f32x4*)(Mt + (pq * 64 + d) * 64 + e20); const float w0 = Wl[(2 * klp) * 65 + d], w1 = Wl[(2 * klp + 1) * 65 + d];
              s0 = s0 + m4 * w0; s1 = s1 + m4 * w1; }
#pragma unroll
          for (int i = 0; i < 4; ++i) *(unsigned*)(WIN + (size_t)(512 + 256 * pq + 64 * g + e20 + i) * 1024 + 32 * kblk + 2 * klp) = cvt_pk_bf16(s0[i], s1[i]); }
    }
    __syncthreads();
    {
        const int gt = bx * NTHR + tid, GT = G * NTHR;
        bf16* G1 = (bf16*)(ws + WS_TAB + T_G1); bf16* G3 = (bf16*)(ws + WS_TAB + T_G3); bf16* GC = (bf16*)(ws + WS_TAB + T_GC); bf16* WSB = (bf16*)(ws + WS_TAB + T_WS);
        float* RC = (float*)(ws + WS_TAB + T_ROPE); float* RS = RC + 2048;
        for (int idx = gt; idx < 128 * 128; idx += GT) { const int m = idx >> 7, kk = idx & 127; const int w = m >> 4, x = m & 15, k1 = 8 * w + 2 * (x >> 2) + ((x & 3) >> 1), ri = x & 1, pq = kk >> 6, n1 = kk & 63;
            const float fr = (float)((k1 * n1) & 63) * (1.0f / 64.0f), c = __builtin_amdgcn_cosf(fr), s = __builtin_amdgcn_sinf(fr);
            G1[idx] = f2bf(ri == 0 ? (pq == 0 ? c : -s) : (pq == 0 ? s : c)); }
        for (int idx = gt; idx < 128 * 256; idx += GT) { const int k2 = idx >> 8, kk = idx & 255, ri = kk >> 7, n2 = kk & 127; const float fr = (float)((k2 * n2) & 127) * (1.0f / 128.0f);
            G3[idx] = f2bf(ri == 0 ? __builtin_amdgcn_cosf(fr) : __builtin_amdgcn_sinf(fr)); }
        for (int idx = gt; idx < 256 * 512; idx += GT) { const int k = idx >> 9, kk = idx & 511, pq = kk >> 8, n = kk & 255; const float fr = (float)((k * n) & 255) * (1.0f / 256.0f);
            GC[idx] = f2bf(pq == 0 ? __builtin_amdgcn_cosf(fr) : -__builtin_amdgcn_sinf(fr)); }
        for (int idx = gt; idx < 2 * 4 * 128 * 128; idx += GT) WSB[idx] = f2bf(a.in[I_WS][idx]);
        { int* t0 = (int*)(ws + WS_RT + RT_TOK); int* d0 = (int*)(ws + WS_RT + RT_DST); float* g0 = (float*)(ws + WS_RT + RT_GATE);
          for (int idx = gt; idx < MALL; idx += GT) { t0[idx] = idx; d0[idx] = idx; g0[idx] = 1.0f; }
          int* t1 = (int*)(ws + WS_RT1 + RT1_TOK); int* d1 = (int*)(ws + WS_RT1 + RT1_DST); float* g1 = (float*)(ws + WS_RT1 + RT1_GATE);
          for (int idx = gt; idx < NE * CAP; idx += GT) { t1[idx] = 0; d1[idx] = -1; g1[idx] = 0.f; } }
        for (int idx = gt; idx < 2048; idx += GT) { const int pos = idx >> 4, f = idx & 15; const float inv = powf(10000.0f, -(float)f / 16.0f); const float ang = (float)pos * inv; RC[idx] = cosf(ang); RS[idx] = sinf(ang); }
    }
    {
        LAS float* scr = (LAS float*)(lds + wave * 16384);
        bf16* WB = (bf16*)(ws + WS_W);
        const int gw = bx * NWAVES + wave, NGW = G * NWAVES;
        f32x4 va[16], vb[16]; TJob Ja, Jb;
        int ia = gw;
        if (ia < TJ_NOW) { Ja = tj_decode(a, WB, ia); tj_load(Ja, lane, va); }
        for (;;) {
            if (ia >= TJ_NOW) break;
            const int ib = ia + NGW;
            if (ib < TJ_NOW) { Jb = tj_decode(a, WB, ib); tj_load(Jb, lane, vb); }
            tj_store(Ja, scr, lane, va);
            if (ib >= TJ_NOW) break;
            ia = ib + NGW;
            if (ia < TJ_NOW) { Ja = tj_decode(a, WB, ia); tj_load(Ja, lane, va); }
            tj_store(Jb, scr, lane, vb);
        }
    }
}

DI void cvt_filler(const Args& a, unsigned char* ws, LAS unsigned char* lds, int tid, int wave, int lane, int* done, int need) {
    LAS int* sh = (LAS int*)(lds + LDSCTL_OFF + LC_FILL);
    int* cur = (int*)(ws + WS_CTL) + CW_CVT;
    LAS float* scr = (LAS float*)(lds + wave * 16384);
    bf16* WB = (bf16*)(ws + WS_W);
    __syncthreads();
    for (int it = 0;; ++it) {
        if (tid == 0) { int b = -1;
            const bool stop = done && __hip_atomic_load(done, __ATOMIC_RELAXED, __HIP_MEMORY_SCOPE_AGENT) >= need;
            if (!stop) { b = __hip_atomic_fetch_add(cur, done ? TJ_BATCH / 2 : TJ_BATCH, __ATOMIC_RELAXED, __HIP_MEMORY_SCOPE_AGENT); if (b >= TJ_DEF) b = -1; }
            sh[it & 1] = b; }
        __syncthreads();
        const int b = __builtin_amdgcn_readfirstlane(sh[it & 1]);
        if (b < 0) break;
        f32x4 va[16], vb[16];
        const int ia = b + (done ? wave : 2 * wave), ib = done ? TJ_DEF : ia + 1;
        if (ia < TJ_DEF) { const TJob Ja = tj_decode(a, WB, TJ_NOW + ia); tj_load(Ja, lane, va);
            if (ib < TJ_DEF) { const TJob Jb = tj_decode(a, WB, TJ_NOW + ib); tj_load(Jb, lane, vb); tj_store(Ja, scr, lane, va); tj_store(Jb, scr, lane, vb); }
            else tj_store(Ja, scr, lane, va); }
    }
    __syncthreads();
}

DI void ld_row_f32(const float* row, int lane, f32x4 (&v)[4]) { const f32x4* p = (const f32x4*)row + lane;
#pragma unroll
    for (int j = 0; j < 4; ++j) v[j] = p[64 * j]; }
DI void st_row_f32(float* row, int lane, const f32x4 (&v)[4]) { f32x4* p = (f32x4*)row + lane;
#pragma unroll
    for (int j = 0; j < 4; ++j) p[64 * j] = v[j]; }
DI void ld_row_bf16(const bf16* row, int lane, f32x4 (&v)[4]) { const u32x2* p = (const u32x2*)row + lane;
#pragma unroll
    for (int j = 0; j < 4; ++j) { const u32x2 w = p[64 * j]; v[j] = (f32x4){bflo(w.x), bfhi(w.x), bflo(w.y), bfhi(w.y)}; } }
DI void st_row_bf16(bf16* row, int lane, const f32x4 (&v)[4]) { u32x2* p = (u32x2*)row + lane;
#pragma unroll
    for (int j = 0; j < 4; ++j) { u32x2 w; w.x = cvt_pk_bf16(v[j][0], v[j][1]); w.y = cvt_pk_bf16(v[j][2], v[j][3]); p[64 * j] = w; } }
DI float row_rstd(const f32x4 (&v)[4], int lane) { float s = 0.f;
#pragma unroll
    for (int j = 0; j < 4; ++j) s += (v[j][0] * v[j][0] + v[j][1] * v[j][1]) + (v[j][2] * v[j][2] + v[j][3] * v[j][3]);
    return 1.0f / sqrtf(wave_sum(s, lane) * (1.0f / 1024.0f) + EPS); }
DI void modulate_row(const f32x4 (&h)[4], float rstd, const float* g, const float* sh, const float* sc, int lane, f32x4 (&y)[4]) {
#pragma unroll
    for (int j = 0; j < 4; ++j) { const f32x4 gv = ((const f32x4*)g + lane)[64 * j], shv = ((const f32x4*)sh + lane)[64 * j], scv = ((const f32x4*)sc + lane)[64 * j];
        y[j] = h[j] * rstd * gv * (1.0f + scv) + shv; } }
DI int mod_set(int r) { return r < MLAT ? (r >> 13) : 4; }

DI void ldraw_f32(const float* row, int lane, f32x4 (&v)[4]) { const f32x4* p = (const f32x4*)row + lane;
#pragma unroll
    for (int j = 0; j < 4; ++j) v[j] = p[64 * j]; }
DI void ldraw_bf16(const bf16* row, int lane, u32x2 (&v)[4]) { const u32x2* p = (const u32x2*)row + lane;
#pragma unroll
    for (int j = 0; j < 4; ++j) v[j] = p[64 * j]; }
DI void unpack_bf16(const u32x2 (&w)[4], f32x4 (&v)[4]) {
#pragma unroll
    for (int j = 0; j < 4; ++j) v[j] = (f32x4){bflo(w[j].x), bfhi(w[j].x), bflo(w[j].y), bfhi(w[j].y)}; }
DI void ldvec(const float* p, int lane, f32x4 (&v)[4]) { ldraw_f32(p, lane, v); }
DI void ldmod(const Args& a, const unsigned char* ws, int L, int s, int j, int lane, f32x4 (&v)[4]) {
    ldraw_f32(a.in[I_BADA] + L * 6144 + j * 1024, lane, v);
#pragma unroll 1
    for (int ks = 0; ks < 8; ++ks) { f32x4 t[4]; ldraw_f32((const float*)(ws + WS_MOD) + ((size_t)(L * 8 + ks) * 5 + s) * 6144 + j * 1024, lane, t);
#pragma unroll
        for (int q = 0; q < 4; ++q) v[q] = v[q] + t[q]; }
}

DI void norm0_phase(const Args& a, unsigned char* ws, int wave, int lane) {
    constexpr int RPW = MALL / 256; const int bx = blockIdx.x;
    bf16* Y = (bf16*)(ws + WS_Y);
    if (bx >= 256) return;
    f32x4 g[4], sh[4], sc[4], hn[4]; int cs = -1;
    ldvec(a.in[I_GMPRE], lane, g);
    { const int r = bx * RPW + wave; ldraw_f32(r < MLAT ? a.in[I_X] + (size_t)r * DM : a.in[I_CTX] + (size_t)(r - MLAT) * DM, lane, hn); }
    for (int rr = wave; rr < RPW; rr += NWAVES) {
        const int r = bx * RPW + rr, s = mod_set(r);
        f32x4 h[4], y[4];
#pragma unroll
        for (int j = 0; j < 4; ++j) h[j] = hn[j];
        if (rr + NWAVES < RPW) { const int rn = r + NWAVES; ldraw_f32(rn < MLAT ? a.in[I_X] + (size_t)rn * DM : a.in[I_CTX] + (size_t)(rn - MLAT) * DM, lane, hn); }
        if (s != cs) { ldmod(a, ws, 0, s, 0, lane, sh); ldmod(a, ws, 0, s, 1, lane, sc); cs = s; }
        const float rs = row_rstd(h, lane);
#pragma unroll
        for (int j = 0; j < 4; ++j) y[j] = h[j] * rs * g[j] * (1.0f + sc[j]) + sh[j];
        st_row_bf16(Y + (size_t)r * DM, lane, y);
    }
}

DI void norm_mid_phase(const Args& a, unsigned char* ws, LAS unsigned char* lds, int L, int tid, int wave, int lane) {
    const int M = L == 0 ? MALL : MLAT, RPW = M / 256, bx = blockIdx.x;
    const bool moe = (L == 1);
    LAS int* cnt = (LAS int*)(lds + LDSCTL_OFF + LC_CNT);
    __syncthreads();
    if (tid < 8) cnt[tid] = 0;
    LAS float* wrl = (LAS float*)(lds + 4096);
    if (moe) { f32x4 w4[2048 / NTHR];
#pragma unroll
        for (int k = 0; k < 2048 / NTHR; ++k) w4[k] = ((const f32x4*)a.in[I_WR])[tid + k * NTHR];
#pragma unroll
        for (int k = 0; k < 2048 / NTHR; ++k) { const int i = tid + k * NTHR, c = i >> 1, e0 = 4 * (i & 1);
#pragma unroll
            for (int q = 0; q < 4; ++q) wrl[(e0 + q) * 1024 + c] = w4[k][q]; } }
    __syncthreads();
    const bf16* O = (const bf16*)(ws + WS_R + R_O); bf16* Y = (bf16*)(ws + WS_Y);
    bf16* hctx1 = (bf16*)(ws + WS_HCTX); const bf16* h2lat = (const bf16*)a.out + (size_t)MLAT * DM; bf16* h3 = (bf16*)(ws + WS_H3);
    LAS int* rec = (LAS int*)lds;
    if (bx < 256) {
        f32x4 gpost[4], gpre[4], gtm[4], shf[4], scf[4]; u32x4 hr[4], hr2[4]; u32x2 hb[4], hb2[4]; u32x2 on[4], on2[4]; int cs = -1;
        ldvec(a.in[I_GMPOST] + L * DM, lane, gpost); ldvec(a.in[I_GFPRE] + L * DM, lane, gpre);
#define NM_LOAD(rq_, o_, h_, hb_) do { const int rq = (rq_); ldraw_bf16(O + (size_t)rq * DM, lane, o_); \
            if (L == 0) { const u32x4* p_ = (const u32x4*)(rq < MLAT ? a.in[I_X] + (size_t)rq * DM : a.in[I_CTX] + (size_t)(rq - MLAT) * DM) + lane; _Pragma("unroll") for (int j = 0; j < 4; ++j) h_[j] = p_[64 * j]; } \
            else ldraw_bf16(h2lat + (size_t)rq * DM, lane, hb_); } while (0)
#define NM_ROW(rr_) ((L == 0 && SPLITK) ? ((rr_) < 4 ? MLAT + 4 * bx + (rr_) : 128 * bx + ((rr_) - 4)) : bx * RPW + (rr_))
        NM_LOAD(NM_ROW(wave), on, hr, hb);
        if (wave + NWAVES < RPW) NM_LOAD(NM_ROW(wave + NWAVES), on2, hr2, hb2);
        for (int rr = wave; rr < RPW; rr += NWAVES) {
            const int r = NM_ROW(rr), s = mod_set(r);
            bf16* hout = L == 0 ? (r < MLAT ? (bf16*)a.out + (size_t)r * DM : hctx1 + (size_t)(r - MLAT) * DM) : h3 + (size_t)r * DM;
            f32x4 o[4], h[4], y[4]; unpack_bf16(on, o);
#pragma unroll
            for (int j = 0; j < 4; ++j) h[j] = L == 0 ? __builtin_bit_cast(f32x4, hr[j]) : (f32x4){bflo(hb[j].x), bfhi(hb[j].x), bflo(hb[j].y), bfhi(hb[j].y)};
#pragma unroll
            for (int j = 0; j < 4; ++j) { on[j] = on2[j]; hr[j] = hr2[j]; hb[j] = hb2[j]; }
            if (rr + 2 * NWAVES < RPW) NM_LOAD(NM_ROW(rr + 2 * NWAVES), on2, hr2, hb2);
            if (SPLITK && L == 0 && r >= MLAT) {
#pragma unroll
                for (int j = 0; j < 4; ++j) o[j] = (f32x4){0.f, 0.f, 0.f, 0.f};
#pragma unroll 2
                for (int ks = 0; ks < 4; ++ks) { f32x4 t4[4]; ldraw_f32((const float*)(ws + WS_R + R_T) + ((size_t)ks * MCTX + (r - MLAT)) * DM, lane, t4);
#pragma unroll
                    for (int j = 0; j < 4; ++j) o[j] = o[j] + t4[j]; }
            }
            if (s != cs) { ldmod(a, ws, L, s, 2, lane, gtm); ldmod(a, ws, L, s, 3, lane, shf); ldmod(a, ws, L, s, 4, lane, scf); cs = s; }
            const float ro = row_rstd(o, lane);
#pragma unroll
            for (int j = 0; j < 4; ++j) h[j] = h[j] + gtm[j] * (o[j] * ro * gpost[j]);
            st_row_bf16(hout, lane, h);
            const float rh = row_rstd(h, lane);
#pragma unroll
            for (int j = 0; j < 4; ++j) y[j] = h[j] * rh * gpre[j] * (1.0f + scf[j]) + shf[j];
            if (moe || FP8_DGU) { unsigned* y8 = (unsigned*)((unsigned char*)Y + (size_t)r * DM) + lane;
#pragma unroll
                for (int j = 0; j < 4; ++j) y8[64 * j] = pg8::pk_fp8x4(y[j][0] * pg8::S8_Y, y[j][1] * pg8::S8_Y, y[j][2] * pg8::S8_Y, y[j][3] * pg8::S8_Y); }
            else st_row_bf16(Y + (size_t)r * DM, lane, y);
            if (moe) {
                float lg[8];
#pragma unroll
                for (int e = 0; e < 8; ++e) { float acc = 0.f;
#pragma unroll
                    for (int j = 0; j < 4; ++j) { const f32x4 w4 = *(const LAS f32x4*)(wrl + e * 1024 + 4 * lane + 256 * j); acc += (y[j][0] * w4[0] + y[j][1] * w4[1]) + (y[j][2] * w4[2] + y[j][3] * w4[3]); }
                    lg[e] = acc; }
#pragma unroll
                for (int e = 0; e < 8; ++e) lg[e] = wave_sum(lg[e], lane) + a.in[I_BR][e];
                int i0 = 0; float v0 = lg[0];
#pragma unroll
                for (int e = 1; e < 8; ++e) if (lg[e] > v0) { v0 = lg[e]; i0 = e; }
                int i1 = -1; float v1 = -3.0e38f;
#pragma unroll
                for (int e = 0; e < 8; ++e) if (e != i0 && lg[e] > v1) { v1 = lg[e]; i1 = e; }
                const float g0 = 1.0f / (1.0f + expf(v1 - v0)), g1 = 1.0f - g0;
                if (lane == 0) { const int p0 = __hip_atomic_fetch_add(&cnt[i0], 1, __ATOMIC_RELAXED, __HIP_MEMORY_SCOPE_WORKGROUP), p1 = __hip_atomic_fetch_add(&cnt[i1], 1, __ATOMIC_RELAXED, __HIP_MEMORY_SCOPE_WORKGROUP);
                    rec[rr * 4 + 0] = (i0 << 16) | p0; rec[rr * 4 + 1] = __float_as_int(g0); rec[rr * 4 + 2] = (i1 << 16) | p1; rec[rr * 4 + 3] = __float_as_int(g1); }
            }
        }
    }
    if (moe) {
        __syncthreads();
        if (bx < 256 && tid < 8) cnt[8 + tid] = __hip_atomic_fetch_add((int*)(ws + WS_CTL) + CW_GCNT + tid, cnt[tid], __ATOMIC_RELAXED, __HIP_MEMORY_SCOPE_AGENT);
        __syncthreads();
        if (bx < 256 && tid < 2 * RPW) { const int rr = tid >> 1, k = tid & 1, r = bx * RPW + rr; const int info = rec[rr * 4 + 2 * k], e = info >> 16, slot = e * CAP + cnt[8 + e] + (info & 0xffff);
            ((int*)(ws + WS_RT1 + RT1_TOK))[slot] = r; ((int*)(ws + WS_RT1 + RT1_DST))[slot] = k * MALL + r; ((int*)(ws + WS_RT1 + RT1_GATE))[slot] = rec[rr * 4 + 2 * k + 1]; }
    }
}

#undef NM_LOAD
#undef NM_ROW
DI void norm_end_phase(const Args& a, unsigned char* ws, int L, int wave, int lane) {
    const int M = L == 0 ? MALL : MLAT, RPW = M / 256, bx = blockIdx.x; const bool moe = (L == 1);
    const bf16* F = (const bf16*)(ws + WS_R + R_F); bf16* Y = (bf16*)(ws + WS_Y);
    const bf16* hctx1 = (const bf16*)(ws + WS_HCTX); bf16* hctx2 = (bf16*)(ws + WS_HCTX) + (size_t)MCTX * DM; bf16* h2lat = (bf16*)a.out + (size_t)MLAT * DM; const bf16* h3 = (const bf16*)(ws + WS_H3);
    if (bx >= 256) return;
    f32x4 gpost[4], gnx[4], gtf[4], shn[4], scn[4]; u32x2 f0n[4], hbn[4]; unsigned q0[4], q1[4], q02[4], q12[4]; int cs = -1;
    ldvec(a.in[I_GFPOST] + L * DM, lane, gpost); ldvec(a.in[I_GMPRE] + DM, lane, gnx);
#define NE_HIN(r_) (L == 0 ? ((r_) < MLAT ? (const bf16*)a.out + (size_t)(r_) * DM : hctx1 + (size_t)((r_) - MLAT) * DM) : h3 + (size_t)(r_) * DM)
#define NE_ROW(rr_) (L == 0 ? ((rr_) < 4 ? MLAT + 4 * bx + (rr_) : 128 * bx + ((rr_) - 4)) : bx * RPW + (rr_))
    u32x2 f0n2[4], hbn2[4];
#define NE_LOAD(rq_, f0_, q0_, q1_, hb_) do { const int rq = (rq_); \
        if (moe) { const unsigned* p0_ = (const unsigned*)((const unsigned char*)F + (size_t)rq * DM) + lane; const unsigned* p1_ = (const unsigned*)((const unsigned char*)F + (size_t)(MALL + rq) * DM) + lane; \
            _Pragma("unroll") for (int j = 0; j < 4; ++j) { q0_[j] = p0_[64 * j]; q1_[j] = p1_[64 * j]; } } \
        else ldraw_bf16(F + (size_t)rq * DM, lane, f0_); \
        ldraw_bf16(NE_HIN(rq), lane, hb_); } while (0)
    NE_LOAD(NE_ROW(wave), f0n, q0, q1, hbn);
    if (wave + NWAVES < RPW) NE_LOAD(NE_ROW(wave + NWAVES), f0n2, q02, q12, hbn2);
    for (int rr = wave; rr < RPW; rr += NWAVES) {
        const int r = NE_ROW(rr), s = mod_set(r);
        f32x4 f[4], h[4]; unpack_bf16(hbn, h);
        if (moe) {
#pragma unroll
            for (int j = 0; j < 4; ++j) { const int a0 = (int)q0[j], a1 = (int)q1[j];
                f[j] = (f32x4){__builtin_amdgcn_cvt_f32_fp8(a0, 0) + __builtin_amdgcn_cvt_f32_fp8(a1, 0), __builtin_amdgcn_cvt_f32_fp8(a0, 1) + __builtin_amdgcn_cvt_f32_fp8(a1, 1),
                               __builtin_amdgcn_cvt_f32_fp8(a0, 2) + __builtin_amdgcn_cvt_f32_fp8(a1, 2), __builtin_amdgcn_cvt_f32_fp8(a0, 3) + __builtin_amdgcn_cvt_f32_fp8(a1, 3)} * (1.0f / pg8::S8_F); }
        } else unpack_bf16(f0n, f);
#pragma unroll
        for (int j = 0; j < 4; ++j) { f0n[j] = f0n2[j]; q0[j] = q02[j]; q1[j] = q12[j]; hbn[j] = hbn2[j]; }
        if (rr + 2 * NWAVES < RPW) NE_LOAD(NE_ROW(rr + 2 * NWAVES), f0n2, q02, q12, hbn2);
        if (SPLITK && L == 0 && r >= MLAT) {
#pragma unroll
            for (int j = 0; j < 4; ++j) f[j] = (f32x4){0.f, 0.f, 0.f, 0.f};
#pragma unroll 2
            for (int ks = 0; ks < (FP8_DDN ? 7 : 14); ++ks) { f32x4 t[4]; ldraw_f32((const float*)(ws + WS_R + (FP8_DDN ? R_PART : R_PART0)) + ((size_t)ks * MCTX + (r - MLAT)) * DM, lane, t);
#pragma unroll
                for (int j = 0; j < 4; ++j) f[j] = f[j] + t[j]; }
            if (FP8_DDN) {
#pragma unroll
                for (int j = 0; j < 4; ++j) f[j] = f[j] * (1.0f / (pg8::S8_ACT * pg8::S8_W)); }
        }
        if (s != cs) { ldmod(a, ws, L, s, 5, lane, gtf); if (L == 0) { ldmod(a, ws, 1, s, 0, lane, shn); ldmod(a, ws, 1, s, 1, lane, scn); } cs = s; }
        const float rf = row_rstd(f, lane);
#pragma unroll
        for (int j = 0; j < 4; ++j) h[j] = h[j] + gtf[j] * (f[j] * rf * gpost[j]);
        if (L == 0) st_row_bf16(r < MLAT ? h2lat + (size_t)r * DM : hctx2 + (size_t)(r - MLAT) * DM, lane, h);
        else st_row_f32(a.out + (size_t)r * DM, lane, h);
        if (L == 0) { f32x4 y[4]; const float rh = row_rstd(h, lane);
#pragma unroll
            for (int j = 0; j < 4; ++j) y[j] = h[j] * rh * gnx[j] * (1.0f + scn[j]) + shn[j];
            st_row_bf16(Y + (size_t)r * DM, lane, y); }
    }
#undef NE_HIN
#undef NE_ROW
#undef NE_LOAD
}

constexpr int AT_KS = 0, AT_VT = 9216, AT_BUF = 19456;
DI void attn_unit(LAS unsigned char* lds, const bf16* Z, bf16* OC, const float* sinkL, int u, int tid, int wave, int lane) {
    int b, blk, kh; bool isctx;
    if (u < 512) { kh = u & 1; blk = (u >> 1) & 63; b = u >> 7; isctx = false; } else { const int j = u - 512; kh = j & 1; blk = (j >> 1) & 1; b = j >> 2; isctx = true; }
    const int qrowbase = isctx ? (MLAT + b * NCTX + 128 * blk) : (b * NLAT + 128 * blk);
    const int hq = 4 * kh + (wave & 3), qrow0 = (wave >> 2) * 64, i16 = lane & 15, h4 = lane >> 4;
    bf16x8 Qf[4][2];
#pragma unroll
    for (int qt = 0; qt < 4; ++qt)
#pragma unroll
        for (int ks = 0; ks < 2; ++ks) Qf[qt][ks] = *(const bf16x8*)(Z + (size_t)(qrowbase + qrow0 + 16 * qt + i16) * NZ + ZQ + 64 * hq + 32 * ks + 8 * h4);
    float mrun[4], lrun[4]; f32x4 o[4][4];
    const float sk = sinkL[hq] * LOG2E;
#pragma unroll
    for (int qt = 0; qt < 4; ++qt) { mrun[qt] = sk; lrun[qt] = (h4 == 0) ? 1.f : 0.f;
#pragma unroll
        for (int dt = 0; dt < 4; ++dt) o[dt][qt] = (f32x4){0.f, 0.f, 0.f, 0.f}; }
    const int ntl = isctx ? 0 : 6, ntt = ntl + 4;
#define AT_TILE(t, kr, mt, k0) (((t) < ntl) ? ((kr) = b * NLAT + 128 * (blk - 1 + ((t) >> 1)) + 64 * ((t) & 1), (mt) = ((t) >> 1) == 0 ? 1 : (((t) >> 1) == 2 ? 2 : 0), (k0) = 64 * ((t) & 1), (blk - 1 + ((t) >> 1)) >= 0 && (blk - 1 + ((t) >> 1)) <= 63) \
                                            : ((kr) = MLAT + b * NCTX + 64 * ((t) - ntl), (mt) = 0, (k0) = 0, true))
    const int skey = tid >> 3, sch = tid & 7;
#define AT_LOAD(kr) do { const bf16* src = Z + (size_t)((kr) + skey) * NZ; kvr = *(const u32x4*)(src + ZK + 64 * kh + 8 * sch); vvr = *(const u32x4*)(src + ZVV + 64 * kh + 8 * sch); } while (0)
#define AT_STORE(pb_) do { *(LAS u32x4*)(lds + (pb_) * AT_BUF + AT_KS + skey * 144 + sch * 16) = kvr; *(LAS u32x4*)(lds + (pb_) * AT_BUF + AT_VT + skey * 160 + sch * 16) = vvr; } while (0)
    u32x4 kvr, vvr;
    int tix = 0, krow0 = 0, cmtype = 0, ckb0 = 0, nmtype = 0, nkb0 = 0, pb = 0;
    while (tix < ntt && !AT_TILE(tix, krow0, cmtype, ckb0)) ++tix;
    AT_LOAD(krow0);
    __syncthreads();
    AT_STORE(0);
#pragma unroll
    for (int qt = 0; qt < 4; ++qt)
#pragma unroll
        for (int ks = 0; ks < 2; ++ks) asm volatile("" : "+v"(Qf[qt][ks]));
    ++tix; while (tix < ntt && !AT_TILE(tix, krow0, nmtype, nkb0)) ++tix;
    bool nvalid = tix < ntt;
    if (nvalid) AT_LOAD(krow0);
    __syncthreads();
    for (;;) {
        int n2mtype = 0, n2kb0 = 0; bool n2valid = false;
        if (nvalid) { AT_STORE(pb ^ 1);
            ++tix; while (tix < ntt && !AT_TILE(tix, krow0, n2mtype, n2kb0)) ++tix;
            n2valid = tix < ntt; if (n2valid) AT_LOAD(krow0); }
        const LAS unsigned char* ldt = lds + pb * AT_BUF;
        const bool skipw = (cmtype == 1 && ckb0 < qrow0) || (cmtype == 2 && ckb0 > qrow0);
        if (!skipw) {
        f32x4 sa[4][4];
#pragma unroll
        for (int kt = 0; kt < 4; ++kt)
#pragma unroll
            for (int qt = 0; qt < 4; ++qt) { const float nm = -mrun[qt]; sa[kt][qt] = (f32x4){nm, nm, nm, nm}; }
#pragma unroll
        for (int ks = 0; ks < 2; ++ks)
#pragma unroll
            for (int kt = 0; kt < 4; ++kt) { const bf16x8 ak = *(const LAS bf16x8*)(ldt + AT_KS + (16 * kt + i16) * 144 + (32 * ks + 8 * h4) * 2);
#pragma unroll
                for (int qt = 0; qt < 4; ++qt) sa[kt][qt] = mfma16(ak, Qf[qt][ks], sa[kt][qt]); }
        if (cmtype && ckb0 == qrow0) {
            int ln; asm volatile("v_mbcnt_lo_u32_b32 %0, -1, 0\n\tv_mbcnt_hi_u32_b32 %0, -1, %0" : "=v"(ln));
            const int dl = 4 * (ln >> 4) - (ln & 15);
            if (cmtype == 1) {
#pragma unroll
                for (int kt = 0; kt < 4; ++kt)
#pragma unroll
                    for (int qt = 0; qt < 4; ++qt) {
                        if (kt < qt) sa[kt][qt] = (f32x4){-1.0e30f, -1.0e30f, -1.0e30f, -1.0e30f};
                        else if (kt == qt) {
#pragma unroll
                            for (int r = 0; r < 4; ++r) if (dl + r < 0) sa[kt][qt][r] = -1.0e30f; } }
            } else {
#pragma unroll
                for (int kt = 0; kt < 4; ++kt)
#pragma unroll
                    for (int qt = 0; qt < 4; ++qt) {
                        if (kt > qt) sa[kt][qt] = (f32x4){-1.0e30f, -1.0e30f, -1.0e30f, -1.0e30f};
                        else if (kt == qt) {
#pragma unroll
                            for (int r = 0; r < 4; ++r) if (dl + r > 0) sa[kt][qt][r] = -1.0e30f; } }
            }
        }
#pragma unroll
        for (int qt = 0; qt < 4; ++qt) {
            float mx = vmax3(vmax3(vmax3(sa[0][qt][0], sa[0][qt][1], sa[0][qt][2]), vmax3(sa[0][qt][3], sa[1][qt][0], sa[1][qt][1]), sa[1][qt][2]),
                             vmax3(sa[1][qt][3], sa[2][qt][0], sa[2][qt][1]), vmax3(vmax3(sa[2][qt][2], sa[2][qt][3], sa[3][qt][0]), vmax3(sa[3][qt][1], sa[3][qt][2], sa[3][qt][3]), sa[3][qt][3]));
            if (__builtin_amdgcn_ballot_w64(mx > 6.0f) != 0ull) {
                mx = xrow16_max(mx);
                const float dl = fmaxf(mx, 0.f), alpha = fexp2(-dl); mrun[qt] += dl; lrun[qt] *= alpha;
#pragma unroll
                for (int kt = 0; kt < 4; ++kt) sa[kt][qt] = sa[kt][qt] - dl;
#pragma unroll
                for (int dt = 0; dt < 4; ++dt) o[dt][qt] = o[dt][qt] * alpha;
            }
            f32x2 ps = (f32x2){0.f, 0.f};
#pragma unroll
            for (int kt = 0; kt < 4; ++kt) { f32x4 p; p[0] = fexp2(sa[kt][qt][0]); p[1] = fexp2(sa[kt][qt][1]); p[2] = fexp2(sa[kt][qt][2]); p[3] = fexp2(sa[kt][qt][3]); sa[kt][qt] = p;
                ps = ps + (f32x2){p[0], p[1]} + (f32x2){p[2], p[3]}; }
            lrun[qt] += ps.x + ps.y;
        }
#pragma unroll
        for (int s = 0; s < 2; ++s) {
            bf16x8 pf[4];
#pragma unroll
            for (int qt = 0; qt < 4; ++qt) { u32x4 w; const f32x4 p0 = sa[2 * s][qt], p1 = sa[2 * s + 1][qt];
                w.x = cvt_pk_bf16(p0[0], p0[1]); w.y = cvt_pk_bf16(p0[2], p0[3]); w.z = cvt_pk_bf16(p1[0], p1[1]); w.w = cvt_pk_bf16(p1[2], p1[3]); pf[qt] = __builtin_bit_cast(bf16x8, w); }
#pragma unroll
            for (int dt = 0; dt < 4; ++dt) {
                const LAS unsigned char* vp = ldt + AT_VT + (32 * s + 4 * h4 + (i16 >> 2)) * 160 + (16 * dt + 4 * (i16 & 3)) * 2;
                const v4i16_t lo = __builtin_amdgcn_ds_read_tr16_b64_v4i16((LAS v4i16_t*)vp), hi = __builtin_amdgcn_ds_read_tr16_b64_v4i16((LAS v4i16_t*)(vp + 16 * 160)); const bf16x8 av = __builtin_shufflevector(lo, hi, 0, 1, 2, 3, 4, 5, 6, 7);
#pragma unroll
                for (int qt = 0; qt < 4; ++qt) o[dt][qt] = mfma16(av, pf[qt], o[dt][qt]); }
        }
        }
        if (!nvalid) break;
        __syncthreads();
        pb ^= 1; cmtype = nmtype; ckb0 = nkb0; nvalid = n2valid; nmtype = n2mtype; nkb0 = n2kb0;
    }
#undef AT_LOAD
#undef AT_STORE
    const int trs = (((lane & 3) << 4) | (lane >> 2)) << 2;
#pragma unroll
    for (int qt = 0; qt < 4; ++qt) { const float lt = xrow16_sum(lrun[qt]); const float inv = 1.0f / lt;
        bf16* orow = OC + (size_t)(qrowbase + qrow0 + 16 * qt + (lane >> 2)) * DM + 512 + 64 * hq + 4 * (lane & 3);
#pragma unroll
        for (int dt = 0; dt < 4; ++dt) { const f32x4 v = o[dt][qt] * inv; u32x2 w; w.x = (unsigned)__builtin_amdgcn_ds_bpermute(trs, (int)cvt_pk_bf16(v[0], v[1])); w.y = (unsigned)__builtin_amdgcn_ds_bpermute(trs, (int)cvt_pk_bf16(v[2], v[3])); *(u32x2*)(orow + 16 * dt) = w; } }
#undef AT_TILE
}

DI void sgu_unit(LAS unsigned char* lds, const bf16* Z, bf16* OC, const bf16* wsb, const float* bs, const float* gv, int c, int tid, int wave, int lane) {
    const int rowbase = 128 * c, i16 = lane & 15, h4 = lane >> 4;
    __syncthreads();
    { const int q = tid >> 2, hh = tid & 3; const u32x4* src = (const u32x4*)(Z + (size_t)(rowbase + q) * NZ + ZV + 64 * hh);
      u32x4 v[8]; float ss = 0.f;
#pragma unroll
      for (int j = 0; j < 8; ++j) { v[j] = src[j];
#pragma unroll
          for (int q2 = 0; q2 < 4; ++q2) { const float x0 = bflo(v[j][q2]), x1 = bfhi(v[j][q2]); ss += x0 * x0 + x1 * x1; } }
      const float rstd = 1.0f / sqrtf(ss * (1.0f / 64.0f) + EPS);
      const f32x4* gp = (const f32x4*)(gv + hh * 64);
#pragma unroll
      for (int j = 0; j < 8; ++j) { const f32x4 ga = gp[2 * j], gb = gp[2 * j + 1]; u32x4 w;
          w.x = cvt_pk_bf16(bflo(v[j].x) * rstd * ga[0], bfhi(v[j].x) * rstd * ga[1]); w.y = cvt_pk_bf16(bflo(v[j].y) * rstd * ga[2], bfhi(v[j].y) * rstd * ga[3]);
          w.z = cvt_pk_bf16(bflo(v[j].z) * rstd * gb[0], bfhi(v[j].z) * rstd * gb[1]); w.w = cvt_pk_bf16(bflo(v[j].w) * rstd * gb[2], bfhi(v[j].w) * rstd * gb[3]);
          *(LAS u32x4*)(lds + q * 544 + (hh * 64 + 8 * j) * 2) = w; } }
    __syncthreads();
    const int p = 16 * wave + i16;
#pragma unroll 1
    for (int hh = 0; hh < 4; ++hh) {
        f32x4 acc[4];
#pragma unroll
        for (int ct = 0; ct < 4; ++ct) acc[ct] = (f32x4){0.f, 0.f, 0.f, 0.f};
#pragma unroll
        for (int ks = 0; ks < 4; ++ks) { const bf16x8 bw = *(const bf16x8*)(wsb + ((size_t)hh * 128 + p) * 128 + 32 * ks + 8 * h4);
#pragma unroll
            for (int ct = 0; ct < 4; ++ct) { const bf16x8 av = trfrag(lds + 32 * ks * 544 + (hh * 64 + 16 * ct) * 2, 544, lane); acc[ct] = mfma16(av, bw, acc[ct]); } }
        const float bias = bs[hh * 128 + p];
#pragma unroll
        for (int ct = 0; ct < 4; ++ct) { const u32x2 uu = *(const u32x2*)(Z + (size_t)(rowbase + p) * NZ + ZU + 64 * hh + 16 * ct + 4 * h4);
            u32x2 w; w.x = cvt_pk_bf16(bflo(uu.x) * (acc[ct][0] + bias), bfhi(uu.x) * (acc[ct][1] + bias)); w.y = cvt_pk_bf16(bflo(uu.y) * (acc[ct][2] + bias), bfhi(uu.y) * (acc[ct][3] + bias));
            const int trs = (((lane & 3) << 4) | (lane >> 2)) << 2;
            w.x = (unsigned)__builtin_amdgcn_ds_bpermute(trs, (int)w.x); w.y = (unsigned)__builtin_amdgcn_ds_bpermute(trs, (int)w.y);
            *(u32x2*)(OC + (size_t)(rowbase + 16 * wave + (lane >> 2)) * DM + 64 * hh + 16 * ct + 4 * (lane & 3)) = w; }
    }
}

DI void fft1_unit(LAS unsigned char* lds, const bf16* Z, bf16* T, const bf16* G1, int u, int tid, int wave, int lane) {
    const int n2g = u & 31, g = (u >> 5) & 3, b = u >> 7, i16 = lane & 15, h4 = lane >> 4;
    __syncthreads();
    constexpr int PB = 544;
    { const int ch = tid & 7, n2l = (tid >> 3) & 3, k0 = tid >> 5;
      u32x4 v[8];
#pragma unroll
      for (int it = 0; it < 8; ++it) { const int k = k0 + 16 * it, pq = k >> 6, n1 = k & 63;
          v[it] = *(const u32x4*)(Z + (size_t)(b * NLAT + 128 * n1 + 4 * n2g + n2l) * NZ + ZP + 256 * pq + 64 * g + 8 * ch); }
#pragma unroll
      for (int it = 0; it < 8; ++it) { const int k = k0 + 16 * it;
          *(LAS u32x4*)(lds + k * PB + (n2l * 64 + 8 * ch) * 2) = v[it]; } }
    __syncthreads();
    bf16x8 ga[4];
#pragma unroll
    for (int ks = 0; ks < 4; ++ks) ga[ks] = *(const bf16x8*)(G1 + (16 * wave + i16) * 128 + 32 * ks + 8 * h4);
    const int k1a = 8 * wave + 2 * h4;
#pragma unroll 4
    for (int ct = 0; ct < 16; ++ct) {
        f32x4 acc = (f32x4){0.f, 0.f, 0.f, 0.f};
#pragma unroll
        for (int ks = 0; ks < 4; ++ks) { const bf16x8 bd = trfrag(lds + 32 * ks * PB + 32 * ct, PB, lane); acc = mfma16(ga[ks], bd, acc); }
        const int n2 = 4 * n2g + (ct >> 2), e2 = 16 * (ct & 3) + i16;
#pragma unroll
        for (int hf = 0; hf < 2; ++hf) { const int k1 = k1a + hf; const float ar = acc[2 * hf], mai = acc[2 * hf + 1];
            const float fr = (float)((k1 * n2) & 8191) * (1.0f / 8192.0f), c = __builtin_amdgcn_cosf(fr), s = __builtin_amdgcn_sinf(fr);
            const float apr = ar * c - mai * s, api = -mai * c - ar * s;
            const size_t base = ((((size_t)(b * 4 + g) * 64 + k1) * 2) * 128 + n2) * 64 + e2;
            T[base] = f2bf(apr); T[base + 128 * 64] = f2bf(api); }
    }
}

template <int KD> DI void dft_unit(LAS unsigned char* lds, const bf16* Gt, const bf16* P0, const bf16* P1, int pitch, bf16* outp, int rstride, float scale, int tid, int wave, int lane) {
    constexpr int PB = 160; const int i16 = lane & 15, h4 = lane >> 4;
    __syncthreads();
    { const int ch = tid & 7, r0 = tid >> 3;
      u32x4 v[KD / 64];
#pragma unroll
      for (int it = 0; it < KD / 64; ++it) { const int k = r0 + 64 * it, pl = k / (KD / 2), rr = k % (KD / 2);
          v[it] = *(const u32x4*)((pl ? P1 : P0) + (size_t)rr * pitch + 8 * ch); }
#pragma unroll
      for (int it = 0; it < KD / 64; ++it) { const int k = r0 + 64 * it;
          *(LAS u32x4*)(lds + k * PB + 16 * ch) = v[it]; } }
    __syncthreads();
    f32x4 acc[4];
#pragma unroll
    for (int ct = 0; ct < 4; ++ct) acc[ct] = (f32x4){0.f, 0.f, 0.f, 0.f};
#pragma unroll 4
    for (int ks = 0; ks < KD / 32; ++ks) { const bf16x8 gb = *(const bf16x8*)(Gt + (size_t)(16 * wave + i16) * KD + 32 * ks + 8 * h4);
#pragma unroll
        for (int ct = 0; ct < 4; ++ct) { const bf16x8 ad = trfrag(lds + 32 * ks * PB + 32 * ct, PB, lane); acc[ct] = mfma16(ad, gb, acc[ct]); } }
    bf16* orow = outp + (size_t)rstride * (16 * wave + i16) * DM + 4 * h4;
#pragma unroll
    for (int ct = 0; ct < 4; ++ct) { const f32x4 v = acc[ct] * scale; u32x2 w; w.x = cvt_pk_bf16(v[0], v[1]); w.y = cvt_pk_bf16(v[2], v[3]); *(u32x2*)(orow + 16 * ct) = w; }
}

DI void fft3_phase(LAS unsigned char* lds, const bf16* T, const bf16* G3, bf16* OC, int bx, int G, int tid, int wave, int lane) {
    constexpr int PB = 160, BUF = 256 * PB; const int i16 = lane & 15, h4 = lane >> 4, ch = tid & 7, r0 = tid >> 3;
    int u = bx; if (u >= 1024) return;
    bf16x8 gb[8];
#pragma unroll
    for (int ks = 0; ks < 8; ++ks) gb[ks] = *(const bf16x8*)(G3 + (size_t)(16 * wave + i16) * 256 + 32 * ks + 8 * h4);
    u32x4 v[4];
#define F3_LOAD(uu) do { const bf16* p_ = T + (size_t)(uu) * 2 * 8192 + (size_t)r0 * 64 + 8 * ch; _Pragma("unroll") for (int it = 0; it < 4; ++it) v[it] = *(const u32x4*)(p_ + (size_t)it * 64 * 64); } while (0)
#define F3_STORE(pb_) do { _Pragma("unroll") for (int it = 0; it < 4; ++it) *(LAS u32x4*)(lds + (pb_) * BUF + (r0 + 64 * it) * PB + 16 * ch) = v[it]; } while (0)
    F3_LOAD(u);
    __syncthreads();
    F3_STORE(0);
    int un = u + G; bool nvalid = un < 1024;
    if (nvalid) F3_LOAD(un);
    __syncthreads();
    int pb = 0;
    for (;;) {
        int u2 = un + G; bool n2valid = false;
        if (nvalid) { F3_STORE(pb ^ 1); n2valid = u2 < 1024; if (n2valid) F3_LOAD(u2); }
        const LAS unsigned char* ldt = lds + pb * BUF;
        f32x4 acc[4];
#pragma unroll
        for (int ct = 0; ct < 4; ++ct) acc[ct] = (f32x4){0.f, 0.f, 0.f, 0.f};
#pragma unroll
        for (int ks = 0; ks < 8; ++ks)
#pragma unroll
            for (int ct = 0; ct < 4; ++ct) { const bf16x8 ad = trfrag(ldt + 32 * ks * PB + 32 * ct, PB, lane); acc[ct] = mfma16(ad, gb[ks], acc[ct]); }
        const int k1 = u & 63, g = (u >> 6) & 3, b = u >> 8;
        bf16* orow = OC + (size_t)(b * NLAT + k1 + 64 * (16 * wave + (lane >> 2))) * DM + 256 + 64 * g + 4 * (lane & 3);
        const int trs = (((lane & 3) << 4) | (lane >> 2)) << 2;
#pragma unroll
        for (int ct = 0; ct < 4; ++ct) { const f32x4 w4 = acc[ct] * (1.0f / 724.0773439350247f); u32x2 w; w.x = (unsigned)__builtin_amdgcn_ds_bpermute(trs, (int)cvt_pk_bf16(w4[0], w4[1])); w.y = (unsigned)__builtin_amdgcn_ds_bpermute(trs, (int)cvt_pk_bf16(w4[2], w4[3])); *(u32x2*)(orow + 16 * ct) = w; }
        if (!nvalid) break;
        __syncthreads();
        pb ^= 1; u = un; un = u2; nvalid = n2valid;
    }
#undef F3_LOAD
#undef F3_STORE
}

constexpr int PH_L = 20, PH_END = 2 + 2 * PH_L;
__global__ void __launch_bounds__(NTHR, 2) fwd_kernel(Args args) {
    extern __shared__ __attribute__((aligned(16))) unsigned char lds_raw[];
    LAS unsigned char* const lds0 = (LAS unsigned char*)lds_raw;
    const int tid0 = threadIdx.x; const int wave0 = __builtin_amdgcn_readfirstlane(tid0 >> 6);
    const int G0 = gridDim.x, bx0 = blockIdx.x;
    unsigned char* ws0 = args.ws;
#define PHASE_REGS() int bx = bx0, G = G0; asm volatile("" : "+s"(bx), "+s"(G)); LAS unsigned char* lds = lds0; asm volatile("" : "+s"(lds)); int tid; asm volatile("v_mbcnt_lo_u32_b32 %0, -1, 0\n\tv_mbcnt_hi_u32_b32 %0, -1, %0" : "=v"(tid)); tid += wave0 * 64; GAS unsigned char* wsg_ = (GAS unsigned char*)ws0; asm volatile("" : "+s"(wsg_)); unsigned char* ws = (unsigned char*)wsg_; const int lane = tid & 63, wave = __builtin_amdgcn_readfirstlane(tid >> 6); (void)lane; (void)wave; \
    bf16* Z = (bf16*)(ws + WS_R + R_Z); bf16* OC = (bf16*)(ws + WS_R + R_OC); bf16* TT = (bf16*)(ws + WS_R + R_T); bf16* Y = (bf16*)(ws + WS_Y); (void)Z; (void)OC; (void)TT; (void)Y
    for (int u = tid0; u < (LDS_BYTES - LDSCTL_OFF) / 4; u += NTHR) ((LAS unsigned*)(lds0 + LDSCTL_OFF))[u] = 0u;
    __syncthreads();
#if MK_MULTI
#define GRID_BAR() do { } while (0)
#else
    XcdBarrier bar = xcd_barrier_post((unsigned*)(ws0 + WS_CTL) + CW_BAR, (volatile LAS unsigned*)(lds0 + LDSCTL_OFF + LC_BAR));
#define GRID_BAR() do { XcdBarrier b_ = bar; { GAS unsigned* bp_ = (GAS unsigned*)bar.bar; asm volatile("" : "+s"(bp_)); b_.bar = (unsigned*)bp_; } int l_; asm volatile("v_mbcnt_lo_u32_b32 %0, -1, 0\n\tv_mbcnt_hi_u32_b32 %0, -1, %0" : "=v"(l_)); xcd_barrier(b_, wave0 == 0 && l_ == 0); if (MK_PROBE == 40) xcd_barrier(b_, wave0 == 0 && l_ == 0); } while (0)
#endif
    const int lo = args.ph_lo, hi = args.ph_hi;
#define IN(k) (lo <= (k) && (k) < hi)
#define TAIL_FILL(id, nunits) do { if (FILL) { PHASE_REGS(); const int nu_ = (nunits), last_ = nu_ - ((nu_ + G - 1) / G - 1) * G; int* dn_ = (int*)(ws + WS_CTL) + CW_DONE + 64 * (L * 16 + (id)); \
        if (last_ < G) { if (bx < last_) { if (tid == 0) __hip_atomic_fetch_add(dn_, 1, __ATOMIC_RELAXED, __HIP_MEMORY_SCOPE_AGENT); } else cvt_filler(args, ws, lds, tid, wave, lane, dn_, 1); } } } while (0)
#define SEAM(k) do { if (IN(k) && IN((k) + 1)) GRID_BAR(); } while (0)

    if (EN(0) && IN(0)) { PHASE_REGS(); for (int rep = 0; rep < REP(1); ++rep) prologue_a(args, ws, lds, tid, wave, lane); }
    SEAM(0);
    if (EN(1) && IN(1)) { PHASE_REGS(); for (int rep = 0; rep < REP(2); ++rep) norm0_phase(args, ws, wave, lane); }
    SEAM(1);

#pragma unroll 1
    for (int L = 0; L < 2; ++L) {
        const int pb = 2 + PH_L * L;
        if (EN(2) && IN(pb + 0)) { PHASE_REGS();
            pg8::SchedIn S{G, bx, L == 0 ? 28 : 4, L == 0, (const char*)(ws + WS_W + W_IN) + (size_t)L * NZ * 1024 * 2, 2048};
            { LAS f32x4* rl = (LAS f32x4*)(lds + LDSCTL_OFF + LC_ROPE); const f32x4* src = (const f32x4*)(ws + WS_TAB + T_ROPE); const f32x4 r0_ = src[tid], r1_ = src[tid + NTHR]; rl[tid] = r0_; rl[tid + NTHR] = r1_; __syncthreads(); }
            pg8::EpiZ E{Z, (const LAS float*)(lds + LDSCTL_OFF + LC_ROPE), (const LAS float*)(lds + LDSCTL_OFF + LC_ROPE) + 2048};
            pg8::gemm_phase<pg8::EpiZ, pg8::SchedIn, false, false>(lds, (const unsigned char*)Y, 2048, S, E, tid);
        }
        if (IN(pb + 0)) TAIL_FILL(0, 896 + (L == 0 ? 28 : 4));
        SEAM(pb + 0);
        if (IN(pb + 1)) {
            const int nattn = L == 0 ? 528 : 512, nsgu = L == 0 ? 264 : 256;
            if (EN(3)) { PHASE_REGS(); for (int rep = 0; rep < REP(3); ++rep) { for (int u = bx; u < 512; u += G) attn_unit(lds, Z, OC, args.in[I_SINK] + L * 8, u, tid, wave, lane);
                { PHASE_REGS(); for (int u = 512 + ((bx + 16) % G); u < nattn; u += G) attn_unit(lds, Z, OC, args.in[I_SINK] + L * 8, u, tid, wave, lane); } } }
            if (EN(4)) { PHASE_REGS(); for (int rep = 0; rep < REP(4); ++rep) { for (int u = bx; u < 256; u += G) sgu_unit(lds, Z, OC, (const bf16*)(ws + WS_TAB + T_WS) + (size_t)L * 4 * 128 * 128, args.in[I_BS] + L * 512, args.in[I_GV] + L * 256, u, tid, wave, lane);
                for (int u = 256 + ((bx + 32) % G); u < nsgu; u += G) sgu_unit(lds, Z, OC, (const bf16*)(ws + WS_TAB + T_WS) + (size_t)L * 4 * 128 * 128, args.in[I_BS] + L * 512, args.in[I_GV] + L * 256, u, tid, wave, lane); } }
            if (EN(5)) { PHASE_REGS(); for (int rep = 0; rep < REP(5); ++rep) for (int u = bx; u < 512; u += G) fft1_unit(lds, Z, TT, (const bf16*)(ws + WS_TAB + T_G1), u, tid, wave, lane); }
            if (L == 0) { PHASE_REGS(); for (int u = (bx + 96) % G; u < 32; u += G) {     const int mh = u & 1, g = (u >> 1) & 3, b = u >> 3; const bf16* zr = Z + (size_t)(MLAT + b * NCTX) * NZ;
                dft_unit<512>(lds, (const bf16*)(ws + WS_TAB + T_GC) + (size_t)128 * mh * 512, zr + ZP + 64 * g, zr + ZQI + 64 * g, NZ, OC + (size_t)(MLAT + b * NCTX + 128 * mh) * DM + 256 + 64 * g, 1, 1.0f / 128.0f, tid, wave, lane); } }
            __syncthreads();
            if (FILL && L == 0 && G0 == 256) { PHASE_REGS();
                const bool extra = bx >= 240 || (bx >= 224 && bx < 232) || (bx >= 160 && bx < 192);
                int* dn_ = (int*)(ws + WS_CTL) + CW_DONE + 64 * 15;
                if (extra) { if (tid == 0) __hip_atomic_fetch_add(dn_, 1, __ATOMIC_RELAXED, __HIP_MEMORY_SCOPE_AGENT); } else cvt_filler(args, ws, lds, tid, wave, lane, dn_, 1); }
        }
        SEAM(pb + 1);
        if (EN(6) && IN(pb + 2)) { PHASE_REGS();
            for (int rep = 0; rep < REP(6); ++rep) fft3_phase(lds, TT, (const bf16*)(ws + WS_TAB + T_G3), OC, bx, G, tid, wave, lane);
            __syncthreads();
        }
        SEAM(pb + 2);
        if (EN(7) && IN(pb + 3)) { PHASE_REGS();
            pg8::SchedPlain S{G, bx, (L == 0 && !SPLITK) ? 132 : 128, 4, (const char*)(ws + WS_W + W_OUT) + (size_t)L * 1024 * 1024 * 2, 2048};
            pg8::EpiO E{(bf16*)(ws + WS_R + R_O), DM};
            pg8::gemm_phase<pg8::EpiO, pg8::SchedPlain, false, false>(lds, (const unsigned char*)OC, 2048, S, E, tid);
        }
        if (EN(7) && IN(pb + 3) && L == 0 && SPLITK) { PHASE_REGS();
            pg8::SchedSplit S{G, bx, 4, 4, 4, 4, (const char*)(ws + WS_W + W_OUT), 2048};
            pg8::EpiPart E{(float*)(ws + WS_R + R_T), MCTX, DM};
            pg8::gemm_phase<pg8::EpiPart, pg8::SchedSplit, false, false>(lds, (const unsigned char*)(OC + (size_t)MLAT * DM), 2048, S, E, tid, 4);
        }
        if (IN(pb + 3)) TAIL_FILL(3, (L == 0 && SPLITK) ? 512 + 64 : (L == 0 ? 132 : 128) * 4);
        SEAM(pb + 3);
        if (EN(8) && IN(pb + 4)) { PHASE_REGS(); for (int rep = 0; rep < (L == 0 ? REP(7) : 1); ++rep) norm_mid_phase(args, ws, lds, L, tid, wave, lane); }
        if (IN(pb + 4) && L == 1) { PHASE_REGS(); cvt_filler(args, ws, lds, tid, wave, lane, nullptr, 0); }
        SEAM(pb + 4);
#pragma unroll 1
        for (int c = 0; c < 5; ++c) {
            const bool any = IN(pb + 6 + 2 * c) || IN(pb + 7 + 2 * c);
            int ntiles = 0;
            PHASE_REGS();
            if (any) {
                LAS int* tlw = (LAS int*)(lds + LDSCTL_OFF + LC_TILE);
                int pre[9]; pre[0] = 0;
#pragma unroll
                for (int e = 0; e < 8; ++e) { const int ce = L == 0 ? (e == 0 ? MALL : 0) : __builtin_amdgcn_readfirstlane(__hip_atomic_load((int*)(ws + WS_CTL) + CW_GCNT + e, RLX_AGENT)); pre[e + 1] = pre[e] + ((ce + 255) >> 8); }
                ntiles = pre[8];
                __syncthreads();
                for (int t = tid; t < ntiles && t < 512; t += NTHR) { int e = 0;
#pragma unroll
                    for (int q = 1; q < 8; ++q) if (pre[q] <= t) e = q;
                    int pe = 0;
#pragma unroll
                    for (int q = 0; q < 8; ++q) if (q == e) pe = pre[q];
                    tlw[t] = (e << 24) | ((L == 0 ? 0 : e * CAP) + 256 * (t - pe)); }
                __syncthreads(); }
            const int CT = L == 0 ? CHUNK_TILES : 128;
            const int t0 = c * CT; int nM = ntiles - t0;
            if (L == 0 && SPLITK && !FP8_DDN) { if (c == 0) nM = nM > CT ? CT : nM; else if (c > 1) nM = 0; }
            else if (L == 1 && !MK_MULTI) { if (c == 0) nM = nM > CT ? CT : nM; else if (c > 1) nM = 0; }
            else nM = nM > CT ? CT : nM;
            unsigned char* const actb = (L == 0 && SPLITK && !FP8_DDN) ? ws + WS_R - ACT0_BACK : (L == 1 && !MK_MULTI) ? ws + WS_R - ACT1_BACK : ws + WS_R + R_ACT;
            if (!MK_MULTI && nM <= 0) break;
            const LAS int* tl = (const LAS int*)(lds + LDSCTL_OFF + LC_TILE);
            const int* tokmap = L == 0 ? (const int*)(ws + WS_RT + RT_TOK) : (const int*)(ws + WS_RT1 + RT1_TOK);
            const int* dstmap = L == 0 ? (const int*)(ws + WS_RT + RT_DST) : (const int*)(ws + WS_RT1 + RT1_DST);
            const float* gatemap = L == 0 ? (const float*)(ws + WS_RT + RT_GATE) : (const float*)(ws + WS_RT1 + RT1_GATE);
            if (EN(10) && IN(pb + 6 + 2 * c) && nM > 0) {
                if (L == 0 && FP8_DGU && !FP8_DDN) { PHASE_REGS();
                    pg8::SchedGrp S{G, bx, t0, nM, 28, (const char*)(ws + WS_W + W_GUD), (size_t)0, 1024, tl, tokmap, true, MK_PROBE == 21};
                    pg8::EpiGUm E{(bf16*)actb, t0};
                    pg8::gemm_phase<pg8::EpiGUm, pg8::SchedGrp, true, true>(lds, (const unsigned char*)Y, 1024, S, E, tid);
                    TAIL_FILL(4 + 2 * c, nM * 28);
                } else if (L == 0 && !FP8_DGU) { PHASE_REGS();
                    pg8::SchedGrp S{G, bx, t0, nM, 28, (const char*)(ws + WS_W + W_GUD), (size_t)0, 2048, tl, tokmap, true, MK_PROBE == 21};
                    pg8::EpiGU E{(bf16*)(ws + WS_R + R_ACT), t0};
                    pg8::gemm_phase<pg8::EpiGU, pg8::SchedGrp, true, false>(lds, (const unsigned char*)Y, 2048, S, E, tid);
                    TAIL_FILL(4 + 2 * c, nM * 28);
                } else { PHASE_REGS();
                    pg8::SchedGrp S{G, bx, t0, nM, 28, (const char*)(ws + WS_W + (L == 0 ? W_GUD : W_GUE)), L == 0 ? (size_t)0 : (size_t)7168 * 1024, 1024, tl, tokmap, true, MK_PROBE == 23};
                    pg8::EpiGU8 E{(unsigned char*)actb, t0};
                    pg8::gemm_phase<pg8::EpiGU8, pg8::SchedGrp, true, true>(lds, (const unsigned char*)Y, 1024, S, E, tid);
                }
            }
            SEAM(pb + 6 + 2 * c);
            if (EN(11) && IN(pb + 7 + 2 * c) && nM > 0) {
                if (L == 0 && SPLITK && c == 2 && FP8_DDN) { PHASE_REGS();
                    pg8::SchedSplit S{G, bx, nM, 4, 7, 4, (const char*)(ws + WS_W + W_DD), DFF};
                    pg8::EpiPart E{(float*)(ws + WS_R + R_PART), nM * 256, DM};
                    pg8::gemm_phase<pg8::EpiPart, pg8::SchedSplit, false, true>(lds, (const unsigned char*)(ws + WS_R + R_ACT), DFF, S, E, tid, 4);
                } else if (L == 0 && !FP8_DDN) {
                    const int ng = (SPLITK && nM > CHUNK_TILES) ? CHUNK_TILES : nM;
                    { PHASE_REGS();
                      pg8::SchedGrp S{G, bx, t0, ng, 4, (const char*)(ws + WS_W + W_DD), (size_t)0, 2 * DFF, tl, tokmap, false, MK_PROBE == 22};
                      pg8::EpiDown E{(bf16*)(ws + WS_R + R_F), dstmap, gatemap};
                      pg8::gemm_phase<pg8::EpiDown, pg8::SchedGrp, false, false>(lds, (const unsigned char*)actb, 2 * DFF, S, E, tid); }
                    if (nM > ng) { PHASE_REGS();
                      pg8::SchedSplit S{G, bx, nM - ng, 4, 14, 4, (const char*)(ws + WS_W + W_DD), 2 * DFF};
                      pg8::EpiPart E{(float*)(ws + WS_R + R_PART0), (nM - ng) * 256, DM};
                      pg8::gemm_phase<pg8::EpiPart, pg8::SchedSplit, false, false>(lds, (const unsigned char*)actb + (size_t)ng * 256 * 2 * DFF, 2 * DFF, S, E, tid, 4); }
                } else { PHASE_REGS();
                    pg8::SchedGrp S{G, bx, t0, nM, 4, (const char*)(ws + WS_W + (L == 0 ? W_DD : W_DE)), L == 0 ? (size_t)0 : (size_t)1024 * DFF, DFF, tl, tokmap, false, MK_PROBE == 24};
                    pg8::EpiDown8 E{(bf16*)(ws + WS_R + R_F), dstmap, gatemap};
                    pg8::gemm_phase<pg8::EpiDown8, pg8::SchedGrp, false, true>(lds, (const unsigned char*)actb, DFF, S, E, tid);
                }
            }
            SEAM(pb + 7 + 2 * c);
        }
        if (EN(12) && IN(pb + 16)) { PHASE_REGS(); norm_end_phase(args, ws, L, wave, lane); }
        if (L == 0) SEAM(pb + 16);
    }
#undef IN
#undef SEAM
}

extern "C" void kernel_launch(void* const* d_in, const int* in_sizes, int n_in, void* d_out, int out_size, void* d_ws, size_t ws_size, hipStream_t stream) {
    static int grid = 0;
    if (grid == 0) {
        if (n_in != 25 || out_size != MLAT * DM || ws_size < WS_END) { fprintf(stderr, "kernel_launch: unexpected shapes (n_in %d out %d ws %zu, need %zu)\n", n_in, out_size, ws_size, (size_t)WS_END); grid = -1; return; }
        int dev = 0, cus = 0, per_cu = 0;
        if (hipGetDevice(&dev) != hipSuccess || hipDeviceGetAttribute(&cus, hipDeviceAttributeMultiprocessorCount, dev) != hipSuccess) { grid = -1; return; }
        if (hipFuncSetAttribute((const void*)fwd_kernel, hipFuncAttributeMaxDynamicSharedMemorySize, LDS_BYTES) != hipSuccess) { fprintf(stderr, "kernel_launch: hipFuncSetAttribute failed\n"); grid = -1; return; }
        if (hipOccupancyMaxActiveBlocksPerMultiprocessor(&per_cu, (const void*)fwd_kernel, NTHR, LDS_BYTES) != hipSuccess || per_cu < 1) fprintf(stderr, "kernel_launch: occupancy query says %d\n", per_cu);
        (void)hipGetLastError();
        grid = cus > 256 ? 256 : cus;
    }
    if (grid < 0) return;
    (void)hipMemsetAsync((char*)d_ws + WS_CTL, 0, CTL_ZERO_BYTES, stream);
    Args a{};
    for (int i = 0; i < 25; ++i) a.in[i] = (const float*)d_in[i];
    a.out = (float*)d_out; a.ws = (unsigned char*)d_ws;
#if MK_MULTI
    for (int p = 0; p < PH_END; ++p) {
        const int k = p < 2 ? -1 : (p - 2) % PH_L;
        if (k > 16 || k == 5) continue;
        a.ph_lo = p; a.ph_hi = p + 1;
        hipLaunchKernelGGL(fwd_kernel, dim3(grid), dim3(NTHR), LDS_BYTES, stream, a);
    }
#else
    a.ph_lo = 0; a.ph_hi = PH_END;
    hipLaunchKernelGGL(fwd_kernel, dim3(grid), dim3(NTHR), LDS_BYTES, stream, a);
#endif
}
```

```cpp
#include <hip/hip_runtime.h>
#include <cstdio>
#include <cstdint>

#ifndef MK_MULTI
#define MK_MULTI 0
#endif
#define SPLITK (!MK_MULTI)
#ifndef MK_EN
#define MK_EN 0xFFFF
#endif
#define EN(b) (((MK_EN) >> (b)) & 1)
#ifndef MK_PROBE
#define MK_PROBE 0
#endif
#define KDUP_IN (MK_PROBE == 20)
#define KDUP_GRP (MK_PROBE >= 21 && MK_PROBE <= 24)
#define REP(k) ((MK_PROBE == (k)) ? 2 : 1)
#ifndef FILL
#define FILL 1
#endif

#define GAS __attribute__((address_space(1)))
#define LAS __attribute__((address_space(3)))
typedef unsigned short bf16;
typedef short bf16x8 __attribute__((ext_vector_type(8)));
typedef float f32x4 __attribute__((ext_vector_type(4)));
typedef float f32x2 __attribute__((ext_vector_type(2)));
typedef unsigned u32x4 __attribute__((ext_vector_type(4)));
typedef unsigned u32x2 __attribute__((ext_vector_type(2)));
typedef int i32x8 __attribute__((ext_vector_type(8)));
typedef GAS unsigned gu32;
#define RLX_AGENT __ATOMIC_RELAXED, __HIP_MEMORY_SCOPE_AGENT
#define LDS_WAIT() asm volatile("s_waitcnt lgkmcnt(0)" ::: "memory")
#define VM_WAIT() asm volatile("s_waitcnt vmcnt(0)" ::: "memory")
#define DI __device__ __forceinline__

constexpr int NB = 4, NLAT = 8192, NCTX = 256, DM = 1024;
constexpr int MLAT = NB * NLAT, MCTX = NB * NCTX, MALL = MLAT + MCTX;
constexpr int NZ = 1792;
constexpr int ZU = 0, ZV = 256, ZP = 512, ZQI = 768, ZQ = 1024, ZK = 1536, ZVV = 1664;
constexpr int DFF = 3584, NE = 8;
constexpr float EPS = 1e-6f, LOG2E = 1.4426950408889634f, QSCALE = 0.125f * 1.4426950408889634f;
constexpr int NWAVES = 8, NTHR = 512;
#ifndef FP8_DGU
#define FP8_DGU 1
#endif
#ifndef FP8_DDN
#define FP8_DDN 0
#endif
constexpr int CHUNK_TILES = 64;

constexpr size_t MiB = 1u << 20;
constexpr size_t WS_CTL = 0, CTL_ZERO_BYTES = 1 * MiB;
constexpr size_t WS_MOD = 6 * MiB;
constexpr size_t WS_TAB = 2 * MiB;
constexpr size_t T_G1 = 0, T_G3 = 32768, T_GC = 98304, T_WS = 360448, T_ROPE = 622592;
constexpr size_t WS_RT = 3 * MiB;
constexpr size_t RT_TOK = 0, RT_DST = 327680, RT_GATE = 655360, RT_TILE = 983040, RT_WGCNT = 985088, RT_ROW = 1 * MiB;
constexpr size_t WS_W = 8 * MiB;
constexpr size_t W_IN = 0, W_OUT = 7 * MiB, W_GUD = 11 * MiB, W_DD = 25 * MiB, W_GUE = 32 * MiB, W_DE = 88 * MiB;
constexpr size_t WS_H3 = 8 * MiB + 120 * MiB + 17 * 4096 + 512;
constexpr size_t WS_HCTX = 208 * MiB;
constexpr size_t WS_Y = 212 * MiB;
constexpr size_t WS_R = 278 * MiB;
constexpr size_t R_Z = 0, R_O = 9 * 4096 + 256  , R_OC = 116 * MiB, R_T = 182 * MiB, R_ACT = 0, R_F = 116 * MiB;
constexpr size_t ACT0_BACK = 8 * MiB;
constexpr size_t ACT1_BACK = 16 * MiB;
constexpr size_t R_PART0 = 182 * MiB;
constexpr size_t R_PART = 8 * MiB;
static_assert((size_t)MCTX * DFF * 2 <= 8 * MiB && R_PART + (size_t)14 * MCTX * DM * 4 <= 116 * MiB, "partials fit the activation region");
constexpr size_t WS_RT1 = 278 * MiB + 248 * MiB;
constexpr int CAP = 32768;
constexpr size_t RT1_TOK = 0, RT1_DST = 1 * MiB, RT1_GATE = 2 * MiB;
constexpr size_t WS_END = WS_RT1 + 3 * MiB;
static_assert((size_t)MALL * NZ * 2 <= 116 * MiB && (size_t)(CHUNK_TILES * 256) * DFF * 2 <= 116 * MiB && (size_t)(132 * 256) * DFF <= 116 * MiB && (size_t)2 * MALL * DM * 2 <= 132 * MiB, "ws map");
constexpr int CW_TMO = 0, CW_NTILES = 16, CW_CVT = 32, CW_GCNT = 48, CW_DONE = 64, CW_BAR = 4096;

constexpr int RING_BYTES = 131072, LDSCTL_OFF = RING_BYTES, LDS_BYTES = 163840;
constexpr int LC_ROPE = 16384;
constexpr int LC_BAR = 0;
constexpr int LC_TILE = 64;
constexpr int LC_CNT = 64 + 2048;
constexpr int LC_FILL = 64 + 2048 + 128;

DI unsigned cvt_pk_bf16(float lo, float hi) { unsigned r; asm volatile("v_cvt_pk_bf16_f32 %0, %1, %2" : "=v"(r) : "v"(lo), "v"(hi)); return r; }
DI unsigned short f2bf(float f) { return (unsigned short)(cvt_pk_bf16(f, 0.f) & 0xffffu); }
DI float bflo(unsigned w) { return __uint_as_float(w << 16); }
DI float bfhi(unsigned w) { return __uint_as_float(w & 0xffff0000u); }
DI float shx(float v, int mask, int lane) { return __builtin_bit_cast(float, __builtin_amdgcn_ds_bpermute((lane ^ mask) << 2, __builtin_bit_cast(int, v))); }
template <int CTRL> DI float dppx(float x) { return __builtin_bit_cast(float, __builtin_amdgcn_mov_dpp(__builtin_bit_cast(int, x), CTRL, 0xf, 0xf, true)); }
DI float xrow16_sum(float x) {
    auto s = __builtin_amdgcn_permlane16_swap(__float_as_uint(x), __float_as_uint(x), false, false);
    x = __uint_as_float(s[0]) + __uint_as_float(s[1]);
    auto t = __builtin_amdgcn_permlane32_swap(__float_as_uint(x), __float_as_uint(x), false, false);
    return __uint_as_float(t[0]) + __uint_as_float(t[1]);
}
DI float xrow16_max(float x) {
    auto s = __builtin_amdgcn_permlane16_swap(__float_as_uint(x), __float_as_uint(x), false, false);
    x = fmaxf(__uint_as_float(s[0]), __uint_as_float(s[1]));
    auto t = __builtin_amdgcn_permlane32_swap(__float_as_uint(x), __float_as_uint(x), false, false);
    return fmaxf(__uint_as_float(t[0]), __uint_as_float(t[1]));
}
DI float wave_sum(float v, int) {
    v += dppx<0xB1>(v);
    v += dppx<0x4E>(v);
    v += dppx<0x141>(v);
    v += dppx<0x128>(v);
    return xrow16_sum(v);
}
DI float fexp2(float x) { return __builtin_amdgcn_exp2f(x); }
DI float vmax3(float a, float b, float c) { float r; asm("v_max3_f32 %0, %1, %2, %3" : "=v"(r) : "v"(a), "v"(b), "v"(c)); return r; }
DI float frcp(float x) { return __builtin_amdgcn_rcpf(x); }
DI float gelu_tanh(float x) { const float u = 0.7978845608028654f * (x + 0.044715f * x * x * x); return x * frcp(1.0f + fexp2(-2.0f * LOG2E * u)); }
DI float silu_f(float x) { return x * frcp(1.0f + fexp2(-LOG2E * x)); }
DI f32x4 mfma16(bf16x8 a, bf16x8 b, f32x4 c) { return __builtin_amdgcn_mfma_f32_16x16x32_bf16(a, b, c, 0, 0, 0); }
typedef short v4i16_t __attribute__((ext_vector_type(4)));
DI bf16x8 trfrag(const LAS unsigned char* p, int pitch, int lane) {
    const LAS unsigned char* q = p + (8 * (lane >> 4) + ((lane & 15) >> 2)) * pitch + 8 * (lane & 3);
    const v4i16_t lo = __builtin_amdgcn_ds_read_tr16_b64_v4i16((LAS v4i16_t*)q), hi = __builtin_amdgcn_ds_read_tr16_b64_v4i16((LAS v4i16_t*)(q + 4 * pitch));
    return __builtin_shufflevector(lo, hi, 0, 1, 2, 3, 4, 5, 6, 7);
}

#define XB_TMO      128
#define XB_XCNT(j)  (256  + 64 * (j))
#define XB_XSUB(j)  (1280 + 64 * (j))
#define XB_XGEN(j)  (2304 + 64 * (j))
#define XB_TOP      3328
#define XB_TOPGEN   3392
#define XCD_BAR_WORDS 3456
#define XB_SPIN_CAP (1u << 18)
DI unsigned xb_ld(unsigned* p)              { return __hip_atomic_load(p, __ATOMIC_RELAXED, __HIP_MEMORY_SCOPE_AGENT); }
DI unsigned xb_add(unsigned* p, unsigned v) { return __hip_atomic_fetch_add(p, v, __ATOMIC_RELAXED, __HIP_MEMORY_SCOPE_AGENT); }
DI unsigned xb_xcc_id() { return (unsigned)__builtin_amdgcn_s_getreg((3 << 11) | 20) & 0xFu; }
#define XB_SPIN(cond, bar) do { unsigned _sp = 0; while (cond) { __builtin_amdgcn_s_sleep(1); \
    if ((++_sp & 255u) == 0u) { if (xb_ld(&(bar)[XB_TMO])) break; if (_sp > XB_SPIN_CAP) { atomicAdd(&(bar)[XB_TMO], 1u); break; } } } } while (0)
struct XcdBarrier { unsigned* bar; unsigned x; volatile LAS unsigned* st; };
DI XcdBarrier xcd_barrier_post(unsigned* bar, volatile LAS unsigned* st) {
    XcdBarrier b; b.bar = bar; b.x = xb_xcc_id(); b.st = st;
    if (threadIdx.x == 0) (void)xb_add(&bar[XB_XCNT(b.x)], 1u);
    return b;
}
DI void xcd_barrier_complete(unsigned* bar, unsigned x, unsigned& nloc, unsigned& nx) {
    const unsigned G = gridDim.x * gridDim.y * gridDim.z;
    unsigned sum, cnt, mine, sp = 0u;
    for (;;) {
        sum = 0u; cnt = 0u; mine = 0u;
#pragma unroll
        for (unsigned j = 0; j < 16; ++j) { const unsigned c = xb_ld(&bar[XB_XCNT(j)]); sum += c; cnt += (c > 0u) ? 1u : 0u; mine = (j == x) ? c : mine; }
        if (sum == G) break;
        __builtin_amdgcn_s_sleep(1);
        if ((++sp & 255u) == 0u) { if (xb_ld(&bar[XB_TMO])) break; if (sp > XB_SPIN_CAP) { atomicAdd(&bar[XB_TMO], 1u); break; } }
    }
    nloc = mine > 0u ? mine : 1u; nx = cnt > 0u ? cnt : 1u;
}
DI void xcd_barrier(const XcdBarrier& b, const bool leader) {
    asm volatile("s_waitcnt vmcnt(0)" ::: "memory");
    __syncthreads();
    if (leader) {
        unsigned* bar = b.bar;
        __builtin_amdgcn_s_waitcnt(0);
        unsigned nloc = b.st[0], nx = b.st[1];
        if (nloc == 0u) { xcd_barrier_complete(bar, b.x, nloc, nx); b.st[0] = nloc; b.st[1] = nx; }
        const unsigned old = xb_add(&bar[XB_XSUB(b.x)], 1u);
        const unsigned gen = old / nloc;
        if (old + 1u == (gen + 1u) * nloc) {
            __builtin_amdgcn_fence(__ATOMIC_RELEASE, "agent");
            asm volatile("s_waitcnt vmcnt(0)" ::: "memory");
            const unsigned og = xb_add(&bar[XB_TOP], 1u);
            const unsigned tg = og / nx;
            if (og + 1u == (tg + 1u) * nx) xb_add(&bar[XB_TOPGEN], 1u);
            else XB_SPIN(xb_ld(&bar[XB_TOPGEN]) == tg, bar);
            __builtin_amdgcn_fence(__ATOMIC_ACQUIRE, "agent");
            xb_add(&bar[XB_XGEN(b.x)], 1u);
            asm volatile("s_waitcnt vmcnt(0)" ::: "memory");
        } else {
            XB_SPIN(xb_ld(&bar[XB_XGEN(b.x)]) == gen, bar);
            __builtin_amdgcn_fence(__ATOMIC_ACQUIRE, "agent");
            asm volatile("s_waitcnt vmcnt(0)" ::: "memory");
        }
    }
    __syncthreads();
}

namespace pg8 {
typedef unsigned short bf16_t;
constexpr int BM = 256, BK = 64, HALF = 128, HTB = HALF * BK * 2, STAGE_BYTES = 8 * HTB;
DI int lds_byte(int r, int c) { const int st = (r >> 4) * 2 + (c >> 5), rr = r & 15, cc = c & 31, ob = rr * 64 + cc * 2; return st * 1024 + (ob ^ (((ob >> 9) & 1) << 5)); }
DI void stage_rc(int b, int& R, int& C) { const int st = b / 1024, sb = b % 1024, swz = sb ^ (((sb >> 9) & 1) << 5); R = (st >> 1) * 16 + swz / 64; C = (st & 1) * 32 + (swz % 64) / 2; }
DI int perm32(int rho) { const int n = rho >> 4, i = rho & 15; return 8 * (i >> 2) + 4 * n + (i & 3); }

struct Unit { int pm, pn; int arow; unsigned boff; int dup; int slot0; unsigned kofs; int ks; };

DI void static_map(int wgid, int nM, int nN, int& pm, int& pn) {
    const int nwg = nM * nN; const int q = nwg / 8, r = nwg % 8, xcd = wgid % 8, off = wgid / 8;
    wgid = (xcd < r ? xcd * (q + 1) : r * (q + 1) + (xcd - r) * q) + off;
    const int nig = 8 * nN, gid = wgid / nig, fm = gid * 8, gsz = (nM - fm) < 8 ? (nM - fm) : 8;
    pm = fm + ((wgid % nig) % gsz); pn = (wgid % nig) / gsz;
}

template <class Epi, class Sched, bool GATHER, bool FP8>
DI void gemm_phase(LAS unsigned char* lds, const unsigned char* Abase, const int rowbytes, const Sched& S, const Epi& E, const int tid, const int ntk = 0) {
    const int wid = __builtin_amdgcn_readfirstlane(tid >> 6), lane = tid & 63, wr = wid >> 2, wc = wid & 3, fr = lane & 15, fq = lane >> 4;
    const int nt = ntk ? ntk : rowbytes / 128;
    unsigned voffA, voffB, cofs; int Rr[2];
    { int R, C; stage_rc(tid * 16, R, C); const int Rb = (R & ~31) + perm32(R & 31);
      voffA = (unsigned)(R * rowbytes + C * 2); voffB = (unsigned)(Rb * rowbytes + C * 2); cofs = (unsigned)C * 2u; Rr[0] = R; Rr[1] = R + 64; }
    const unsigned kstep = (unsigned)(BK * 2);
    const unsigned hstep = (unsigned)HALF * (unsigned)rowbytes;
    const unsigned istep = 64u * (unsigned)rowbytes;
    const unsigned rowb = (unsigned)rowbytes;
    const unsigned ldsw = (unsigned)wid * 1024u;
    const int aoff = lds_byte(wr * 64 + fr, fq * 8), boff = lds_byte(wc * 32 + fr, fq * 8);
    const __amdgpu_buffer_rsrc_t rA = __builtin_amdgcn_make_buffer_rsrc((void*)Abase, (short)0, 0x7fffffff, 0x00020000);
    const __amdgpu_buffer_rsrc_t rB = __builtin_amdgcn_make_buffer_rsrc((void*)S.wbase(), (short)0, 0x7fffffff, 0x00020000);
#define PG8_SA(b, h) (((b) * 2 + (h)) * HTB)
#define PG8_SB(b, h) ((4 + (b) * 2 + (h)) * HTB)
#define PG8_DMA(rs, ldsoff, vo, so) __builtin_amdgcn_raw_ptr_buffer_load_lds(rs, (LAS void*)(lds + (ldsoff)), 16, (int)(vo), (int)(so), 0, 0)
#define PG8_STAGE(bufoff, so) do { PG8_DMA(rB, (bufoff) + ldsw, voffB, (so)); PG8_DMA(rB, (bufoff) + ldsw + 8192, voffB, (so) + istep); } while (0)
#define PG8_STAGE_A(bufoff, h, kb, nx) do { if constexpr (GATHER) { PG8_DMA(rA, (bufoff) + ldsw, aoC[h][0], (kb)); PG8_DMA(rA, (bufoff) + ldsw + 8192, aoC[h][1], (kb)); } \
        else { const unsigned so_ = ((nx) ? nA : cA) + (unsigned)(h) * hstep + (kb); PG8_DMA(rA, (bufoff) + ldsw, voffA, so_); PG8_DMA(rA, (bufoff) + ldsw + 8192, voffA, so_ + istep); } } while (0)
#define PG8_LDA(dst, b, h) do { _Pragma("unroll") for (int m = 0; m < 4; ++m) { const u32x4 lo_ = *(const LAS u32x4*)(lds + PG8_SA(b, h) + aoff + m * 2048), hi_ = *(const LAS u32x4*)(lds + PG8_SA(b, h) + aoff + m * 2048 + 1024); \
        dst[m] = (i32x8){(int)lo_.x, (int)lo_.y, (int)lo_.z, (int)lo_.w, (int)hi_.x, (int)hi_.y, (int)hi_.z, (int)hi_.w}; } } while (0)
#define PG8_LDB(dst, b, h) do { _Pragma("unroll") for (int n = 0; n < 2; ++n) { const u32x4 lo_ = *(const LAS u32x4*)(lds + PG8_SB(b, h) + boff + n * 2048), hi_ = *(const LAS u32x4*)(lds + PG8_SB(b, h) + boff + n * 2048 + 1024); \
        dst[n] = (i32x8){(int)lo_.x, (int)lo_.y, (int)lo_.z, (int)lo_.w, (int)hi_.x, (int)hi_.y, (int)hi_.z, (int)hi_.w}; } } while (0)
#define PG8_HALF(v, k) __builtin_bit_cast(bf16x8, __builtin_shufflevector(v, v, 4 * (k), 4 * (k) + 1, 4 * (k) + 2, 4 * (k) + 3))
#define PG8_MMA(ai, bj, At, Bt) do { __builtin_amdgcn_s_setprio(1); if constexpr (FP8) { _Pragma("unroll") for (int m = 0; m < 4; ++m) _Pragma("unroll") for (int n = 0; n < 2; ++n) \
        acc[ai][bj][m][n] = __builtin_amdgcn_mfma_scale_f32_16x16x128_f8f6f4(Bt[n], At[m], acc[ai][bj][m][n], 0, 0, 0, 0, 0, 0); } \
    else { _Pragma("unroll") for (int m = 0; m < 4; ++m) _Pragma("unroll") for (int n = 0; n < 2; ++n) { \
        acc[ai][bj][m][n] = __builtin_amdgcn_mfma_f32_16x16x32_bf16(PG8_HALF(Bt[n], 0), PG8_HALF(At[m], 0), acc[ai][bj][m][n], 0, 0, 0); \
        acc[ai][bj][m][n] = __builtin_amdgcn_mfma_f32_16x16x32_bf16(PG8_HALF(Bt[n], 1), PG8_HALF(At[m], 1), acc[ai][bj][m][n], 0, 0, 0); } } __builtin_amdgcn_s_setprio(0); } while (0)
#define PG8_WAIT_V(n) asm volatile("s_waitcnt vmcnt(" #n ")" ::: "memory")
#define PG8_WAIT_L(n) asm volatile("s_waitcnt lgkmcnt(" #n ")" ::: "memory")
#define PG8_BAR __builtin_amdgcn_s_barrier()
#define PG8_SCHED __builtin_amdgcn_sched_barrier(0)
    Unit cur, nxt; int ui = 0;
    if (!S.next(0, cur)) return;
    f32x4 acc[2][2][4][2];
#pragma unroll
    for (int a = 0; a < 2; ++a)
#pragma unroll
        for (int b = 0; b < 2; ++b)
#pragma unroll
            for (int m = 0; m < 4; ++m)
#pragma unroll
                for (int n = 0; n < 2; ++n) acc[a][b][m][n] = (f32x4){0.f, 0.f, 0.f, 0.f};
    i32x8 At[4], B0[2], B1[2];
    unsigned aoC[2][2];
    LAS unsigned short* gidx = (LAS unsigned short*)(lds + 131072 + 4096);
    unsigned cA = (unsigned)cur.arow * rowb + cur.kofs, cB = cur.boff + cur.kofs;
    if constexpr (GATHER) {
        Unit pu;
        for (int i = 0; i < 16 && S.next(i, pu); ++i) if (tid < 256) gidx[i * 256 + tid] = (unsigned short)S.rowidx(pu.arow + tid);
        __syncthreads();
    }
#pragma unroll
    for (int h = 0; h < 2; ++h)
#pragma unroll
        for (int i = 0; i < 2; ++i) aoC[h][i] = GATHER ? (unsigned)gidx[128 * h + Rr[i]] * rowb + cofs : 0u;
    unsigned nA = cA, nB = cB;
    PG8_STAGE(PG8_SB(0, 0), cB); PG8_STAGE(PG8_SB(0, 1), cB + hstep); PG8_STAGE_A(PG8_SA(0, 0), 0, 0u, false); PG8_STAGE_A(PG8_SA(0, 1), 1, 0u, false);
    if (wr == 1) PG8_BAR;
    PG8_WAIT_V(2); PG8_BAR;
    PG8_STAGE(PG8_SB(1, 0), cB + kstep); PG8_STAGE_A(PG8_SA(1, 0), 0, kstep, false); PG8_STAGE(PG8_SB(1, 1), cB + hstep + kstep);
    PG8_WAIT_V(6); PG8_BAR;
    for (;;) {
        const bool has_next = S.next(ui + 1, nxt);
        nA = has_next ? (unsigned)nxt.arow * rowb + nxt.kofs : cA; nB = has_next ? nxt.boff + nxt.kofs : cB;
#pragma unroll 1
        for (int t = 0; t < nt; t += 2) {
            const bool last = (t == nt - 2);
            const unsigned kb1 = (unsigned)(t + 1) * kstep, kb2 = last ? 0u : (unsigned)(t + 2) * kstep, kb3 = kb2 + kstep;
            const unsigned b2 = (last ? nB : cB) + kb2, b3 = b2 + kstep;
            PG8_LDB(B0, 0, 0); PG8_LDB(B1, 0, 1); PG8_SCHED; PG8_LDA(At, 0, 0); PG8_STAGE_A(PG8_SA(1, 1), 1, kb1, false);
            PG8_WAIT_V(8); PG8_WAIT_L(0); PG8_BAR; PG8_MMA(0, 0, At, B0); PG8_MMA(0, 1, At, B1); PG8_BAR; PG8_SCHED;
            if constexpr (GATHER) { if (last && has_next) { const LAS unsigned short* gi = gidx + (ui + 1) * 256;
                aoC[0][0] = (unsigned)gi[Rr[0]] * rowb + cofs; aoC[0][1] = (unsigned)gi[Rr[1]] * rowb + cofs; aoC[1][0] = (unsigned)gi[128 + Rr[0]] * rowb + cofs; aoC[1][1] = (unsigned)gi[128 + Rr[1]] * rowb + cofs; } }
            PG8_LDA(At, 0, 1); PG8_STAGE(PG8_SB(0, 0), b2); PG8_STAGE(PG8_SB(0, 1), b2 + hstep); PG8_STAGE_A(PG8_SA(0, 0), 0, kb2, last);
            PG8_WAIT_V(8); PG8_WAIT_L(0); PG8_BAR; PG8_MMA(1, 0, At, B0); PG8_MMA(1, 1, At, B1); PG8_BAR; PG8_SCHED;
            PG8_LDB(B0, 1, 0); PG8_LDB(B1, 1, 1); PG8_SCHED; PG8_LDA(At, 1, 0); PG8_STAGE_A(PG8_SA(0, 1), 1, kb2, last);
            PG8_WAIT_V(8); PG8_WAIT_L(0); PG8_BAR; PG8_MMA(0, 0, At, B0); PG8_MMA(0, 1, At, B1); PG8_BAR; PG8_SCHED;
            PG8_LDA(At, 1, 1); PG8_STAGE(PG8_SB(1, 0), b3); PG8_STAGE(PG8_SB(1, 1), b3 + hstep); PG8_STAGE_A(PG8_SA(1, 0), 0, kb3, last);
            PG8_WAIT_V(8); PG8_WAIT_L(0); PG8_BAR; PG8_MMA(1, 0, At, B0); PG8_MMA(1, 1, At, B1); PG8_BAR; PG8_SCHED;
        }
        if (wr == 0) PG8_BAR;
        if (!cur.dup) { int te; asm volatile("v_mbcnt_lo_u32_b32 %0, -1, 0\n\tv_mbcnt_hi_u32_b32 %0, -1, %0" : "=v"(te));
          for (int rep = 0; rep < REP(30); ++rep) E(acc, cur, wr, wc, te & 15, (te & 63) >> 4); }
        if (!has_next) break;
#pragma unroll
        for (int a = 0; a < 2; ++a)
#pragma unroll
            for (int b = 0; b < 2; ++b)
#pragma unroll
                for (int m = 0; m < 4; ++m)
#pragma unroll
                    for (int n = 0; n < 2; ++n) acc[a][b][m][n] = (f32x4){0.f, 0.f, 0.f, 0.f};
        cur = nxt; cA = nA; cB = nB; ++ui;
        if (wr == 1) PG8_BAR;
    }
    PG8_WAIT_V(0);
    PG8_BAR;
#undef PG8_SA
#undef PG8_SB
#undef PG8_STAGE
#undef PG8_DMA
#undef PG8_STAGE_A
#undef PG8_LDA
#undef PG8_LDB
#undef PG8_MMA
#undef PG8_HALF
#undef PG8_WAIT_V
#undef PG8_WAIT_L
#undef PG8_BAR
#undef PG8_SCHED
}

struct SchedIn {
    int G, c, nctx; bool ctx_all; const char* Bt; int rb;
    DI bool next(int i0, Unit& u) const {
        const int i = KDUP_IN ? (i0 >> 1) : i0; u.dup = KDUP_IN ? !(i0 & 1) : 0;
        const long Lx = (long)i * G + c; int pm, pn;
        if (Lx < 896) static_map((int)Lx, 128, 7, pm, pn);
        else { const int j = (int)(Lx - 896); if (j >= nctx) return false; if (ctx_all) { pm = 128 + j / 7; pn = j % 7; } else { pm = 128 + j; pn = 6; } }
        u.pm = pm; u.pn = pn; u.arow = pm * 256; u.boff = (unsigned)(pn * 256 * rb); u.kofs = 0u; u.ks = 0; return true;
    }
    DI int rowidx(int) const { return 0; }
    DI const void* wbase() const { return Bt; }
};
struct SchedPlain {
    int G, c, nM, nN; const char* Bt; int rb;
    DI bool next(int i, Unit& u) const {
        u.dup = 0; const long Lx = (long)i * G + c; if (Lx >= (long)nM * nN) return false; int pm, pn; static_map((int)Lx, nM, nN, pm, pn);
        u.pm = pm; u.pn = pn; u.arow = pm * 256; u.boff = (unsigned)(pn * 256 * rb); u.kofs = 0u; u.ks = 0; return true;
    }
    DI int rowidx(int) const { return 0; }
    DI const void* wbase() const { return Bt; }
};
struct SchedGrp {
    int G, c, t0, nM, nN; const char* W; size_t wstride; int rb; const LAS int* tile_e; const int* tokmap; bool gather; bool kdup;
    DI bool next(int i0, Unit& u) const {
        const int i = (KDUP_GRP && kdup) ? (i0 >> 1) : i0; u.dup = (KDUP_GRP && kdup) ? !(i0 & 1) : 0;
        const long Lx = (long)i * G + c; if (Lx >= (long)nM * nN) return false; int pm, pn; static_map((int)Lx, nM, nN, pm, pn);
        const int te = __builtin_amdgcn_readfirstlane(tile_e[t0 + pm]);
        const int e = te >> 24; u.slot0 = te & 0xffffff;
        u.pm = t0 + pm; u.pn = pn; u.arow = gather ? u.slot0 : pm * 256; u.boff = (unsigned)e * (unsigned)wstride + (unsigned)(pn * 256 * rb); u.kofs = 0u; u.ks = 0; return true;
    }
    DI int rowidx(int slot) const { return tokmap[slot]; }
    DI const void* wbase() const { return W; }
};

struct SchedSplit {
    int G, c, nM, nN, S, ntk; const char* Bt; int rb;
    DI bool next(int i, Unit& u) const {
        const long Lx = (long)i * G + c; if (Lx >= (long)nM * nN * S) return false;
        const int ks = (int)(Lx % S), rest = (int)(Lx / S), pn = rest % nN, pm = rest / nN;
        u.pm = pm; u.pn = pn; u.arow = pm * 256; u.boff = (unsigned)(pn * 256 * rb); u.kofs = (unsigned)(ks * ntk * 128); u.ks = ks; u.dup = 0; u.slot0 = 0; return true;
    }
    DI int rowidx(int) const { return 0; }
    DI const void* wbase() const { return Bt; }
};
#ifndef EPI_NT
#define EPI_NT 0
#endif
#if EPI_NT
#define EPI_ST(p, v) __builtin_nontemporal_store((v), (p))
#else
#define EPI_ST(p, v) (*(p) = (v))
#endif
typedef f32x4 Acc[2][2][4][2];
DI u32x4 tr4(u32x4 w, int te) { const int src = (((te & 3) << 4) | (te >> 2)) << 2; u32x4 r;
    r.x = (unsigned)__builtin_amdgcn_ds_bpermute(src, (int)w.x); r.y = (unsigned)__builtin_amdgcn_ds_bpermute(src, (int)w.y); r.z = (unsigned)__builtin_amdgcn_ds_bpermute(src, (int)w.z); r.w = (unsigned)__builtin_amdgcn_ds_bpermute(src, (int)w.w); return r; }
struct EpiZ {
    bf16_t* Z; const LAS float* rc; const LAS float* rs;
    DI void operator()(const Acc& acc, const Unit& u, int wr, int wc, int fr, int fq) const {
        const int pn = u.pn, row0 = u.pm * 256 + wr * 64 + fr, te = fq * 16 + fr;
        const bool lat = u.pm < 128;
        bf16_t* rowp0 = Z + (size_t)(u.pm * 256 + wr * 64 + (te >> 2)) * NZ + pn * 256 + wc * 32 + 8 * (te & 3);
#pragma unroll
        for (int ai = 0; ai < 2; ++ai)
#pragma unroll
            for (int m = 0; m < 4; ++m) {
                const int row = row0 + ai * 128 + m * 16; bf16_t* rowp = rowp0 + (size_t)(ai * 128 + m * 16) * NZ;
#pragma unroll
                for (int bj = 0; bj < 2; ++bj) {
                    f32x4 v0 = acc[ai][bj][m][0], v1 = acc[ai][bj][m][1];
                    if (pn < 2) {
#pragma unroll
                        for (int j = 0; j < 4; ++j) { v0[j] = gelu_tanh(v0[j]); v1[j] = gelu_tanh(v1[j]); }
                    } else if (pn >= 4 && !(pn == 6 && bj == 1)) {
                        if (lat) {
                            const int n = row & (NLAT - 1); const int pos = (wc & 1) ? (n & 63) : (n >> 6); const int fb = 8 * (fq & 1);
                            const f32x4 c0 = *(const LAS f32x4*)(rc + pos * 16 + fb), c1 = *(const LAS f32x4*)(rc + pos * 16 + fb + 4);
                            const f32x4 s0 = *(const LAS f32x4*)(rs + pos * 16 + fb), s1 = *(const LAS f32x4*)(rs + pos * 16 + fb + 4);
                            const float sg = (fq >> 1) ? 1.f : -1.f;
                            f32x4 p0, p1;
#pragma unroll
                            for (int j = 0; j < 4; ++j) { p0[j] = shx(v0[j], 32, fq * 16 + fr); p1[j] = shx(v1[j], 32, fq * 16 + fr); }
                            v0 = v0 * c0 + sg * p0 * s0; v1 = v1 * c1 + sg * p1 * s1;
                        }
                        if (pn < 6) { v0 = v0 * QSCALE; v1 = v1 * QSCALE; }
                    }
                    u32x4 w; w.x = cvt_pk_bf16(v0[0], v0[1]); w.y = cvt_pk_bf16(v0[2], v0[3]); w.z = cvt_pk_bf16(v1[0], v1[1]); w.w = cvt_pk_bf16(v1[2], v1[3]);
                    EPI_ST((u32x4*)(rowp + bj * 128), tr4(w, te));
                }
            }
    }
};
struct EpiO {
    bf16_t* O; int ldc;
    DI void operator()(const Acc& acc, const Unit& u, int wr, int wc, int fr, int fq) const {
        const int te = fq * 16 + fr, row0 = u.pm * 256 + wr * 64 + (te >> 2), colb = u.pn * 256 + wc * 32 + 8 * (te & 3);
#pragma unroll
        for (int ai = 0; ai < 2; ++ai)
#pragma unroll
            for (int m = 0; m < 4; ++m) { bf16_t* rowp = O + (size_t)(row0 + ai * 128 + m * 16) * ldc + colb;
#pragma unroll
                for (int bj = 0; bj < 2; ++bj) { const f32x4 v0 = acc[ai][bj][m][0], v1 = acc[ai][bj][m][1];
                    u32x4 w; w.x = cvt_pk_bf16(v0[0], v0[1]); w.y = cvt_pk_bf16(v0[2], v0[3]); w.z = cvt_pk_bf16(v1[0], v1[1]); w.w = cvt_pk_bf16(v1[2], v1[3]);
                    EPI_ST((u32x4*)(rowp + bj * 128), tr4(w, te)); } }
    }
};
DI f32x2 swiglu2(f32x2 g, f32x2 u, float c1, float c0, float k0) {
    const f32x2 t = g * c1 + c0; f32x2 e; e.x = fexp2(t.x); e.y = fexp2(t.y);
    const f32x2 d = e + k0; f32x2 r; r.x = frcp(d.x); r.y = frcp(d.y);
    return (g * u) * r;
}
DI f32x2 swiglu2d(f32x2 g, f32x2 u) {
    f32x2 e; e.x = fexp2(-g.x); e.y = fexp2(-g.y);
    const f32x2 d = e * LOG2E + LOG2E; f32x2 r; r.x = frcp(d.x); r.y = frcp(d.y);
    return (g * u) * r;
}
struct EpiGU {
    bf16_t* ACT; int t0;
    DI void operator()(const Acc& acc, const Unit& u, int wr, int wc, int fr, int fq) const {
        const int row0 = (u.pm - t0) * 256 + wr * 64 + fr, colb = u.pn * 128 + wc * 32 + 8 * fq;
#pragma unroll
        for (int ai = 0; ai < 2; ++ai)
#pragma unroll
            for (int m = 0; m < 4; ++m) { bf16_t* rowp = ACT + (size_t)(row0 + ai * 128 + m * 16) * DFF + colb;
                const f32x4 g0 = acc[ai][0][m][0], g1 = acc[ai][0][m][1], u0 = acc[ai][1][m][0], u1 = acc[ai][1][m][1];
                const f32x2 a = swiglu2d((f32x2){g0[0], g0[1]}, (f32x2){u0[0], u0[1]}), b = swiglu2d((f32x2){g0[2], g0[3]}, (f32x2){u0[2], u0[3]});
                const f32x2 c = swiglu2d((f32x2){g1[0], g1[1]}, (f32x2){u1[0], u1[1]}), d = swiglu2d((f32x2){g1[2], g1[3]}, (f32x2){u1[2], u1[3]});
                u32x4 w; w.x = cvt_pk_bf16(a.x, a.y); w.y = cvt_pk_bf16(b.x, b.y); w.z = cvt_pk_bf16(c.x, c.y); w.w = cvt_pk_bf16(d.x, d.y);
                EPI_ST((u32x4*)rowp, w); }
    }
};
struct EpiPart {
    float* P; int rows, ldc;
    DI void operator()(const Acc& acc, const Unit& u, int wr, int wc, int fr, int fq) const {
        const int te = fq * 16 + fr, row0 = u.pm * 256 + wr * 64 + (te >> 2), colb = u.pn * 256 + wc * 32 + 8 * (te & 3);
        float* base = P + (size_t)u.ks * rows * ldc;
#pragma unroll
        for (int ai = 0; ai < 2; ++ai)
#pragma unroll
            for (int m = 0; m < 4; ++m) { float* rowp = base + (size_t)(row0 + ai * 128 + m * 16) * ldc + colb;
#pragma unroll
                for (int bj = 0; bj < 2; ++bj) { *(u32x4*)(rowp + bj * 128) = tr4(__builtin_bit_cast(u32x4, acc[ai][bj][m][0]), te); *(u32x4*)(rowp + bj * 128 + 4) = tr4(__builtin_bit_cast(u32x4, acc[ai][bj][m][1]), te); } }
    }
};
struct EpiDown {
    bf16_t* F; const int* dstmap; const float* gate;
    DI void operator()(const Acc& acc, const Unit& u, int wr, int wc, int fr, int fq) const {
        const int te = fq * 16 + fr, slot0 = u.slot0 + wr * 64 + fr, slot0s = u.slot0 + wr * 64 + (te >> 2), colb = u.pn * 256 + wc * 32 + 8 * (te & 3);
        int dstv[2][4]; float gtv[2][4];
#pragma unroll
        for (int ai = 0; ai < 2; ++ai)
#pragma unroll
            for (int m = 0; m < 4; ++m) { dstv[ai][m] = dstmap[slot0s + ai * 128 + m * 16]; gtv[ai][m] = gate[slot0 + ai * 128 + m * 16]; }
#pragma unroll
        for (int ai = 0; ai < 2; ++ai)
#pragma unroll
            for (int m = 0; m < 4; ++m) { const int dst = dstv[ai][m]; const float gt = gtv[ai][m];
                bf16_t* rowp = F + (size_t)dst * DM + colb;
#pragma unroll
                for (int bj = 0; bj < 2; ++bj) { const f32x4 v0 = acc[ai][bj][m][0] * gt, v1 = acc[ai][bj][m][1] * gt;
                    u32x4 w; w.x = cvt_pk_bf16(v0[0], v0[1]); w.y = cvt_pk_bf16(v0[2], v0[3]); w.z = cvt_pk_bf16(v1[0], v1[1]); w.w = cvt_pk_bf16(v1[2], v1[3]);
                    const u32x4 wt = tr4(w, te);
                    if (dst >= 0) EPI_ST((u32x4*)(rowp + bj * 128), wt); } }
    }
};

constexpr float S8_Y = 16.0f, S8_W = 256.0f, S8_ACT = 8.0f, S8_F = 16.0f;
DI float clamp8(float v) { return __builtin_amdgcn_fmed3f(v, -448.0f, 448.0f); }
DI unsigned pk_fp8x4(float a, float b, float c, float d) { int w0; asm volatile("" : "=v"(w0));
    int w = __builtin_amdgcn_cvt_pk_fp8_f32(clamp8(a), clamp8(b), w0, false); w = __builtin_amdgcn_cvt_pk_fp8_f32(clamp8(c), clamp8(d), w, true); return (unsigned)w; }
struct EpiGU8 {
    unsigned char* ACT; int t0;
    DI void operator()(const Acc& acc, const Unit& u, int wr, int wc, int fr, int fq) const {
        constexpr float us = 1.0f / (S8_Y * S8_W), c1 = -us * LOG2E, c0 = 21.0f, k0 = 2097152.0f;
        static_assert(us * us * S8_ACT * k0 == 1.0f, "k0 = 1 / c2, c0 = log2 k0");
        const int te = fq * 16 + fr, rho = te >> 1, hf = te & 1, srcl = (((2 * hf + (rho >> 4)) << 4) | (rho & 15)) << 2;
        unsigned char* base = ACT + (size_t)((u.pm - t0) * 256 + wr * 64 + rho) * DFF + u.pn * 128 + wc * 32 + 16 * hf;
#pragma unroll
        for (int ai = 0; ai < 2; ++ai)
#pragma unroll
            for (int mp = 0; mp < 4; mp += 2) { u32x2 w[2];
#pragma unroll
                for (int k = 0; k < 2; ++k) { const int m = mp + k;
                    const f32x4 g0 = acc[ai][0][m][0], g1 = acc[ai][0][m][1], u0 = acc[ai][1][m][0], u1 = acc[ai][1][m][1];
                    const f32x2 a = swiglu2((f32x2){g0[0], g0[1]}, (f32x2){u0[0], u0[1]}, c1, c0, k0), b = swiglu2((f32x2){g0[2], g0[3]}, (f32x2){u0[2], u0[3]}, c1, c0, k0);
                    const f32x2 c = swiglu2((f32x2){g1[0], g1[1]}, (f32x2){u1[0], u1[1]}, c1, c0, k0), d = swiglu2((f32x2){g1[2], g1[3]}, (f32x2){u1[2], u1[3]}, c1, c0, k0);
                    w[k].x = pk_fp8x4(a.x, a.y, b.x, b.y); w[k].y = pk_fp8x4(c.x, c.y, d.x, d.y); }
                const auto rx = __builtin_amdgcn_permlane16_swap(w[0].x, w[1].x, false, false), ry = __builtin_amdgcn_permlane16_swap(w[0].y, w[1].y, false, false);
                u32x4 o; o.x = (unsigned)__builtin_amdgcn_ds_bpermute(srcl, (int)rx[0]); o.y = (unsigned)__builtin_amdgcn_ds_bpermute(srcl, (int)ry[0]); o.z = (unsigned)__builtin_amdgcn_ds_bpermute(srcl, (int)rx[1]); o.w = (unsigned)__builtin_amdgcn_ds_bpermute(srcl, (int)ry[1]);
                EPI_ST((u32x4*)(base + (size_t)(ai * 128 + mp * 16) * DFF), o); }
    }
};
struct EpiGUm {
    bf16_t* ACT; int t0;
    DI void operator()(const Acc& acc, const Unit& u, int wr, int wc, int fr, int fq) const {
        const int te = fq * 16 + fr, row0 = (u.pm - t0) * 256 + wr * 64 + (te >> 2), colb = u.pn * 128 + wc * 32 + 8 * (te & 3);
        constexpr float us = 1.0f / (S8_Y * S8_W), c1 = -us * LOG2E, c0 = 24.0f, k0 = 16777216.0f;
        static_assert(us * us * k0 == 1.0f, "k0 = 1 / us^2, c0 = log2 k0");
#pragma unroll
        for (int ai = 0; ai < 2; ++ai)
#pragma unroll
            for (int m = 0; m < 4; ++m) { bf16_t* rowp = ACT + (size_t)(row0 + ai * 128 + m * 16) * DFF + colb;
                const f32x4 g0 = acc[ai][0][m][0], g1 = acc[ai][0][m][1], u0 = acc[ai][1][m][0], u1 = acc[ai][1][m][1];
                const f32x2 a = swiglu2((f32x2){g0[0], g0[1]}, (f32x2){u0[0], u0[1]}, c1, c0, k0), b = swiglu2((f32x2){g0[2], g0[3]}, (f32x2){u0[2], u0[3]}, c1, c0, k0);
                const f32x2 c = swiglu2((f32x2){g1[0], g1[1]}, (f32x2){u1[0], u1[1]}, c1, c0, k0), d = swiglu2((f32x2){g1[2], g1[3]}, (f32x2){u1[2], u1[3]}, c1, c0, k0);
                u32x4 w; w.x = cvt_pk_bf16(a.x, a.y); w.y = cvt_pk_bf16(b.x, b.y); w.z = cvt_pk_bf16(c.x, c.y); w.w = cvt_pk_bf16(d.x, d.y);
                EPI_ST((u32x4*)rowp, tr4(w, te)); }
    }
};
struct EpiDown8 {
    bf16_t* F; const int* dstmap; const float* gate;
    DI void operator()(const Acc& acc, const Unit& u, int wr, int wc, int fr, int fq) const {
        static_assert(!FP8_DDN, "the dense layer's norm_end reads bf16 F rows");
        const int te = fq * 16 + fr, slot0 = u.slot0 + wr * 64 + fr, slot0s = u.slot0 + wr * 64 + (te >> 2), colb = u.pn * 256 + wc * 32 + 8 * (te & 3);
        constexpr float us = S8_F / (S8_ACT * S8_W);
        const int trs = (((te & 3) << 4) | (te >> 2)) << 2;
        int dstv[2][4]; float gtv[2][4];
#pragma unroll
        for (int ai = 0; ai < 2; ++ai)
#pragma unroll
            for (int m = 0; m < 4; ++m) { dstv[ai][m] = dstmap[slot0s + ai * 128 + m * 16]; gtv[ai][m] = gate[slot0 + ai * 128 + m * 16] * us; }
#pragma unroll
        for (int ai = 0; ai < 2; ++ai)
#pragma unroll
            for (int m = 0; m < 4; ++m) { const int dst = dstv[ai][m]; const float gt = gtv[ai][m];
                unsigned char* rowp = (unsigned char*)F + (size_t)dst * DM + colb;
#pragma unroll
                for (int bj = 0; bj < 2; ++bj) { const f32x4 v0 = acc[ai][bj][m][0] * gt, v1 = acc[ai][bj][m][1] * gt;
                    u32x2 w; w.x = (unsigned)__builtin_amdgcn_ds_bpermute(trs, (int)pk_fp8x4(v0[0], v0[1], v0[2], v0[3])); w.y = (unsigned)__builtin_amdgcn_ds_bpermute(trs, (int)pk_fp8x4(v1[0], v1[1], v1[2], v1[3]));
                    if (dst >= 0) *(u32x2*)(rowp + bj * 128) = w; } }
    }
};
}

struct Args { const float* in[25]; float* out; unsigned char* ws; int ph_lo, ph_hi; };
enum { I_X = 0, I_C, I_CTX, I_CCTX, I_WADA, I_BADA, I_GMPRE, I_GMPOST, I_GFPRE, I_GFPOST, I_WIN, I_WS, I_BS, I_GV, I_WF, I_SINK, I_WOUT, I_WGD, I_WUD, I_WDD, I_WR, I_BR, I_WGE, I_WUE, I_WDE };

struct TJob { const float* src; bf16* dst; int K, Nsrc, ncol0, drow0, kb, f8; float sc; };
constexpr int TJ_IN_A = 256, TJ_IN_B = 384, TJ_OUT = 512, TJ_D = 896, TJ_E = 7168;
constexpr int TJ_TOTAL = TJ_IN_A + TJ_IN_B + TJ_OUT + 3 * TJ_D + 3 * TJ_E;
constexpr int TJ_NOW = TJ_IN_A + TJ_IN_B + TJ_OUT + 3 * TJ_D;
constexpr int TJ_DEF = TJ_TOTAL - TJ_NOW, TJ_BATCH = 16;
static_assert(TJ_DEF % TJ_BATCH == 0, "deferred queue is dealt in whole batches");
DI TJob tj_decode(const Args& a, bf16* WB, int it) {
    TJob J; J.f8 = 0; J.sc = 1.0f;
    if (it < TJ_IN_A) { const int L = it / 128, r = it % 128; J.kb = r / 8; const int nb = r % 8;
        J.src = a.in[I_WIN] + (size_t)L * 1024 * 1536; J.K = 1024; J.Nsrc = 1536; J.ncol0 = 64 * nb; J.dst = WB + W_IN / 2 + (size_t)L * NZ * 1024; J.drow0 = 64 * nb; return J; }
    it -= TJ_IN_A;
    if (it < TJ_IN_B) { const int L = it / 192, r = it % 192; J.kb = r / 12; const int nb = r % 12;
        J.src = a.in[I_WIN] + (size_t)L * 1024 * 1536; J.K = 1024; J.Nsrc = 1536; J.ncol0 = 768 + 64 * nb; J.dst = WB + W_IN / 2 + (size_t)L * NZ * 1024; J.drow0 = 1024 + 64 * nb; return J; }
    it -= TJ_IN_B;
    if (it < TJ_OUT) { const int L = it / 256, r = it % 256; J.kb = r / 16; const int nb = r % 16;
        J.src = a.in[I_WOUT] + (size_t)L * 1024 * 1024; J.K = 1024; J.Nsrc = 1024; J.ncol0 = 64 * nb; J.dst = WB + W_OUT / 2 + (size_t)L * 1024 * 1024; J.drow0 = 64 * nb; return J; }
    it -= TJ_OUT;
    if (it < 2 * TJ_D) { const int up = it / TJ_D, r = it % TJ_D; J.kb = r / 56; const int nb = r % 56, f0 = 64 * nb;
        J.src = a.in[up ? I_WUD : I_WGD]; J.K = 1024; J.Nsrc = DFF; J.ncol0 = f0; J.dst = WB + W_GUD / 2; J.drow0 = (f0 / 128) * 256 + (f0 % 128) + 128 * up; J.sc = FP8_DGU ? pg8::S8_W : (up ? 1.0f : LOG2E); J.f8 = FP8_DGU; return J; }
    it -= 2 * TJ_D;
    if (it < TJ_D) { J.kb = it / 16; const int nb = it % 16;
        J.src = a.in[I_WDD]; J.K = DFF; J.Nsrc = 1024; J.ncol0 = 64 * nb; J.dst = WB + W_DD / 2; J.drow0 = 64 * nb; if (FP8_DDN) { J.f8 = 1; J.sc = pg8::S8_W; } return J; }
    it -= TJ_D;
    if (it < 2 * TJ_E) { const int up = it / TJ_E, r0 = it % TJ_E, e = r0 / TJ_D, r = r0 % TJ_D; J.kb = r / 56; const int nb = r % 56, f0 = 64 * nb;
        J.src = a.in[up ? I_WUE : I_WGE] + (size_t)e * 1024 * DFF; J.K = 1024; J.Nsrc = DFF; J.ncol0 = f0; J.dst = (bf16*)((unsigned char*)WB + W_GUE + (size_t)e * 7168 * 1024); J.drow0 = (f0 / 128) * 256 + (f0 % 128) + 128 * up; J.f8 = 1; J.sc = pg8::S8_W; return J; }
    it -= 2 * TJ_E;
    { const int e = it / TJ_D, r = it % TJ_D; J.kb = r / 16; const int nb = r % 16;
        J.src = a.in[I_WDE] + (size_t)e * DFF * 1024; J.K = DFF; J.Nsrc = 1024; J.ncol0 = 64 * nb; J.dst = (bf16*)((unsigned char*)WB + W_DE + (size_t)e * 1024 * DFF); J.drow0 = 64 * nb; J.f8 = 1; J.sc = pg8::S8_W; return J; }
}
DI void tj_load(const TJob& J, int lane, f32x4 (&v)[16]) {
    const float* p = J.src + (size_t)(64 * J.kb + (lane >> 4)) * J.Nsrc + J.ncol0 + 4 * (lane & 15);
#pragma unroll
    for (int i = 0; i < 16; ++i) v[i] = *(const f32x4*)(p + (size_t)(4 * i) * J.Nsrc);
}
DI void tj_store(const TJob& J, LAS float* scr, int lane, const f32x4 (&v)[16]) {
#pragma unroll
    for (int i = 0; i < 16; ++i) { const int k = 4 * i + (lane >> 4); *(LAS f32x4*)(scr + k * 64 + ((4 * (lane & 15)) ^ (4 * ((k >> 3) & 7)))) = v[i]; }
    LDS_WAIT();
    const int c = lane & 7, k0 = 64 * J.kb;
#pragma unroll
    for (int j = 0; j < 8; ++j) { const int n = (lane >> 3) + 8 * j; const LAS float* s = scr + (8 * c) * 64 + (((n & ~3) ^ (4 * c)) + (n & 3));
        const float x0 = s[0 * 64], x1 = s[1 * 64], x2 = s[2 * 64], x3 = s[3 * 64], x4 = s[4 * 64], x5 = s[5 * 64], x6 = s[6 * 64], x7 = s[7 * 64];
        const float sw = J.sc;
        if (J.f8) { u32x2 o; o.x = pg8::pk_fp8x4(x0 * sw, x1 * sw, x2 * sw, x3 * sw); o.y = pg8::pk_fp8x4(x4 * sw, x5 * sw, x6 * sw, x7 * sw);
            *(u32x2*)((unsigned char*)J.dst + (size_t)(J.drow0 + n) * J.K + k0 + 8 * c) = o; }
        else { u32x4 o; o.x = cvt_pk_bf16(x0 * sw, x1 * sw); o.y = cvt_pk_bf16(x2 * sw, x3 * sw); o.z = cvt_pk_bf16(x4 * sw, x5 * sw); o.w = cvt_pk_bf16(x6 * sw, x7 * sw);
            *(u32x4*)(J.dst + (size_t)(J.drow0 + n) * J.K + k0 + 8 * c) = o; } }
    LDS_WAIT();
}

DI void prologue_a(const Args& a, unsigned char* ws, LAS unsigned char* lds, int tid, int wave, int lane) {
    const int G = gridDim.x, bx = blockIdx.x;
    {
        const int gw = bx * NWAVES + wave, NGW = G * NWAVES;
        float* mp = (float*)(ws + WS_MOD);
        for (int it = gw; it < 2 * 96 * 8; it += NGW) {
            const int ks = it & 7, jg = (it >> 3) % 96, L = it / 768, j0 = 64 * jg;
            float sil[5][2];
#pragma unroll
            for (int s = 0; s < 5; ++s)
#pragma unroll
                for (int hf = 0; hf < 2; ++hf) { const int k = 128 * ks + 64 * hf + lane; sil[s][hf] = silu_f(s < 4 ? a.in[I_C][s * 1024 + k] : a.in[I_CCTX][k]); }
            float acc[5] = {0.f, 0.f, 0.f, 0.f, 0.f};
            const float* wp = a.in[I_WADA] + (size_t)L * 1024 * 6144 + (size_t)(128 * ks) * 6144 + j0 + lane;
#pragma unroll
            for (int hf = 0; hf < 2; ++hf)
#pragma unroll 16
                for (int kk = 0; kk < 64; ++kk) { const float w = wp[(size_t)(64 * hf + kk) * 6144];
#pragma unroll
                    for (int s = 0; s < 5; ++s) acc[s] += __builtin_bit_cast(float, __builtin_amdgcn_readlane(__builtin_bit_cast(int, sil[s][hf]), kk)) * w; }
#pragma unroll
            for (int s = 0; s < 5; ++s) mp[((size_t)(L * 8 + ks) * 5 + s) * 6144 + j0 + lane] = acc[s];
        }
    }
    for (int it = bx; it < 256; it += G) {
        const int L = it >> 7, g = (it >> 5) & 3, kblk = it & 31;
        LAS float* Mt = (LAS float*)lds; LAS float* Wl = (LAS float*)(lds + 32768);
        __syncthreads();
        const float* wf = a.in[I_WF] + (size_t)(L * 4 + g) * 4096;
        LAS float* trg = (LAS float*)(lds + 49152); LAS float* wfl = (LAS float*)(lds + 49152 + 512);
        if (tid < 128) { const float fr = (float)(tid & 63) * (1.0f / 64.0f); trg[tid] = tid < 64 ? __builtin_amdgcn_cosf(fr) : __builtin_amdgcn_sinf(fr); }
        { float t8[8];
#pragma unroll
          for (int k = 0; k < 8; ++k) t8[k] = wf[tid + k * NTHR];
#pragma unroll
          for (int k = 0; k < 8; ++k) wfl[tid + k * NTHR] = t8[k]; }
        const float* wi = a.in[I_WIN] + (size_t)L * 1024 * 1536;
        { float t4[4];
#pragma unroll
          for (int k = 0; k < 4; ++k) { const int idx = tid + k * NTHR, kl = idx >> 6, d = idx & 63; t4[k] = wi[(size_t)(32 * kblk + kl) * 1536 + 512 + 64 * g + d]; }
#pragma unroll
          for (int k = 0; k < 4; ++k) { const int idx = tid + k * NTHR, kl = idx >> 6, d = idx & 63; Wl[kl * 65 + d] = t4[k]; } }
        __syncthreads();
        { const int rg = tid >> 4, cg = tid & 15, pq = rg >> 4, d0 = 4 * (rg & 15);
          f32x4 acc4[4];
#pragma unroll
          for (int i = 0; i < 4; ++i) acc4[i] = (f32x4){0.f, 0.f, 0.f, 0.f};
#pragma unroll 4
          for (int e = 0; e < 64; ++e) { const f32x4 w4 = *(const LAS f32x4*)(wfl + e * 64 + 4 * cg);
#pragma unroll
              for (int i = 0; i < 4; ++i) { const float tv = trg[64 * pq + (((d0 + i) * e) & 63)]; acc4[i] = acc4[i] + w4 * tv; } }
#pragma unroll
          for (int i = 0; i < 4; ++i) *(LAS f32x4*)(Mt + (pq * 64 + d0 + i) * 64 + 4 * cg) = acc4[i]; }
        __syncthreads();
        { const int klp = tid & 15, cgrp = tid >> 4, pq = cgrp >> 4, e20 = 4 * (cgrp & 15);
          bf16* WIN = (bf16*)(ws + WS_W + W_IN) + (size_t)L * NZ * 1024;
          f32x4 s0 = (f32x4){0.f, 0.f, 0.f, 0.f}, s1 = (f32x4){0.f, 0.f, 0.f, 0.f};
#pragma unroll 8
          for (int d = 0; d < 64; ++d) { const f32x4 m4 = *(const LAS f32x4*)(Mt + (pq * 64 + d) * 64 + e20); const float w0 = Wl[(2 * klp) * 65 + d], w1 = Wl[(2 * klp + 1) * 65 + d];
              s0 = s0 + m4 * w0; s1 = s1 + m4 * w1; }
#pragma unroll
          for (int i = 0; i < 4; ++i) *(unsigned*)(WIN + (size_t)(512 + 256 * pq + 64 * g + e20 + i) * 1024 + 32 * kblk + 2 * klp) = cvt_pk_bf16(s0[i], s1[i]); }
    }
    __syncthreads();
    {
        const int gt = bx * NTHR + tid, GT = G * NTHR;
        bf16* G1 = (bf16*)(ws + WS_TAB + T_G1); bf16* G3 = (bf16*)(ws + WS_TAB + T_G3); bf16* GC = (bf16*)(ws + WS_TAB + T_GC); bf16* WSB = (bf16*)(ws + WS_TAB + T_WS);
        float* RC = (float*)(ws + WS_TAB + T_ROPE); float* RS = RC + 2048;
        for (int idx = gt; idx < 128 * 128; idx += GT) { const int m = idx >> 7, kk = idx & 127; const int w = m >> 4, x = m & 15, k1 = 8 * w + 2 * (x >> 2) + ((x & 3) >> 1), ri = x & 1, pq = kk >> 6, n1 = kk & 63;
            const float fr = (float)((k1 * n1) & 63) * (1.0f / 64.0f), c = __builtin_amdgcn_cosf(fr), s = __builtin_amdgcn_sinf(fr);
            G1[idx] = f2bf(ri == 0 ? (pq == 0 ? c : -s) : (pq == 0 ? s : c)); }
        for (int idx = gt; idx < 128 * 256; idx += GT) { const int k2 = idx >> 8, kk = idx & 255, ri = kk >> 7, n2 = kk & 127; const float fr = (float)((k2 * n2) & 127) * (1.0f / 128.0f);
            G3[idx] = f2bf(ri == 0 ? __builtin_amdgcn_cosf(fr) : __builtin_amdgcn_sinf(fr)); }
        for (int idx = gt; idx < 256 * 512; idx += GT) { const int k = idx >> 9, kk = idx & 511, pq = kk >> 8, n = kk & 255; const float fr = (float)((k * n) & 255) * (1.0f / 256.0f);
            GC[idx] = f2bf(pq == 0 ? __builtin_amdgcn_cosf(fr) : -__builtin_amdgcn_sinf(fr)); }
        for (int idx = gt; idx < 2 * 4 * 128 * 128; idx += GT) WSB[idx] = f2bf(a.in[I_WS][idx]);
        { int* t0 = (int*)(ws + WS_RT + RT_TOK); int* d0 = (int*)(ws + WS_RT + RT_DST); float* g0 = (float*)(ws + WS_RT + RT_GATE);
          for (int idx = gt; idx < MALL; idx += GT) { t0[idx] = idx; d0[idx] = idx; g0[idx] = 1.0f; }
          int* t1 = (int*)(ws + WS_RT1 + RT1_TOK); int* d1 = (int*)(ws + WS_RT1 + RT1_DST); float* g1 = (float*)(ws + WS_RT1 + RT1_GATE);
          for (int idx = gt; idx < NE * CAP; idx += GT) { t1[idx] = 0; d1[idx] = -1; g1[idx] = 0.f; } }
        for (int idx = gt; idx < 2048; idx += GT) { const int pos = idx >> 4, f = idx & 15; const float inv = powf(10000.0f, -(float)f / 16.0f); const float ang = (float)pos * inv; RC[idx] = cosf(ang); RS[idx] = sinf(ang); }
    }
    {
        LAS float* scr = (LAS float*)(lds + wave * 16384);
        bf16* WB = (bf16*)(ws + WS_W);
        const int gw = bx * NWAVES + wave, NGW = G * NWAVES;
        f32x4 va[16], vb[16]; TJob Ja, Jb;
        int ia = gw;
        if (ia < TJ_NOW) { Ja = tj_decode(a, WB, ia); tj_load(Ja, lane, va); }
        for (;;) {
            if (ia >= TJ_NOW) break;
            const int ib = ia + NGW;
            if (ib < TJ_NOW) { Jb = tj_decode(a, WB, ib); tj_load(Jb, lane, vb); }
            tj_store(Ja, scr, lane, va);
            if (ib >= TJ_NOW) break;
            ia = ib + NGW;
            if (ia < TJ_NOW) { Ja = tj_decode(a, WB, ia); tj_load(Ja, lane, va); }
            tj_store(Jb, scr, lane, vb);
        }
    }
}

DI void cvt_filler(const Args& a, unsigned char* ws, LAS unsigned char* lds, int tid, int wave, int lane, int* done, int need) {
    LAS int* sh = (LAS int*)(lds + LDSCTL_OFF + LC_FILL);
    int* cur = (int*)(ws + WS_CTL) + CW_CVT;
    LAS float* scr = (LAS float*)(lds + wave * 16384);
    bf16* WB = (bf16*)(ws + WS_W);
    __syncthreads();
    for (int it = 0;; ++it) {
        if (tid == 0) { int b = -1;
            const bool stop = done && __hip_atomic_load(done, __ATOMIC_RELAXED, __HIP_MEMORY_SCOPE_AGENT) >= need;
            if (!stop) { b = __hip_atomic_fetch_add(cur, done ? TJ_BATCH / 2 : TJ_BATCH, __ATOMIC_RELAXED, __HIP_MEMORY_SCOPE_AGENT); if (b >= TJ_DEF) b = -1; }
            sh[it & 1] = b; }
        __syncthreads();
        const int b = __builtin_amdgcn_readfirstlane(sh[it & 1]);
        if (b < 0) break;
        f32x4 va[16], vb[16];
        const int ia = b + (done ? wave : 2 * wave), ib = done ? TJ_DEF : ia + 1;
        if (ia < TJ_DEF) { const TJob Ja = tj_decode(a, WB, TJ_NOW + ia); tj_load(Ja, lane, va);
            if (ib < TJ_DEF) { const TJob Jb = tj_decode(a, WB, TJ_NOW + ib); tj_load(Jb, lane, vb); tj_store(Ja, scr, lane, va); tj_store(Jb, scr, lane, vb); }
            else tj_store(Ja, scr, lane, va); }
    }
    __syncthreads();
}

DI void ld_row_f32(const float* row, int lane, f32x4 (&v)[4]) { const f32x4* p = (const f32x4*)row + lane;
#pragma unroll
    for (int j = 0; j < 4; ++j) v[j] = p[64 * j]; }
DI void st_row_f32(float* row, int lane, const f32x4 (&v)[4]) { f32x4* p = (f32x4*)row + lane;
#pragma unroll
    for (int j = 0; j < 4; ++j) p[64 * j] = v[j]; }
DI void ld_row_bf16(const bf16* row, int lane, f32x4 (&v)[4]) { const u32x2* p = (const u32x2*)row + lane;
#pragma unroll
    for (int j = 0; j < 4; ++j) { const u32x2 w = p[64 * j]; v[j] = (f32x4){bflo(w.x), bfhi(w.x), bflo(w.y), bfhi(w.y)}; } }
DI void st_row_bf16(bf16* row, int lane, const f32x4 (&v)[4]) { u32x2* p = (u32x2*)row + lane;
#pragma unroll
    for (int j = 0; j < 4; ++j) { u32x2 w; w.x = cvt_pk_bf16(v[j][0], v[j][1]); w.y = cvt_pk_bf16(v[j][2], v[j][3]); p[64 * j] = w; } }
DI float row_rstd(const f32x4 (&v)[4], int lane) { float s = 0.f;
#pragma unroll
    for (int j = 0; j < 4; ++j) s += (v[j][0] * v[j][0] + v[j][1] * v[j][1]) + (v[j][2] * v[j][2] + v[j][3] * v[j][3]);
    return 1.0f / sqrtf(wave_sum(s, lane) * (1.0f / 1024.0f) + EPS); }
DI void modulate_row(const f32x4 (&h)[4], float rstd, const float* g, const float* sh, const float* sc, int lane, f32x4 (&y)[4]) {
#pragma unroll
    for (int j = 0; j < 4; ++j) { const f32x4 gv = ((const f32x4*)g + lane)[64 * j], shv = ((const f32x4*)sh + lane)[64 * j], scv = ((const f32x4*)sc + lane)[64 * j];
        y[j] = h[j] * rstd * gv * (1.0f + scv) + shv; } }
DI int mod_set(int r) { return r < MLAT ? (r >> 13) : 4; }

DI void ldraw_f32(const float* row, int lane, f32x4 (&v)[4]) { const f32x4* p = (const f32x4*)row + lane;
#pragma unroll
    for (int j = 0; j < 4; ++j) v[j] = p[64 * j]; }
DI void ldraw_bf16(const bf16* row, int lane, u32x2 (&v)[4]) { const u32x2* p = (const u32x2*)row + lane;
#pragma unroll
    for (int j = 0; j < 4; ++j) v[j] = p[64 * j]; }
DI void unpack_bf16(const u32x2 (&w)[4], f32x4 (&v)[4]) {
#pragma unroll
    for (int j = 0; j < 4; ++j) v[j] = (f32x4){bflo(w[j].x), bfhi(w[j].x), bflo(w[j].y), bfhi(w[j].y)}; }
DI void ldvec(const float* p, int lane, f32x4 (&v)[4]) { ldraw_f32(p, lane, v); }
DI void ldmod(const Args& a, const unsigned char* ws, int L, int s, int j, int lane, f32x4 (&v)[4]) {
    ldraw_f32(a.in[I_BADA] + L * 6144 + j * 1024, lane, v);
#pragma unroll 1
    for (int ks = 0; ks < 8; ++ks) { f32x4 t[4]; ldraw_f32((const float*)(ws + WS_MOD) + ((size_t)(L * 8 + ks) * 5 + s) * 6144 + j * 1024, lane, t);
#pragma unroll
        for (int q = 0; q < 4; ++q) v[q] = v[q] + t[q]; }
}

DI void norm0_phase(const Args& a, unsigned char* ws, int wave, int lane) {
    constexpr int RPW = MALL / 256; const int bx = blockIdx.x;
    bf16* Y = (bf16*)(ws + WS_Y);
    if (bx >= 256) return;
    f32x4 g[4], sh[4], sc[4], hn[4]; int cs = -1;
    ldvec(a.in[I_GMPRE], lane, g);
    { const int r = bx * RPW + wave; ldraw_f32(r < MLAT ? a.in[I_X] + (size_t)r * DM : a.in[I_CTX] + (size_t)(r - MLAT) * DM, lane, hn); }
    for (int rr = wave; rr < RPW; rr += NWAVES) {
        const int r = bx * RPW + rr, s = mod_set(r);
        f32x4 h[4], y[4];
#pragma unroll
        for (int j = 0; j < 4; ++j) h[j] = hn[j];
        if (rr + NWAVES < RPW) { const int rn = r + NWAVES; ldraw_f32(rn < MLAT ? a.in[I_X] + (size_t)rn * DM : a.in[I_CTX] + (size_t)(rn - MLAT) * DM, lane, hn); }
        if (s != cs) { ldmod(a, ws, 0, s, 0, lane, sh); ldmod(a, ws, 0, s, 1, lane, sc); cs = s; }
        const float rs = row_rstd(h, lane);
#pragma unroll
        for (int j = 0; j < 4; ++j) y[j] = h[j] * rs * g[j] * (1.0f + sc[j]) + sh[j];
        st_row_bf16(Y + (size_t)r * DM, lane, y);
    }
}

DI void norm_mid_phase(const Args& a, unsigned char* ws, LAS unsigned char* lds, int L, int tid, int wave, int lane) {
    const int M = L == 0 ? MALL : MLAT, RPW = M / 256, bx = blockIdx.x;
    const bool moe = (L == 1);
    LAS int* cnt = (LAS int*)(lds + LDSCTL_OFF + LC_CNT);
    __syncthreads();
    if (tid < 8) cnt[tid] = 0;
    LAS float* wrl = (LAS float*)(lds + 4096);
    if (moe) { f32x4 w4[2048 / NTHR];
#pragma unroll
        for (int k = 0; k < 2048 / NTHR; ++k) w4[k] = ((const f32x4*)a.in[I_WR])[tid + k * NTHR];
#pragma unroll
        for (int k = 0; k < 2048 / NTHR; ++k) { const int i = tid + k * NTHR, c = i >> 1, e0 = 4 * (i & 1);
#pragma unroll
            for (int q = 0; q < 4; ++q) wrl[(e0 + q) * 1024 + c] = w4[k][q]; } }
    __syncthreads();
    const bf16* O = (const bf16*)(ws + WS_R + R_O); bf16* Y = (bf16*)(ws + WS_Y);
    bf16* hctx1 = (bf16*)(ws + WS_HCTX); const bf16* h2lat = (const bf16*)a.out + (size_t)MLAT * DM; bf16* h3 = (bf16*)(ws + WS_H3);
    LAS int* rec = (LAS int*)lds;
    if (bx < 256) {
        f32x4 gpost[4], gpre[4], gtm[4], shf[4], scf[4]; u32x4 hr[4], hr2[4]; u32x2 hb[4], hb2[4]; u32x2 on[4], on2[4]; int cs = -1;
        ldvec(a.in[I_GMPOST] + L * DM, lane, gpost); ldvec(a.in[I_GFPRE] + L * DM, lane, gpre);
#define NM_LOAD(rq_, o_, h_, hb_) do { const int rq = (rq_); ldraw_bf16(O + (size_t)rq * DM, lane, o_); \
            if (L == 0) { const u32x4* p_ = (const u32x4*)(rq < MLAT ? a.in[I_X] + (size_t)rq * DM : a.in[I_CTX] + (size_t)(rq - MLAT) * DM) + lane; _Pragma("unroll") for (int j = 0; j < 4; ++j) h_[j] = p_[64 * j]; } \
            else ldraw_bf16(h2lat + (size_t)rq * DM, lane, hb_); } while (0)
#define NM_ROW(rr_) ((L == 0 && SPLITK) ? ((rr_) < 4 ? MLAT + 4 * bx + (rr_) : 128 * bx + ((rr_) - 4)) : bx * RPW + (rr_))
        NM_LOAD(NM_ROW(wave), on, hr, hb);
        if (wave + NWAVES < RPW) NM_LOAD(NM_ROW(wave + NWAVES), on2, hr2, hb2);
        for (int rr = wave; rr < RPW; rr += NWAVES) {
            const int r = NM_ROW(rr), s = mod_set(r);
            bf16* hout = L == 0 ? (r < MLAT ? (bf16*)a.out + (size_t)r * DM : hctx1 + (size_t)(r - MLAT) * DM) : h3 + (size_t)r * DM;
            f32x4 o[4], h[4], y[4]; unpack_bf16(on, o);
#pragma unroll
            for (int j = 0; j < 4; ++j) h[j] = L == 0 ? __builtin_bit_cast(f32x4, hr[j]) : (f32x4){bflo(hb[j].x), bfhi(hb[j].x), bflo(hb[j].y), bfhi(hb[j].y)};
#pragma unroll
            for (int j = 0; j < 4; ++j) { on[j] = on2[j]; hr[j] = hr2[j]; hb[j] = hb2[j]; }
            if (rr + 2 * NWAVES < RPW) NM_LOAD(NM_ROW(rr + 2 * NWAVES), on2, hr2, hb2);
            if (SPLITK && L == 0 && r >= MLAT) {
#pragma unroll
                for (int j = 0; j < 4; ++j) o[j] = (f32x4){0.f, 0.f, 0.f, 0.f};
#pragma unroll 2
                for (int ks = 0; ks < 4; ++ks) { f32x4 t4[4]; ldraw_f32((const float*)(ws + WS_R + R_T) + ((size_t)ks * MCTX + (r - MLAT)) * DM, lane, t4);
#pragma unroll
                    for (int j = 0; j < 4; ++j) o[j] = o[j] + t4[j]; }
            }
            if (s != cs) { ldmod(a, ws, L, s, 2, lane, gtm); ldmod(a, ws, L, s, 3, lane, shf); ldmod(a, ws, L, s, 4, lane, scf); cs = s; }
            const float ro = row_rstd(o, lane);
#pragma unroll
            for (int j = 0; j < 4; ++j) h[j] = h[j] + gtm[j] * (o[j] * ro * gpost[j]);
            st_row_bf16(hout, lane, h);
            const float rh = row_rstd(h, lane);
#pragma unroll
            for (int j = 0; j < 4; ++j) y[j] = h[j] * rh * gpre[j] * (1.0f + scf[j]) + shf[j];
            if (moe || FP8_DGU) { unsigned* y8 = (unsigned*)((unsigned char*)Y + (size_t)r * DM) + lane;
#pragma unroll
                for (int j = 0; j < 4; ++j) y8[64 * j] = pg8::pk_fp8x4(y[j][0] * pg8::S8_Y, y[j][1] * pg8::S8_Y, y[j][2] * pg8::S8_Y, y[j][3] * pg8::S8_Y); }
            else st_row_bf16(Y + (size_t)r * DM, lane, y);
            if (moe) {
                float lg[8];
#pragma unroll
                for (int e = 0; e < 8; ++e) { float acc = 0.f;
#pragma unroll
                    for (int j = 0; j < 4; ++j) { const f32x4 w4 = *(const LAS f32x4*)(wrl + e * 1024 + 4 * lane + 256 * j); acc += (y[j][0] * w4[0] + y[j][1] * w4[1]) + (y[j][2] * w4[2] + y[j][3] * w4[3]); }
                    lg[e] = acc; }
#pragma unroll
                for (int e = 0; e < 8; ++e) lg[e] = wave_sum(lg[e], lane) + a.in[I_BR][e];
                int i0 = 0; float v0 = lg[0];
#pragma unroll
                for (int e = 1; e < 8; ++e) if (lg[e] > v0) { v0 = lg[e]; i0 = e; }
                int i1 = -1; float v1 = -3.0e38f;
#pragma unroll
                for (int e = 0; e < 8; ++e) if (e != i0 && lg[e] > v1) { v1 = lg[e]; i1 = e; }
                const float g0 = 1.0f / (1.0f + expf(v1 - v0)), g1 = 1.0f - g0;
                if (lane == 0) { const int p0 = __hip_atomic_fetch_add(&cnt[i0], 1, __ATOMIC_RELAXED, __HIP_MEMORY_SCOPE_WORKGROUP), p1 = __hip_atomic_fetch_add(&cnt[i1], 1, __ATOMIC_RELAXED, __HIP_MEMORY_SCOPE_WORKGROUP);
                    rec[rr * 4 + 0] = (i0 << 16) | p0; rec[rr * 4 + 1] = __float_as_int(g0); rec[rr * 4 + 2] = (i1 << 16) | p1; rec[rr * 4 + 3] = __float_as_int(g1); }
            }
        }
    }
    if (moe) {
        __syncthreads();
        if (bx < 256 && tid < 8) cnt[8 + tid] = __hip_atomic_fetch_add((int*)(ws + WS_CTL) + CW_GCNT + tid, cnt[tid], __ATOMIC_RELAXED, __HIP_MEMORY_SCOPE_AGENT);
        __syncthreads();
        if (bx < 256 && tid < 2 * RPW) { const int rr = tid >> 1, k = tid & 1, r = bx * RPW + rr; const int info = rec[rr * 4 + 2 * k], e = info >> 16, slot = e * CAP + cnt[8 + e] + (info & 0xffff);
            ((int*)(ws + WS_RT1 + RT1_TOK))[slot] = r; ((int*)(ws + WS_RT1 + RT1_DST))[slot] = k * MALL + r; ((int*)(ws + WS_RT1 + RT1_GATE))[slot] = rec[rr * 4 + 2 * k + 1]; }
    }
}

#undef NM_LOAD
#undef NM_ROW
DI void norm_end_phase(const Args& a, unsigned char* ws, int L, int wave, int lane) {
    const int M = L == 0 ? MALL : MLAT, RPW = M / 256, bx = blockIdx.x; const bool moe = (L == 1);
    const bf16* F = (const bf16*)(ws + WS_R + R_F); bf16* Y = (bf16*)(ws + WS_Y);
    const bf16* hctx1 = (const bf16*)(ws + WS_HCTX); bf16* hctx2 = (bf16*)(ws + WS_HCTX) + (size_t)MCTX * DM; bf16* h2lat = (bf16*)a.out + (size_t)MLAT * DM; const bf16* h3 = (const bf16*)(ws + WS_H3);
    if (bx >= 256) return;
    f32x4 gpost[4], gnx[4], gtf[4], shn[4], scn[4]; u32x2 f0n[4], hbn[4]; unsigned q0[4], q1[4], q02[4], q12[4]; int cs = -1;
    ldvec(a.in[I_GFPOST] + L * DM, lane, gpost); ldvec(a.in[I_GMPRE] + DM, lane, gnx);
#define NE_HIN(r_) (L == 0 ? ((r_) < MLAT ? (const bf16*)a.out + (size_t)(r_) * DM : hctx1 + (size_t)((r_) - MLAT) * DM) : h3 + (size_t)(r_) * DM)
#define NE_ROW(rr_) (L == 0 ? ((rr_) < 4 ? MLAT + 4 * bx + (rr_) : 128 * bx + ((rr_) - 4)) : bx * RPW + (rr_))
    u32x2 f0n2[4], hbn2[4];
#define NE_LOAD(rq_, f0_, q0_, q1_, hb_) do { const int rq = (rq_); \
        if (moe) { const unsigned* p0_ = (const unsigned*)((const unsigned char*)F + (size_t)rq * DM) + lane; const unsigned* p1_ = (const unsigned*)((const unsigned char*)F + (size_t)(MALL + rq) * DM) + lane; \
            _Pragma("unroll") for (int j = 0; j < 4; ++j) { q0_[j] = p0_[64 * j]; q1_[j] = p1_[64 * j]; } } \
        else ldraw_bf16(F + (size_t)rq * DM, lane, f0_); \
        ldraw_bf16(NE_HIN(rq), lane, hb_); } while (0)
    NE_LOAD(NE_ROW(wave), f0n, q0, q1, hbn);
    if (wave + NWAVES < RPW) NE_LOAD(NE_ROW(wave + NWAVES), f0n2, q02, q12, hbn2);
    for (int rr = wave; rr < RPW; rr += NWAVES) {
        const int r = NE_ROW(rr), s = mod_set(r);
        f32x4 f[4], h[4]; unpack_bf16(hbn, h);
        if (moe) {
#pragma unroll
            for (int j = 0; j < 4; ++j) { const int a0 = (int)q0[j], a1 = (int)q1[j];
                f[j] = (f32x4){__builtin_amdgcn_cvt_f32_fp8(a0, 0) + __builtin_amdgcn_cvt_f32_fp8(a1, 0), __builtin_amdgcn_cvt_f32_fp8(a0, 1) + __builtin_amdgcn_cvt_f32_fp8(a1, 1),
                               __builtin_amdgcn_cvt_f32_fp8(a0, 2) + __builtin_amdgcn_cvt_f32_fp8(a1, 2), __builtin_amdgcn_cvt_f32_fp8(a0, 3) + __builtin_amdgcn_cvt_f32_fp8(a1, 3)} * (1.0f / pg8::S8_F); }
        } else unpack_bf16(f0n, f);
#pragma unroll
        for (int j = 0; j < 4; ++j) { f0n[j] = f0n2[j]; q0[j] = q02[j]; q1[j] = q12[j]; hbn[j] = hbn2[j]; }
        if (rr + 2 * NWAVES < RPW) NE_LOAD(NE_ROW(rr + 2 * NWAVES), f0n2, q02, q12, hbn2);
        if (SPLITK && L == 0 && r >= MLAT) {
#pragma unroll
            for (int j = 0; j < 4; ++j) f[j] = (f32x4){0.f, 0.f, 0.f, 0.f};
#pragma unroll 2
            for (int ks = 0; ks < (FP8_DDN ? 7 : 14); ++ks) { f32x4 t[4]; ldraw_f32((const float*)(ws + WS_R + (FP8_DDN ? R_PART : R_PART0)) + ((size_t)ks * MCTX + (r - MLAT)) * DM, lane, t);
#pragma unroll
                for (int j = 0; j < 4; ++j) f[j] = f[j] + t[j]; }
            if (FP8_DDN) {
#pragma unroll
                for (int j = 0; j < 4; ++j) f[j] = f[j] * (1.0f / (pg8::S8_ACT * pg8::S8_W)); }
        }
        if (s != cs) { ldmod(a, ws, L, s, 5, lane, gtf); if (L == 0) { ldmod(a, ws, 1, s, 0, lane, shn); ldmod(a, ws, 1, s, 1, lane, scn); } cs = s; }
        const float rf = row_rstd(f, lane);
#pragma unroll
        for (int j = 0; j < 4; ++j) h[j] = h[j] + gtf[j] * (f[j] * rf * gpost[j]);
        if (L == 0) st_row_bf16(r < MLAT ? h2lat + (size_t)r * DM : hctx2 + (size_t)(r - MLAT) * DM, lane, h);
        else st_row_f32(a.out + (size_t)r * DM, lane, h);
        if (L == 0) { f32x4 y[4]; const float rh = row_rstd(h, lane);
#pragma unroll
            for (int j = 0; j < 4; ++j) y[j] = h[j] * rh * gnx[j] * (1.0f + scn[j]) + shn[j];
            st_row_bf16(Y + (size_t)r * DM, lane, y); }
    }
#undef NE_HIN
#undef NE_ROW
#undef NE_LOAD
}

constexpr int AT_KS = 0, AT_VT = 9216, AT_BUF = 19456;
DI void attn_unit(LAS unsigned char* lds, const bf16* Z, bf16* OC, const float* sinkL, int u, int tid, int wave, int lane) {
    int b, blk, kh; bool isctx;
    if (u < 512) { kh = u & 1; blk = (u >> 1) & 63; b = u >> 7; isctx = false; } else { const int j = u - 512; kh = j & 1; blk = (j >> 1) & 1; b = j >> 2; isctx = true; }
    const int qrowbase = isctx ? (MLAT + b * NCTX + 128 * blk) : (b * NLAT + 128 * blk);
    const int hq = 4 * kh + (wave & 3), qrow0 = (wave >> 2) * 64, i16 = lane & 15, h4 = lane >> 4;
    bf16x8 Qf[4][2];
#pragma unroll
    for (int qt = 0; qt < 4; ++qt)
#pragma unroll
        for (int ks = 0; ks < 2; ++ks) Qf[qt][ks] = *(const bf16x8*)(Z + (size_t)(qrowbase + qrow0 + 16 * qt + i16) * NZ + ZQ + 64 * hq + 32 * ks + 8 * h4);
    float mrun[4], lrun[4]; f32x4 o[4][4];
    const float sk = sinkL[hq] * LOG2E;
#pragma unroll
    for (int qt = 0; qt < 4; ++qt) { mrun[qt] = sk; lrun[qt] = (h4 == 0) ? 1.f : 0.f;
#pragma unroll
        for (int dt = 0; dt < 4; ++dt) o[dt][qt] = (f32x4){0.f, 0.f, 0.f, 0.f}; }
    const int ntl = isctx ? 0 : 6, ntt = ntl + 4;
#define AT_TILE(t, kr, mt, k0) (((t) < ntl) ? ((kr) = b * NLAT + 128 * (blk - 1 + ((t) >> 1)) + 64 * ((t) & 1), (mt) = ((t) >> 1) == 0 ? 1 : (((t) >> 1) == 2 ? 2 : 0), (k0) = 64 * ((t) & 1), (blk - 1 + ((t) >> 1)) >= 0 && (blk - 1 + ((t) >> 1)) <= 63) \
                                            : ((kr) = MLAT + b * NCTX + 64 * ((t) - ntl), (mt) = 0, (k0) = 0, true))
    const int skey = tid >> 3, sch = tid & 7;
#define AT_LOAD(kr) do { const bf16* src = Z + (size_t)((kr) + skey) * NZ; kvr = *(const u32x4*)(src + ZK + 64 * kh + 8 * sch); vvr = *(const u32x4*)(src + ZVV + 64 * kh + 8 * sch); } while (0)
#define AT_STORE(pb_) do { *(LAS u32x4*)(lds + (pb_) * AT_BUF + AT_KS + skey * 144 + sch * 16) = kvr; *(LAS u32x4*)(lds + (pb_) * AT_BUF + AT_VT + skey * 160 + sch * 16) = vvr; } while (0)
    u32x4 kvr, vvr;
    int tix = 0, krow0 = 0, cmtype = 0, ckb0 = 0, nmtype = 0, nkb0 = 0, pb = 0;
    while (tix < ntt && !AT_TILE(tix, krow0, cmtype, ckb0)) ++tix;
    AT_LOAD(krow0);
    __syncthreads();
    AT_STORE(0);
#pragma unroll
    for (int qt = 0; qt < 4; ++qt)
#pragma unroll
        for (int ks = 0; ks < 2; ++ks) asm volatile("" : "+v"(Qf[qt][ks]));
    ++tix; while (tix < ntt && !AT_TILE(tix, krow0, nmtype, nkb0)) ++tix;
    bool nvalid = tix < ntt;
    if (nvalid) AT_LOAD(krow0);
    __syncthreads();
    for (;;) {
        int n2mtype = 0, n2kb0 = 0; bool n2valid = false;
        if (nvalid) { AT_STORE(pb ^ 1);
            ++tix; while (tix < ntt && !AT_TILE(tix, krow0, n2mtype, n2kb0)) ++tix;
            n2valid = tix < ntt; if (n2valid) AT_LOAD(krow0); }
        const LAS unsigned char* ldt = lds + pb * AT_BUF;
        const bool skipw = (cmtype == 1 && ckb0 < qrow0) || (cmtype == 2 && ckb0 > qrow0);
        if (!skipw) {
        f32x4 sa[4][4];
#pragma unroll
        for (int kt = 0; kt < 4; ++kt)
#pragma unroll
            for (int qt = 0; qt < 4; ++qt) { const float nm = -mrun[qt]; sa[kt][qt] = (f32x4){nm, nm, nm, nm}; }
#pragma unroll
        for (int ks = 0; ks < 2; ++ks)
#pragma unroll
            for (int kt = 0; kt < 4; ++kt) { const bf16x8 ak = *(const LAS bf16x8*)(ldt + AT_KS + (16 * kt + i16) * 144 + (32 * ks + 8 * h4) * 2);
#pragma unroll
                for (int qt = 0; qt < 4; ++qt) sa[kt][qt] = mfma16(ak, Qf[qt][ks], sa[kt][qt]); }
        if (cmtype && ckb0 == qrow0) {
            int ln; asm volatile("v_mbcnt_lo_u32_b32 %0, -1, 0\n\tv_mbcnt_hi_u32_b32 %0, -1, %0" : "=v"(ln));
            const int dl = 4 * (ln >> 4) - (ln & 15);
            if (cmtype == 1) {
#pragma unroll
                for (int kt = 0; kt < 4; ++kt)
#pragma unroll
                    for (int qt = 0; qt < 4; ++qt) {
                        if (kt < qt) sa[kt][qt] = (f32x4){-1.0e30f, -1.0e30f, -1.0e30f, -1.0e30f};
                        else if (kt == qt) {
#pragma unroll
                            for (int r = 0; r < 4; ++r) if (dl + r < 0) sa[kt][qt][r] = -1.0e30f; } }
            } else {
#pragma unroll
                for (int kt = 0; kt < 4; ++kt)
#pragma unroll
                    for (int qt = 0; qt < 4; ++qt) {
                        if (kt > qt) sa[kt][qt] = (f32x4){-1.0e30f, -1.0e30f, -1.0e30f, -1.0e30f};
                        else if (kt == qt) {
#pragma unroll
                            for (int r = 0; r < 4; ++r) if (dl + r > 0) sa[kt][qt][r] = -1.0e30f; } }
            }
        }
#pragma unroll
        for (int qt = 0; qt < 4; ++qt) {
            float mx = vmax3(vmax3(vmax3(sa[0][qt][0], sa[0][qt][1], sa[0][qt][2]), vmax3(sa[0][qt][3], sa[1][qt][0], sa[1][qt][1]), sa[1][qt][2]),
                             vmax3(sa[1][qt][3], sa[2][qt][0], sa[2][qt][1]), vmax3(vmax3(sa[2][qt][2], sa[2][qt][3], sa[3][qt][0]), vmax3(sa[3][qt][1], sa[3][qt][2], sa[3][qt][3]), sa[3][qt][3]));
            if (__builtin_amdgcn_ballot_w64(mx > 6.0f) != 0ull) {
                mx = xrow16_max(mx);
                const float dl = fmaxf(mx, 0.f), alpha = fexp2(-dl); mrun[qt] += dl; lrun[qt] *= alpha;
#pragma unroll
                for (int kt = 0; kt < 4; ++kt) sa[kt][qt] = sa[kt][qt] - dl;
#pragma unroll
                for (int dt = 0; dt < 4; ++dt) o[dt][qt] = o[dt][qt] * alpha;
            }
            f32x2 ps = (f32x2){0.f, 0.f};
#pragma unroll
            for (int kt = 0; kt < 4; ++kt) { f32x4 p; p[0] = fexp2(sa[kt][qt][0]); p[1] = fexp2(sa[kt][qt][1]); p[2] = fexp2(sa[kt][qt][2]); p[3] = fexp2(sa[kt][qt][3]); sa[kt][qt] = p;
                ps = ps + (f32x2){p[0], p[1]} + (f32x2){p[2], p[3]}; }
            lrun[qt] += ps.x + ps.y;
        }
#pragma unroll
        for (int s = 0; s < 2; ++s) {
            bf16x8 pf[4];
#pragma unroll
            for (int qt = 0; qt < 4; ++qt) { u32x4 w; const f32x4 p0 = sa[2 * s][qt], p1 = sa[2 * s + 1][qt];
                w.x = cvt_pk_bf16(p0[0], p0[1]); w.y = cvt_pk_bf16(p0[2], p0[3]); w.z = cvt_pk_bf16(p1[0], p1[1]); w.w = cvt_pk_bf16(p1[2], p1[3]); pf[qt] = __builtin_bit_cast(bf16x8, w); }
#pragma unroll
            for (int dt = 0; dt < 4; ++dt) {
                const LAS unsigned char* vp = ldt + AT_VT + (32 * s + 4 * h4 + (i16 >> 2)) * 160 + (16 * dt + 4 * (i16 & 3)) * 2;
                const v4i16_t lo = __builtin_amdgcn_ds_read_tr16_b64_v4i16((LAS v4i16_t*)vp), hi = __builtin_amdgcn_ds_read_tr16_b64_v4i16((LAS v4i16_t*)(vp + 16 * 160)); const bf16x8 av = __builtin_shufflevector(lo, hi, 0, 1, 2, 3, 4, 5, 6, 7);
#pragma unroll
                for (int qt = 0; qt < 4; ++qt) o[dt][qt] = mfma16(av, pf[qt], o[dt][qt]); }
        }
        }
        if (!nvalid) break;
        __syncthreads();
        pb ^= 1; cmtype = nmtype; ckb0 = nkb0; nvalid = n2valid; nmtype = n2mtype; nkb0 = n2kb0;
    }
#undef AT_LOAD
#undef AT_STORE
    const int trs = (((lane & 3) << 4) | (lane >> 2)) << 2;
#pragma unroll
    for (int qt = 0; qt < 4; ++qt) { const float lt = xrow16_sum(lrun[qt]); const float inv = 1.0f / lt;
        bf16* orow = OC + (size_t)(qrowbase + qrow0 + 16 * qt + (lane >> 2)) * DM + 512 + 64 * hq + 4 * (lane & 3);
#pragma unroll
        for (int dt = 0; dt < 4; ++dt) { const f32x4 v = o[dt][qt] * inv; u32x2 w; w.x = (unsigned)__builtin_amdgcn_ds_bpermute(trs, (int)cvt_pk_bf16(v[0], v[1])); w.y = (unsigned)__builtin_amdgcn_ds_bpermute(trs, (int)cvt_pk_bf16(v[2], v[3])); *(u32x2*)(orow + 16 * dt) = w; } }
#undef AT_TILE
}

DI void sgu_unit(LAS unsigned char* lds, const bf16* Z, bf16* OC, const bf16* wsb, const float* bs, const float* gv, int c, int tid, int wave, int lane) {
    const int rowbase = 128 * c, i16 = lane & 15, h4 = lane >> 4;
    __syncthreads();
    { const int q = tid >> 2, hh = tid & 3; const u32x4* src = (const u32x4*)(Z + (size_t)(rowbase + q) * NZ + ZV + 64 * hh);
      u32x4 v[8]; float ss = 0.f;
#pragma unroll
      for (int j = 0; j < 8; ++j) { v[j] = src[j];
#pragma unroll
          for (int q2 = 0; q2 < 4; ++q2) { const float x0 = bflo(v[j][q2]), x1 = bfhi(v[j][q2]); ss += x0 * x0 + x1 * x1; } }
      const float rstd = 1.0f / sqrtf(ss * (1.0f / 64.0f) + EPS);
      const f32x4* gp = (const f32x4*)(gv + hh * 64);
#pragma unroll
      for (int j = 0; j < 8; ++j) { const f32x4 ga = gp[2 * j], gb = gp[2 * j + 1]; u32x4 w;
          w.x = cvt_pk_bf16(bflo(v[j].x) * rstd * ga[0], bfhi(v[j].x) * rstd * ga[1]); w.y = cvt_pk_bf16(bflo(v[j].y) * rstd * ga[2], bfhi(v[j].y) * rstd * ga[3]);
          w.z = cvt_pk_bf16(bflo(v[j].z) * rstd * gb[0], bfhi(v[j].z) * rstd * gb[1]); w.w = cvt_pk_bf16(bflo(v[j].w) * rstd * gb[2], bfhi(v[j].w) * rstd * gb[3]);
          *(LAS u32x4*)(lds + q * 544 + (hh * 64 + 8 * j) * 2) = w; } }
    __syncthreads();
    const int p = 16 * wave + i16;
#pragma unroll 1
    for (int hh = 0; hh < 4; ++hh) {
        f32x4 acc[4];
#pragma unroll
        for (int ct = 0; ct < 4; ++ct) acc[ct] = (f32x4){0.f, 0.f, 0.f, 0.f};
#pragma unroll
        for (int ks = 0; ks < 4; ++ks) { const bf16x8 bw = *(const bf16x8*)(wsb + ((size_t)hh * 128 + p) * 128 + 32 * ks + 8 * h4);
#pragma unroll
            for (int ct = 0; ct < 4; ++ct) { const bf16x8 av = trfrag(lds + 32 * ks * 544 + (hh * 64 + 16 * ct) * 2, 544, lane); acc[ct] = mfma16(av, bw, acc[ct]); } }
        const float bias = bs[hh * 128 + p];
#pragma unroll
        for (int ct = 0; ct < 4; ++ct) { const u32x2 uu = *(const u32x2*)(Z + (size_t)(rowbase + p) * NZ + ZU + 64 * hh + 16 * ct + 4 * h4);
            u32x2 w; w.x = cvt_pk_bf16(bflo(uu.x) * (acc[ct][0] + bias), bfhi(uu.x) * (acc[ct][1] + bias)); w.y = cvt_pk_bf16(bflo(uu.y) * (acc[ct][2] + bias), bfhi(uu.y) * (acc[ct][3] + bias));
            const int trs = (((lane & 3) << 4) | (lane >> 2)) << 2;
            w.x = (unsigned)__builtin_amdgcn_ds_bpermute(trs, (int)w.x); w.y = (unsigned)__builtin_amdgcn_ds_bpermute(trs, (int)w.y);
            *(u32x2*)(OC + (size_t)(rowbase + 16 * wave + (lane >> 2)) * DM + 64 * hh + 16 * ct + 4 * (lane & 3)) = w; }
    }
}

DI void fft1_unit(LAS unsigned char* lds, const bf16* Z, bf16* T, const bf16* G1, int u, int tid, int wave, int lane) {
    const int n2g = u & 31, g = (u >> 5) & 3, b = u >> 7, i16 = lane & 15, h4 = lane >> 4;
    __syncthreads();
    constexpr int PB = 544;
    { const int ch = tid & 7, n2l = (tid >> 3) & 3, k0 = tid >> 5;
      u32x4 v[8];
#pragma unroll
      for (int it = 0; it < 8; ++it) { const int k = k0 + 16 * it, pq = k >> 6, n1 = k & 63;
          v[it] = *(const u32x4*)(Z + (size_t)(b * NLAT + 128 * n1 + 4 * n2g + n2l) * NZ + ZP + 256 * pq + 64 * g + 8 * ch); }
#pragma unroll
      for (int it = 0; it < 8; ++it) { const int k = k0 + 16 * it;
          *(LAS u32x4*)(lds + k * PB + (n2l * 64 + 8 * ch) * 2) = v[it]; } }
    __syncthreads();
    bf16x8 ga[4];
#pragma unroll
    for (int ks = 0; ks < 4; ++ks) ga[ks] = *(const bf16x8*)(G1 + (16 * wave + i16) * 128 + 32 * ks + 8 * h4);
    const int k1a = 8 * wave + 2 * h4;
#pragma unroll 4
    for (int ct = 0; ct < 16; ++ct) {
        f32x4 acc = (f32x4){0.f, 0.f, 0.f, 0.f};
#pragma unroll
        for (int ks = 0; ks < 4; ++ks) { const bf16x8 bd = trfrag(lds + 32 * ks * PB + 32 * ct, PB, lane); acc = mfma16(ga[ks], bd, acc); }
        const int n2 = 4 * n2g + (ct >> 2), e2 = 16 * (ct & 3) + i16;
#pragma unroll
        for (int hf = 0; hf < 2; ++hf) { const int k1 = k1a + hf; const float ar = acc[2 * hf], mai = acc[2 * hf + 1];
            const float fr = (float)((k1 * n2) & 8191) * (1.0f / 8192.0f), c = __builtin_amdgcn_cosf(fr), s = __builtin_amdgcn_sinf(fr);
            const float apr = ar * c - mai * s, api = -mai * c - ar * s;
            const size_t base = ((((size_t)(b * 4 + g) * 64 + k1) * 2) * 128 + n2) * 64 + e2;
            T[base] = f2bf(apr); T[base + 128 * 64] = f2bf(api); }
    }
}

template <int KD> DI void dft_unit(LAS unsigned char* lds, const bf16* Gt, const bf16* P0, const bf16* P1, int pitch, bf16* outp, int rstride, float scale, int tid, int wave, int lane) {
    constexpr int PB = 160; const int i16 = lane & 15, h4 = lane >> 4;
    __syncthreads();
    { const int ch = tid & 7, r0 = tid >> 3;
      u32x4 v[KD / 64];
#pragma unroll
      for (int it = 0; it < KD / 64; ++it) { const int k = r0 + 64 * it, pl = k / (KD / 2), rr = k % (KD / 2);
          v[it] = *(const u32x4*)((pl ? P1 : P0) + (size_t)rr * pitch + 8 * ch); }
#pragma unroll
      for (int it = 0; it < KD / 64; ++it) { const int k = r0 + 64 * it;
          *(LAS u32x4*)(lds + k * PB + 16 * ch) = v[it]; } }
    __syncthreads();
    f32x4 acc[4];
#pragma unroll
    for (int ct = 0; ct < 4; ++ct) acc[ct] = (f32x4){0.f, 0.f, 0.f, 0.f};
#pragma unroll 4
    for (int ks = 0; ks < KD / 32; ++ks) { const bf16x8 gb = *(const bf16x8*)(Gt + (size_t)(16 * wave + i16) * KD + 32 * ks + 8 * h4);
#pragma unroll
        for (int ct = 0; ct < 4; ++ct) { const bf16x8 ad = trfrag(lds + 32 * ks * PB + 32 * ct, PB, lane); acc[ct] = mfma16(ad, gb, acc[ct]); } }
    bf16* orow = outp + (size_t)rstride * (16 * wave + i16) * DM + 4 * h4;
#pragma unroll
    for (int ct = 0; ct < 4; ++ct) { const f32x4 v = acc[ct] * scale; u32x2 w; w.x = cvt_pk_bf16(v[0], v[1]); w.y = cvt_pk_bf16(v[2], v[3]); *(u32x2*)(orow + 16 * ct) = w; }
}

DI void fft3_phase(LAS unsigned char* lds, const bf16* T, const bf16* G3, bf16* OC, int bx, int G, int tid, int wave, int lane) {
    constexpr int PB = 160, BUF = 256 * PB; const int i16 = lane & 15, h4 = lane >> 4, ch = tid & 7, r0 = tid >> 3;
    int u = bx; if (u >= 1024) return;
    bf16x8 gb[8];
#pragma unroll
    for (int ks = 0; ks < 8; ++ks) gb[ks] = *(const bf16x8*)(G3 + (size_t)(16 * wave + i16) * 256 + 32 * ks + 8 * h4);
    u32x4 v[4];
#define F3_LOAD(uu) do { const bf16* p_ = T + (size_t)(uu) * 2 * 8192 + (size_t)r0 * 64 + 8 * ch; _Pragma("unroll") for (int it = 0; it < 4; ++it) v[it] = *(const u32x4*)(p_ + (size_t)it * 64 * 64); } while (0)
#define F3_STORE(pb_) do { _Pragma("unroll") for (int it = 0; it < 4; ++it) *(LAS u32x4*)(lds + (pb_) * BUF + (r0 + 64 * it) * PB + 16 * ch) = v[it]; } while (0)
    F3_LOAD(u);
    __syncthreads();
    F3_STORE(0);
    int un = u + G; bool nvalid = un < 1024;
    if (nvalid) F3_LOAD(un);
    __syncthreads();
    int pb = 0;
    for (;;) {
        int u2 = un + G; bool n2valid = false;
        if (nvalid) { F3_STORE(pb ^ 1); n2valid = u2 < 1024; if (n2valid) F3_LOAD(u2); }
        const LAS unsigned char* ldt = lds + pb * BUF;
        f32x4 acc[4];
#pragma unroll
        for (int ct = 0; ct < 4; ++ct) acc[ct] = (f32x4){0.f, 0.f, 0.f, 0.f};
#pragma unroll
        for (int ks = 0; ks < 8; ++ks)
#pragma unroll
            for (int ct = 0; ct < 4; ++ct) { const bf16x8 ad = trfrag(ldt + 32 * ks * PB + 32 * ct, PB, lane); acc[ct] = mfma16(ad, gb[ks], acc[ct]); }
        const int k1 = u & 63, g = (u >> 6) & 3, b = u >> 8;
        bf16* orow = OC + (size_t)(b * NLAT + k1 + 64 * (16 * wave + (lane >> 2))) * DM + 256 + 64 * g + 4 * (lane & 3);
        const int trs = (((lane & 3) << 4) | (lane >> 2)) << 2;
#pragma unroll
        for (int ct = 0; ct < 4; ++ct) { const f32x4 w4 = acc[ct] * (1.0f / 724.0773439350247f); u32x2 w; w.x = (unsigned)__builtin_amdgcn_ds_bpermute(trs, (int)cvt_pk_bf16(w4[0], w4[1])); w.y = (unsigned)__builtin_amdgcn_ds_bpermute(trs, (int)cvt_pk_bf16(w4[2], w4[3])); *(u32x2*)(orow + 16 * ct) = w; }
        if (!nvalid) break;
        __syncthreads();
        pb ^= 1; u = un; un = u2; nvalid = n2valid;
    }
#undef F3_LOAD
#undef F3_STORE
}

constexpr int PH_L = 20, PH_END = 2 + 2 * PH_L;
__global__ void __launch_bounds__(NTHR, 2) fwd_kernel(Args args) {
    extern __shared__ __attribute__((aligned(16))) unsigned char lds_raw[];
    LAS unsigned char* const lds0 = (LAS unsigned char*)lds_raw;
    const int tid0 = threadIdx.x; const int wave0 = __builtin_amdgcn_readfirstlane(tid0 >> 6);
    const int G0 = gridDim.x, bx0 = blockIdx.x;
    unsigned char* ws0 = args.ws;
#define PHASE_REGS() int bx = bx0, G = G0; asm volatile("" : "+s"(bx), "+s"(G)); LAS unsigned char* lds = lds0; asm volatile("" : "+s"(lds)); int tid; asm volatile("v_mbcnt_lo_u32_b32 %0, -1, 0\n\tv_mbcnt_hi_u32_b32 %0, -1, %0" : "=v"(tid)); tid += wave0 * 64; GAS unsigned char* wsg_ = (GAS unsigned char*)ws0; asm volatile("" : "+s"(wsg_)); unsigned char* ws = (unsigned char*)wsg_; const int lane = tid & 63, wave = __builtin_amdgcn_readfirstlane(tid >> 6); (void)lane; (void)wave; \
    bf16* Z = (bf16*)(ws + WS_R + R_Z); bf16* OC = (bf16*)(ws + WS_R + R_OC); bf16* TT = (bf16*)(ws + WS_R + R_T); bf16* Y = (bf16*)(ws + WS_Y); (void)Z; (void)OC; (void)TT; (void)Y
    for (int u = tid0; u < (LDS_BYTES - LDSCTL_OFF) / 4; u += NTHR) ((LAS unsigned*)(lds0 + LDSCTL_OFF))[u] = 0u;
    __syncthreads();
#if MK_MULTI
#define GRID_BAR() do { } while (0)
#else
    XcdBarrier bar = xcd_barrier_post((unsigned*)(ws0 + WS_CTL) + CW_BAR, (volatile LAS unsigned*)(lds0 + LDSCTL_OFF + LC_BAR));
#define GRID_BAR() do { XcdBarrier b_ = bar; { GAS unsigned* bp_ = (GAS unsigned*)bar.bar; asm volatile("" : "+s"(bp_)); b_.bar = (unsigned*)bp_; } int l_; asm volatile("v_mbcnt_lo_u32_b32 %0, -1, 0\n\tv_mbcnt_hi_u32_b32 %0, -1, %0" : "=v"(l_)); xcd_barrier(b_, wave0 == 0 && l_ == 0); if (MK_PROBE == 40) xcd_barrier(b_, wave0 == 0 && l_ == 0); } while (0)
#endif
    const int lo = args.ph_lo, hi = args.ph_hi;
#define IN(k) (lo <= (k) && (k) < hi)
#define TAIL_FILL(id, nunits) do { if (FILL) { PHASE_REGS(); const int nu_ = (nunits), last_ = nu_ - ((nu_ + G - 1) / G - 1) * G; int* dn_ = (int*)(ws + WS_CTL) + CW_DONE + 64 * (L * 16 + (id)); \
        if (last_ < G) { if (bx < last_) { if (tid == 0) __hip_atomic_fetch_add(dn_, 1, __ATOMIC_RELAXED, __HIP_MEMORY_SCOPE_AGENT); } else cvt_filler(args, ws, lds, tid, wave, lane, dn_, 1); } } } while (0)
#define SEAM(k) do { if (IN(k) && IN((k) + 1)) GRID_BAR(); } while (0)

    if (EN(0) && IN(0)) { PHASE_REGS(); for (int rep = 0; rep < REP(1); ++rep) prologue_a(args, ws, lds, tid, wave, lane); }
    SEAM(0);
    if (EN(1) && IN(1)) { PHASE_REGS(); for (int rep = 0; rep < REP(2); ++rep) norm0_phase(args, ws, wave, lane); }
    SEAM(1);

#pragma unroll 1
    for (int L = 0; L < 2; ++L) {
        const int pb = 2 + PH_L * L;
        if (EN(2) && IN(pb + 0)) { PHASE_REGS();
            pg8::SchedIn S{G, bx, L == 0 ? 28 : 4, L == 0, (const char*)(ws + WS_W + W_IN) + (size_t)L * NZ * 1024 * 2, 2048};
            { LAS f32x4* rl = (LAS f32x4*)(lds + LDSCTL_OFF + LC_ROPE); const f32x4* src = (const f32x4*)(ws + WS_TAB + T_ROPE); const f32x4 r0_ = src[tid], r1_ = src[tid + NTHR]; rl[tid] = r0_; rl[tid + NTHR] = r1_; __syncthreads(); }
            pg8::EpiZ E{Z, (const LAS float*)(lds + LDSCTL_OFF + LC_ROPE), (const LAS float*)(lds + LDSCTL_OFF + LC_ROPE) + 2048};
            pg8::gemm_phase<pg8::EpiZ, pg8::SchedIn, false, false>(lds, (const unsigned char*)Y, 2048, S, E, tid);
        }
        if (IN(pb + 0)) TAIL_FILL(0, 896 + (L == 0 ? 28 : 4));
        SEAM(pb + 0);
        if (IN(pb + 1)) {
            const int nattn = L == 0 ? 528 : 512, nsgu = L == 0 ? 264 : 256;
            if (EN(3)) { PHASE_REGS(); for (int rep = 0; rep < REP(3); ++rep) { for (int u = bx; u < 512; u += G) attn_unit(lds, Z, OC, args.in[I_SINK] + L * 8, u, tid, wave, lane);
                { PHASE_REGS(); for (int u = 512 + ((bx + 16) % G); u < nattn; u += G) attn_unit(lds, Z, OC, args.in[I_SINK] + L * 8, u, tid, wave, lane); } } }
            if (EN(4)) { PHASE_REGS(); for (int rep = 0; rep < REP(4); ++rep) { for (int u = bx; u < 256; u += G) sgu_unit(lds, Z, OC, (const bf16*)(ws + WS_TAB + T_WS) + (size_t)L * 4 * 128 * 128, args.in[I_BS] + L * 512, args.in[I_GV] + L * 256, u, tid, wave, lane);
                for (int u = 256 + ((bx + 32) % G); u < nsgu; u += G) sgu_unit(lds, Z, OC, (const bf16*)(ws + WS_TAB + T_WS) + (size_t)L * 4 * 128 * 128, args.in[I_BS] + L * 512, args.in[I_GV] + L * 256, u, tid, wave, lane); } }
            if (EN(5)) { PHASE_REGS(); for (int rep = 0; rep < REP(5); ++rep) for (int u = bx; u < 512; u += G) fft1_unit(lds, Z, TT, (const bf16*)(ws + WS_TAB + T_G1), u, tid, wave, lane); }
            if (L == 0) { PHASE_REGS(); for (int u = (bx + 96) % G; u < 32; u += G) {     const int mh = u & 1, g = (u >> 1) & 3, b = u >> 3; const bf16* zr = Z + (size_t)(MLAT + b * NCTX) * NZ;
                dft_unit<512>(lds, (const bf16*)(ws + WS_TAB + T_GC) + (size_t)128 * mh * 512, zr + ZP + 64 * g, zr + ZQI + 64 * g, NZ, OC + (size_t)(MLAT + b * NCTX + 128 * mh) * DM + 256 + 64 * g, 1, 1.0f / 128.0f, tid, wave, lane); } }
            __syncthreads();
            if (FILL && L == 0 && G0 == 256) { PHASE_REGS();
                const bool extra = bx >= 240 || (bx >= 224 && bx < 232) || (bx >= 160 && bx < 192);
                int* dn_ = (int*)(ws + WS_CTL) + CW_DONE + 64 * 15;
                if (extra) { if (tid == 0) __hip_atomic_fetch_add(dn_, 1, __ATOMIC_RELAXED, __HIP_MEMORY_SCOPE_AGENT); } else cvt_filler(args, ws, lds, tid, wave, lane, dn_, 1); }
        }
        SEAM(pb + 1);
        if (EN(6) && IN(pb + 2)) { PHASE_REGS();
            for (int rep = 0; rep < REP(6); ++rep) fft3_phase(lds, TT, (const bf16*)(ws + WS_TAB + T_G3), OC, bx, G, tid, wave, lane);
            __syncthreads();
        }
        SEAM(pb + 2);
        if (EN(7) && IN(pb + 3)) { PHASE_REGS();
            pg8::SchedPlain S{G, bx, (L == 0 && !SPLITK) ? 132 : 128, 4, (const char*)(ws + WS_W + W_OUT) + (size_t)L * 1024 * 1024 * 2, 2048};
            pg8::EpiO E{(bf16*)(ws + WS_R + R_O), DM};
            pg8::gemm_phase<pg8::EpiO, pg8::SchedPlain, false, false>(lds, (const unsigned char*)OC, 2048, S, E, tid);
        }
        if (EN(7) && IN(pb + 3) && L == 0 && SPLITK) { PHASE_REGS();
            pg8::SchedSplit S{G, bx, 4, 4, 4, 4, (const char*)(ws + WS_W + W_OUT), 2048};
            pg8::EpiPart E{(float*)(ws + WS_R + R_T), MCTX, DM};
            pg8::gemm_phase<pg8::EpiPart, pg8::SchedSplit, false, false>(lds, (const unsigned char*)(OC + (size_t)MLAT * DM), 2048, S, E, tid, 4);
        }
        if (IN(pb + 3)) TAIL_FILL(3, (L == 0 && SPLITK) ? 512 + 64 : (L == 0 ? 132 : 128) * 4);
        SEAM(pb + 3);
        if (EN(8) && IN(pb + 4)) { PHASE_REGS(); for (int rep = 0; rep < (L == 0 ? REP(7) : 1); ++rep) norm_mid_phase(args, ws, lds, L, tid, wave, lane); }
        if (IN(pb + 4) && L == 1) { PHASE_REGS(); cvt_filler(args, ws, lds, tid, wave, lane, nullptr, 0); }
        SEAM(pb + 4);
#pragma unroll 1
        for (int c = 0; c < 5; ++c) {
            const bool any = IN(pb + 6 + 2 * c) || IN(pb + 7 + 2 * c);
            int ntiles = 0;
            PHASE_REGS();
            if (any) {
                LAS int* tlw = (LAS int*)(lds + LDSCTL_OFF + LC_TILE);
                int pre[9]; pre[0] = 0;
#pragma unroll
                for (int e = 0; e < 8; ++e) { const int ce = L == 0 ? (e == 0 ? MALL : 0) : __builtin_amdgcn_readfirstlane(__hip_atomic_load((int*)(ws + WS_CTL) + CW_GCNT + e, RLX_AGENT)); pre[e + 1] = pre[e] + ((ce + 255) >> 8); }
                ntiles = pre[8];
                __syncthreads();
                for (int t = tid; t < ntiles && t < 512; t += NTHR) { int e = 0;
#pragma unroll
                    for (int q = 1; q < 8; ++q) if (pre[q] <= t) e = q;
                    int pe = 0;
#pragma unroll
                    for (int q = 0; q < 8; ++q) if (q == e) pe = pre[q];
                    tlw[t] = (e << 24) | ((L == 0 ? 0 : e * CAP) + 256 * (t - pe)); }
                __syncthreads(); }
            const int CT = L == 0 ? CHUNK_TILES : 128;
            const int t0 = c * CT; int nM = ntiles - t0;
            if (L == 0 && SPLITK && !FP8_DDN) { if (c == 0) nM = nM > CT ? CT : nM; else if (c > 1) nM = 0; }
            else if (L == 1 && !MK_MULTI) { if (c == 0) nM = nM > CT ? CT : nM; else if (c > 1) nM = 0; }
            else nM = nM > CT ? CT : nM;
            unsigned char* const actb = (L == 0 && SPLITK && !FP8_DDN) ? ws + WS_R - ACT0_BACK : (L == 1 && !MK_MULTI) ? ws + WS_R - ACT1_BACK : ws + WS_R + R_ACT;
            if (!MK_MULTI && nM <= 0) break;
            const LAS int* tl = (const LAS int*)(lds + LDSCTL_OFF + LC_TILE);
            const int* tokmap = L == 0 ? (const int*)(ws + WS_RT + RT_TOK) : (const int*)(ws + WS_RT1 + RT1_TOK);
            const int* dstmap = L == 0 ? (const int*)(ws + WS_RT + RT_DST) : (const int*)(ws + WS_RT1 + RT1_DST);
            const float* gatemap = L == 0 ? (const float*)(ws + WS_RT + RT_GATE) : (const float*)(ws + WS_RT1 + RT1_GATE);
            if (EN(10) && IN(pb + 6 + 2 * c) && nM > 0) {
                if (L == 0 && FP8_DGU && !FP8_DDN) { PHASE_REGS();
                    pg8::SchedGrp S{G, bx, t0, nM, 28, (const char*)(ws + WS_W + W_GUD), (size_t)0, 1024, tl, tokmap, true, MK_PROBE == 21};
                    pg8::EpiGUm E{(bf16*)actb, t0};
                    pg8::gemm_phase<pg8::EpiGUm, pg8::SchedGrp, true, true>(lds, (const unsigned char*)Y, 1024, S, E, tid);
                    TAIL_FILL(4 + 2 * c, nM * 28);
                } else if (L == 0 && !FP8_DGU) { PHASE_REGS();
                    pg8::SchedGrp S{G, bx, t0, nM, 28, (const char*)(ws + WS_W + W_GUD), (size_t)0, 2048, tl, tokmap, true, MK_PROBE == 21};
                    pg8::EpiGU E{(bf16*)(ws + WS_R + R_ACT), t0};
                    pg8::gemm_phase<pg8::EpiGU, pg8::SchedGrp, true, false>(lds, (const unsigned char*)Y, 2048, S, E, tid);
                    TAIL_FILL(4 + 2 * c, nM * 28);
                } else { PHASE_REGS();
                    pg8::SchedGrp S{G, bx, t0, nM, 28, (const char*)(ws + WS_W + (L == 0 ? W_GUD : W_GUE)), L == 0 ? (size_t)0 : (size_t)7168 * 1024, 1024, tl, tokmap, true, MK_PROBE == 23};
                    pg8::EpiGU8 E{(unsigned char*)actb, t0};
                    pg8::gemm_phase<pg8::EpiGU8, pg8::SchedGrp, true, true>(lds, (const unsigned char*)Y, 1024, S, E, tid);
                }
            }
            SEAM(pb + 6 + 2 * c);
            if (EN(11) && IN(pb + 7 + 2 * c) && nM > 0) {
                if (L == 0 && SPLITK && c == 2 && FP8_DDN) { PHASE_REGS();
                    pg8::SchedSplit S{G, bx, nM, 4, 7, 4, (const char*)(ws + WS_W + W_DD), DFF};
                    pg8::EpiPart E{(float*)(ws + WS_R + R_PART), nM * 256, DM};
                    pg8::gemm_phase<pg8::EpiPart, pg8::SchedSplit, false, true>(lds, (const unsigned char*)(ws + WS_R + R_ACT), DFF, S, E, tid, 4);
                } else if (L == 0 && !FP8_DDN) {
                    const int ng = (SPLITK && nM > CHUNK_TILES) ? CHUNK_TILES : nM;
                    { PHASE_REGS();
                      pg8::SchedGrp S{G, bx, t0, ng, 4, (const char*)(ws + WS_W + W_DD), (size_t)0, 2 * DFF, tl, tokmap, false, MK_PROBE == 22};
                      pg8::EpiDown E{(bf16*)(ws + WS_R + R_F), dstmap, gatemap};
                      pg8::gemm_phase<pg8::EpiDown, pg8::SchedGrp, false, false>(lds, (const unsigned char*)actb, 2 * DFF, S, E, tid); }
                    if (nM > ng) { PHASE_REGS();
                      pg8::SchedSplit S{G, bx, nM - ng, 4, 14, 4, (const char*)(ws + WS_W + W_DD), 2 * DFF};
                      pg8::EpiPart E{(float*)(ws + WS_R + R_PART0), (nM - ng) * 256, DM};
                      pg8::gemm_phase<pg8::EpiPart, pg8::SchedSplit, false, false>(lds, (const unsigned char*)actb + (size_t)ng * 256 * 2 * DFF, 2 * DFF, S, E, tid, 4); }
                } else { PHASE_REGS();
                    pg8::SchedGrp S{G, bx, t0, nM, 4, (const char*)(ws + WS_W + (L == 0 ? W_DD : W_DE)), L == 0 ? (size_t)0 : (size_t)1024 * DFF, DFF, tl, tokmap, false, MK_PROBE == 24};
                    pg8::EpiDown8 E{(bf16*)(ws + WS_R + R_F), dstmap, gatemap};
                    pg8::gemm_phase<pg8::EpiDown8, pg8::SchedGrp, false, true>(lds, (const unsigned char*)actb, DFF, S, E, tid);
                }
            }
            SEAM(pb + 7 + 2 * c);
        }
        if (EN(12) && IN(pb + 16)) { PHASE_REGS(); norm_end_phase(args, ws, L, wave, lane); }
        if (L == 0) SEAM(pb + 16);
    }
#undef IN
#undef SEAM
}

extern "C" void kernel_launch(void* const* d_in, const int* in_sizes, int n_in, void* d_out, int out_size, void* d_ws, size_t ws_size, hipStream_t stream) {
    static int grid = 0;
    if (grid == 0) {
        if (n_in != 25 || out_size != MLAT * DM || ws_size < WS_END) { fprintf(stderr, "kernel_launch: unexpected shapes (n_in %d out %d ws %zu, need %zu)\n", n_in, out_size, ws_size, (size_t)WS_END); grid = -1; return; }
        int dev = 0, cus = 0, per_cu = 0;
        if (hipGetDevice(&dev) != hipSuccess || hipDeviceGetAttribute(&cus, hipDeviceAttributeMultiprocessorCount, dev) != hipSuccess) { grid = -1; return; }
        if (hipFuncSetAttribute((const void*)fwd_kernel, hipFuncAttributeMaxDynamicSharedMemorySize, LDS_BYTES) != hipSuccess) { fprintf(stderr, "kernel_launch: hipFuncSetAttribute failed\n"); grid = -1; return; }
        if (hipOccupancyMaxActiveBlocksPerMultiprocessor(&per_cu, (const void*)fwd_kernel, NTHR, LDS_BYTES) != hipSuccess || per_cu < 1) fprintf(stderr, "kernel_launch: occupancy query says %d\n", per_cu);
        (void)hipGetLastError();
        grid = cus > 256 ? 256 : cus;
    }
    if (grid < 0) return;
    (void)hipMemsetAsync((char*)d_ws + WS_CTL, 0, CTL_ZERO_BYTES, stream);
    Args a{};
    for (int i = 0; i < 25; ++i) a.in[i] = (const float*)d_in[i];
    a.out = (float*)d_out; a.ws = (unsigned char*)d_ws;
#if MK_MULTI
    for (int p = 0; p < PH_END; ++p) {
        const int k = p < 2 ? -1 : (p - 2) % PH_L;
        if (k > 16 || k == 5) continue;
        a.ph_lo = p; a.ph_hi = p + 1;
        hipLaunchKernelGGL(fwd_kernel, dim3(grid), dim3(NTHR), LDS_BYTES, stream, a);
    }
#else
    a.ph_lo = 0; a.ph_hi = PH_END;
    hipLaunchKernelGGL(fwd_kernel, dim3(grid), dim3(NTHR), LDS_BYTES, stream, a);
#endif
}
```

```cpp
#include <hip/hip_runtime.h>
#include <cstdio>
#include <cstdint>

#ifndef MK_MULTI
#define MK_MULTI 0
#endif
#define SPLITK (!MK_MULTI)
#ifndef MK_EN
#define MK_EN 0xFFFF
#endif
#define EN(b) (((MK_EN) >> (b)) & 1)
#ifndef MK_PROBE
#define MK_PROBE 0
#endif
#define KDUP_IN (MK_PROBE == 20)
#define KDUP_GRP (MK_PROBE >= 21 && MK_PROBE <= 24)
#define REP(k) ((MK_PROBE == (k)) ? 2 : 1)
#ifndef FILL
#define FILL 1
#endif

#define GAS __attribute__((address_space(1)))
#define LAS __attribute__((address_space(3)))
typedef unsigned short bf16;
typedef short bf16x8 __attribute__((ext_vector_type(8)));
typedef float f32x4 __attribute__((ext_vector_type(4)));
typedef float f32x2 __attribute__((ext_vector_type(2)));
typedef unsigned u32x4 __attribute__((ext_vector_type(4)));
typedef unsigned u32x2 __attribute__((ext_vector_type(2)));
typedef int i32x8 __attribute__((ext_vector_type(8)));
typedef GAS unsigned gu32;
#define RLX_AGENT __ATOMIC_RELAXED, __HIP_MEMORY_SCOPE_AGENT
#define LDS_WAIT() asm volatile("s_waitcnt lgkmcnt(0)" ::: "memory")
#define VM_WAIT() asm volatile("s_waitcnt vmcnt(0)" ::: "memory")
#define DI __device__ __forceinline__

constexpr int NB = 4, NLAT = 8192, NCTX = 256, DM = 1024;
constexpr int MLAT = NB * NLAT, MCTX = NB * NCTX, MALL = MLAT + MCTX;
constexpr int NZ = 1792;
constexpr int ZU = 0, ZV = 256, ZP = 512, ZQI = 768, ZQ = 1024, ZK = 1536, ZVV = 1664;
constexpr int DFF = 3584, NE = 8;
constexpr float EPS = 1e-6f, LOG2E = 1.4426950408889634f, QSCALE = 0.125f * 1.4426950408889634f;
constexpr int NWAVES = 8, NTHR = 512;
#ifndef FP8_DGU
#define FP8_DGU 1
#endif
#ifndef FP8_DDN
#define FP8_DDN 0
#endif
constexpr int CHUNK_TILES = 64;

constexpr size_t MiB = 1u << 20;
constexpr size_t WS_CTL = 0, CTL_ZERO_BYTES = 1 * MiB;
constexpr size_t WS_MOD = 6 * MiB;
constexpr size_t WS_TAB = 2 * MiB;
constexpr size_t T_G1 = 0, T_G3 = 32768, T_GC = 98304, T_WS = 360448, T_ROPE = 622592;
constexpr size_t WS_RT = 3 * MiB;
constexpr size_t RT_TOK = 0, RT_DST = 327680, RT_GATE = 655360, RT_TILE = 983040, RT_WGCNT = 985088, RT_ROW = 1 * MiB;
constexpr size_t WS_W = 8 * MiB;
constexpr size_t W_IN = 0, W_OUT = 7 * MiB, W_GUD = 11 * MiB, W_DD = 25 * MiB, W_GUE = 32 * MiB, W_DE = 88 * MiB;
constexpr size_t WS_H3 = 8 * MiB + 120 * MiB;
constexpr size_t WS_HCTX = 208 * MiB;
constexpr size_t WS_Y = 212 * MiB;
constexpr size_t WS_R = 278 * MiB;
constexpr size_t R_Z = 0, R_O = 0, R_OC = 116 * MiB, R_T = 182 * MiB, R_ACT = 0, R_F = 116 * MiB;
constexpr size_t ACT0_BACK = 8 * MiB;
constexpr size_t ACT1_BACK = 16 * MiB;
constexpr size_t R_PART0 = 182 * MiB;
constexpr size_t R_PART = 8 * MiB;
static_assert((size_t)MCTX * DFF * 2 <= 8 * MiB && R_PART + (size_t)14 * MCTX * DM * 4 <= 116 * MiB, "partials fit the activation region");
constexpr size_t WS_RT1 = 278 * MiB + 248 * MiB;
constexpr int CAP = 32768;
constexpr size_t RT1_TOK = 0, RT1_DST = 1 * MiB, RT1_GATE = 2 * MiB;
constexpr size_t WS_END = WS_RT1 + 3 * MiB;
static_assert((size_t)MALL * NZ * 2 <= 116 * MiB && (size_t)(CHUNK_TILES * 256) * DFF * 2 <= 116 * MiB && (size_t)(132 * 256) * DFF <= 116 * MiB && (size_t)2 * MALL * DM * 2 <= 132 * MiB, "ws map");
constexpr int CW_TMO = 0, CW_NTILES = 16, CW_CVT = 32, CW_GCNT = 48, CW_DONE = 64, CW_BAR = 4096;

constexpr int RING_BYTES = 131072, LDSCTL_OFF = RING_BYTES, LDS_BYTES = 163840;
constexpr int LC_ROPE = 16384;
constexpr int LC_BAR = 0;
constexpr int LC_TILE = 64;
constexpr int LC_CNT = 64 + 2048;
constexpr int LC_FILL = 64 + 2048 + 128;

DI unsigned cvt_pk_bf16(float lo, float hi) { unsigned r; asm volatile("v_cvt_pk_bf16_f32 %0, %1, %2" : "=v"(r) : "v"(lo), "v"(hi)); return r; }
DI unsigned short f2bf(float f) { return (unsigned short)(cvt_pk_bf16(f, 0.f) & 0xffffu); }
DI float bflo(unsigned w) { return __uint_as_float(w << 16); }
DI float bfhi(unsigned w) { return __uint_as_float(w & 0xffff0000u); }
DI float shx(float v, int mask, int lane) { return __builtin_bit_cast(float, __builtin_amdgcn_ds_bpermute((lane ^ mask) << 2, __builtin_bit_cast(int, v))); }
template <int CTRL> DI float dppx(float x) { return __builtin_bit_cast(float, __builtin_amdgcn_mov_dpp(__builtin_bit_cast(int, x), CTRL, 0xf, 0xf, true)); }
DI float xrow16_sum(float x) {
    auto s = __builtin_amdgcn_permlane16_swap(__float_as_uint(x), __float_as_uint(x), false, false);
    x = __uint_as_float(s[0]) + __uint_as_float(s[1]);
    auto t = __builtin_amdgcn_permlane32_swap(__float_as_uint(x), __float_as_uint(x), false, false);
    return __uint_as_float(t[0]) + __uint_as_float(t[1]);
}
DI float xrow16_max(float x) {
    auto s = __builtin_amdgcn_permlane16_swap(__float_as_uint(x), __float_as_uint(x), false, false);
    x = fmaxf(__uint_as_float(s[0]), __uint_as_float(s[1]));
    auto t = __builtin_amdgcn_permlane32_swap(__float_as_uint(x), __float_as_uint(x), false, false);
    return fmaxf(__uint_as_float(t[0]), __uint_as_float(t[1]));
}
DI float wave_sum(float v, int) {
    v += dppx<0xB1>(v);
    v += dppx<0x4E>(v);
    v += dppx<0x141>(v);
    v += dppx<0x128>(v);
    return xrow16_sum(v);
}
DI float fexp2(float x) { return __builtin_amdgcn_exp2f(x); }
DI float vmax3(float a, float b, float c) { float r; asm("v_max3_f32 %0, %1, %2, %3" : "=v"(r) : "v"(a), "v"(b), "v"(c)); return r; }
DI float frcp(float x) { return __builtin_amdgcn_rcpf(x); }
DI float gelu_tanh(float x) { const float u = 0.7978845608028654f * (x + 0.044715f * x * x * x); return x * frcp(1.0f + fexp2(-2.0f * LOG2E * u)); }
DI float silu_f(float x) { return x * frcp(1.0f + fexp2(-LOG2E * x)); }
DI f32x4 mfma16(bf16x8 a, bf16x8 b, f32x4 c) { return __builtin_amdgcn_mfma_f32_16x16x32_bf16(a, b, c, 0, 0, 0); }
typedef short v4i16_t __attribute__((ext_vector_type(4)));
DI bf16x8 trfrag(const LAS unsigned char* p, int pitch, int lane) {
    const LAS unsigned char* q = p + (8 * (lane >> 4) + ((lane & 15) >> 2)) * pitch + 8 * (lane & 3);
    const v4i16_t lo = __builtin_amdgcn_ds_read_tr16_b64_v4i16((LAS v4i16_t*)q), hi = __builtin_amdgcn_ds_read_tr16_b64_v4i16((LAS v4i16_t*)(q + 4 * pitch));
    return __builtin_shufflevector(lo, hi, 0, 1, 2, 3, 4, 5, 6, 7);
}

#define XB_TMO      128
#define XB_XCNT(j)  (256  + 64 * (j))
#define XB_XSUB(j)  (1280 + 64 * (j))
#define XB_XGEN(j)  (2304 + 64 * (j))
#define XB_TOP      3328
#define XB_TOPGEN   3392
#define XCD_BAR_WORDS 3456
#define XB_SPIN_CAP (1u << 18)
DI unsigned xb_ld(unsigned* p)              { return __hip_atomic_load(p, __ATOMIC_RELAXED, __HIP_MEMORY_SCOPE_AGENT); }
DI unsigned xb_add(unsigned* p, unsigned v) { return __hip_atomic_fetch_add(p, v, __ATOMIC_RELAXED, __HIP_MEMORY_SCOPE_AGENT); }
DI unsigned xb_xcc_id() { return (unsigned)__builtin_amdgcn_s_getreg((3 << 11) | 20) & 0xFu; }
#define XB_SPIN(cond, bar) do { unsigned _sp = 0; while (cond) { __builtin_amdgcn_s_sleep(1); \
    if ((++_sp & 255u) == 0u) { if (xb_ld(&(bar)[XB_TMO])) break; if (_sp > XB_SPIN_CAP) { atomicAdd(&(bar)[XB_TMO], 1u); break; } } } } while (0)
struct XcdBarrier { unsigned* bar; unsigned x; volatile LAS unsigned* st; };
DI XcdBarrier xcd_barrier_post(unsigned* bar, volatile LAS unsigned* st) {
    XcdBarrier b; b.bar = bar; b.x = xb_xcc_id(); b.st = st;
    if (threadIdx.x == 0) (void)xb_add(&bar[XB_XCNT(b.x)], 1u);
    return b;
}
DI void xcd_barrier_complete(unsigned* bar, unsigned x, unsigned& nloc, unsigned& nx) {
    const unsigned G = gridDim.x * gridDim.y * gridDim.z;
    unsigned sum, cnt, mine, sp = 0u;
    for (;;) {
        sum = 0u; cnt = 0u; mine = 0u;
#pragma unroll
        for (unsigned j = 0; j < 16; ++j) { const unsigned c = xb_ld(&bar[XB_XCNT(j)]); sum += c; cnt += (c > 0u) ? 1u : 0u; mine = (j == x) ? c : mine; }
        if (sum == G) break;
        __builtin_amdgcn_s_sleep(1);
        if ((++sp & 255u) == 0u) { if (xb_ld(&bar[XB_TMO])) break; if (sp > XB_SPIN_CAP) { atomicAdd(&bar[XB_TMO], 1u); break; } }
    }
    nloc = mine > 0u ? mine : 1u; nx = cnt > 0u ? cnt : 1u;
}
DI void xcd_barrier(const XcdBarrier& b, const bool leader) {
    asm volatile("s_waitcnt vmcnt(0)" ::: "memory");
    __syncthreads();
    if (leader) {
        unsigned* bar = b.bar;
        __builtin_amdgcn_s_waitcnt(0);
        unsigned nloc = b.st[0], nx = b.st[1];
        if (nloc == 0u) { xcd_barrier_complete(bar, b.x, nloc, nx); b.st[0] = nloc; b.st[1] = nx; }
        const unsigned old = xb_add(&bar[XB_XSUB(b.x)], 1u);
        const unsigned gen = old / nloc;
        if (old + 1u == (gen + 1u) * nloc) {
            __builtin_amdgcn_fence(__ATOMIC_RELEASE, "agent");
            asm volatile("s_waitcnt vmcnt(0)" ::: "memory");
            const unsigned og = xb_add(&bar[XB_TOP], 1u);
            const unsigned tg = og / nx;
            if (og + 1u == (tg + 1u) * nx) xb_add(&bar[XB_TOPGEN], 1u);
            else XB_SPIN(xb_ld(&bar[XB_TOPGEN]) == tg, bar);
            __builtin_amdgcn_fence(__ATOMIC_ACQUIRE, "agent");
            xb_add(&bar[XB_XGEN(b.x)], 1u);
            asm volatile("s_waitcnt vmcnt(0)" ::: "memory");
        } else {
            XB_SPIN(xb_ld(&bar[XB_XGEN(b.x)]) == gen, bar);
            __builtin_amdgcn_fence(__ATOMIC_ACQUIRE, "agent");
            asm volatile("s_waitcnt vmcnt(0)" ::: "memory");
        }
    }
    __syncthreads();
}

namespace pg8 {
typedef unsigned short bf16_t;
constexpr int BM = 256, BK = 64, HALF = 128, HTB = HALF * BK * 2, STAGE_BYTES = 8 * HTB;
DI int lds_byte(int r, int c) { const int st = (r >> 4) * 2 + (c >> 5), rr = r & 15, cc = c & 31, ob = rr * 64 + cc * 2; return st * 1024 + (ob ^ (((ob >> 9) & 1) << 5)); }
DI void stage_rc(int b, int& R, int& C) { const int st = b / 1024, sb = b % 1024, swz = sb ^ (((sb >> 9) & 1) << 5); R = (st >> 1) * 16 + swz / 64; C = (st & 1) * 32 + (swz % 64) / 2; }
DI int perm32(int rho) { const int n = rho >> 4, i = rho & 15; return 8 * (i >> 2) + 4 * n + (i & 3); }

struct Unit { int pm, pn; int arow; unsigned boff; int dup; int slot0; unsigned kofs; int ks; };

DI void static_map(int wgid, int nM, int nN, int& pm, int& pn) {
    const int nwg = nM * nN; const int q = nwg / 8, r = nwg % 8, xcd = wgid % 8, off = wgid / 8;
    wgid = (xcd < r ? xcd * (q + 1) : r * (q + 1) + (xcd - r) * q) + off;
    const int nig = 8 * nN, gid = wgid / nig, fm = gid * 8, gsz = (nM - fm) < 8 ? (nM - fm) : 8;
    pm = fm + ((wgid % nig) % gsz); pn = (wgid % nig) / gsz;
}

template <class Epi, class Sched, bool GATHER, bool FP8>
DI void gemm_phase(LAS unsigned char* lds, const unsigned char* Abase, const int rowbytes, const Sched& S, const Epi& E, const int tid, const int ntk = 0) {
    const int wid = __builtin_amdgcn_readfirstlane(tid >> 6), lane = tid & 63, wr = wid >> 2, wc = wid & 3, fr = lane & 15, fq = lane >> 4;
    const int nt = ntk ? ntk : rowbytes / 128;
    unsigned voffA, voffB, cofs; int Rr[2];
    { int R, C; stage_rc(tid * 16, R, C); const int Rb = (R & ~31) + perm32(R & 31);
      voffA = (unsigned)(R * rowbytes + C * 2); voffB = (unsigned)(Rb * rowbytes + C * 2); cofs = (unsigned)C * 2u; Rr[0] = R; Rr[1] = R + 64; }
    const unsigned kstep = (unsigned)(BK * 2);
    const unsigned hstep = (unsigned)HALF * (unsigned)rowbytes;
    const unsigned istep = 64u * (unsigned)rowbytes;
    const unsigned rowb = (unsigned)rowbytes;
    const unsigned ldsw = (unsigned)wid * 1024u;
    const int aoff = lds_byte(wr * 64 + fr, fq * 8), boff = lds_byte(wc * 32 + fr, fq * 8);
    const __amdgpu_buffer_rsrc_t rA = __builtin_amdgcn_make_buffer_rsrc((void*)Abase, (short)0, 0x7fffffff, 0x00020000);
    const __amdgpu_buffer_rsrc_t rB = __builtin_amdgcn_make_buffer_rsrc((void*)S.wbase(), (short)0, 0x7fffffff, 0x00020000);
#define PG8_SA(b, h) (((b) * 2 + (h)) * HTB)
#define PG8_SB(b, h) ((4 + (b) * 2 + (h)) * HTB)
#define PG8_DMA(rs, ldsoff, vo, so) __builtin_amdgcn_raw_ptr_buffer_load_lds(rs, (LAS void*)(lds + (ldsoff)), 16, (int)(vo), (int)(so), 0, 0)
#define PG8_STAGE(bufoff, so) do { PG8_DMA(rB, (bufoff) + ldsw, voffB, (so)); PG8_DMA(rB, (bufoff) + ldsw + 8192, voffB, (so) + istep); } while (0)
#define PG8_STAGE_A(bufoff, h, kb, nx) do { if constexpr (GATHER) { PG8_DMA(rA, (bufoff) + ldsw, aoC[h][0], (kb)); PG8_DMA(rA, (bufoff) + ldsw + 8192, aoC[h][1], (kb)); } \
        else { const unsigned so_ = ((nx) ? nA : cA) + (unsigned)(h) * hstep + (kb); PG8_DMA(rA, (bufoff) + ldsw, voffA, so_); PG8_DMA(rA, (bufoff) + ldsw + 8192, voffA, so_ + istep); } } while (0)
#define PG8_LDA(dst, b, h) do { _Pragma("unroll") for (int m = 0; m < 4; ++m) { const u32x4 lo_ = *(const LAS u32x4*)(lds + PG8_SA(b, h) + aoff + m * 2048), hi_ = *(const LAS u32x4*)(lds + PG8_SA(b, h) + aoff + m * 2048 + 1024); \
        dst[m] = (i32x8){(int)lo_.x, (int)lo_.y, (int)lo_.z, (int)lo_.w, (int)hi_.x, (int)hi_.y, (int)hi_.z, (int)hi_.w}; } } while (0)
#define PG8_LDB(dst, b, h) do { _Pragma("unroll") for (int n = 0; n < 2; ++n) { const u32x4 lo_ = *(const LAS u32x4*)(lds + PG8_SB(b, h) + boff + n * 2048), hi_ = *(const LAS u32x4*)(lds + PG8_SB(b, h) + boff + n * 2048 + 1024); \
        dst[n] = (i32x8){(int)lo_.x, (int)lo_.y, (int)lo_.z, (int)lo_.w, (int)hi_.x, (int)hi_.y, (int)hi_.z, (int)hi_.w}; } } while (0)
#define PG8_HALF(v, k) __builtin_bit_cast(bf16x8, __builtin_shufflevector(v, v, 4 * (k), 4 * (k) + 1, 4 * (k) + 2, 4 * (k) + 3))
#define PG8_MMA(ai, bj, At, Bt) do { __builtin_amdgcn_s_setprio(1); if constexpr (FP8) { _Pragma("unroll") for (int m = 0; m < 4; ++m) _Pragma("unroll") for (int n = 0; n < 2; ++n) \
        acc[ai][bj][m][n] = __builtin_amdgcn_mfma_scale_f32_16x16x128_f8f6f4(Bt[n], At[m], acc[ai][bj][m][n], 0, 0, 0, 0, 0, 0); } \
    else { _Pragma("unroll") for (int m = 0; m < 4; ++m) _Pragma("unroll") for (int n = 0; n < 2; ++n) { \
        acc[ai][bj][m][n] = __builtin_amdgcn_mfma_f32_16x16x32_bf16(PG8_HALF(Bt[n], 0), PG8_HALF(At[m], 0), acc[ai][bj][m][n], 0, 0, 0); \
        acc[ai][bj][m][n] = __builtin_amdgcn_mfma_f32_16x16x32_bf16(PG8_HALF(Bt[n], 1), PG8_HALF(At[m], 1), acc[ai][bj][m][n], 0, 0, 0); } } __builtin_amdgcn_s_setprio(0); } while (0)
#define PG8_WAIT_V(n) asm volatile("s_waitcnt vmcnt(" #n ")" ::: "memory")
#define PG8_WAIT_L(n) asm volatile("s_waitcnt lgkmcnt(" #n ")" ::: "memory")
#define PG8_BAR __builtin_amdgcn_s_barrier()
#define PG8_SCHED __builtin_amdgcn_sched_barrier(0)
    Unit cur, nxt; int ui = 0;
    if (!S.next(0, cur)) return;
    f32x4 acc[2][2][4][2];
#pragma unroll
    for (int a = 0; a < 2; ++a)
#pragma unroll
        for (int b = 0; b < 2; ++b)
#pragma unroll
            for (int m = 0; m < 4; ++m)
#pragma unroll
                for (int n = 0; n < 2; ++n) acc[a][b][m][n] = (f32x4){0.f, 0.f, 0.f, 0.f};
    i32x8 At[4], B0[2], B1[2];
    unsigned aoC[2][2];
    LAS unsigned short* gidx = (LAS unsigned short*)(lds + 131072 + 4096);
    unsigned cA = (unsigned)cur.arow * rowb + cur.kofs, cB = cur.boff + cur.kofs;
    if constexpr (GATHER) {
        Unit pu;
        for (int i = 0; i < 16 && S.next(i, pu); ++i) if (tid < 256) gidx[i * 256 + tid] = (unsigned short)S.rowidx(pu.arow + tid);
        __syncthreads();
    }
#pragma unroll
    for (int h = 0; h < 2; ++h)
#pragma unroll
        for (int i = 0; i < 2; ++i) aoC[h][i] = GATHER ? (unsigned)gidx[128 * h + Rr[i]] * rowb + cofs : 0u;
    unsigned nA = cA, nB = cB;
    PG8_STAGE(PG8_SB(0, 0), cB); PG8_STAGE(PG8_SB(0, 1), cB + hstep); PG8_STAGE_A(PG8_SA(0, 0), 0, 0u, false); PG8_STAGE_A(PG8_SA(0, 1), 1, 0u, false);
    if (wr == 1) PG8_BAR;
    PG8_WAIT_V(2); PG8_BAR;
    PG8_STAGE(PG8_SB(1, 0), cB + kstep); PG8_STAGE_A(PG8_SA(1, 0), 0, kstep, false); PG8_STAGE(PG8_SB(1, 1), cB + hstep + kstep);
    PG8_WAIT_V(6); PG8_BAR;
    for (;;) {
        const bool has_next = S.next(ui + 1, nxt);
        nA = has_next ? (unsigned)nxt.arow * rowb + nxt.kofs : cA; nB = has_next ? nxt.boff + nxt.kofs : cB;
#pragma unroll 1
        for (int t = 0; t < nt; t += 2) {
            const bool last = (t == nt - 2);
            const unsigned kb1 = (unsigned)(t + 1) * kstep, kb2 = last ? 0u : (unsigned)(t + 2) * kstep, kb3 = kb2 + kstep;
            const unsigned b2 = (last ? nB : cB) + kb2, b3 = b2 + kstep;
            PG8_LDB(B0, 0, 0); PG8_LDB(B1, 0, 1); PG8_SCHED; PG8_LDA(At, 0, 0); PG8_STAGE_A(PG8_SA(1, 1), 1, kb1, false);
            PG8_WAIT_V(8); PG8_WAIT_L(0); PG8_BAR; PG8_MMA(0, 0, At, B0); PG8_MMA(0, 1, At, B1); PG8_BAR; PG8_SCHED;
            if constexpr (GATHER) { if (last && has_next) { const LAS unsigned short* gi = gidx + (ui + 1) * 256;
                aoC[0][0] = (unsigned)gi[Rr[0]] * rowb + cofs; aoC[0][1] = (unsigned)gi[Rr[1]] * rowb + cofs; aoC[1][0] = (unsigned)gi[128 + Rr[0]] * rowb + cofs; aoC[1][1] = (unsigned)gi[128 + Rr[1]] * rowb + cofs; } }
            PG8_LDA(At, 0, 1); PG8_STAGE(PG8_SB(0, 0), b2); PG8_STAGE(PG8_SB(0, 1), b2 + hstep); PG8_STAGE_A(PG8_SA(0, 0), 0, kb2, last);
            PG8_WAIT_V(8); PG8_WAIT_L(0); PG8_BAR; PG8_MMA(1, 0, At, B0); PG8_MMA(1, 1, At, B1); PG8_BAR; PG8_SCHED;
            PG8_LDB(B0, 1, 0); PG8_LDB(B1, 1, 1); PG8_SCHED; PG8_LDA(At, 1, 0); PG8_STAGE_A(PG8_SA(0, 1), 1, kb2, last);
            PG8_WAIT_V(8); PG8_WAIT_L(0); PG8_BAR; PG8_MMA(0, 0, At, B0); PG8_MMA(0, 1, At, B1); PG8_BAR; PG8_SCHED;
            PG8_LDA(At, 1, 1); PG8_STAGE(PG8_SB(1, 0), b3); PG8_STAGE(PG8_SB(1, 1), b3 + hstep); PG8_STAGE_A(PG8_SA(1, 0), 0, kb3, last);
            PG8_WAIT_V(8); PG8_WAIT_L(0); PG8_BAR; PG8_MMA(1, 0, At, B0); PG8_MMA(1, 1, At, B1); PG8_BAR; PG8_SCHED;
        }
        if (wr == 0) PG8_BAR;
        if (!cur.dup) { int te; asm volatile("v_mbcnt_lo_u32_b32 %0, -1, 0\n\tv_mbcnt_hi_u32_b32 %0, -1, %0" : "=v"(te));
          for (int rep = 0; rep < REP(30); ++rep) E(acc, cur, wr, wc, te & 15, (te & 63) >> 4); }
        if (!has_next) break;
#pragma unroll
        for (int a = 0; a < 2; ++a)
#pragma unroll
            for (int b = 0; b < 2; ++b)
#pragma unroll
                for (int m = 0; m < 4; ++m)
#pragma unroll
                    for (int n = 0; n < 2; ++n) acc[a][b][m][n] = (f32x4){0.f, 0.f, 0.f, 0.f};
        cur = nxt; cA = nA; cB = nB; ++ui;
        if (wr == 1) PG8_BAR;
    }
    PG8_WAIT_V(0);
    PG8_BAR;
#undef PG8_SA
#undef PG8_SB
#undef PG8_STAGE
#undef PG8_DMA
#undef PG8_STAGE_A
#undef PG8_LDA
#undef PG8_LDB
#undef PG8_MMA
#undef PG8_HALF
#undef PG8_WAIT_V
#undef PG8_WAIT_L
#undef PG8_BAR
#undef PG8_SCHED
}

struct SchedIn {
    int G, c, nctx; bool ctx_all; const char* Bt; int rb;
    DI bool next(int i0, Unit& u) const {
        const int i = KDUP_IN ? (i0 >> 1) : i0; u.dup = KDUP_IN ? !(i0 & 1) : 0;
        const long Lx = (long)i * G + c; int pm, pn;
        if (Lx < 896) static_map((int)Lx, 128, 7, pm, pn);
        else { const int j = (int)(Lx - 896); if (j >= nctx) return false; if (ctx_all) { pm = 128 + j / 7; pn = j % 7; } else { pm = 128 + j; pn = 6; } }
        u.pm = pm; u.pn = pn; u.arow = pm * 256; u.boff = (unsigned)(pn * 256 * rb); u.kofs = 0u; u.ks = 0; return true;
    }
    DI int rowidx(int) const { return 0; }
    DI const void* wbase() const { return Bt; }
};
struct SchedPlain {
    int G, c, nM, nN; const char* Bt; int rb;
    DI bool next(int i, Unit& u) const {
        u.dup = 0; const long Lx = (long)i * G + c; if (Lx >= (long)nM * nN) return false; int pm, pn; static_map((int)Lx, nM, nN, pm, pn);
        u.pm = pm; u.pn = pn; u.arow = pm * 256; u.boff = (unsigned)(pn * 256 * rb); u.kofs = 0u; u.ks = 0; return true;
    }
    DI int rowidx(int) const { return 0; }
    DI const void* wbase() const { return Bt; }
};
struct SchedGrp {
    int G, c, t0, nM, nN; const char* W; size_t wstride; int rb; const LAS int* tile_e; const int* tokmap; bool gather; bool kdup;
    DI bool next(int i0, Unit& u) const {
        const int i = (KDUP_GRP && kdup) ? (i0 >> 1) : i0; u.dup = (KDUP_GRP && kdup) ? !(i0 & 1) : 0;
        const long Lx = (long)i * G + c; if (Lx >= (long)nM * nN) return false; int pm, pn; static_map((int)Lx, nM, nN, pm, pn);
        const int te = __builtin_amdgcn_readfirstlane(tile_e[t0 + pm]);
        const int e = te >> 24; u.slot0 = te & 0xffffff;
        u.pm = t0 + pm; u.pn = pn; u.arow = gather ? u.slot0 : pm * 256; u.boff = (unsigned)e * (unsigned)wstride + (unsigned)(pn * 256 * rb); u.kofs = 0u; u.ks = 0; return true;
    }
    DI int rowidx(int slot) const { return tokmap[slot]; }
    DI const void* wbase() const { return W; }
};

struct SchedSplit {
    int G, c, nM, nN, S, ntk; const char* Bt; int rb;
    DI bool next(int i, Unit& u) const {
        const long Lx = (long)i * G + c; if (Lx >= (long)nM * nN * S) return false;
        const int ks = (int)(Lx % S), rest = (int)(Lx / S), pn = rest % nN, pm = rest / nN;
        u.pm = pm; u.pn = pn; u.arow = pm * 256; u.boff = (unsigned)(pn * 256 * rb); u.kofs = (unsigned)(ks * ntk * 128); u.ks = ks; u.dup = 0; u.slot0 = 0; return true;
    }
    DI int rowidx(int) const { return 0; }
    DI const void* wbase() const { return Bt; }
};
#ifndef EPI_NT
#define EPI_NT 0
#endif
#if EPI_NT
#define EPI_ST(p, v) __builtin_nontemporal_store((v), (p))
#else
#define EPI_ST(p, v) (*(p) = (v))
#endif
typedef f32x4 Acc[2][2][4][2];
DI u32x4 tr4(u32x4 w, int te) { const int src = (((te & 3) << 4) | (te >> 2)) << 2; u32x4 r;
    r.x = (unsigned)__builtin_amdgcn_ds_bpermute(src, (int)w.x); r.y = (unsigned)__builtin_amdgcn_ds_bpermute(src, (int)w.y); r.z = (unsigned)__builtin_amdgcn_ds_bpermute(src, (int)w.z); r.w = (unsigned)__builtin_amdgcn_ds_bpermute(src, (int)w.w); return r; }
struct EpiZ {
    bf16_t* Z; const LAS float* rc; const LAS float* rs;
    DI void operator()(const Acc& acc, const Unit& u, int wr, int wc, int fr, int fq) const {
        const int pn = u.pn, row0 = u.pm * 256 + wr * 64 + fr, te = fq * 16 + fr;
        const bool lat = u.pm < 128;
        bf16_t* rowp0 = Z + (size_t)(u.pm * 256 + wr * 64 + (te >> 2)) * NZ + pn * 256 + wc * 32 + 8 * (te & 3);
#pragma unroll
        for (int ai = 0; ai < 2; ++ai)
#pragma unroll
            for (int m = 0; m < 4; ++m) {
                const int row = row0 + ai * 128 + m * 16; bf16_t* rowp = rowp0 + (size_t)(ai * 128 + m * 16) * NZ;
#pragma unroll
                for (int bj = 0; bj < 2; ++bj) {
                    f32x4 v0 = acc[ai][bj][m][0], v1 = acc[ai][bj][m][1];
                    if (pn < 2) {
#pragma unroll
                        for (int j = 0; j < 4; ++j) { v0[j] = gelu_tanh(v0[j]); v1[j] = gelu_tanh(v1[j]); }
                    } else if (pn >= 4 && !(pn == 6 && bj == 1)) {
                        if (lat) {
                            const int n = row & (NLAT - 1); const int pos = (wc & 1) ? (n & 63) : (n >> 6); const int fb = 8 * (fq & 1);
                            const f32x4 c0 = *(const LAS f32x4*)(rc + pos * 16 + fb), c1 = *(const LAS f32x4*)(rc + pos * 16 + fb + 4);
                            const f32x4 s0 = *(const LAS f32x4*)(rs + pos * 16 + fb), s1 = *(const LAS f32x4*)(rs + pos * 16 + fb + 4);
                            const float sg = (fq >> 1) ? 1.f : -1.f;
                            f32x4 p0, p1;
#pragma unroll
                            for (int j = 0; j < 4; ++j) { p0[j] = shx(v0[j], 32, fq * 16 + fr); p1[j] = shx(v1[j], 32, fq * 16 + fr); }
                            v0 = v0 * c0 + sg * p0 * s0; v1 = v1 * c1 + sg * p1 * s1;
                        }
                        if (pn < 6) { v0 = v0 * QSCALE; v1 = v1 * QSCALE; }
                    }
                    u32x4 w; w.x = cvt_pk_bf16(v0[0], v0[1]); w.y = cvt_pk_bf16(v0[2], v0[3]); w.z = cvt_pk_bf16(v1[0], v1[1]); w.w = cvt_pk_bf16(v1[2], v1[3]);
                    EPI_ST((u32x4*)(rowp + bj * 128), tr4(w, te));
                }
            }
    }
};
struct EpiO {
    bf16_t* O; int ldc;
    DI void operator()(const Acc& acc, const Unit& u, int wr, int wc, int fr, int fq) const {
        const int te = fq * 16 + fr, row0 = u.pm * 256 + wr * 64 + (te >> 2), colb = u.pn * 256 + wc * 32 + 8 * (te & 3);
#pragma unroll
        for (int ai = 0; ai < 2; ++ai)
#pragma unroll
            for (int m = 0; m < 4; ++m) { bf16_t* rowp = O + (size_t)(row0 + ai * 128 + m * 16) * ldc + colb;
#pragma unroll
                for (int bj = 0; bj < 2; ++bj) { const f32x4 v0 = acc[ai][bj][m][0], v1 = acc[ai][bj][m][1];
                    u32x4 w; w.x = cvt_pk_bf16(v0[0], v0[1]); w.y = cvt_pk_bf16(v0[2], v0[3]); w.z = cvt_pk_bf16(v1[0], v1[1]); w.w = cvt_pk_bf16(v1[2], v1[3]);
                    EPI_ST((u32x4*)(rowp + bj * 128), tr4(w, te)); } }
    }
};
DI f32x2 swiglu2(f32x2 g, f32x2 u, float c1, float c0, float k0) {
    const f32x2 t = g * c1 + c0; f32x2 e; e.x = fexp2(t.x); e.y = fexp2(t.y);
    const f32x2 d = e + k0; f32x2 r; r.x = frcp(d.x); r.y = frcp(d.y);
    return (g * u) * r;
}
DI f32x2 swiglu2d(f32x2 g, f32x2 u) {
    f32x2 e; e.x = fexp2(-g.x); e.y = fexp2(-g.y);
    const f32x2 d = e * LOG2E + LOG2E; f32x2 r; r.x = frcp(d.x); r.y = frcp(d.y);
    return (g * u) * r;
}
struct EpiGU {
    bf16_t* ACT; int t0;
    DI void operator()(const Acc& acc, const Unit& u, int wr, int wc, int fr, int fq) const {
        const int row0 = (u.pm - t0) * 256 + wr * 64 + fr, colb = u.pn * 128 + wc * 32 + 8 * fq;
#pragma unroll
        for (int ai = 0; ai < 2; ++ai)
#pragma unroll
            for (int m = 0; m < 4; ++m) { bf16_t* rowp = ACT + (size_t)(row0 + ai * 128 + m * 16) * DFF + colb;
                const f32x4 g0 = acc[ai][0][m][0], g1 = acc[ai][0][m][1], u0 = acc[ai][1][m][0], u1 = acc[ai][1][m][1];
                const f32x2 a = swiglu2d((f32x2){g0[0], g0[1]}, (f32x2){u0[0], u0[1]}), b = swiglu2d((f32x2){g0[2], g0[3]}, (f32x2){u0[2], u0[3]});
                const f32x2 c = swiglu2d((f32x2){g1[0], g1[1]}, (f32x2){u1[0], u1[1]}), d = swiglu2d((f32x2){g1[2], g1[3]}, (f32x2){u1[2], u1[3]});
                u32x4 w; w.x = cvt_pk_bf16(a.x, a.y); w.y = cvt_pk_bf16(b.x, b.y); w.z = cvt_pk_bf16(c.x, c.y); w.w = cvt_pk_bf16(d.x, d.y);
                EPI_ST((u32x4*)rowp, w); }
    }
};
struct EpiPart {
    float* P; int rows, ldc;
    DI void operator()(const Acc& acc, const Unit& u, int wr, int wc, int fr, int fq) const {
        const int te = fq * 16 + fr, row0 = u.pm * 256 + wr * 64 + (te >> 2), colb = u.pn * 256 + wc * 32 + 8 * (te & 3);
        float* base = P + (size_t)u.ks * rows * ldc;
#pragma unroll
        for (int ai = 0; ai < 2; ++ai)
#pragma unroll
            for (int m = 0; m < 4; ++m) { float* rowp = base + (size_t)(row0 + ai * 128 + m * 16) * ldc + colb;
#pragma unroll
                for (int bj = 0; bj < 2; ++bj) { *(u32x4*)(rowp + bj * 128) = tr4(__builtin_bit_cast(u32x4, acc[ai][bj][m][0]), te); *(u32x4*)(rowp + bj * 128 + 4) = tr4(__builtin_bit_cast(u32x4, acc[ai][bj][m][1]), te); } }
    }
};
struct EpiDown {
    bf16_t* F; const int* dstmap; const float* gate;
    DI void operator()(const Acc& acc, const Unit& u, int wr, int wc, int fr, int fq) const {
        const int te = fq * 16 + fr, slot0 = u.slot0 + wr * 64 + fr, slot0s = u.slot0 + wr * 64 + (te >> 2), colb = u.pn * 256 + wc * 32 + 8 * (te & 3);
        int dstv[2][4]; float gtv[2][4];
#pragma unroll
        for (int ai = 0; ai < 2; ++ai)
#pragma unroll
            for (int m = 0; m < 4; ++m) { dstv[ai][m] = dstmap[slot0s + ai * 128 + m * 16]; gtv[ai][m] = gate[slot0 + ai * 128 + m * 16]; }
#pragma unroll
        for (int ai = 0; ai < 2; ++ai)
#pragma unroll
            for (int m = 0; m < 4; ++m) { const int dst = dstv[ai][m]; const float gt = gtv[ai][m];
                bf16_t* rowp = F + (size_t)dst * DM + colb;
#pragma unroll
                for (int bj = 0; bj < 2; ++bj) { const f32x4 v0 = acc[ai][bj][m][0] * gt, v1 = acc[ai][bj][m][1] * gt;
                    u32x4 w; w.x = cvt_pk_bf16(v0[0], v0[1]); w.y = cvt_pk_bf16(v0[2], v0[3]); w.z = cvt_pk_bf16(v1[0], v1[1]); w.w = cvt_pk_bf16(v1[2], v1[3]);
                    const u32x4 wt = tr4(w, te);
                    if (dst >= 0) EPI_ST((u32x4*)(rowp + bj * 128), wt); } }
    }
};

constexpr float S8_Y = 16.0f, S8_W = 256.0f, S8_ACT = 8.0f, S8_F = 16.0f;
DI float clamp8(float v) { return __builtin_amdgcn_fmed3f(v, -448.0f, 448.0f); }
DI unsigned pk_fp8x4(float a, float b, float c, float d) { int w0; asm volatile("" : "=v"(w0));
    int w = __builtin_amdgcn_cvt_pk_fp8_f32(clamp8(a), clamp8(b), w0, false); w = __builtin_amdgcn_cvt_pk_fp8_f32(clamp8(c), clamp8(d), w, true); return (unsigned)w; }
struct EpiGU8 {
    unsigned char* ACT; int t0;
    DI void operator()(const Acc& acc, const Unit& u, int wr, int wc, int fr, int fq) const {
        constexpr float us = 1.0f / (S8_Y * S8_W), c1 = -us * LOG2E, c0 = 21.0f, k0 = 2097152.0f;
        static_assert(us * us * S8_ACT * k0 == 1.0f, "k0 = 1 / c2, c0 = log2 k0");
        const int te = fq * 16 + fr, rho = te >> 1, hf = te & 1, srcl = (((2 * hf + (rho >> 4)) << 4) | (rho & 15)) << 2;
        unsigned char* base = ACT + (size_t)((u.pm - t0) * 256 + wr * 64 + rho) * DFF + u.pn * 128 + wc * 32 + 16 * hf;
#pragma unroll
        for (int ai = 0; ai < 2; ++ai)
#pragma unroll
            for (int mp = 0; mp < 4; mp += 2) { u32x2 w[2];
#pragma unroll
                for (int k = 0; k < 2; ++k) { const int m = mp + k;
                    const f32x4 g0 = acc[ai][0][m][0], g1 = acc[ai][0][m][1], u0 = acc[ai][1][m][0], u1 = acc[ai][1][m][1];
                    const f32x2 a = swiglu2((f32x2){g0[0], g0[1]}, (f32x2){u0[0], u0[1]}, c1, c0, k0), b = swiglu2((f32x2){g0[2], g0[3]}, (f32x2){u0[2], u0[3]}, c1, c0, k0);
                    const f32x2 c = swiglu2((f32x2){g1[0], g1[1]}, (f32x2){u1[0], u1[1]}, c1, c0, k0), d = swiglu2((f32x2){g1[2], g1[3]}, (f32x2){u1[2], u1[3]}, c1, c0, k0);
                    w[k].x = pk_fp8x4(a.x, a.y, b.x, b.y); w[k].y = pk_fp8x4(c.x, c.y, d.x, d.y); }
                const auto rx = __builtin_amdgcn_permlane16_swap(w[0].x, w[1].x, false, false), ry = __builtin_amdgcn_permlane16_swap(w[0].y, w[1].y, false, false);
                u32x4 o; o.x = (unsigned)__builtin_amdgcn_ds_bpermute(srcl, (int)rx[0]); o.y = (unsigned)__builtin_amdgcn_ds_bpermute(srcl, (int)ry[0]); o.z = (unsigned)__builtin_amdgcn_ds_bpermute(srcl, (int)rx[1]); o.w = (unsigned)__builtin_amdgcn_ds_bpermute(srcl, (int)ry[1]);
                EPI_ST((u32x4*)(base + (size_t)(ai * 128 + mp * 16) * DFF), o); }
    }
};
struct EpiGUm {
    bf16_t* ACT; int t0;
    DI void operator()(const Acc& acc, const Unit& u, int wr, int wc, int fr, int fq) const {
        const int te = fq * 16 + fr, row0 = (u.pm - t0) * 256 + wr * 64 + (te >> 2), colb = u.pn * 128 + wc * 32 + 8 * (te & 3);
        constexpr float us = 1.0f / (S8_Y * S8_W), c1 = -us * LOG2E, c0 = 24.0f, k0 = 16777216.0f;
        static_assert(us * us * k0 == 1.0f, "k0 = 1 / us^2, c0 = log2 k0");
#pragma unroll
        for (int ai = 0; ai < 2; ++ai)
#pragma unroll
            for (int m = 0; m < 4; ++m) { bf16_t* rowp = ACT + (size_t)(row0 + ai * 128 + m * 16) * DFF + colb;
                const f32x4 g0 = acc[ai][0][m][0], g1 = acc[ai][0][m][1], u0 = acc[ai][1][m][0], u1 = acc[ai][1][m][1];
                const f32x2 a = swiglu2((f32x2){g0[0], g0[1]}, (f32x2){u0[0], u0[1]}, c1, c0, k0), b = swiglu2((f32x2){g0[2], g0[3]}, (f32x2){u0[2], u0[3]}, c1, c0, k0);
                const f32x2 c = swiglu2((f32x2){g1[0], g1[1]}, (f32x2){u1[0], u1[1]}, c1, c0, k0), d = swiglu2((f32x2){g1[2], g1[3]}, (f32x2){u1[2], u1[3]}, c1, c0, k0);
                u32x4 w; w.x = cvt_pk_bf16(a.x, a.y); w.y = cvt_pk_bf16(b.x, b.y); w.z = cvt_pk_bf16(c.x, c.y); w.w = cvt_pk_bf16(d.x, d.y);
                EPI_ST((u32x4*)rowp, tr4(w, te)); }
    }
};
struct EpiDown8 {
    bf16_t* F; const int* dstmap; const float* gate;
    DI void operator()(const Acc& acc, const Unit& u, int wr, int wc, int fr, int fq) const {
        static_assert(!FP8_DDN, "the dense layer's norm_end reads bf16 F rows");
        const int te = fq * 16 + fr, slot0 = u.slot0 + wr * 64 + fr, slot0s = u.slot0 + wr * 64 + (te >> 2), colb = u.pn * 256 + wc * 32 + 8 * (te & 3);
        constexpr float us = S8_F / (S8_ACT * S8_W);
        const int trs = (((te & 3) << 4) | (te >> 2)) << 2;
        int dstv[2][4]; float gtv[2][4];
#pragma unroll
        for (int ai = 0; ai < 2; ++ai)
#pragma unroll
            for (int m = 0; m < 4; ++m) { dstv[ai][m] = dstmap[slot0s + ai * 128 + m * 16]; gtv[ai][m] = gate[slot0 + ai * 128 + m * 16] * us; }
#pragma unroll
        for (int ai = 0; ai < 2; ++ai)
#pragma unroll
            for (int m = 0; m < 4; ++m) { const int dst = dstv[ai][m]; const float gt = gtv[ai][m];
                unsigned char* rowp = (unsigned char*)F + (size_t)dst * DM + colb;
#pragma unroll
                for (int bj = 0; bj < 2; ++bj) { const f32x4 v0 = acc[ai][bj][m][0] * gt, v1 = acc[ai][bj][m][1] * gt;
                    u32x2 w; w.x = (unsigned)__builtin_amdgcn_ds_bpermute(trs, (int)pk_fp8x4(v0[0], v0[1], v0[2], v0[3])); w.y = (unsigned)__builtin_amdgcn_ds_bpermute(trs, (int)pk_fp8x4(v1[0], v1[1], v1[2], v1[3]));
                    if (dst >= 0) *(u32x2*)(rowp + bj * 128) = w; } }
    }
};
}

struct Args { const float* in[25]; float* out; unsigned char* ws; int ph_lo, ph_hi; };
enum { I_X = 0, I_C, I_CTX, I_CCTX, I_WADA, I_BADA, I_GMPRE, I_GMPOST, I_GFPRE, I_GFPOST, I_WIN, I_WS, I_BS, I_GV, I_WF, I_SINK, I_WOUT, I_WGD, I_WUD, I_WDD, I_WR, I_BR, I_WGE, I_WUE, I_WDE };

struct TJob { const float* src; bf16* dst; int K, Nsrc, ncol0, drow0, kb, f8; float sc; };
constexpr int TJ_IN_A = 256, TJ_IN_B = 384, TJ_OUT = 512, TJ_D = 896, TJ_E = 7168;
constexpr int TJ_TOTAL = TJ_IN_A + TJ_IN_B + TJ_OUT + 3 * TJ_D + 3 * TJ_E;
constexpr int TJ_NOW = TJ_IN_A + TJ_IN_B + TJ_OUT + 3 * TJ_D;
constexpr int TJ_DEF = TJ_TOTAL - TJ_NOW, TJ_BATCH = 16;
static_assert(TJ_DEF % TJ_BATCH == 0, "deferred queue is dealt in whole batches");
DI TJob tj_decode(const Args& a, bf16* WB, int it) {
    TJob J; J.f8 = 0; J.sc = 1.0f;
    if (it < TJ_IN_A) { const int L = it / 128, r = it % 128; J.kb = r / 8; const int nb = r % 8;
        J.src = a.in[I_WIN] + (size_t)L * 1024 * 1536; J.K = 1024; J.Nsrc = 1536; J.ncol0 = 64 * nb; J.dst = WB + W_IN / 2 + (size_t)L * NZ * 1024; J.drow0 = 64 * nb; return J; }
    it -= TJ_IN_A;
    if (it < TJ_IN_B) { const int L = it / 192, r = it % 192; J.kb = r / 12; const int nb = r % 12;
        J.src = a.in[I_WIN] + (size_t)L * 1024 * 1536; J.K = 1024; J.Nsrc = 1536; J.ncol0 = 768 + 64 * nb; J.dst = WB + W_IN / 2 + (size_t)L * NZ * 1024; J.drow0 = 1024 + 64 * nb; return J; }
    it -= TJ_IN_B;
    if (it < TJ_OUT) { const int L = it / 256, r = it % 256; J.kb = r / 16; const int nb = r % 16;
        J.src = a.in[I_WOUT] + (size_t)L * 1024 * 1024; J.K = 1024; J.Nsrc = 1024; J.ncol0 = 64 * nb; J.dst = WB + W_OUT / 2 + (size_t)L * 1024 * 1024; J.drow0 = 64 * nb; return J; }
    it -= TJ_OUT;
    if (it < 2 * TJ_D) { const int up = it / TJ_D, r = it % TJ_D; J.kb = r / 56; const int nb = r % 56, f0 = 64 * nb;
        J.src = a.in[up ? I_WUD : I_WGD]; J.K = 1024; J.Nsrc = DFF; J.ncol0 = f0; J.dst = WB + W_GUD / 2; J.drow0 = (f0 / 128) * 256 + (f0 % 128) + 128 * up; J.sc = FP8_DGU ? pg8::S8_W : (up ? 1.0f : LOG2E); J.f8 = FP8_DGU; return J; }
    it -= 2 * TJ_D;
    if (it < TJ_D) { J.kb = it / 16; const int nb = it % 16;
        J.src = a.in[I_WDD]; J.K = DFF; J.Nsrc = 1024; J.ncol0 = 64 * nb; J.dst = WB + W_DD / 2; J.drow0 = 64 * nb; if (FP8_DDN) { J.f8 = 1; J.sc = pg8::S8_W; } return J; }
    it -= TJ_D;
    if (it < 2 * TJ_E) { const int up = it / TJ_E, r0 = it % TJ_E, e = r0 / TJ_D, r = r0 % TJ_D; J.kb = r / 56; const int nb = r % 56, f0 = 64 * nb;
        J.src = a.in[up ? I_WUE : I_WGE] + (size_t)e * 1024 * DFF; J.K = 1024; J.Nsrc = DFF; J.ncol0 = f0; J.dst = (bf16*)((unsigned char*)WB + W_GUE + (size_t)e * 7168 * 1024); J.drow0 = (f0 / 128) * 256 + (f0 % 128) + 128 * up; J.f8 = 1; J.sc = pg8::S8_W; return J; }
    it -= 2 * TJ_E;
    { const int e = it / TJ_D, r = it % TJ_D; J.kb = r / 16; const int nb = r % 16;
        J.src = a.in[I_WDE] + (size_t)e * DFF * 1024; J.K = DFF; J.Nsrc = 1024; J.ncol0 = 64 * nb; J.dst = (bf16*)((unsigned char*)WB + W_DE + (size_t)e * 1024 * DFF); J.drow0 = 64 * nb; J.f8 = 1; J.sc = pg8::S8_W; return J; }
}
DI void tj_load(const TJob& J, int lane, f32x4 (&v)[16]) {
    const float* p = J.src + (size_t)(64 * J.kb + (lane >> 4)) * J.Nsrc + J.ncol0 + 4 * (lane & 15);
#pragma unroll
    for (int i = 0; i < 16; ++i) v[i] = *(const f32x4*)(p + (size_t)(4 * i) * J.Nsrc);
}
DI void tj_store(const TJob& J, LAS float* scr, int lane, const f32x4 (&v)[16]) {
#pragma unroll
    for (int i = 0; i < 16; ++i) { const int k = 4 * i + (lane >> 4); *(LAS f32x4*)(scr + k * 64 + ((4 * (lane & 15)) ^ (4 * ((k >> 3) & 7)))) = v[i]; }
    LDS_WAIT();
    const int c = lane & 7, k0 = 64 * J.kb;
#pragma unroll
    for (int j = 0; j < 8; ++j) { const int n = (lane >> 3) + 8 * j; const LAS float* s = scr + (8 * c) * 64 + (((n & ~3) ^ (4 * c)) + (n & 3));
        const float x0 = s[0 * 64], x1 = s[1 * 64], x2 = s[2 * 64], x3 = s[3 * 64], x4 = s[4 * 64], x5 = s[5 * 64], x6 = s[6 * 64], x7 = s[7 * 64];
        const float sw = J.sc;
        if (J.f8) { u32x2 o; o.x = pg8::pk_fp8x4(x0 * sw, x1 * sw, x2 * sw, x3 * sw); o.y = pg8::pk_fp8x4(x4 * sw, x5 * sw, x6 * sw, x7 * sw);
            *(u32x2*)((unsigned char*)J.dst + (size_t)(J.drow0 + n) * J.K + k0 + 8 * c) = o; }
        else { u32x4 o; o.x = cvt_pk_bf16(x0 * sw, x1 * sw); o.y = cvt_pk_bf16(x2 * sw, x3 * sw); o.z = cvt_pk_bf16(x4 * sw, x5 * sw); o.w = cvt_pk_bf16(x6 * sw, x7 * sw);
            *(u32x4*)(J.dst + (size_t)(J.drow0 + n) * J.K + k0 + 8 * c) = o; } }
    LDS_WAIT();
}

DI void prologue_a(const Args& a, unsigned char* ws, LAS unsigned char* lds, int tid, int wave, int lane) {
    const int G = gridDim.x, bx = blockIdx.x;
    {
        const int gw = bx * NWAVES + wave, NGW = G * NWAVES;
        float* mp = (float*)(ws + WS_MOD);
        for (int it = gw; it < 2 * 96 * 8; it += NGW) {
            const int ks = it & 7, jg = (it >> 3) % 96, L = it / 768, j0 = 64 * jg;
            float sil[5][2];
#pragma unroll
            for (int s = 0; s < 5; ++s)
#pragma unroll
                for (int hf = 0; hf < 2; ++hf) { const int k = 128 * ks + 64 * hf + lane; sil[s][hf] = silu_f(s < 4 ? a.in[I_C][s * 1024 + k] : a.in[I_CCTX][k]); }
            float acc[5] = {0.f, 0.f, 0.f, 0.f, 0.f};
            const float* wp = a.in[I_WADA] + (size_t)L * 1024 * 6144 + (size_t)(128 * ks) * 6144 + j0 + lane;
#pragma unroll
            for (int hf = 0; hf < 2; ++hf)
#pragma unroll 16
                for (int kk = 0; kk < 64; ++kk) { const float w = wp[(size_t)(64 * hf + kk) * 6144];
#pragma unroll
                    for (int s = 0; s < 5; ++s) acc[s] += __builtin_bit_cast(float, __builtin_amdgcn_readlane(__builtin_bit_cast(int, sil[s][hf]), kk)) * w; }
#pragma unroll
            for (int s = 0; s < 5; ++s) mp[((size_t)(L * 8 + ks) * 5 + s) * 6144 + j0 + lane] = acc[s];
        }
    }
    for (int it = bx; it < 256; it += G) {
        const int L = it >> 7, g = (it >> 5) & 3, kblk = it & 31;
        LAS float* Mt = (LAS float*)lds; LAS float* Wl = (LAS float*)(lds + 32768);
        __syncthreads();
        const float* wf = a.in[I_WF] + (size_t)(L * 4 + g) * 4096;
        LAS float* trg = (LAS float*)(lds + 49152); LAS float* wfl = (LAS float*)(lds + 49152 + 512);
        if (tid < 128) { const float fr = (float)(tid & 63) * (1.0f / 64.0f); trg[tid] = tid < 64 ? __builtin_amdgcn_cosf(fr) : __builtin_amdgcn_sinf(fr); }
        { float t8[8];
#pragma unroll
          for (int k = 0; k < 8; ++k) t8[k] = wf[tid + k * NTHR];
#pragma unroll
          for (int k = 0; k < 8; ++k) wfl[tid + k * NTHR] = t8[k]; }
        const float* wi = a.in[I_WIN] + (size_t)L * 1024 * 1536;
        { float t4[4];
#pragma unroll
          for (int k = 0; k < 4; ++k) { const int idx = tid + k * NTHR, kl = idx >> 6, d = idx & 63; t4[k] = wi[(size_t)(32 * kblk + kl) * 1536 + 512 + 64 * g + d]; }
#pragma unroll
          for (int k = 0; k < 4; ++k) { const int idx = tid + k * NTHR, kl = idx >> 6, d = idx & 63; Wl[kl * 65 + d] = t4[k]; } }
        __syncthreads();
        { const int rg = tid >> 4, cg = tid & 15, pq = rg >> 4, d0 = 4 * (rg & 15);
          f32x4 acc4[4];
#pragma unroll
          for (int i = 0; i < 4; ++i) acc4[i] = (f32x4){0.f, 0.f, 0.f, 0.f};
#pragma unroll 4
          for (int e = 0; e < 64; ++e) { const f32x4 w4 = *(const LAS f32x4*)(wfl + e * 64 + 4 * cg);
#pragma unroll
              for (int i = 0; i < 4; ++i) { const float tv = trg[64 * pq + (((d0 + i) * e) & 63)]; acc4[i] = acc4[i] + w4 * tv; } }
#pragma unroll
          for (int i = 0; i < 4; ++i) *(LAS f32x4*)(Mt + (pq * 64 + d0 + i) * 64 + 4 * cg) = acc4[i]; }
        __syncthreads();
        { const int klp = tid & 15, cgrp = tid >> 4, pq = cgrp >> 4, e20 = 4 * (cgrp & 15);
          bf16* WIN = (bf16*)(ws + WS_W + W_IN) + (size_t)L * NZ * 1024;
          f32x4 s0 = (f32x4){0.f, 0.f, 0.f, 0.f}, s1 = (f32x4){0.f, 0.f, 0.f, 0.f};
#pragma unroll 8
          for (int d = 0; d < 64; ++d) { const f32x4 m4 = *(const LAS f32x4*)(Mt + (pq * 64 + d) * 64 + e20); const float w0 = Wl[(2 * klp) * 65 + d], w1 = Wl[(2 * klp + 1) * 65 + d];
              s0 = s0 + m4 * w0; s1 = s1 + m4 * w1; }
#pragma unroll
          for (int i = 0; i < 4; ++i) *(unsigned*)(WIN + (size_t)(512 + 256 * pq + 64 * g + e20 + i) * 1024 + 32 * kblk + 2 * klp) = cvt_pk_bf16(s0[i], s1[i]); }
    }
    __syncthreads();
    {
        const int gt = bx * NTHR + tid, GT = G * NTHR;
        bf16* G1 = (bf16*)(ws + WS_TAB + T_G1); bf16* G3 = (bf16*)(ws + WS_TAB + T_G3); bf16* GC = (bf16*)(ws + WS_TAB + T_GC); bf16* WSB = (bf16*)(ws + WS_TAB + T_WS);
        float* RC = (float*)(ws + WS_TAB + T_ROPE); float* RS = RC + 2048;
        for (int idx = gt; idx < 128 * 128; idx += GT) { const int m = idx >> 7, kk = idx & 127; const int w = m >> 4, x = m & 15, k1 = 8 * w + 2 * (x >> 2) + ((x & 3) >> 1), ri = x & 1, pq = kk >> 6, n1 = kk & 63;
            const float fr = (float)((k1 * n1) & 63) * (1.0f / 64.0f), c = __builtin_amdgcn_cosf(fr), s = __builtin_amdgcn_sinf(fr);
            G1[idx] = f2bf(ri == 0 ? (pq == 0 ? c : -s) : (pq == 0 ? s : c)); }
        for (int idx = gt; idx < 128 * 256; idx += GT) { const int k2 = idx >> 8, kk = idx & 255, ri = kk >> 7, n2 = kk & 127; const float fr = (float)((k2 * n2) & 127) * (1.0f / 128.0f);
            G3[idx] = f2bf(ri == 0 ? __builtin_amdgcn_cosf(fr) : __builtin_amdgcn_sinf(fr)); }
        for (int idx = gt; idx < 256 * 512; idx += GT) { const int k = idx >> 9, kk = idx & 511, pq = kk >> 8, n = kk & 255; const float fr = (float)((k * n) & 255) * (1.0f / 256.0f);
            GC[idx] = f2bf(pq == 0 ? __builtin_amdgcn_cosf(fr) : -__builtin_amdgcn_sinf(fr)); }
        for (int idx = gt; idx < 2 * 4 * 128 * 128; idx += GT) WSB[idx] = f2bf(a.in[I_WS][idx]);
        { int* t0 = (int*)(ws + WS_RT + RT_TOK); int* d0 = (int*)(ws + WS_RT + RT_DST); float* g0 = (float*)(ws + WS_RT + RT_GATE);
          for (int idx = gt; idx < MALL; idx += GT) { t0[idx] = idx; d0[idx] = idx; g0[idx] = 1.0f; }
          int* t1 = (int*)(ws + WS_RT1 + RT1_TOK); int* d1 = (int*)(ws + WS_RT1 + RT1_DST); float* g1 = (float*)(ws + WS_RT1 + RT1_GATE);
          for (int idx = gt; idx < NE * CAP; idx += GT) { t1[idx] = 0; d1[idx] = -1; g1[idx] = 0.f; } }
        for (int idx = gt; idx < 2048; idx += GT) { const int pos = idx >> 4, f = idx & 15; const float inv = powf(10000.0f, -(float)f / 16.0f); const float ang = (float)pos * inv; RC[idx] = cosf(ang); RS[idx] = sinf(ang); }
    }
    {
        LAS float* scr = (LAS float*)(lds + wave * 16384);
        bf16* WB = (bf16*)(ws + WS_W);
        const int gw = bx * NWAVES + wave, NGW = G * NWAVES;
        f32x4 va[16], vb[16]; TJob Ja, Jb;
        int ia = gw;
        if (ia < TJ_NOW) { Ja = tj_decode(a, WB, ia); tj_load(Ja, lane, va); }
        for (;;) {
            if (ia >= TJ_NOW) break;
            const int ib = ia + NGW;
            if (ib < TJ_NOW) { Jb = tj_decode(a, WB, ib); tj_load(Jb, lane, vb); }
            tj_store(Ja, scr, lane, va);
            if (ib >= TJ_NOW) break;
            ia = ib + NGW;
            if (ia < TJ_NOW) { Ja = tj_decode(a, WB, ia); tj_load(Ja, lane, va); }
            tj_store(Jb, scr, lane, vb);
        }
    }
}

DI void cvt_filler(const Args& a, unsigned char* ws, LAS unsigned char* lds, int tid, int wave, int lane, int* done, int need) {
    LAS int* sh = (LAS int*)(lds + LDSCTL_OFF + LC_FILL);
    int* cur = (int*)(ws + WS_CTL) + CW_CVT;
    LAS float* scr = (LAS float*)(lds + wave * 16384);
    bf16* WB = (bf16*)(ws + WS_W);
    __syncthreads();
    for (int it = 0;; ++it) {
        if (tid == 0) { int b = -1;
            const bool stop = done && __hip_atomic_load(done, __ATOMIC_RELAXED, __HIP_MEMORY_SCOPE_AGENT) >= need;
            if (!stop) { b = __hip_atomic_fetch_add(cur, done ? TJ_BATCH / 2 : TJ_BATCH, __ATOMIC_RELAXED, __HIP_MEMORY_SCOPE_AGENT); if (b >= TJ_DEF) b = -1; }
            sh[it & 1] = b; }
        __syncthreads();
        const int b = __builtin_amdgcn_readfirstlane(sh[it & 1]);
        if (b < 0) break;
        f32x4 va[16], vb[16];
        const int ia = b + (done ? wave : 2 * wave), ib = done ? TJ_DEF : ia + 1;
        if (ia < TJ_DEF) { const TJob Ja = tj_decode(a, WB, TJ_NOW + ia); tj_load(Ja, lane, va);
            if (ib < TJ_DEF) { const TJob Jb = tj_decode(a, WB, TJ_NOW + ib); tj_load(Jb, lane, vb); tj_store(Ja, scr, lane, va); tj_store(Jb, scr, lane, vb); }
            else tj_store(Ja, scr, lane, va); }
    }
    __syncthreads();
}

DI void ld_row_f32(const float* row, int lane, f32x4 (&v)[4]) { const f32x4* p = (const f32x4*)row + lane;
#pragma unroll
    for (int j = 0; j < 4; ++j) v[j] = p[64 * j]; }
DI void st_row_f32(float* row, int lane, const f32x4 (&v)[4]) { f32x4* p = (f32x4*)row + lane;
#pragma unroll
    for (int j = 0; j < 4; ++j) p[64 * j] = v[j]; }
DI void ld_row_bf16(const bf16* row, int lane, f32x4 (&v)[4]) { const u32x2* p = (const u32x2*)row + lane;
#pragma unroll
    for (int j = 0; j < 4; ++j) { const u32x2 w = p[64 * j]; v[j] = (f32x4){bflo(w.x), bfhi(w.x), bflo(w.y), bfhi(w.y)}; } }
DI void st_row_bf16(bf16* row, int lane, const f32x4 (&v)[4]) { u32x2* p = (u32x2*)row + lane;
#pragma unroll
    for (int j = 0; j < 4; ++j) { u32x2 w; w.x = cvt_pk_bf16(v[j][0], v[j][1]); w.y = cvt_pk_bf16(v[j][2], v[j][3]); p[64 * j] = w; } }
DI float row_rstd(const f32x4 (&v)[4], int lane) { float s = 0.f;
#pragma unroll
    for (int j = 0; j < 4; ++j) s += (v[j][0] * v[j][0] + v[j][1] * v[j][1]) + (v[j][2] * v[j][2] + v[j][3] * v[j][3]);
    return 1.0f / sqrtf(wave_sum(s, lane) * (1.0f / 1024.0f) + EPS); }
DI void modulate_row(const f32x4 (&h)[4], float rstd, const float* g, const float* sh, const float* sc, int lane, f32x4 (&y)[4]) {
#pragma unroll
    for (int j = 0; j < 4; ++j) { const f32x4 gv = ((const f32x4*)g + lane)[64 * j], shv = ((const f32x4*)sh + lane)[64 * j], scv = ((const f32x4*)sc + lane)[64 * j];
        y[j] = h[j] * rstd * gv * (1.0f + scv) + shv; } }
DI int mod_set(int r) { return r < MLAT ? (r >> 13) : 4; }

DI void ldraw_f32(const float* row, int lane, f32x4 (&v)[4]) { const f32x4* p = (const f32x4*)row + lane;
#pragma unroll
    for (int j = 0; j < 4; ++j) v[j] = p[64 * j]; }
DI void ldraw_bf16(const bf16* row, int lane, u32x2 (&v)[4]) { const u32x2* p = (const u32x2*)row + lane;
#pragma unroll
    for (int j = 0; j < 4; ++j) v[j] = p[64 * j]; }
DI void unpack_bf16(const u32x2 (&w)[4], f32x4 (&v)[4]) {
#pragma unroll
    for (int j = 0; j < 4; ++j) v[j] = (f32x4){bflo(w[j].x), bfhi(w[j].x), bflo(w[j].y), bfhi(w[j].y)}; }
DI void ldvec(const float* p, int lane, f32x4 (&v)[4]) { ldraw_f32(p, lane, v); }
DI void ldmod(const Args& a, const unsigned char* ws, int L, int s, int j, int lane, f32x4 (&v)[4]) {
    ldraw_f32(a.in[I_BADA] + L * 6144 + j * 1024, lane, v);
#pragma unroll 1
    for (int ks = 0; ks < 8; ++ks) { f32x4 t[4]; ldraw_f32((const float*)(ws + WS_MOD) + ((size_t)(L * 8 + ks) * 5 + s) * 6144 + j * 1024, lane, t);
#pragma unroll
        for (int q = 0; q < 4; ++q) v[q] = v[q] + t[q]; }
}

DI void norm0_phase(const Args& a, unsigned char* ws, int wave, int lane) {
    constexpr int RPW = MALL / 256; const int bx = blockIdx.x;
    bf16* Y = (bf16*)(ws + WS_Y);
    if (bx >= 256) return;
    f32x4 g[4], sh[4], sc[4], hn[4]; int cs = -1;
    ldvec(a.in[I_GMPRE], lane, g);
    { const int r = bx * RPW + wave; ldraw_f32(r < MLAT ? a.in[I_X] + (size_t)r * DM : a.in[I_CTX] + (size_t)(r - MLAT) * DM, lane, hn); }
    for (int rr = wave; rr < RPW; rr += NWAVES) {
        const int r = bx * RPW + rr, s = mod_set(r);
        f32x4 h[4], y[4];
#pragma unroll
        for (int j = 0; j < 4; ++j) h[j] = hn[j];
        if (rr + NWAVES < RPW) { const int rn = r + NWAVES; ldraw_f32(rn < MLAT ? a.in[I_X] + (size_t)rn * DM : a.in[I_CTX] + (size_t)(rn - MLAT) * DM, lane, hn); }
        if (s != cs) { ldmod(a, ws, 0, s, 0, lane, sh); ldmod(a, ws, 0, s, 1, lane, sc); cs = s; }
        const float rs = row_rstd(h, lane);
#pragma unroll
        for (int j = 0; j < 4; ++j) y[j] = h[j] * rs * g[j] * (1.0f + sc[j]) + sh[j];
        st_row_bf16(Y + (size_t)r * DM, lane, y);
    }
}

DI void norm_mid_phase(const Args& a, unsigned char* ws, LAS unsigned char* lds, int L, int tid, int wave, int lane) {
    const int M = L == 0 ? MALL : MLAT, RPW = M / 256, bx = blockIdx.x;
    const bool moe = (L == 1);
    LAS int* cnt = (LAS int*)(lds + LDSCTL_OFF + LC_CNT);
    __syncthreads();
    if (tid < 8) cnt[tid] = 0;
    LAS float* wrl = (LAS float*)(lds + 4096);
    if (moe) { f32x4 w4[2048 / NTHR];
#pragma unroll
        for (int k = 0; k < 2048 / NTHR; ++k) w4[k] = ((const f32x4*)a.in[I_WR])[tid + k * NTHR];
#pragma unroll
        for (int k = 0; k < 2048 / NTHR; ++k) { const int i = tid + k * NTHR, c = i >> 1, e0 = 4 * (i & 1);
#pragma unroll
            for (int q = 0; q < 4; ++q) wrl[(e0 + q) * 1024 + c] = w4[k][q]; } }
    __syncthreads();
    const bf16* O = (const bf16*)(ws + WS_R + R_O); bf16* Y = (bf16*)(ws + WS_Y);
    bf16* hctx1 = (bf16*)(ws + WS_HCTX); const bf16* h2lat = (const bf16*)a.out + (size_t)MLAT * DM; bf16* h3 = (bf16*)(ws + WS_H3);
    LAS int* rec = (LAS int*)lds;
    if (bx < 256) {
        f32x4 gpost[4], gpre[4], gtm[4], shf[4], scf[4]; u32x4 hr[4], hr2[4]; u32x2 hb[4], hb2[4]; u32x2 on[4], on2[4]; int cs = -1;
        ldvec(a.in[I_GMPOST] + L * DM, lane, gpost); ldvec(a.in[I_GFPRE] + L * DM, lane, gpre);
#define NM_LOAD(rq_, o_, h_, hb_) do { const int rq = (rq_); ldraw_bf16(O + (size_t)rq * DM, lane, o_); \
            if (L == 0) { const u32x4* p_ = (const u32x4*)(rq < MLAT ? a.in[I_X] + (size_t)rq * DM : a.in[I_CTX] + (size_t)(rq - MLAT) * DM) + lane; _Pragma("unroll") for (int j = 0; j < 4; ++j) h_[j] = p_[64 * j]; } \
            else ldraw_bf16(h2lat + (size_t)rq * DM, lane, hb_); } while (0)
#define NM_ROW(rr_) ((L == 0 && SPLITK) ? ((rr_) < 4 ? MLAT + 4 * bx + (rr_) : 128 * bx + ((rr_) - 4)) : bx * RPW + (rr_))
        NM_LOAD(NM_ROW(wave), on, hr, hb);
        if (wave + NWAVES < RPW) NM_LOAD(NM_ROW(wave + NWAVES), on2, hr2, hb2);
        for (int rr = wave; rr < RPW; rr += NWAVES) {
            const int r = NM_ROW(rr), s = mod_set(r);
            bf16* hout = L == 0 ? (r < MLAT ? (bf16*)a.out + (size_t)r * DM : hctx1 + (size_t)(r - MLAT) * DM) : h3 + (size_t)r * DM;
            f32x4 o[4], h[4], y[4]; unpack_bf16(on, o);
#pragma unroll
            for (int j = 0; j < 4; ++j) h[j] = L == 0 ? __builtin_bit_cast(f32x4, hr[j]) : (f32x4){bflo(hb[j].x), bfhi(hb[j].x), bflo(hb[j].y), bfhi(hb[j].y)};
#pragma unroll
            for (int j = 0; j < 4; ++j) { on[j] = on2[j]; hr[j] = hr2[j]; hb[j] = hb2[j]; }
            if (rr + 2 * NWAVES < RPW) NM_LOAD(NM_ROW(rr + 2 * NWAVES), on2, hr2, hb2);
            if (SPLITK && L == 0 && r >= MLAT) {
#pragma unroll
                for (int j = 0; j < 4; ++j) o[j] = (f32x4){0.f, 0.f, 0.f, 0.f};
#pragma unroll 2
                for (int ks = 0; ks < 4; ++ks) { f32x4 t4[4]; ldraw_f32((const float*)(ws + WS_R + R_T) + ((size_t)ks * MCTX + (r - MLAT)) * DM, lane, t4);
#pragma unroll
                    for (int j = 0; j < 4; ++j) o[j] = o[j] + t4[j]; }
            }
            if (s != cs) { ldmod(a, ws, L, s, 2, lane, gtm); ldmod(a, ws, L, s, 3, lane, shf); ldmod(a, ws, L, s, 4, lane, scf); cs = s; }
            const float ro = row_rstd(o, lane);
#pragma unroll
            for (int j = 0; j < 4; ++j) h[j] = h[j] + gtm[j] * (o[j] * ro * gpost[j]);
            st_row_bf16(hout, lane, h);
            const float rh = row_rstd(h, lane);
#pragma unroll
            for (int j = 0; j < 4; ++j) y[j] = h[j] * rh * gpre[j] * (1.0f + scf[j]) + shf[j];
            if (moe || FP8_DGU) { unsigned* y8 = (unsigned*)((unsigned char*)Y + (size_t)r * DM) + lane;
#pragma unroll
                for (int j = 0; j < 4; ++j) y8[64 * j] = pg8::pk_fp8x4(y[j][0] * pg8::S8_Y, y[j][1] * pg8::S8_Y, y[j][2] * pg8::S8_Y, y[j][3] * pg8::S8_Y); }
            else st_row_bf16(Y + (size_t)r * DM, lane, y);
            if (moe) {
                float lg[8];
#pragma unroll
                for (int e = 0; e < 8; ++e) { float acc = 0.f;
#pragma unroll
                    for (int j = 0; j < 4; ++j) { const f32x4 w4 = *(const LAS f32x4*)(wrl + e * 1024 + 4 * lane + 256 * j); acc += (y[j][0] * w4[0] + y[j][1] * w4[1]) + (y[j][2] * w4[2] + y[j][3] * w4[3]); }
                    lg[e] = acc; }
#pragma unroll
                for (int e = 0; e < 8; ++e) lg[e] = wave_sum(lg[e], lane) + a.in[I_BR][e];
                int i0 = 0; float v0 = lg[0];
#pragma unroll
                for (int e = 1; e < 8; ++e) if (lg[e] > v0) { v0 = lg[e]; i0 = e; }
                int i1 = -1; float v1 = -3.0e38f;
#pragma unroll
                for (int e = 0; e < 8; ++e) if (e != i0 && lg[e] > v1) { v1 = lg[e]; i1 = e; }
                const float g0 = 1.0f / (1.0f + expf(v1 - v0)), g1 = 1.0f - g0;
                if (lane == 0) { const int p0 = __hip_atomic_fetch_add(&cnt[i0], 1, __ATOMIC_RELAXED, __HIP_MEMORY_SCOPE_WORKGROUP), p1 = __hip_atomic_fetch_add(&cnt[i1], 1, __ATOMIC_RELAXED, __HIP_MEMORY_SCOPE_WORKGROUP);
                    rec[rr * 4 + 0] = (i0 << 16) | p0; rec[rr * 4 + 1] = __float_as_int(g0); rec[rr * 4 + 2] = (i1 << 16) | p1; rec[rr * 4 + 3] = __float_as_int(g1); }
            }
        }
    }
    if (moe) {
        __syncthreads();
        if (bx < 256 && tid < 8) cnt[8 + tid] = __hip_atomic_fetch_add((int*)(ws + WS_CTL) + CW_GCNT + tid, cnt[tid], __ATOMIC_RELAXED, __HIP_MEMORY_SCOPE_AGENT);
        __syncthreads();
        if (bx < 256 && tid < 2 * RPW) { const int rr = tid >> 1, k = tid & 1, r = bx * RPW + rr; const int info = rec[rr * 4 + 2 * k], e = info >> 16, slot = e * CAP + cnt[8 + e] + (info & 0xffff);
            ((int*)(ws + WS_RT1 + RT1_TOK))[slot] = r; ((int*)(ws + WS_RT1 + RT1_DST))[slot] = k * MALL + r; ((int*)(ws + WS_RT1 + RT1_GATE))[slot] = rec[rr * 4 + 2 * k + 1]; }
    }
}

#undef NM_LOAD
#undef NM_ROW
DI void norm_end_phase(const Args& a, unsigned char* ws, int L, int wave, int lane) {
    const int M = L == 0 ? MALL : MLAT, RPW = M / 256, bx = blockIdx.x; const bool moe = (L == 1);
    const bf16* F = (const bf16*)(ws + WS_R + R_F); bf16* Y = (bf16*)(ws + WS_Y);
    const bf16* hctx1 = (const bf16*)(ws + WS_HCTX); bf16* hctx2 = (bf16*)(ws + WS_HCTX) + (size_t)MCTX * DM; bf16* h2lat = (bf16*)a.out + (size_t)MLAT * DM; const bf16* h3 = (const bf16*)(ws + WS_H3);
    if (bx >= 256) return;
    f32x4 gpost[4], gnx[4], gtf[4], shn[4], scn[4]; u32x2 f0n[4], hbn[4]; unsigned q0[4], q1[4], q02[4], q12[4]; int cs = -1;
    ldvec(a.in[I_GFPOST] + L * DM, lane, gpost); ldvec(a.in[I_GMPRE] + DM, lane, gnx);
#define NE_HIN(r_) (L == 0 ? ((r_) < MLAT ? (const bf16*)a.out + (size_t)(r_) * DM : hctx1 + (size_t)((r_) - MLAT) * DM) : h3 + (size_t)(r_) * DM)
#define NE_ROW(rr_) (L == 0 ? ((rr_) < 4 ? MLAT + 4 * bx + (rr_) : 128 * bx + ((rr_) - 4)) : bx * RPW + (rr_))
    u32x2 f0n2[4], hbn2[4];
#define NE_LOAD(rq_, f0_, q0_, q1_, hb_) do { const int rq = (rq_); \
        if (moe) { const unsigned* p0_ = (const unsigned*)((const unsigned char*)F + (size_t)rq * DM) + lane; const unsigned* p1_ = (const unsigned*)((const unsigned char*)F + (size_t)(MALL + rq) * DM) + lane; \
            _Pragma("unroll") for (int j = 0; j < 4; ++j) { q0_[j] = p0_[64 * j]; q1_[j] = p1_[64 * j]; } } \
        else ldraw_bf16(F + (size_t)rq * DM, lane, f0_); \
        ldraw_bf16(NE_HIN(rq), lane, hb_); } while (0)
    NE_LOAD(NE_ROW(wave), f0n, q0, q1, hbn);
    if (wave + NWAVES < RPW) NE_LOAD(NE_ROW(wave + NWAVES), f0n2, q02, q12, hbn2);
    for (int rr = wave; rr < RPW; rr += NWAVES) {
        const int r = NE_ROW(rr), s = mod_set(r);
        f32x4 f[4], h[4]; unpack_bf16(hbn, h);
        if (moe) {
#pragma unroll
            for (int j = 0; j < 4; ++j) { const int a0 = (int)q0[j], a1 = (int)q1[j];
                f[j] = (f32x4){__builtin_amdgcn_cvt_f32_fp8(a0, 0) + __builtin_amdgcn_cvt_f32_fp8(a1, 0), __builtin_amdgcn_cvt_f32_fp8(a0, 1) + __builtin_amdgcn_cvt_f32_fp8(a1, 1),
                               __builtin_amdgcn_cvt_f32_fp8(a0, 2) + __builtin_amdgcn_cvt_f32_fp8(a1, 2), __builtin_amdgcn_cvt_f32_fp8(a0, 3) + __builtin_amdgcn_cvt_f32_fp8(a1, 3)} * (1.0f / pg8::S8_F); }
        } else unpack_bf16(f0n, f);
#pragma unroll
        for (int j = 0; j < 4; ++j) { f0n[j] = f0n2[j]; q0[j] = q02[j]; q1[j] = q12[j]; hbn[j] = hbn2[j]; }
        if (rr + 2 * NWAVES < RPW) NE_LOAD(NE_ROW(rr + 2 * NWAVES), f0n2, q02, q12, hbn2);
        if (SPLITK && L == 0 && r >= MLAT) {
#pragma unroll
            for (int j = 0; j < 4; ++j) f[j] = (f32x4){0.f, 0.f, 0.f, 0.f};
#pragma unroll 2
            for (int ks = 0; ks < (FP8_DDN ? 7 : 14); ++ks) { f32x4 t[4]; ldraw_f32((const float*)(ws + WS_R + (FP8_DDN ? R_PART : R_PART0)) + ((size_t)ks * MCTX + (r - MLAT)) * DM, lane, t);
#pragma unroll
                for (int j = 0; j < 4; ++j) f[j] = f[j] + t[j]; }
            if (FP8_DDN) {
#pragma unroll
                for (int j = 0; j < 4; ++j) f[j] = f[j] * (1.0f / (pg8::S8_ACT * pg8::S8_W)); }
        }
        if (s != cs) { ldmod(a, ws, L, s, 5, lane, gtf); if (L == 0) { ldmod(a, ws, 1, s, 0, lane, shn); ldmod(a, ws, 1, s, 1, lane, scn); } cs = s; }
        const float rf = row_rstd(f, lane);
#pragma unroll
        for (int j = 0; j < 4; ++j) h[j] = h[j] + gtf[j] * (f[j] * rf * gpost[j]);
        if (L == 0) st_row_bf16(r < MLAT ? h2lat + (size_t)r * DM : hctx2 + (size_t)(r - MLAT) * DM, lane, h);
        else st_row_f32(a.out + (size_t)r * DM, lane, h);
        if (L == 0) { f32x4 y[4]; const float rh = row_rstd(h, lane);
#pragma unroll
            for (int j = 0; j < 4; ++j) y[j] = h[j] * rh * gnx[j] * (1.0f + scn[j]) + shn[j];
            st_row_bf16(Y + (size_t)r * DM, lane, y); }
    }
#undef NE_HIN
#undef NE_ROW
#undef NE_LOAD
}

constexpr int AT_KS = 0, AT_VT = 9216, AT_BUF = 19456;
DI void attn_unit(LAS unsigned char* lds, const bf16* Z, bf16* OC, const float* sinkL, int u, int tid, int wave, int lane) {
    int b, blk, kh; bool isctx;
    if (u < 512) { kh = u & 1; blk = (u >> 1) & 63; b = u >> 7; isctx = false; } else { const int j = u - 512; kh = j & 1; blk = (j >> 1) & 1; b = j >> 2; isctx = true; }
    const int qrowbase = isctx ? (MLAT + b * NCTX + 128 * blk) : (b * NLAT + 128 * blk);
    const int hq = 4 * kh + (wave & 3), qrow0 = (wave >> 2) * 64, i16 = lane & 15, h4 = lane >> 4;
    bf16x8 Qf[4][2];
#pragma unroll
    for (int qt = 0; qt < 4; ++qt)
#pragma unroll
        for (int ks = 0; ks < 2; ++ks) Qf[qt][ks] = *(const bf16x8*)(Z + (size_t)(qrowbase + qrow0 + 16 * qt + i16) * NZ + ZQ + 64 * hq + 32 * ks + 8 * h4);
    float mrun[4], lrun[4]; f32x4 o[4][4];
    const float sk = sinkL[hq] * LOG2E;
#pragma unroll
    for (int qt = 0; qt < 4; ++qt) { mrun[qt] = sk; lrun[qt] = (h4 == 0) ? 1.f : 0.f;
#pragma unroll
        for (int dt = 0; dt < 4; ++dt) o[dt][qt] = (f32x4){0.f, 0.f, 0.f, 0.f}; }
    const int ntl = isctx ? 0 : 6, ntt = ntl + 4;
#define AT_TILE(t, kr, mt, k0) (((t) < ntl) ? ((kr) = b * NLAT + 128 * (blk - 1 + ((t) >> 1)) + 64 * ((t) & 1), (mt) = ((t) >> 1) == 0 ? 1 : (((t) >> 1) == 2 ? 2 : 0), (k0) = 64 * ((t) & 1), (blk - 1 + ((t) >> 1)) >= 0 && (blk - 1 + ((t) >> 1)) <= 63) \
                                            : ((kr) = MLAT + b * NCTX + 64 * ((t) - ntl), (mt) = 0, (k0) = 0, true))
    const int skey = tid >> 3, sch = tid & 7;
#define AT_LOAD(kr) do { const bf16* src = Z + (size_t)((kr) + skey) * NZ; kvr = *(const u32x4*)(src + ZK + 64 * kh + 8 * sch); vvr = *(const u32x4*)(src + ZVV + 64 * kh + 8 * sch); } while (0)
#define AT_STORE(pb_) do { *(LAS u32x4*)(lds + (pb_) * AT_BUF + AT_KS + skey * 144 + sch * 16) = kvr; *(LAS u32x4*)(lds + (pb_) * AT_BUF + AT_VT + skey * 160 + sch * 16) = vvr; } while (0)
    u32x4 kvr, vvr;
    int tix = 0, krow0 = 0, cmtype = 0, ckb0 = 0, nmtype = 0, nkb0 = 0, pb = 0;
    while (tix < ntt && !AT_TILE(tix, krow0, cmtype, ckb0)) ++tix;
    AT_LOAD(krow0);
    __syncthreads();
    AT_STORE(0);
#pragma unroll
    for (int qt = 0; qt < 4; ++qt)
#pragma unroll
        for (int ks = 0; ks < 2; ++ks) asm volatile("" : "+v"(Qf[qt][ks]));
    ++tix; while (tix < ntt && !AT_TILE(tix, krow0, nmtype, nkb0)) ++tix;
    bool nvalid = tix < ntt;
    if (nvalid) AT_LOAD(krow0);
    __syncthreads();
    for (;;) {
        int n2mtype = 0, n2kb0 = 0; bool n2valid = false;
        if (nvalid) { AT_STORE(pb ^ 1);
            ++tix; while (tix < ntt && !AT_TILE(tix, krow0, n2mtype, n2kb0)) ++tix;
            n2valid = tix < ntt; if (n2valid) AT_LOAD(krow0); }
        const LAS unsigned char* ldt = lds + pb * AT_BUF;
        const bool skipw = (cmtype == 1 && ckb0 < qrow0) || (cmtype == 2 && ckb0 > qrow0);
        if (!skipw) {
        f32x4 sa[4][4];
#pragma unroll
        for (int kt = 0; kt < 4; ++kt)
#pragma unroll
            for (int qt = 0; qt < 4; ++qt) { const float nm = -mrun[qt]; sa[kt][qt] = (f32x4){nm, nm, nm, nm}; }
#pragma unroll
        for (int ks = 0; ks < 2; ++ks)
#pragma unroll
            for (int kt = 0; kt < 4; ++kt) { const bf16x8 ak = *(const LAS bf16x8*)(ldt + AT_KS + (16 * kt + i16) * 144 + (32 * ks + 8 * h4) * 2);
#pragma unroll
                for (int qt = 0; qt < 4; ++qt) sa[kt][qt] = mfma16(ak, Qf[qt][ks], sa[kt][qt]); }
        if (cmtype && ckb0 == qrow0) {
            int ln; asm volatile("v_mbcnt_lo_u32_b32 %0, -1, 0\n\tv_mbcnt_hi_u32_b32 %0, -1, %0" : "=v"(ln));
            const int dl = 4 * (ln >> 4) - (ln & 15);
            if (cmtype == 1) {
#pragma unroll
                for (int kt = 0; kt < 4; ++kt)
#pragma unroll
                    for (int qt = 0; qt < 4; ++qt) {
                        if (kt < qt) sa[kt][qt] = (f32x4){-1.0e30f, -1.0e30f, -1.0e30f, -1.0e30f};
                        else if (kt == qt) {
#pragma unroll
                            for (int r = 0; r < 4; ++r) if (dl + r < 0) sa[kt][qt][r] = -1.0e30f; } }
            } else {
#pragma unroll
                for (int kt = 0; kt < 4; ++kt)
#pragma unroll
                    for (int qt = 0; qt < 4; ++qt) {
                        if (kt > qt) sa[kt][qt] = (f32x4){-1.0e30f, -1.0e30f, -1.0e30f, -1.0e30f};
                        else if (kt == qt) {
#pragma unroll
                            for (int r = 0; r < 4; ++r) if (dl + r > 0) sa[kt][qt][r] = -1.0e30f; } }
            }
        }
#pragma unroll
        for (int qt = 0; qt < 4; ++qt) {
            float mx = vmax3(vmax3(vmax3(sa[0][qt][0], sa[0][qt][1], sa[0][qt][2]), vmax3(sa[0][qt][3], sa[1][qt][0], sa[1][qt][1]), sa[1][qt][2]),
                             vmax3(sa[1][qt][3], sa[2][qt][0], sa[2][qt][1]), vmax3(vmax3(sa[2][qt][2], sa[2][qt][3], sa[3][qt][0]), vmax3(sa[3][qt][1], sa[3][qt][2], sa[3][qt][3]), sa[3][qt][3]));
            if (__builtin_amdgcn_ballot_w64(mx > 6.0f) != 0ull) {
                mx = xrow16_max(mx);
                const float dl = fmaxf(mx, 0.f), alpha = fexp2(-dl); mrun[qt] += dl; lrun[qt] *= alpha;
#pragma unroll
                for (int kt = 0; kt < 4; ++kt) sa[kt][qt] = sa[kt][qt] - dl;
#pragma unroll
                for (int dt = 0; dt < 4; ++dt) o[dt][qt] = o[dt][qt] * alpha;
            }
            f32x2 ps = (f32x2){0.f, 0.f};
#pragma unroll
            for (int kt = 0; kt < 4; ++kt) { f32x4 p; p[0] = fexp2(sa[kt][qt][0]); p[1] = fexp2(sa[kt][qt][1]); p[2] = fexp2(sa[kt][qt][2]); p[3] = fexp2(sa[kt][qt][3]); sa[kt][qt] = p;
                ps = ps + (f32x2){p[0], p[1]} + (f32x2){p[2], p[3]}; }
            lrun[qt] += ps.x + ps.y;
        }
#pragma unroll
        for (int s = 0; s < 2; ++s) {
            bf16x8 pf[4];
#pragma unroll
            for (int qt = 0; qt < 4; ++qt) { u32x4 w; const f32x4 p0 = sa[2 * s][qt], p1 = sa[2 * s + 1][qt];
                w.x = cvt_pk_bf16(p0[0], p0[1]); w.y = cvt_pk_bf16(p0[2], p0[3]); w.z = cvt_pk_bf16(p1[0], p1[1]); w.w = cvt_pk_bf16(p1[2], p1[3]); pf[qt] = __builtin_bit_cast(bf16x8, w); }
#pragma unroll
            for (int dt = 0; dt < 4; ++dt) {
                const LAS unsigned char* vp = ldt + AT_VT + (32 * s + 4 * h4 + (i16 >> 2)) * 160 + (16 * dt + 4 * (i16 & 3)) * 2;
                const v4i16_t lo = __builtin_amdgcn_ds_read_tr16_b64_v4i16((LAS v4i16_t*)vp), hi = __builtin_amdgcn_ds_read_tr16_b64_v4i16((LAS v4i16_t*)(vp + 16 * 160)); const bf16x8 av = __builtin_shufflevector(lo, hi, 0, 1, 2, 3, 4, 5, 6, 7);
#pragma unroll
                for (int qt = 0; qt < 4; ++qt) o[dt][qt] = mfma16(av, pf[qt], o[dt][qt]); }
        }
        }
        if (!nvalid) break;
        __syncthreads();
        pb ^= 1; cmtype = nmtype; ckb0 = nkb0; nvalid = n2valid; nmtype = n2mtype; nkb0 = n2kb0;
    }
#undef AT_LOAD
#undef AT_STORE
    const int trs = (((lane & 3) << 4) | (lane >> 2)) << 2;
#pragma unroll
    for (int qt = 0; qt < 4; ++qt) { const float lt = xrow16_sum(lrun[qt]); const float inv = 1.0f / lt;
        bf16* orow = OC + (size_t)(qrowbase + qrow0 + 16 * qt + (lane >> 2)) * DM + 512 + 64 * hq + 4 * (lane & 3);
#pragma unroll
        for (int dt = 0; dt < 4; ++dt) { const f32x4 v = o[dt][qt] * inv; u32x2 w; w.x = (unsigned)__builtin_amdgcn_ds_bpermute(trs, (int)cvt_pk_bf16(v[0], v[1])); w.y = (unsigned)__builtin_amdgcn_ds_bpermute(trs, (int)cvt_pk_bf16(v[2], v[3])); *(u32x2*)(orow + 16 * dt) = w; } }
#undef AT_TILE
}

DI void sgu_unit(LAS unsigned char* lds, const bf16* Z, bf16* OC, const bf16* wsb, const float* bs, const float* gv, int c, int tid, int wave, int lane) {
    const int rowbase = 128 * c, i16 = lane & 15, h4 = lane >> 4, p = 16 * wave + i16;
    __syncthreads();
    const int pc = tid & 31, sh = pc >> 3;
    u32x4 v[8];
#pragma unroll
    for (int k = 0; k < 8; ++k) v[k] = *(const u32x4*)(Z + (size_t)(rowbase + (tid >> 5) + 16 * k) * NZ + ZV + 8 * pc);
    const f32x4 ga = *(const f32x4*)(gv + 8 * pc), gb = *(const f32x4*)(gv + 8 * pc + 4);
    const int lr = lane >> 2, lp = lane & 3;
    const int mfl = ((i16 << 2) | h4) << 2, trs = ((lp << 4) | lr) << 2;
    u32x4 bwn[4]; u32x2 uun[4]; float bn;
#define SG_LDH(hh_) do { _Pragma("unroll") for (int ks = 0; ks < 4; ++ks) bwn[ks] = *(const u32x4*)(wsb + ((size_t)(hh_) * 128 + 16 * wave + lr) * 128 + 32 * ks + 8 * lp); \
        _Pragma("unroll") for (int ct = 0; ct < 4; ++ct) uun[ct] = *(const u32x2*)(Z + (size_t)(rowbase + 16 * wave + lr) * NZ + ZU + 64 * (hh_) + 16 * ct + 4 * lp); \
        bn = bs[(hh_) * 128 + p]; } while (0)
    SG_LDH(0);
#pragma unroll
    for (int k = 0; k < 8; ++k) { float ss = 0.f;
#pragma unroll
        for (int q2 = 0; q2 < 4; ++q2) { const float x0 = bflo(v[k][q2]), x1 = bfhi(v[k][q2]); ss += x0 * x0 + x1 * x1; }
        ss += dppx<0xB1>(ss); ss += dppx<0x4E>(ss); ss += dppx<0x141>(ss);
        const float rstd = 1.0f / sqrtf(ss * (1.0f / 64.0f) + EPS);
        u32x4 w;
        w.x = cvt_pk_bf16(bflo(v[k].x) * rstd * ga[0], bfhi(v[k].x) * rstd * ga[1]); w.y = cvt_pk_bf16(bflo(v[k].y) * rstd * ga[2], bfhi(v[k].y) * rstd * ga[3]);
        w.z = cvt_pk_bf16(bflo(v[k].z) * rstd * gb[0], bfhi(v[k].z) * rstd * gb[1]); w.w = cvt_pk_bf16(bflo(v[k].w) * rstd * gb[2], bfhi(v[k].w) * rstd * gb[3]);
        *(LAS u32x4*)(lds + ((tid >> 5) + 16 * k) * 544 + pc * 16) = w; }
    __syncthreads();
#pragma unroll
    for (int hh = 0; hh < 4; ++hh) {
        u32x4 bw[4]; u32x2 uu[4]; const float bias = bn;
#pragma unroll
        for (int k = 0; k < 4; ++k) { bw[k] = bwn[k]; uu[k] = uun[k]; }
        if (hh < 3) SG_LDH(hh + 1);
        f32x4 acc[4];
#pragma unroll
        for (int ct = 0; ct < 4; ++ct) acc[ct] = (f32x4){0.f, 0.f, 0.f, 0.f};
#pragma unroll
        for (int ks = 0; ks < 4; ++ks) { u32x4 t;
            t.x = (unsigned)__builtin_amdgcn_ds_bpermute(mfl, (int)bw[ks].x); t.y = (unsigned)__builtin_amdgcn_ds_bpermute(mfl, (int)bw[ks].y); t.z = (unsigned)__builtin_amdgcn_ds_bpermute(mfl, (int)bw[ks].z); t.w = (unsigned)__builtin_amdgcn_ds_bpermute(mfl, (int)bw[ks].w);
            const bf16x8 bwf = __builtin_bit_cast(bf16x8, t);
#pragma unroll
            for (int ct = 0; ct < 4; ++ct) { const bf16x8 av = trfrag(lds + 32 * ks * 544 + (hh * 64 + 16 * ct) * 2, 544, lane); acc[ct] = mfma16(av, bwf, acc[ct]); } }
#pragma unroll
        for (int ct = 0; ct < 4; ++ct) { f32x4 t;
#pragma unroll
            for (int r = 0; r < 4; ++r) t[r] = __builtin_bit_cast(float, __builtin_amdgcn_ds_bpermute(trs, __builtin_bit_cast(int, acc[ct][r] + bias)));
            u32x2 w; w.x = cvt_pk_bf16(bflo(uu[ct].x) * t[0], bfhi(uu[ct].x) * t[1]); w.y = cvt_pk_bf16(bflo(uu[ct].y) * t[2], bfhi(uu[ct].y) * t[3]);
            *(u32x2*)(OC + (size_t)(rowbase + 16 * wave + lr) * DM + 64 * hh + 16 * ct + 4 * lp) = w; }
    }
#undef SG_LDH
}

DI void fft1_unit(LAS unsigned char* lds, const bf16* Z, bf16* T, const bf16* G1, int u, int tid, int wave, int lane) {
    const int n2g = u & 31, g = (u >> 5) & 3, b = u >> 7, i16 = lane & 15, h4 = lane >> 4;
    __syncthreads();
    constexpr int PB = 544;
    { const int ch = tid & 7, n2l = (tid >> 3) & 3, k0 = tid >> 5;
      u32x4 v[8];
#pragma unroll
      for (int it = 0; it < 8; ++it) { const int k = k0 + 16 * it, pq = k >> 6, n1 = k & 63;
          v[it] = *(const u32x4*)(Z + (size_t)(b * NLAT + 128 * n1 + 4 * n2g + n2l) * NZ + ZP + 256 * pq + 64 * g + 8 * ch); }
#pragma unroll
      for (int it = 0; it < 8; ++it) { const int k = k0 + 16 * it;
          *(LAS u32x4*)(lds + k * PB + (n2l * 64 + 8 * ch) * 2) = v[it]; } }
    __syncthreads();
    bf16x8 ga[4];
#pragma unroll
    for (int ks = 0; ks < 4; ++ks) ga[ks] = *(const bf16x8*)(G1 + (16 * wave + i16) * 128 + 32 * ks + 8 * h4);
    const int k1a = 8 * wave + 2 * h4;
#pragma unroll 4
    for (int ct = 0; ct < 16; ++ct) {
        f32x4 acc = (f32x4){0.f, 0.f, 0.f, 0.f};
#pragma unroll
        for (int ks = 0; ks < 4; ++ks) { const bf16x8 bd = trfrag(lds + 32 * ks * PB + 32 * ct, PB, lane); acc = mfma16(ga[ks], bd, acc); }
        const int n2 = 4 * n2g + (ct >> 2), e2 = 16 * (ct & 3) + i16;
#pragma unroll
        for (int hf = 0; hf < 2; ++hf) { const int k1 = k1a + hf; const float ar = acc[2 * hf], mai = acc[2 * hf + 1];
            const float fr = (float)((k1 * n2) & 8191) * (1.0f / 8192.0f), c = __builtin_amdgcn_cosf(fr), s = __builtin_amdgcn_sinf(fr);
            const float apr = ar * c - mai * s, api = -mai * c - ar * s;
            const size_t base = ((((size_t)(b * 4 + g) * 64 + k1) * 2) * 128 + n2) * 64 + e2;
            T[base] = f2bf(apr); T[base + 128 * 64] = f2bf(api); }
    }
}

template <int KD> DI void dft_unit(LAS unsigned char* lds, const bf16* Gt, const bf16* P0, const bf16* P1, int pitch, bf16* outp, int rstride, float scale, int tid, int wave, int lane) {
    constexpr int PB = 160; const int i16 = lane & 15, h4 = lane >> 4;
    __syncthreads();
    { const int ch = tid & 7, r0 = tid >> 3;
      u32x4 v[KD / 64];
#pragma unroll
      for (int it = 0; it < KD / 64; ++it) { const int k = r0 + 64 * it, pl = k / (KD / 2), rr = k % (KD / 2);
          v[it] = *(const u32x4*)((pl ? P1 : P0) + (size_t)rr * pitch + 8 * ch); }
#pragma unroll
      for (int it = 0; it < KD / 64; ++it) { const int k = r0 + 64 * it;
          *(LAS u32x4*)(lds + k * PB + 16 * ch) = v[it]; } }
    __syncthreads();
    f32x4 acc[4];
#pragma unroll
    for (int ct = 0; ct < 4; ++ct) acc[ct] = (f32x4){0.f, 0.f, 0.f, 0.f};
#pragma unroll 4
    for (int ks = 0; ks < KD / 32; ++ks) { const bf16x8 gb = *(const bf16x8*)(Gt + (size_t)(16 * wave + i16) * KD + 32 * ks + 8 * h4);
#pragma unroll
        for (int ct = 0; ct < 4; ++ct) { const bf16x8 ad = trfrag(lds + 32 * ks * PB + 32 * ct, PB, lane); acc[ct] = mfma16(ad, gb, acc[ct]); } }
    bf16* orow = outp + (size_t)rstride * (16 * wave + i16) * DM + 4 * h4;
#pragma unroll
    for (int ct = 0; ct < 4; ++ct) { const f32x4 v = acc[ct] * scale; u32x2 w; w.x = cvt_pk_bf16(v[0], v[1]); w.y = cvt_pk_bf16(v[2], v[3]); *(u32x2*)(orow + 16 * ct) = w; }
}

DI void fft3_phase(LAS unsigned char* lds, const bf16* T, const bf16* G3, bf16* OC, int bx, int G, int tid, int wave, int lane) {
    constexpr int PB = 160, BUF = 256 * PB; const int i16 = lane & 15, h4 = lane >> 4, ch = tid & 7, r0 = tid >> 3;
    int u = bx; if (u >= 1024) return;
    bf16x8 gb[8];
#pragma unroll
    for (int ks = 0; ks < 8; ++ks) gb[ks] = *(const bf16x8*)(G3 + (size_t)(16 * wave + i16) * 256 + 32 * ks + 8 * h4);
    u32x4 v[4];
#define F3_LOAD(uu) do { const bf16* p_ = T + (size_t)(uu) * 2 * 8192 + (size_t)r0 * 64 + 8 * ch; _Pragma("unroll") for (int it = 0; it < 4; ++it) v[it] = *(const u32x4*)(p_ + (size_t)it * 64 * 64); } while (0)
#define F3_STORE(pb_) do { _Pragma("unroll") for (int it = 0; it < 4; ++it) *(LAS u32x4*)(lds + (pb_) * BUF + (r0 + 64 * it) * PB + 16 * ch) = v[it]; } while (0)
    F3_LOAD(u);
    __syncthreads();
    F3_STORE(0);
    int un = u + G; bool nvalid = un < 1024;
    if (nvalid) F3_LOAD(un);
    __syncthreads();
    int pb = 0;
    for (;;) {
        int u2 = un + G; bool n2valid = false;
        if (nvalid) { F3_STORE(pb ^ 1); n2valid = u2 < 1024; if (n2valid) F3_LOAD(u2); }
        const LAS unsigned char* ldt = lds + pb * BUF;
        f32x4 acc[4];
#pragma unroll
        for (int ct = 0; ct < 4; ++ct) acc[ct] = (f32x4){0.f, 0.f, 0.f, 0.f};
#pragma unroll
        for (int ks = 0; ks < 8; ++ks)
#pragma unroll
            for (int ct = 0; ct < 4; ++ct) { const bf16x8 ad = trfrag(ldt + 32 * ks * PB + 32 * ct, PB, lane); acc[ct] = mfma16(ad, gb[ks], acc[ct]); }
        const int k1 = u & 63, g = (u >> 6) & 3, b = u >> 8;
        bf16* orow = OC + (size_t)(b * NLAT + k1 + 64 * (16 * wave + (lane >> 2))) * DM + 256 + 64 * g + 4 * (lane & 3);
        const int trs = (((lane & 3) << 4) | (lane >> 2)) << 2;
#pragma unroll
        for (int ct = 0; ct < 4; ++ct) { const f32x4 w4 = acc[ct] * (1.0f / 724.0773439350247f); u32x2 w; w.x = (unsigned)__builtin_amdgcn_ds_bpermute(trs, (int)cvt_pk_bf16(w4[0], w4[1])); w.y = (unsigned)__builtin_amdgcn_ds_bpermute(trs, (int)cvt_pk_bf16(w4[2], w4[3])); *(u32x2*)(orow + 16 * ct) = w; }
        if (!nvalid) break;
        __syncthreads();
        pb ^= 1; u = un; un = u2; nvalid = n2valid;
    }
#undef F3_LOAD
#undef F3_STORE
}

constexpr int PH_L = 20, PH_END = 2 + 2 * PH_L;
__global__ void __launch_bounds__(NTHR, 2) fwd_kernel(Args args) {
    extern __shared__ __attribute__((aligned(16))) unsigned char lds_raw[];
    LAS unsigned char* const lds0 = (LAS unsigned char*)lds_raw;
    const int tid0 = threadIdx.x; const int wave0 = __builtin_amdgcn_readfirstlane(tid0 >> 6);
    const int G0 = gridDim.x, bx0 = blockIdx.x;
    unsigned char* ws0 = args.ws;
#define PHASE_REGS() int bx = bx0, G = G0; asm volatile("" : "+s"(bx), "+s"(G)); LAS unsigned char* lds = lds0; asm volatile("" : "+s"(lds)); int tid; asm volatile("v_mbcnt_lo_u32_b32 %0, -1, 0\n\tv_mbcnt_hi_u32_b32 %0, -1, %0" : "=v"(tid)); tid += wave0 * 64; GAS unsigned char* wsg_ = (GAS unsigned char*)ws0; asm volatile("" : "+s"(wsg_)); unsigned char* ws = (unsigned char*)wsg_; const int lane = tid & 63, wave = __builtin_amdgcn_readfirstlane(tid >> 6); (void)lane; (void)wave; \
    bf16* Z = (bf16*)(ws + WS_R + R_Z); bf16* OC = (bf16*)(ws + WS_R + R_OC); bf16* TT = (bf16*)(ws + WS_R + R_T); bf16* Y = (bf16*)(ws + WS_Y); (void)Z; (void)OC; (void)TT; (void)Y
    for (int u = tid0; u < (LDS_BYTES - LDSCTL_OFF) / 4; u += NTHR) ((LAS unsigned*)(lds0 + LDSCTL_OFF))[u] = 0u;
    __syncthreads();
#if MK_MULTI
#define GRID_BAR() do { } while (0)
#else
    XcdBarrier bar = xcd_barrier_post((unsigned*)(ws0 + WS_CTL) + CW_BAR, (volatile LAS unsigned*)(lds0 + LDSCTL_OFF + LC_BAR));
#define GRID_BAR() do { XcdBarrier b_ = bar; { GAS unsigned* bp_ = (GAS unsigned*)bar.bar; asm volatile("" : "+s"(bp_)); b_.bar = (unsigned*)bp_; } int l_; asm volatile("v_mbcnt_lo_u32_b32 %0, -1, 0\n\tv_mbcnt_hi_u32_b32 %0, -1, %0" : "=v"(l_)); xcd_barrier(b_, wave0 == 0 && l_ == 0); if (MK_PROBE == 40) xcd_barrier(b_, wave0 == 0 && l_ == 0); } while (0)
#endif
    const int lo = args.ph_lo, hi = args.ph_hi;
#define IN(k) (lo <= (k) && (k) < hi)
#define TAIL_FILL(id, nunits) do { if (FILL) { PHASE_REGS(); const int nu_ = (nunits), last_ = nu_ - ((nu_ + G - 1) / G - 1) * G; int* dn_ = (int*)(ws + WS_CTL) + CW_DONE + 64 * (L * 16 + (id)); \
        if (last_ < G) { if (bx < last_) { if (tid == 0) __hip_atomic_fetch_add(dn_, 1, __ATOMIC_RELAXED, __HIP_MEMORY_SCOPE_AGENT); } else cvt_filler(args, ws, lds, tid, wave, lane, dn_, 1); } } } while (0)
#define SEAM(k) do { if (IN(k) && IN((k) + 1)) GRID_BAR(); } while (0)

    if (EN(0) && IN(0)) { PHASE_REGS(); for (int rep = 0; rep < REP(1); ++rep) prologue_a(args, ws, lds, tid, wave, lane); }
    SEAM(0);
    if (EN(1) && IN(1)) { PHASE_REGS(); for (int rep = 0; rep < REP(2); ++rep) norm0_phase(args, ws, wave, lane); }
    SEAM(1);

#pragma unroll 1
    for (int L = 0; L < 2; ++L) {
        const int pb = 2 + PH_L * L;
        if (EN(2) && IN(pb + 0)) { PHASE_REGS();
            pg8::SchedIn S{G, bx, L == 0 ? 28 : 4, L == 0, (const char*)(ws + WS_W + W_IN) + (size_t)L * NZ * 1024 * 2, 2048};
            { LAS f32x4* rl = (LAS f32x4*)(lds + LDSCTL_OFF + LC_ROPE); const f32x4* src = (const f32x4*)(ws + WS_TAB + T_ROPE); const f32x4 r0_ = src[tid], r1_ = src[tid + NTHR]; rl[tid] = r0_; rl[tid + NTHR] = r1_; __syncthreads(); }
            pg8::EpiZ E{Z, (const LAS float*)(lds + LDSCTL_OFF + LC_ROPE), (const LAS float*)(lds + LDSCTL_OFF + LC_ROPE) + 2048};
            pg8::gemm_phase<pg8::EpiZ, pg8::SchedIn, false, false>(lds, (const unsigned char*)Y, 2048, S, E, tid);
        }
        if (IN(pb + 0)) TAIL_FILL(0, 896 + (L == 0 ? 28 : 4));
        SEAM(pb + 0);
        if (IN(pb + 1)) {
            const int nattn = L == 0 ? 528 : 512, nsgu = L == 0 ? 264 : 256;
            if (EN(3)) { PHASE_REGS(); for (int rep = 0; rep < REP(3); ++rep) { for (int u = bx; u < 512; u += G) attn_unit(lds, Z, OC, args.in[I_SINK] + L * 8, u, tid, wave, lane);
                { PHASE_REGS(); for (int u = 512 + ((bx + 16) % G); u < nattn; u += G) attn_unit(lds, Z, OC, args.in[I_SINK] + L * 8, u, tid, wave, lane); } } }
            if (EN(4)) { PHASE_REGS(); for (int rep = 0; rep < REP(4); ++rep) { for (int u = bx; u < 256; u += G) sgu_unit(lds, Z, OC, (const bf16*)(ws + WS_TAB + T_WS) + (size_t)L * 4 * 128 * 128, args.in[I_BS] + L * 512, args.in[I_GV] + L * 256, u, tid, wave, lane);
                for (int u = 256 + ((bx + 32) % G); u < nsgu; u += G) sgu_unit(lds, Z, OC, (const bf16*)(ws + WS_TAB + T_WS) + (size_t)L * 4 * 128 * 128, args.in[I_BS] + L * 512, args.in[I_GV] + L * 256, u, tid, wave, lane); } }
            if (EN(5)) { PHASE_REGS(); for (int rep = 0; rep < REP(5); ++rep) for (int u = bx; u < 512; u += G) fft1_unit(lds, Z, TT, (const bf16*)(ws + WS_TAB + T_G1), u, tid, wave, lane); }
            if (L == 0) { PHASE_REGS(); for (int u = (bx + 96) % G; u < 32; u += G) {     const int mh = u & 1, g = (u >> 1) & 3, b = u >> 3; const bf16* zr = Z + (size_t)(MLAT + b * NCTX) * NZ;
                dft_unit<512>(lds, (const bf16*)(ws + WS_TAB + T_GC) + (size_t)128 * mh * 512, zr + ZP + 64 * g, zr + ZQI + 64 * g, NZ, OC + (size_t)(MLAT + b * NCTX + 128 * mh) * DM + 256 + 64 * g, 1, 1.0f / 128.0f, tid, wave, lane); } }
            __syncthreads();
            if (FILL && L == 0 && G0 == 256) { PHASE_REGS();
                const bool extra = bx >= 240 || (bx >= 224 && bx < 232) || (bx >= 160 && bx < 192);
                int* dn_ = (int*)(ws + WS_CTL) + CW_DONE + 64 * 15;
                if (extra) { if (tid == 0) __hip_atomic_fetch_add(dn_, 1, __ATOMIC_RELAXED, __HIP_MEMORY_SCOPE_AGENT); } else cvt_filler(args, ws, lds, tid, wave, lane, dn_, 1); }
        }
        SEAM(pb + 1);
        if (EN(6) && IN(pb + 2)) { PHASE_REGS();
            for (int rep = 0; rep < REP(6); ++rep) fft3_phase(lds, TT, (const bf16*)(ws + WS_TAB + T_G3), OC, bx, G, tid, wave, lane);
            __syncthreads();
        }
        SEAM(pb + 2);
        if (EN(7) && IN(pb + 3)) { PHASE_REGS();
            pg8::SchedPlain S{G, bx, (L == 0 && !SPLITK) ? 132 : 128, 4, (const char*)(ws + WS_W + W_OUT) + (size_t)L * 1024 * 1024 * 2, 2048};
            pg8::EpiO E{(bf16*)(ws + WS_R + R_O), DM};
            pg8::gemm_phase<pg8::EpiO, pg8::SchedPlain, false, false>(lds, (const unsigned char*)OC, 2048, S, E, tid);
        }
        if (EN(7) && IN(pb + 3) && L == 0 && SPLITK) { PHASE_REGS();
            pg8::SchedSplit S{G, bx, 4, 4, 4, 4, (const char*)(ws + WS_W + W_OUT), 2048};
            pg8::EpiPart E{(float*)(ws + WS_R + R_T), MCTX, DM};
            pg8::gemm_phase<pg8::EpiPart, pg8::SchedSplit, false, false>(lds, (const unsigned char*)(OC + (size_t)MLAT * DM), 2048, S, E, tid, 4);
        }
        if (IN(pb + 3)) TAIL_FILL(3, (L == 0 && SPLITK) ? 512 + 64 : (L == 0 ? 132 : 128) * 4);
        SEAM(pb + 3);
        if (EN(8) && IN(pb + 4)) { PHASE_REGS(); for (int rep = 0; rep < (L == 0 ? REP(7) : 1); ++rep) norm_mid_phase(args, ws, lds, L, tid, wave, lane); }
        if (IN(pb + 4) && L == 1) { PHASE_REGS(); cvt_filler(args, ws, lds, tid, wave, lane, nullptr, 0); }
        SEAM(pb + 4);
#pragma unroll 1
        for (int c = 0; c < 5; ++c) {
            const bool any = IN(pb + 6 + 2 * c) || IN(pb + 7 + 2 * c);
            int ntiles = 0;
            PHASE_REGS();
            if (any) {
                LAS int* tlw = (LAS int*)(lds + LDSCTL_OFF + LC_TILE);
                int pre[9]; pre[0] = 0;
#pragma unroll
                for (int e = 0; e < 8; ++e) { const int ce = L == 0 ? (e == 0 ? MALL : 0) : __builtin_amdgcn_readfirstlane(__hip_atomic_load((int*)(ws + WS_CTL) + CW_GCNT + e, RLX_AGENT)); pre[e + 1] = pre[e] + ((ce + 255) >> 8); }
                ntiles = pre[8];
                __syncthreads();
                for (int t = tid; t < ntiles && t < 512; t += NTHR) { int e = 0;
#pragma unroll
                    for (int q = 1; q < 8; ++q) if (pre[q] <= t) e = q;
                    int pe = 0;
#pragma unroll
                    for (int q = 0; q < 8; ++q) if (q == e) pe = pre[q];
                    tlw[t] = (e << 24) | ((L == 0 ? 0 : e * CAP) + 256 * (t - pe)); }
                __syncthreads(); }
            const int CT = L == 0 ? CHUNK_TILES : 128;
            const int t0 = c * CT; int nM = ntiles - t0;
            if (L == 0 && SPLITK && !FP8_DDN) { if (c == 0) nM = nM > CT ? CT : nM; else if (c > 1) nM = 0; }
            else if (L == 1 && !MK_MULTI) { if (c == 0) nM = nM > CT ? CT : nM; else if (c > 1) nM = 0; }
            else nM = nM > CT ? CT : nM;
            unsigned char* const actb = (L == 0 && SPLITK && !FP8_DDN) ? ws + WS_R - ACT0_BACK : (L == 1 && !MK_MULTI) ? ws + WS_R - ACT1_BACK : ws + WS_R + R_ACT;
            if (!MK_MULTI && nM <= 0) break;
            const LAS int* tl = (const LAS int*)(lds + LDSCTL_OFF + LC_TILE);
            const int* tokmap = L == 0 ? (const int*)(ws + WS_RT + RT_TOK) : (const int*)(ws + WS_RT1 + RT1_TOK);
            const int* dstmap = L == 0 ? (const int*)(ws + WS_RT + RT_DST) : (const int*)(ws + WS_RT1 + RT1_DST);
            const float* gatemap = L == 0 ? (const float*)(ws + WS_RT + RT_GATE) : (const float*)(ws + WS_RT1 + RT1_GATE);
            if (EN(10) && IN(pb + 6 + 2 * c) && nM > 0) {
                if (L == 0 && FP8_DGU && !FP8_DDN) { PHASE_REGS();
                    pg8::SchedGrp S{G, bx, t0, nM, 28, (const char*)(ws + WS_W + W_GUD), (size_t)0, 1024, tl, tokmap, true, MK_PROBE == 21};
                    pg8::EpiGUm E{(bf16*)actb, t0};
                    pg8::gemm_phase<pg8::EpiGUm, pg8::SchedGrp, true, true>(lds, (const unsigned char*)Y, 1024, S, E, tid);
                    TAIL_FILL(4 + 2 * c, nM * 28);
                } else if (L == 0 && !FP8_DGU) { PHASE_REGS();
                    pg8::SchedGrp S{G, bx, t0, nM, 28, (const char*)(ws + WS_W + W_GUD), (size_t)0, 2048, tl, tokmap, true, MK_PROBE == 21};
                    pg8::EpiGU E{(bf16*)(ws + WS_R + R_ACT), t0};
                    pg8::gemm_phase<pg8::EpiGU, pg8::SchedGrp, true, false>(lds, (const unsigned char*)Y, 2048, S, E, tid);
                    TAIL_FILL(4 + 2 * c, nM * 28);
                } else { PHASE_REGS();
                    pg8::SchedGrp S{G, bx, t0, nM, 28, (const char*)(ws + WS_W + (L == 0 ? W_GUD : W_GUE)), L == 0 ? (size_t)0 : (size_t)7168 * 1024, 1024, tl, tokmap, true, MK_PROBE == 23};
                    pg8::EpiGU8 E{(unsigned char*)actb, t0};
                    pg8::gemm_phase<pg8::EpiGU8, pg8::SchedGrp, true, true>(lds, (const unsigned char*)Y, 1024, S, E, tid);
                }
            }
            SEAM(pb + 6 + 2 * c);
            if (EN(11) && IN(pb + 7 + 2 * c) && nM > 0) {
                if (L == 0 && SPLITK && c == 2 && FP8_DDN) { PHASE_REGS();
                    pg8::SchedSplit S{G, bx, nM, 4, 7, 4, (const char*)(ws + WS_W + W_DD), DFF};
                    pg8::EpiPart E{(float*)(ws + WS_R + R_PART), nM * 256, DM};
                    pg8::gemm_phase<pg8::EpiPart, pg8::SchedSplit, false, true>(lds, (const unsigned char*)(ws + WS_R + R_ACT), DFF, S, E, tid, 4);
                } else if (L == 0 && !FP8_DDN) {
                    const int ng = (SPLITK && nM > CHUNK_TILES) ? CHUNK_TILES : nM;
                    { PHASE_REGS();
                      pg8::SchedGrp S{G, bx, t0, ng, 4, (const char*)(ws + WS_W + W_DD), (size_t)0, 2 * DFF, tl, tokmap, false, MK_PROBE == 22};
                      pg8::EpiDown E{(bf16*)(ws + WS_R + R_F), dstmap, gatemap};
                      pg8::gemm_phase<pg8::EpiDown, pg8::SchedGrp, false, false>(lds, (const unsigned char*)actb, 2 * DFF, S, E, tid); }
                    if (nM > ng) { PHASE_REGS();
                      pg8::SchedSplit S{G, bx, nM - ng, 4, 14, 4, (const char*)(ws + WS_W + W_DD), 2 * DFF};
                      pg8::EpiPart E{(float*)(ws + WS_R + R_PART0), (nM - ng) * 256, DM};
                      pg8::gemm_phase<pg8::EpiPart, pg8::SchedSplit, false, false>(lds, (const unsigned char*)actb + (size_t)ng * 256 * 2 * DFF, 2 * DFF, S, E, tid, 4); }
                } else { PHASE_REGS();
                    pg8::SchedGrp S{G, bx, t0, nM, 4, (const char*)(ws + WS_W + (L == 0 ? W_DD : W_DE)), L == 0 ? (size_t)0 : (size_t)1024 * DFF, DFF, tl, tokmap, false, MK_PROBE == 24};
                    pg8::EpiDown8 E{(bf16*)(ws + WS_R + R_F), dstmap, gatemap};
                    pg8::gemm_phase<pg8::EpiDown8, pg8::SchedGrp, false, true>(lds, (const unsigned char*)actb, DFF, S, E, tid);
                }
            }
            SEAM(pb + 7 + 2 * c);
        }
        if (EN(12) && IN(pb + 16)) { PHASE_REGS(); norm_end_phase(args, ws, L, wave, lane); }
        if (L == 0) SEAM(pb + 16);
    }
#undef IN
#undef SEAM
}

extern "C" void kernel_launch(void* const* d_in, const int* in_sizes, int n_in, void* d_out, int out_size, void* d_ws, size_t ws_size, hipStream_t stream) {
    static int grid = 0;
    if (grid == 0) {
        if (n_in != 25 || out_size != MLAT * DM || ws_size < WS_END) { fprintf(stderr, "kernel_launch: unexpected shapes (n_in %d out %d ws %zu, need %zu)\n", n_in, out_size, ws_size, (size_t)WS_END); grid = -1; return; }
        int dev = 0, cus = 0, per_cu = 0;
        if (hipGetDevice(&dev) != hipSuccess || hipDeviceGetAttribute(&cus, hipDeviceAttributeMultiprocessorCount, dev) != hipSuccess) { grid = -1; return; }
        if (hipFuncSetAttribute((const void*)fwd_kernel, hipFuncAttributeMaxDynamicSharedMemorySize, LDS_BYTES) != hipSuccess) { fprintf(stderr, "kernel_launch: hipFuncSetAttribute failed\n"); grid = -1; return; }
        if (hipOccupancyMaxActiveBlocksPerMultiprocessor(&per_cu, (const void*)fwd_kernel, NTHR, LDS_BYTES) != hipSuccess || per_cu < 1) fprintf(stderr, "kernel_launch: occupancy query says %d\n", per_cu);
        (void)hipGetLastError();
        grid = cus > 256 ? 256 : cus;
    }
    if (grid < 0) return;
    (void)hipMemsetAsync((char*)d_ws + WS_CTL, 0, CTL_ZERO_BYTES, stream);
    Args a{};
    for (int i = 0; i < 25; ++i) a.in[i] = (const float*)d_in[i];
    a.out = (float*)d_out; a.ws = (unsigned char*)d_ws;
#if MK_MULTI
    for (int p = 0; p < PH_END; ++p) {
        const int k = p < 2 ? -1 : (p - 2) % PH_L;
        if (k > 16 || k == 5) continue;
        a.ph_lo = p; a.ph_hi = p + 1;
        hipLaunchKernelGGL(fwd_kernel, dim3(grid), dim3(NTHR), LDS_BYTES, stream, a);
    }
#else
    a.ph_lo = 0; a.ph_hi = PH_END;
    hipLaunchKernelGGL(fwd_kernel, dim3(grid), dim3(NTHR), LDS_BYTES, stream, a);
#endif
}
```

```cpp
#include <hip/hip_runtime.h>
#include <cstdio>
#include <cstdint>

#ifndef MK_MULTI
#define MK_MULTI 0
#endif
#define SPLITK (!MK_MULTI)
#ifndef MK_EN
#define MK_EN 0xFFFF
#endif
#define EN(b) (((MK_EN) >> (b)) & 1)
#ifndef MK_PROBE
#define MK_PROBE 0
#endif
#define KDUP_IN (MK_PROBE == 20)
#define KDUP_GRP (MK_PROBE >= 21 && MK_PROBE <= 24)
#define REP(k) ((MK_PROBE == (k)) ? 2 : 1)
#ifndef FILL
#define FILL 1
#endif

#define GAS __attribute__((address_space(1)))
#define LAS __attribute__((address_space(3)))
typedef unsigned short bf16;
typedef short bf16x8 __attribute__((ext_vector_type(8)));
typedef float f32x4 __attribute__((ext_vector_type(4)));
typedef float f32x2 __attribute__((ext_vector_type(2)));
typedef unsigned u32x4 __attribute__((ext_vector_type(4)));
typedef unsigned u32x2 __attribute__((ext_vector_type(2)));
typedef int i32x8 __attribute__((ext_vector_type(8)));
typedef GAS unsigned gu32;
#define RLX_AGENT __ATOMIC_RELAXED, __HIP_MEMORY_SCOPE_AGENT
#define LDS_WAIT() asm volatile("s_waitcnt lgkmcnt(0)" ::: "memory")
#define VM_WAIT() asm volatile("s_waitcnt vmcnt(0)" ::: "memory")
#define DI __device__ __forceinline__

constexpr int NB = 4, NLAT = 8192, NCTX = 256, DM = 1024;
constexpr int MLAT = NB * NLAT, MCTX = NB * NCTX, MALL = MLAT + MCTX;
constexpr int NZ = 1792;
constexpr int ZU = 0, ZV = 256, ZP = 512, ZQI = 768, ZQ = 1024, ZK = 1536, ZVV = 1664;
constexpr int DFF = 3584, NE = 8;
constexpr float EPS = 1e-6f, LOG2E = 1.4426950408889634f, QSCALE = 0.125f * 1.4426950408889634f;
constexpr int NWAVES = 8, NTHR = 512;
#ifndef FP8_DGU
#define FP8_DGU 1
#endif
#ifndef FP8_DDN
#define FP8_DDN 0
#endif
constexpr int CHUNK_TILES = 64;

constexpr size_t MiB = 1u << 20;
constexpr size_t WS_CTL = 0, CTL_ZERO_BYTES = 1 * MiB;
constexpr size_t WS_MOD = 6 * MiB;
constexpr size_t WS_TAB = 2 * MiB;
constexpr size_t T_G1 = 0, T_G3 = 32768, T_GC = 98304, T_WS = 360448, T_ROPE = 622592;
constexpr size_t WS_RT = 3 * MiB;
constexpr size_t RT_TOK = 0, RT_DST = 327680, RT_GATE = 655360, RT_TILE = 983040, RT_WGCNT = 985088, RT_ROW = 1 * MiB;
constexpr size_t WS_W = 8 * MiB;
constexpr size_t W_IN = 0, W_OUT = 7 * MiB, W_GUD = 11 * MiB, W_DD = 25 * MiB, W_GUE = 32 * MiB, W_DE = 88 * MiB;
constexpr size_t WS_H3 = 8 * MiB + 120 * MiB;
constexpr size_t WS_HCTX = 208 * MiB;
constexpr size_t WS_Y = 212 * MiB;
constexpr size_t WS_R = 278 * MiB;
constexpr size_t R_Z = 0, R_O = 0, R_OC = 116 * MiB, R_T = 182 * MiB, R_ACT = 0, R_F = 116 * MiB;
constexpr size_t ACT0_BACK = 8 * MiB;
constexpr size_t ACT1_BACK = 16 * MiB;
constexpr size_t R_PART0 = 182 * MiB;
constexpr size_t R_PART = 8 * MiB;
static_assert((size_t)MCTX * DFF * 2 <= 8 * MiB && R_PART + (size_t)14 * MCTX * DM * 4 <= 116 * MiB, "partials fit the activation region");
constexpr size_t WS_RT1 = 278 * MiB + 248 * MiB;
constexpr int CAP = 32768;
constexpr size_t RT1_TOK = 0, RT1_DST = 1 * MiB, RT1_GATE = 2 * MiB;
constexpr size_t WS_END = WS_RT1 + 3 * MiB;
static_assert((size_t)MALL * NZ * 2 <= 116 * MiB && (size_t)(CHUNK_TILES * 256) * DFF * 2 <= 116 * MiB && (size_t)(132 * 256) * DFF <= 116 * MiB && (size_t)2 * MALL * DM * 2 <= 132 * MiB, "ws map");
constexpr int CW_TMO = 0, CW_NTILES = 16, CW_CVT = 32, CW_GCNT = 48, CW_DONE = 64, CW_BAR = 4096;

constexpr int RING_BYTES = 131072, LDSCTL_OFF = RING_BYTES, LDS_BYTES = 163840;
constexpr int LC_ROPE = 16384;
constexpr int LC_BAR = 0;
constexpr int LC_TILE = 64;
constexpr int LC_CNT = 64 + 2048;
constexpr int LC_FILL = 64 + 2048 + 128;

DI unsigned cvt_pk_bf16(float lo, float hi) { unsigned r; asm volatile("v_cvt_pk_bf16_f32 %0, %1, %2" : "=v"(r) : "v"(lo), "v"(hi)); return r; }
DI unsigned short f2bf(float f) { return (unsigned short)(cvt_pk_bf16(f, 0.f) & 0xffffu); }
DI float bflo(unsigned w) { return __uint_as_float(w << 16); }
DI float bfhi(unsigned w) { return __uint_as_float(w & 0xffff0000u); }
DI float shx(float v, int mask, int lane) { return __builtin_bit_cast(float, __builtin_amdgcn_ds_bpermute((lane ^ mask) << 2, __builtin_bit_cast(int, v))); }
template <int CTRL> DI float dppx(float x) { return __builtin_bit_cast(float, __builtin_amdgcn_mov_dpp(__builtin_bit_cast(int, x), CTRL, 0xf, 0xf, true)); }
DI float xrow16_sum(float x) {
    auto s = __builtin_amdgcn_permlane16_swap(__float_as_uint(x), __float_as_uint(x), false, false);
    x = __uint_as_float(s[0]) + __uint_as_float(s[1]);
    auto t = __builtin_amdgcn_permlane32_swap(__float_as_uint(x), __float_as_uint(x), false, false);
    return __uint_as_float(t[0]) + __uint_as_float(t[1]);
}
DI float xrow16_max(float x) {
    auto s = __builtin_amdgcn_permlane16_swap(__float_as_uint(x), __float_as_uint(x), false, false);
    x = fmaxf(__uint_as_float(s[0]), __uint_as_float(s[1]));
    auto t = __builtin_amdgcn_permlane32_swap(__float_as_uint(x), __float_as_uint(x), false, false);
    return fmaxf(__uint_as_float(t[0]), __uint_as_float(t[1]));
}
DI float wave_sum(float v, int) {
    v += dppx<0xB1>(v);
    v += dppx<0x4E>(v);
    v += dppx<0x141>(v);
    v += dppx<0x128>(v);
    return xrow16_sum(v);
}
DI float fexp2(float x) { return __builtin_amdgcn_exp2f(x); }
DI float vmax3(float a, float b, float c) { float r; asm("v_max3_f32 %0, %1, %2, %3" : "=v"(r) : "v"(a), "v"(b), "v"(c)); return r; }
DI float frcp(float x) { return __builtin_amdgcn_rcpf(x); }
DI float gelu_tanh(float x) { const float u = 0.7978845608028654f * (x + 0.044715f * x * x * x); return x * frcp(1.0f + fexp2(-2.0f * LOG2E * u)); }
DI float silu_f(float x) { return x * frcp(1.0f + fexp2(-LOG2E * x)); }
DI f32x4 mfma16(bf16x8 a, bf16x8 b, f32x4 c) { return __builtin_amdgcn_mfma_f32_16x16x32_bf16(a, b, c, 0, 0, 0); }
typedef short v4i16_t __attribute__((ext_vector_type(4)));
DI bf16x8 trfrag(const LAS unsigned char* p, int pitch, int lane) {
    const LAS unsigned char* q = p + (8 * (lane >> 4) + ((lane & 15) >> 2)) * pitch + 8 * (lane & 3);
    const v4i16_t lo = __builtin_amdgcn_ds_read_tr16_b64_v4i16((LAS v4i16_t*)q), hi = __builtin_amdgcn_ds_read_tr16_b64_v4i16((LAS v4i16_t*)(q + 4 * pitch));
    return __builtin_shufflevector(lo, hi, 0, 1, 2, 3, 4, 5, 6, 7);
}

#define XB_TMO      128
#define XB_XCNT(j)  (256  + 64 * (j))
#define XB_XSUB(j)  (1280 + 64 * (j))
#define XB_XGEN(j)  (2304 + 64 * (j))
#define XB_TOP      3328
#define XB_TOPGEN   3392
#define XCD_BAR_WORDS 3456
#define XB_SPIN_CAP (1u << 18)
DI unsigned xb_ld(unsigned* p)              { return __hip_atomic_load(p, __ATOMIC_RELAXED, __HIP_MEMORY_SCOPE_AGENT); }
DI unsigned xb_add(unsigned* p, unsigned v) { return __hip_atomic_fetch_add(p, v, __ATOMIC_RELAXED, __HIP_MEMORY_SCOPE_AGENT); }
DI unsigned xb_xcc_id() { return (unsigned)__builtin_amdgcn_s_getreg((3 << 11) | 20) & 0xFu; }
#define XB_SPIN(cond, bar) do { unsigned _sp = 0; while (cond) { __builtin_amdgcn_s_sleep(1); \
    if ((++_sp & 255u) == 0u) { if (xb_ld(&(bar)[XB_TMO])) break; if (_sp > XB_SPIN_CAP) { atomicAdd(&(bar)[XB_TMO], 1u); break; } } } } while (0)
struct XcdBarrier { unsigned* bar; unsigned x; volatile LAS unsigned* st; };
DI XcdBarrier xcd_barrier_post(unsigned* bar, volatile LAS unsigned* st) {
    XcdBarrier b; b.bar = bar; b.x = xb_xcc_id(); b.st = st;
    if (threadIdx.x == 0) (void)xb_add(&bar[XB_XCNT(b.x)], 1u);
    return b;
}
DI void xcd_barrier_complete(unsigned* bar, unsigned x, unsigned& nloc, unsigned& nx) {
    const unsigned G = gridDim.x * gridDim.y * gridDim.z;
    unsigned sum, cnt, mine, sp = 0u;
    for (;;) {
        sum = 0u; cnt = 0u; mine = 0u;
#pragma unroll
        for (unsigned j = 0; j < 16; ++j) { const unsigned c = xb_ld(&bar[XB_XCNT(j)]); sum += c; cnt += (c > 0u) ? 1u : 0u; mine = (j == x) ? c : mine; }
        if (sum == G) break;
        __builtin_amdgcn_s_sleep(1);
        if ((++sp & 255u) == 0u) { if (xb_ld(&bar[XB_TMO])) break; if (sp > XB_SPIN_CAP) { atomicAdd(&bar[XB_TMO], 1u); break; } }
    }
    nloc = mine > 0u ? mine : 1u; nx = cnt > 0u ? cnt : 1u;
}
DI void xcd_barrier(const XcdBarrier& b, const bool leader) {
    asm volatile("s_waitcnt vmcnt(0)" ::: "memory");
    __syncthreads();
    if (leader) {
        unsigned* bar = b.bar;
        __builtin_amdgcn_s_waitcnt(0);
        unsigned nloc = b.st[0], nx = b.st[1];
        if (nloc == 0u) { xcd_barrier_complete(bar, b.x, nloc, nx); b.st[0] = nloc; b.st[1] = nx; }
        const unsigned old = xb_add(&bar[XB_XSUB(b.x)], 1u);
        const unsigned gen = old / nloc;
        if (old + 1u == (gen + 1u) * nloc) {
            __builtin_amdgcn_fence(__ATOMIC_RELEASE, "agent");
            asm volatile("s_waitcnt vmcnt(0)" ::: "memory");
            const unsigned og = xb_add(&bar[XB_TOP], 1u);
            const unsigned tg = og / nx;
            if (og + 1u == (tg + 1u) * nx) xb_add(&bar[XB_TOPGEN], 1u);
            else XB_SPIN(xb_ld(&bar[XB_TOPGEN]) == tg, bar);
            __builtin_amdgcn_fence(__ATOMIC_ACQUIRE, "agent");
            xb_add(&bar[XB_XGEN(b.x)], 1u);
            asm volatile("s_waitcnt vmcnt(0)" ::: "memory");
        } else {
            XB_SPIN(xb_ld(&bar[XB_XGEN(b.x)]) == gen, bar);
            __builtin_amdgcn_fence(__ATOMIC_ACQUIRE, "agent");
            asm volatile("s_waitcnt vmcnt(0)" ::: "memory");
        }
    }
    __syncthreads();
}

namespace pg8 {
typedef unsigned short bf16_t;
constexpr int BM = 256, BK = 64, HALF = 128, HTB = HALF * BK * 2, STAGE_BYTES = 8 * HTB;
DI int lds_byte(int r, int c) { const int st = (r >> 4) * 2 + (c >> 5), rr = r & 15, cc = c & 31, ob = rr * 64 + cc * 2; return st * 1024 + (ob ^ (((ob >> 9) & 1) << 5)); }
DI void stage_rc(int b, int& R, int& C) { const int st = b / 1024, sb = b % 1024, swz = sb ^ (((sb >> 9) & 1) << 5); R = (st >> 1) * 16 + swz / 64; C = (st & 1) * 32 + (swz % 64) / 2; }
DI int perm32(int rho) { const int n = rho >> 4, i = rho & 15; return 8 * (i >> 2) + 4 * n + (i & 3); }

struct Unit { int pm, pn; int arow; unsigned boff; int dup; int slot0; unsigned kofs; int ks; };

DI void static_map(int wgid, int nM, int nN, int& pm, int& pn) {
    const int nwg = nM * nN; const int q = nwg / 8, r = nwg % 8, xcd = wgid % 8, off = wgid / 8;
    wgid = (xcd < r ? xcd * (q + 1) : r * (q + 1) + (xcd - r) * q) + off;
    const int nig = 8 * nN, gid = wgid / nig, fm = gid * 8, gsz = (nM - fm) < 8 ? (nM - fm) : 8;
    pm = fm + ((wgid % nig) % gsz); pn = (wgid % nig) / gsz;
}

template <class Epi, class Sched, bool GATHER, bool FP8>
DI void gemm_phase(LAS unsigned char* lds, const unsigned char* Abase, const int rowbytes, const Sched& S, const Epi& E, const int tid, const int ntk = 0) {
    const int wid = __builtin_amdgcn_readfirstlane(tid >> 6), lane = tid & 63, wr = wid >> 2, wc = wid & 3, fr = lane & 15, fq = lane >> 4;
    const int nt = ntk ? ntk : rowbytes / 128;
    unsigned voffA, voffB, cofs; int Rr[2];
    { int R, C; stage_rc(tid * 16, R, C); const int Rb = (R & ~31) + perm32(R & 31);
      voffA = (unsigned)(R * rowbytes + C * 2); voffB = (unsigned)(Rb * rowbytes + C * 2); cofs = (unsigned)C * 2u; Rr[0] = R; Rr[1] = R + 64; }
    const unsigned kstep = (unsigned)(BK * 2);
    const unsigned hstep = (unsigned)HALF * (unsigned)rowbytes;
    const unsigned istep = 64u * (unsigned)rowbytes;
    const unsigned rowb = (unsigned)rowbytes;
    const unsigned ldsw = (unsigned)wid * 1024u;
    const int aoff = lds_byte(wr * 64 + fr, fq * 8), boff = lds_byte(wc * 32 + fr, fq * 8);
    const __amdgpu_buffer_rsrc_t rA = __builtin_amdgcn_make_buffer_rsrc((void*)Abase, (short)0, 0x7fffffff, 0x00020000);
    const __amdgpu_buffer_rsrc_t rB = __builtin_amdgcn_make_buffer_rsrc((void*)S.wbase(), (short)0, 0x7fffffff, 0x00020000);
#define PG8_SA(b, h) (((b) * 2 + (h)) * HTB)
#define PG8_SB(b, h) ((4 + (b) * 2 + (h)) * HTB)
#define PG8_DMA(rs, ldsoff, vo, so) __builtin_amdgcn_raw_ptr_buffer_load_lds(rs, (LAS void*)(lds + (ldsoff)), 16, (int)(vo), (int)(so), 0, 0)
#define PG8_STAGE(bufoff, so) do { PG8_DMA(rB, (bufoff) + ldsw, voffB, (so)); PG8_DMA(rB, (bufoff) + ldsw + 8192, voffB, (so) + istep); } while (0)
#define PG8_STAGE_A(bufoff, h, kb, nx) do { if constexpr (GATHER) { PG8_DMA(rA, (bufoff) + ldsw, aoC[h][0], (kb)); PG8_DMA(rA, (bufoff) + ldsw + 8192, aoC[h][1], (kb)); } \
        else { const unsigned so_ = ((nx) ? nA : cA) + (unsigned)(h) * hstep + (kb); PG8_DMA(rA, (bufoff) + ldsw, voffA, so_); PG8_DMA(rA, (bufoff) + ldsw + 8192, voffA, so_ + istep); } } while (0)
#define PG8_LDA(dst, b, h) do { _Pragma("unroll") for (int m = 0; m < 4; ++m) { const u32x4 lo_ = *(const LAS u32x4*)(lds + PG8_SA(b, h) + aoff + m * 2048), hi_ = *(const LAS u32x4*)(lds + PG8_SA(b, h) + aoff + m * 2048 + 1024); \
        dst[m] = (i32x8){(int)lo_.x, (int)lo_.y, (int)lo_.z, (int)lo_.w, (int)hi_.x, (int)hi_.y, (int)hi_.z, (int)hi_.w}; } } while (0)
#define PG8_LDB(dst, b, h) do { _Pragma("unroll") for (int n = 0; n < 2; ++n) { const u32x4 lo_ = *(const LAS u32x4*)(lds + PG8_SB(b, h) + boff + n * 2048), hi_ = *(const LAS u32x4*)(lds + PG8_SB(b, h) + boff + n * 2048 + 1024); \
        dst[n] = (i32x8){(int)lo_.x, (int)lo_.y, (int)lo_.z, (int)lo_.w, (int)hi_.x, (int)hi_.y, (int)hi_.z, (int)hi_.w}; } } while (0)
#define PG8_HALF(v, k) __builtin_bit_cast(bf16x8, __builtin_shufflevector(v, v, 4 * (k), 4 * (k) + 1, 4 * (k) + 2, 4 * (k) + 3))
#define PG8_MMA(ai, bj, At, Bt) do { __builtin_amdgcn_s_setprio(1); if constexpr (FP8) { _Pragma("unroll") for (int m = 0; m < 4; ++m) _Pragma("unroll") for (int n = 0; n < 2; ++n) \
        acc[ai][bj][m][n] = __builtin_amdgcn_mfma_scale_f32_16x16x128_f8f6f4(Bt[n], At[m], acc[ai][bj][m][n], 0, 0, 0, 0, 0, 0); } \
    else { _Pragma("unroll") for (int m = 0; m < 4; ++m) _Pragma("unroll") for (int n = 0; n < 2; ++n) { \
        acc[ai][bj][m][n] = __builtin_amdgcn_mfma_f32_16x16x32_bf16(PG8_HALF(Bt[n], 0), PG8_HALF(At[m], 0), acc[ai][bj][m][n], 0, 0, 0); \
        acc[ai][bj][m][n] = __builtin_amdgcn_mfma_f32_16x16x32_bf16(PG8_HALF(Bt[n], 1), PG8_HALF(At[m], 1), acc[ai][bj][m][n], 0, 0, 0); } } __builtin_amdgcn_s_setprio(0); } while (0)
#define PG8_WAIT_V(n) asm volatile("s_waitcnt vmcnt(" #n ")" ::: "memory")
#define PG8_WAIT_L(n) asm volatile("s_waitcnt lgkmcnt(" #n ")" ::: "memory")
#define PG8_BAR __builtin_amdgcn_s_barrier()
#define PG8_SCHED __builtin_amdgcn_sched_barrier(0)
    Unit cur, nxt; int ui = 0;
    if (!S.next(0, cur)) return;
    f32x4 acc[2][2][4][2];
#pragma unroll
    for (int a = 0; a < 2; ++a)
#pragma unroll
        for (int b = 0; b < 2; ++b)
#pragma unroll
            for (int m = 0; m < 4; ++m)
#pragma unroll
                for (int n = 0; n < 2; ++n) acc[a][b][m][n] = (f32x4){0.f, 0.f, 0.f, 0.f};
    i32x8 At[4], B0[2], B1[2];
    unsigned aoC[2][2];
    LAS unsigned short* gidx = (LAS unsigned short*)(lds + 131072 + 4096);
    unsigned cA = (unsigned)cur.arow * rowb + cur.kofs, cB = cur.boff + cur.kofs;
    if constexpr (GATHER) {
        Unit pu;
        for (int i = 0; i < 16 && S.next(i, pu); ++i) if (tid < 256) gidx[i * 256 + tid] = (unsigned short)S.rowidx(pu.arow + tid);
        __syncthreads();
    }
#pragma unroll
    for (int h = 0; h < 2; ++h)
#pragma unroll
        for (int i = 0; i < 2; ++i) aoC[h][i] = GATHER ? (unsigned)gidx[128 * h + Rr[i]] * rowb + cofs : 0u;
    unsigned nA = cA, nB = cB;
    PG8_STAGE(PG8_SB(0, 0), cB); PG8_STAGE(PG8_SB(0, 1), cB + hstep); PG8_STAGE_A(PG8_SA(0, 0), 0, 0u, false); PG8_STAGE_A(PG8_SA(0, 1), 1, 0u, false);
    if (wr == 1) PG8_BAR;
    PG8_WAIT_V(2); PG8_BAR;
    PG8_STAGE(PG8_SB(1, 0), cB + kstep); PG8_STAGE_A(PG8_SA(1, 0), 0, kstep, false); PG8_STAGE(PG8_SB(1, 1), cB + hstep + kstep);
    PG8_WAIT_V(6); PG8_BAR;
    for (;;) {
        const bool has_next = S.next(ui + 1, nxt);
        nA = has_next ? (unsigned)nxt.arow * rowb + nxt.kofs : cA; nB = has_next ? nxt.boff + nxt.kofs : cB;
#pragma unroll 1
        for (int t = 0; t < nt; t += 2) {
            const bool last = (t == nt - 2);
            const unsigned kb1 = (unsigned)(t + 1) * kstep, kb2 = last ? 0u : (unsigned)(t + 2) * kstep, kb3 = kb2 + kstep;
            const unsigned b2 = (last ? nB : cB) + kb2, b3 = b2 + kstep;
            PG8_LDB(B0, 0, 0); PG8_LDB(B1, 0, 1); PG8_SCHED; PG8_LDA(At, 0, 0); PG8_STAGE_A(PG8_SA(1, 1), 1, kb1, false);
            PG8_WAIT_V(8); PG8_WAIT_L(0); PG8_BAR; PG8_MMA(0, 0, At, B0); PG8_MMA(0, 1, At, B1); PG8_BAR; PG8_SCHED;
            if constexpr (GATHER) { if (last && has_next) { const LAS unsigned short* gi = gidx + (ui + 1) * 256;
                aoC[0][0] = (unsigned)gi[Rr[0]] * rowb + cofs; aoC[0][1] = (unsigned)gi[Rr[1]] * rowb + cofs; aoC[1][0] = (unsigned)gi[128 + Rr[0]] * rowb + cofs; aoC[1][1] = (unsigned)gi[128 + Rr[1]] * rowb + cofs; } }
            PG8_LDA(At, 0, 1); PG8_STAGE(PG8_SB(0, 0), b2); PG8_STAGE(PG8_SB(0, 1), b2 + hstep); PG8_STAGE_A(PG8_SA(0, 0), 0, kb2, last);
            PG8_WAIT_V(8); PG8_WAIT_L(0); PG8_BAR; PG8_MMA(1, 0, At, B0); PG8_MMA(1, 1, At, B1); PG8_BAR; PG8_SCHED;
            PG8_LDB(B0, 1, 0); PG8_LDB(B1, 1, 1); PG8_SCHED; PG8_LDA(At, 1, 0); PG8_STAGE_A(PG8_SA(0, 1), 1, kb2, last);
            PG8_WAIT_V(8); PG8_WAIT_L(0); PG8_BAR; PG8_MMA(0, 0, At, B0); PG8_MMA(0, 1, At, B1); PG8_BAR; PG8_SCHED;
            PG8_LDA(At, 1, 1); PG8_STAGE(PG8_SB(1, 0), b3); PG8_STAGE(PG8_SB(1, 1), b3 + hstep); PG8_STAGE_A(PG8_SA(1, 0), 0, kb3, last);
            PG8_WAIT_V(8); PG8_WAIT_L(0); PG8_BAR; PG8_MMA(1, 0, At, B0); PG8_MMA(1, 1, At, B1); PG8_BAR; PG8_SCHED;
        }
        if (wr == 0) PG8_BAR;
        if (!cur.dup) { int te; asm volatile("v_mbcnt_lo_u32_b32 %0, -1, 0\n\tv_mbcnt_hi_u32_b32 %0, -1, %0" : "=v"(te));
          for (int rep = 0; rep < REP(30); ++rep) E(acc, cur, wr, wc, te & 15, (te & 63) >> 4); }
        if (!has_next) break;
#pragma unroll
        for (int a = 0; a < 2; ++a)
#pragma unroll
            for (int b = 0; b < 2; ++b)
#pragma unroll
                for (int m = 0; m < 4; ++m)
#pragma unroll
                    for (int n = 0; n < 2; ++n) acc[a][b][m][n] = (f32x4){0.f, 0.f, 0.f, 0.f};
        cur = nxt; cA = nA; cB = nB; ++ui;
        if (wr == 1) PG8_BAR;
    }
    PG8_WAIT_V(0);
    PG8_BAR;
#undef PG8_SA
#undef PG8_SB
#undef PG8_STAGE
#undef PG8_DMA
#undef PG8_STAGE_A
#undef PG8_LDA
#undef PG8_LDB
#undef PG8_MMA
#undef PG8_HALF
#undef PG8_WAIT_V
#undef PG8_WAIT_L
#undef PG8_BAR
#undef PG8_SCHED
}

struct SchedIn {
    int G, c, nctx; bool ctx_all; const char* Bt; int rb;
    DI bool next(int i0, Unit& u) const {
        const int i = KDUP_IN ? (i0 >> 1) : i0; u.dup = KDUP_IN ? !(i0 & 1) : 0;
        const long Lx = (long)i * G + c; int pm, pn;
        if (Lx < 896) static_map((int)Lx, 128, 7, pm, pn);
        else { const int j = (int)(Lx - 896); if (j >= nctx) return false; if (ctx_all) { pm = 128 + j / 7; pn = j % 7; } else { pm = 128 + j; pn = 6; } }
        u.pm = pm; u.pn = pn; u.arow = pm * 256; u.boff = (unsigned)(pn * 256 * rb); u.kofs = 0u; u.ks = 0; return true;
    }
    DI int rowidx(int) const { return 0; }
    DI const void* wbase() const { return Bt; }
};
struct SchedPlain {
    int G, c, nM, nN; const char* Bt; int rb;
    DI bool next(int i, Unit& u) const {
        u.dup = 0; const long Lx = (long)i * G + c; if (Lx >= (long)nM * nN) return false; int pm, pn; static_map((int)Lx, nM, nN, pm, pn);
        u.pm = pm; u.pn = pn; u.arow = pm * 256; u.boff = (unsigned)(pn * 256 * rb); u.kofs = 0u; u.ks = 0; return true;
    }
    DI int rowidx(int) const { return 0; }
    DI const void* wbase() const { return Bt; }
};
struct SchedGrp {
    int G, c, t0, nM, nN; const char* W; size_t wstride; int rb; const LAS int* tile_e; const int* tokmap; bool gather; bool kdup;
    DI bool next(int i0, Unit& u) const {
        const int i = (KDUP_GRP && kdup) ? (i0 >> 1) : i0; u.dup = (KDUP_GRP && kdup) ? !(i0 & 1) : 0;
        const long Lx = (long)i * G + c; if (Lx >= (long)nM * nN) return false; int pm, pn; static_map((int)Lx, nM, nN, pm, pn);
        const int te = __builtin_amdgcn_readfirstlane(tile_e[t0 + pm]);
        const int e = te >> 24; u.slot0 = te & 0xffffff;
        u.pm = t0 + pm; u.pn = pn; u.arow = gather ? u.slot0 : pm * 256; u.boff = (unsigned)e * (unsigned)wstride + (unsigned)(pn * 256 * rb); u.kofs = 0u; u.ks = 0; return true;
    }
    DI int rowidx(int slot) const { return tokmap[slot]; }
    DI const void* wbase() const { return W; }
};

struct SchedSplit {
    int G, c, nM, nN, S, ntk; const char* Bt; int rb;
    DI bool next(int i, Unit& u) const {
        const long Lx = (long)i * G + c; if (Lx >= (long)nM * nN * S) return false;
        const int ks = (int)(Lx % S), rest = (int)(Lx / S), pn = rest % nN, pm = rest / nN;
        u.pm = pm; u.pn = pn; u.arow = pm * 256; u.boff = (unsigned)(pn * 256 * rb); u.kofs = (unsigned)(ks * ntk * 128); u.ks = ks; u.dup = 0; u.slot0 = 0; return true;
    }
    DI int rowidx(int) const { return 0; }
    DI const void* wbase() const { return Bt; }
};
#ifndef EPI_NT
#define EPI_NT 0
#endif
#if EPI_NT
#define EPI_ST(p, v) __builtin_nontemporal_store((v), (p))
#else
#define EPI_ST(p, v) (*(p) = (v))
#endif
typedef f32x4 Acc[2][2][4][2];
DI u32x4 tr4(u32x4 w, int te) { const int src = (((te & 3) << 4) | (te >> 2)) << 2; u32x4 r;
    r.x = (unsigned)__builtin_amdgcn_ds_bpermute(src, (int)w.x); r.y = (unsigned)__builtin_amdgcn_ds_bpermute(src, (int)w.y); r.z = (unsigned)__builtin_amdgcn_ds_bpermute(src, (int)w.z); r.w = (unsigned)__builtin_amdgcn_ds_bpermute(src, (int)w.w); return r; }
struct EpiZ {
    bf16_t* Z; const LAS float* rc; const LAS float* rs;
    DI void operator()(const Acc& acc, const Unit& u, int wr, int wc, int fr, int fq) const {
        const int pn = u.pn, row0 = u.pm * 256 + wr * 64 + fr, te = fq * 16 + fr;
        const bool lat = u.pm < 128;
        bf16_t* rowp0 = Z + (size_t)(u.pm * 256 + wr * 64 + (te >> 2)) * NZ + pn * 256 + wc * 32 + 8 * (te & 3);
#pragma unroll
        for (int ai = 0; ai < 2; ++ai)
#pragma unroll
            for (int m = 0; m < 4; ++m) {
                const int row = row0 + ai * 128 + m * 16; bf16_t* rowp = rowp0 + (size_t)(ai * 128 + m * 16) * NZ;
#pragma unroll
                for (int bj = 0; bj < 2; ++bj) {
                    f32x4 v0 = acc[ai][bj][m][0], v1 = acc[ai][bj][m][1];
                    if (pn < 2) {
#pragma unroll
                        for (int j = 0; j < 4; ++j) { v0[j] = gelu_tanh(v0[j]); v1[j] = gelu_tanh(v1[j]); }
                    } else if (pn >= 4 && !(pn == 6 && bj == 1)) {
                        if (lat) {
                            const int n = row & (NLAT - 1); const int pos = (wc & 1) ? (n & 63) : (n >> 6); const int fb = 8 * (fq & 1);
                            const f32x4 c0 = *(const LAS f32x4*)(rc + pos * 16 + fb), c1 = *(const LAS f32x4*)(rc + pos * 16 + fb + 4);
                            const f32x4 s0 = *(const LAS f32x4*)(rs + pos * 16 + fb), s1 = *(const LAS f32x4*)(rs + pos * 16 + fb + 4);
                            const float sg = (fq >> 1) ? 1.f : -1.f;
                            f32x4 p0, p1;
#pragma unroll
                            for (int j = 0; j < 4; ++j) { p0[j] = shx(v0[j], 32, fq * 16 + fr); p1[j] = shx(v1[j], 32, fq * 16 + fr); }
                            v0 = v0 * c0 + sg * p0 * s0; v1 = v1 * c1 + sg * p1 * s1;
                        }
                        if (pn < 6) { v0 = v0 * QSCALE; v1 = v1 * QSCALE; }
                    }
                    u32x4 w; w.x = cvt_pk_bf16(v0[0], v0[1]); w.y = cvt_pk_bf16(v0[2], v0[3]); w.z = cvt_pk_bf16(v1[0], v1[1]); w.w = cvt_pk_bf16(v1[2], v1[3]);
                    EPI_ST((u32x4*)(rowp + bj * 128), tr4(w, te));
                }
            }
    }
};
struct EpiO {
    bf16_t* O; int ldc;
    DI void operator()(const Acc& acc, const Unit& u, int wr, int wc, int fr, int fq) const {
        const int te = fq * 16 + fr, row0 = u.pm * 256 + wr * 64 + (te >> 2), colb = u.pn * 256 + wc * 32 + 8 * (te & 3);
#pragma unroll
        for (int ai = 0; ai < 2; ++ai)
#pragma unroll
            for (int m = 0; m < 4; ++m) { bf16_t* rowp = O + (size_t)(row0 + ai * 128 + m * 16) * ldc + colb;
#pragma unroll
                for (int bj = 0; bj < 2; ++bj) { const f32x4 v0 = acc[ai][bj][m][0], v1 = acc[ai][bj][m][1];
                    u32x4 w; w.x = cvt_pk_bf16(v0[0], v0[1]); w.y = cvt_pk_bf16(v0[2], v0[3]); w.z = cvt_pk_bf16(v1[0], v1[1]); w.w = cvt_pk_bf16(v1[2], v1[3]);
                    EPI_ST((u32x4*)(rowp + bj * 128), tr4(w, te)); } }
    }
};
DI f32x2 swiglu2(f32x2 g, f32x2 u, float c1, float c0, float k0) {
    const f32x2 t = g * c1 + c0; f32x2 e; e.x = fexp2(t.x); e.y = fexp2(t.y);
    const f32x2 d = e + k0; f32x2 r; r.x = frcp(d.x); r.y = frcp(d.y);
    return (g * u) * r;
}
DI f32x2 swiglu2d(f32x2 g, f32x2 u) {
    f32x2 e; e.x = fexp2(-g.x); e.y = fexp2(-g.y);
    const f32x2 d = e * LOG2E + LOG2E; f32x2 r; r.x = frcp(d.x); r.y = frcp(d.y);
    return (g * u) * r;
}
struct EpiGU {
    bf16_t* ACT; int t0;
    DI void operator()(const Acc& acc, const Unit& u, int wr, int wc, int fr, int fq) const {
        const int row0 = (u.pm - t0) * 256 + wr * 64 + fr, colb = u.pn * 128 + wc * 32 + 8 * fq;
#pragma unroll
        for (int ai = 0; ai < 2; ++ai)
#pragma unroll
            for (int m = 0; m < 4; ++m) { bf16_t* rowp = ACT + (size_t)(row0 + ai * 128 + m * 16) * DFF + colb;
                const f32x4 g0 = acc[ai][0][m][0], g1 = acc[ai][0][m][1], u0 = acc[ai][1][m][0], u1 = acc[ai][1][m][1];
                const f32x2 a = swiglu2d((f32x2){g0[0], g0[1]}, (f32x2){u0[0], u0[1]}), b = swiglu2d((f32x2){g0[2], g0[3]}, (f32x2){u0[2], u0[3]});
                const f32x2 c = swiglu2d((f32x2){g1[0], g1[1]}, (f32x2){u1[0], u1[1]}), d = swiglu2d((f32x2){g1[2], g1[3]}, (f32x2){u1[2], u1[3]});
                u32x4 w; w.x = cvt_pk_bf16(a.x, a.y); w.y = cvt_pk_bf16(b.x, b.y); w.z = cvt_pk_bf16(c.x, c.y); w.w = cvt_pk_bf16(d.x, d.y);
                EPI_ST((u32x4*)rowp, w); }
    }
};
struct EpiPart {
    float* P; int rows, ldc;
    DI void operator()(const Acc& acc, const Unit& u, int wr, int wc, int fr, int fq) const {
        const int te = fq * 16 + fr, row0 = u.pm * 256 + wr * 64 + (te >> 2), colb = u.pn * 256 + wc * 32 + 8 * (te & 3);
        float* base = P + (size_t)u.ks * rows * ldc;
#pragma unroll
        for (int ai = 0; ai < 2; ++ai)
#pragma unroll
            for (int m = 0; m < 4; ++m) { float* rowp = base + (size_t)(row0 + ai * 128 + m * 16) * ldc + colb;
#pragma unroll
                for (int bj = 0; bj < 2; ++bj) { *(u32x4*)(rowp + bj * 128) = tr4(__builtin_bit_cast(u32x4, acc[ai][bj][m][0]), te); *(u32x4*)(rowp + bj * 128 + 4) = tr4(__builtin_bit_cast(u32x4, acc[ai][bj][m][1]), te); } }
    }
};
struct EpiDown {
    bf16_t* F; const int* dstmap; const float* gate;
    DI void operator()(const Acc& acc, const Unit& u, int wr, int wc, int fr, int fq) const {
        const int te = fq * 16 + fr, slot0 = u.slot0 + wr * 64 + fr, slot0s = u.slot0 + wr * 64 + (te >> 2), colb = u.pn * 256 + wc * 32 + 8 * (te & 3);
        int dstv[2][4]; float gtv[2][4];
#pragma unroll
        for (int ai = 0; ai < 2; ++ai)
#pragma unroll
            for (int m = 0; m < 4; ++m) { dstv[ai][m] = dstmap[slot0s + ai * 128 + m * 16]; gtv[ai][m] = gate[slot0 + ai * 128 + m * 16]; }
#pragma unroll
        for (int ai = 0; ai < 2; ++ai)
#pragma unroll
            for (int m = 0; m < 4; ++m) { const int dst = dstv[ai][m]; const float gt = gtv[ai][m];
                bf16_t* rowp = F + (size_t)dst * DM + colb;
#pragma unroll
                for (int bj = 0; bj < 2; ++bj) { const f32x4 v0 = acc[ai][bj][m][0] * gt, v1 = acc[ai][bj][m][1] * gt;
                    u32x4 w; w.x = cvt_pk_bf16(v0[0], v0[1]); w.y = cvt_pk_bf16(v0[2], v0[3]); w.z = cvt_pk_bf16(v1[0], v1[1]); w.w = cvt_pk_bf16(v1[2], v1[3]);
                    const u32x4 wt = tr4(w, te);
                    if (dst >= 0) EPI_ST((u32x4*)(rowp + bj * 128), wt); } }
    }
};

constexpr float S8_Y = 16.0f, S8_W = 256.0f, S8_ACT = 8.0f, S8_F = 16.0f;
DI float clamp8(float v) { return __builtin_amdgcn_fmed3f(v, -448.0f, 448.0f); }
DI unsigned pk_fp8x4(float a, float b, float c, float d) { int w0; asm volatile("" : "=v"(w0));
    int w = __builtin_amdgcn_cvt_pk_fp8_f32(clamp8(a), clamp8(b), w0, false); w = __builtin_amdgcn_cvt_pk_fp8_f32(clamp8(c), clamp8(d), w, true); return (unsigned)w; }
struct EpiGU8 {
    unsigned char* ACT; int t0;
    DI void operator()(const Acc& acc, const Unit& u, int wr, int wc, int fr, int fq) const {
        constexpr float us = 1.0f / (S8_Y * S8_W), c1 = -us * LOG2E, c0 = 21.0f, k0 = 2097152.0f;
        static_assert(us * us * S8_ACT * k0 == 1.0f, "k0 = 1 / c2, c0 = log2 k0");
        const int te = fq * 16 + fr, rho = te >> 1, hf = te & 1, srcl = (((2 * hf + (rho >> 4)) << 4) | (rho & 15)) << 2;
        unsigned char* base = ACT + (size_t)((u.pm - t0) * 256 + wr * 64 + rho) * DFF + u.pn * 128 + wc * 32 + 16 * hf;
#pragma unroll
        for (int ai = 0; ai < 2; ++ai)
#pragma unroll
            for (int mp = 0; mp < 4; mp += 2) { u32x2 w[2];
#pragma unroll
                for (int k = 0; k < 2; ++k) { const int m = mp + k;
                    const f32x4 g0 = acc[ai][0][m][0], g1 = acc[ai][0][m][1], u0 = acc[ai][1][m][0], u1 = acc[ai][1][m][1];
                    const f32x2 a = swiglu2((f32x2){g0[0], g0[1]}, (f32x2){u0[0], u0[1]}, c1, c0, k0), b = swiglu2((f32x2){g0[2], g0[3]}, (f32x2){u0[2], u0[3]}, c1, c0, k0);
                    const f32x2 c = swiglu2((f32x2){g1[0], g1[1]}, (f32x2){u1[0], u1[1]}, c1, c0, k0), d = swiglu2((f32x2){g1[2], g1[3]}, (f32x2){u1[2], u1[3]}, c1, c0, k0);
                    w[k].x = pk_fp8x4(a.x, a.y, b.x, b.y); w[k].y = pk_fp8x4(c.x, c.y, d.x, d.y); }
                const auto rx = __builtin_amdgcn_permlane16_swap(w[0].x, w[1].x, false, false), ry = __builtin_amdgcn_permlane16_swap(w[0].y, w[1].y, false, false);
                u32x4 o; o.x = (unsigned)__builtin_amdgcn_ds_bpermute(srcl, (int)rx[0]); o.y = (unsigned)__builtin_amdgcn_ds_bpermute(srcl, (int)ry[0]); o.z = (unsigned)__builtin_amdgcn_ds_bpermute(srcl, (int)rx[1]); o.w = (unsigned)__builtin_amdgcn_ds_bpermute(srcl, (int)ry[1]);
                EPI_ST((u32x4*)(base + (size_t)(ai * 128 + mp * 16) * DFF), o); }
    }
};
struct EpiGUm {
    bf16_t* ACT; int t0;
    DI void operator()(const Acc& acc, const Unit& u, int wr, int wc, int fr, int fq) const {
        const int te = fq * 16 + fr, row0 = (u.pm - t0) * 256 + wr * 64 + (te >> 2), colb = u.pn * 128 + wc * 32 + 8 * (te & 3);
        constexpr float us = 1.0f / (S8_Y * S8_W), c1 = -us * LOG2E, c0 = 24.0f, k0 = 16777216.0f;
        static_assert(us * us * k0 == 1.0f, "k0 = 1 / us^2, c0 = log2 k0");
#pragma unroll
        for (int ai = 0; ai < 2; ++ai)
#pragma unroll
            for (int m = 0; m < 4; ++m) { bf16_t* rowp = ACT + (size_t)(row0 + ai * 128 + m * 16) * DFF + colb;
                const f32x4 g0 = acc[ai][0][m][0], g1 = acc[ai][0][m][1], u0 = acc[ai][1][m][0], u1 = acc[ai][1][m][1];
                const f32x2 a = swiglu2((f32x2){g0[0], g0[1]}, (f32x2){u0[0], u0[1]}, c1, c0, k0), b = swiglu2((f32x2){g0[2], g0[3]}, (f32x2){u0[2], u0[3]}, c1, c0, k0);
                const f32x2 c = swiglu2((f32x2){g1[0], g1[1]}, (f32x2){u1[0], u1[1]}, c1, c0, k0), d = swiglu2((f32x2){g1[2], g1[3]}, (f32x2){u1[2], u1[3]}, c1, c0, k0);
                u32x4 w; w.x = cvt_pk_bf16(a.x, a.y); w.y = cvt_pk_bf16(b.x, b.y); w.z = cvt_pk_bf16(c.x, c.y); w.w = cvt_pk_bf16(d.x, d.y);
                EPI_ST((u32x4*)rowp, tr4(w, te)); }
    }
};
struct EpiDown8 {
    bf16_t* F; const int* dstmap; const float* gate;
    DI void operator()(const Acc& acc, const Unit& u, int wr, int wc, int fr, int fq) const {
        static_assert(!FP8_DDN, "the dense layer's norm_end reads bf16 F rows");
        const int te = fq * 16 + fr, slot0 = u.slot0 + wr * 64 + fr, slot0s = u.slot0 + wr * 64 + (te >> 2), colb = u.pn * 256 + wc * 32 + 8 * (te & 3);
        constexpr float us = S8_F / (S8_ACT * S8_W);
        const int trs = (((te & 3) << 4) | (te >> 2)) << 2;
        int dstv[2][4]; float gtv[2][4];
#pragma unroll
        for (int ai = 0; ai < 2; ++ai)
#pragma unroll
            for (int m = 0; m < 4; ++m) { dstv[ai][m] = dstmap[slot0s + ai * 128 + m * 16]; gtv[ai][m] = gate[slot0 + ai * 128 + m * 16] * us; }
#pragma unroll
        for (int ai = 0; ai < 2; ++ai)
#pragma unroll
            for (int m = 0; m < 4; ++m) { const int dst = dstv[ai][m]; const float gt = gtv[ai][m];
                unsigned char* rowp = (unsigned char*)F + (size_t)dst * DM + colb;
#pragma unroll
                for (int bj = 0; bj < 2; ++bj) { const f32x4 v0 = acc[ai][bj][m][0] * gt, v1 = acc[ai][bj][m][1] * gt;
                    u32x2 w; w.x = (unsigned)__builtin_amdgcn_ds_bpermute(trs, (int)pk_fp8x4(v0[0], v0[1], v0[2], v0[3])); w.y = (unsigned)__builtin_amdgcn_ds_bpermute(trs, (int)pk_fp8x4(v1[0], v1[1], v1[2], v1[3]));
                    if (dst >= 0) *(u32x2*)(rowp + bj * 128) = w; } }
    }
};
}

struct Args { const float* in[25]; float* out; unsigned char* ws; int ph_lo, ph_hi; };
enum { I_X = 0, I_C, I_CTX, I_CCTX, I_WADA, I_BADA, I_GMPRE, I_GMPOST, I_GFPRE, I_GFPOST, I_WIN, I_WS, I_BS, I_GV, I_WF, I_SINK, I_WOUT, I_WGD, I_WUD, I_WDD, I_WR, I_BR, I_WGE, I_WUE, I_WDE };

struct TJob { const float* src; bf16* dst; int K, Nsrc, ncol0, drow0, kb, f8; float sc; };
constexpr int TJ_IN_A = 256, TJ_IN_B = 384, TJ_OUT = 512, TJ_D = 896, TJ_E = 7168;
constexpr int TJ_TOTAL = TJ_IN_A + TJ_IN_B + TJ_OUT + 3 * TJ_D + 3 * TJ_E;
constexpr int TJ_NOW = TJ_IN_A + TJ_IN_B + TJ_OUT + 3 * TJ_D;
constexpr int TJ_DEF = TJ_TOTAL - TJ_NOW, TJ_BATCH = 16;
static_assert(TJ_DEF % TJ_BATCH == 0, "deferred queue is dealt in whole batches");
DI TJob tj_decode(const Args& a, bf16* WB, int it) {
    TJob J; J.f8 = 0; J.sc = 1.0f;
    if (it < TJ_IN_A) { const int L = it / 128, r = it % 128; J.kb = r / 8; const int nb = r % 8;
        J.src = a.in[I_WIN] + (size_t)L * 1024 * 1536; J.K = 1024; J.Nsrc = 1536; J.ncol0 = 64 * nb; J.dst = WB + W_IN / 2 + (size_t)L * NZ * 1024; J.drow0 = 64 * nb; return J; }
    it -= TJ_IN_A;
    if (it < TJ_IN_B) { const int L = it / 192, r = it % 192; J.kb = r / 12; const int nb = r % 12;
        J.src = a.in[I_WIN] + (size_t)L * 1024 * 1536; J.K = 1024; J.Nsrc = 1536; J.ncol0 = 768 + 64 * nb; J.dst = WB + W_IN / 2 + (size_t)L * NZ * 1024; J.drow0 = 1024 + 64 * nb; return J; }
    it -= TJ_IN_B;
    if (it < TJ_OUT) { const int L = it / 256, r = it % 256; J.kb = r / 16; const int nb = r % 16;
        J.src = a.in[I_WOUT] + (size_t)L * 1024 * 1024; J.K = 1024; J.Nsrc = 1024; J.ncol0 = 64 * nb; J.dst = WB + W_OUT / 2 + (size_t)L * 1024 * 1024; J.drow0 = 64 * nb; return J; }
    it -= TJ_OUT;
    if (it < 2 * TJ_D) { const int up = it / TJ_D, r = it % TJ_D; J.kb = r / 56; const int nb = r % 56, f0 = 64 * nb;
        J.src = a.in[up ? I_WUD : I_WGD]; J.K = 1024; J.Nsrc = DFF; J.ncol0 = f0; J.dst = WB + W_GUD / 2; J.drow0 = (f0 / 128) * 256 + (f0 % 128) + 128 * up; J.sc = FP8_DGU ? pg8::S8_W : (up ? 1.0f : LOG2E); J.f8 = FP8_DGU; return J; }
    it -= 2 * TJ_D;
    if (it < TJ_D) { J.kb = it / 16; const int nb = it % 16;
        J.src = a.in[I_WDD]; J.K = DFF; J.Nsrc = 1024; J.ncol0 = 64 * nb; J.dst = WB + W_DD / 2; J.drow0 = 64 * nb; if (FP8_DDN) { J.f8 = 1; J.sc = pg8::S8_W; } return J; }
    it -= TJ_D;
    if (it < 2 * TJ_E) { const int up = it / TJ_E, r0 = it % TJ_E, e = r0 / TJ_D, r = r0 % TJ_D; J.kb = r / 56; const int nb = r % 56, f0 = 64 * nb;
        J.src = a.in[up ? I_WUE : I_WGE] + (size_t)e * 1024 * DFF; J.K = 1024; J.Nsrc = DFF; J.ncol0 = f0; J.dst = (bf16*)((unsigned char*)WB + W_GUE + (size_t)e * 7168 * 1024); J.drow0 = (f0 / 128) * 256 + (f0 % 128) + 128 * up; J.f8 = 1; J.sc = pg8::S8_W; return J; }
    it -= 2 * TJ_E;
    { const int e = it / TJ_D, r = it % TJ_D; J.kb = r / 16; const int nb = r % 16;
        J.src = a.in[I_WDE] + (size_t)e * DFF * 1024; J.K = DFF; J.Nsrc = 1024; J.ncol0 = 64 * nb; J.dst = (bf16*)((unsigned char*)WB + W_DE + (size_t)e * 1024 * DFF); J.drow0 = 64 * nb; J.f8 = 1; J.sc = pg8::S8_W; return J; }
}
DI void tj_load(const TJob& J, int lane, f32x4 (&v)[16]) {
    const float* p = J.src + (size_t)(64 * J.kb + (lane >> 4)) * J.Nsrc + J.ncol0 + 4 * (lane & 15);
#pragma unroll
    for (int i = 0; i < 16; ++i) v[i] = *(const f32x4*)(p + (size_t)(4 * i) * J.Nsrc);
}
DI void tj_store(const TJob& J, LAS float* scr, int lane, const f32x4 (&v)[16]) {
#pragma unroll
    for (int i = 0; i < 16; ++i) { const int k = 4 * i + (lane >> 4); *(LAS f32x4*)(scr + k * 64 + ((4 * (lane & 15)) ^ (4 * ((k >> 3) & 7)))) = v[i]; }
    LDS_WAIT();
    const int c = lane & 7, k0 = 64 * J.kb;
#pragma unroll
    for (int j = 0; j < 8; ++j) { const int n = (lane >> 3) + 8 * j; const LAS float* s = scr + (8 * c) * 64 + (((n & ~3) ^ (4 * c)) + (n & 3));
        const float x0 = s[0 * 64], x1 = s[1 * 64], x2 = s[2 * 64], x3 = s[3 * 64], x4 = s[4 * 64], x5 = s[5 * 64], x6 = s[6 * 64], x7 = s[7 * 64];
        const float sw = J.sc;
        if (J.f8) { u32x2 o; o.x = pg8::pk_fp8x4(x0 * sw, x1 * sw, x2 * sw, x3 * sw); o.y = pg8::pk_fp8x4(x4 * sw, x5 * sw, x6 * sw, x7 * sw);
            *(u32x2*)((unsigned char*)J.dst + (size_t)(J.drow0 + n) * J.K + k0 + 8 * c) = o; }
        else { u32x4 o; o.x = cvt_pk_bf16(x0 * sw, x1 * sw); o.y = cvt_pk_bf16(x2 * sw, x3 * sw); o.z = cvt_pk_bf16(x4 * sw, x5 * sw); o.w = cvt_pk_bf16(x6 * sw, x7 * sw);
            *(u32x4*)(J.dst + (size_t)(J.drow0 + n) * J.K + k0 + 8 * c) = o; } }
    LDS_WAIT();
}

DI void prologue_a(const Args& a, unsigned char* ws, LAS unsigned char* lds, int tid, int wave, int lane) {
    const int G = gridDim.x, bx = blockIdx.x;
    {
        const int gw = bx * NWAVES + wave, NGW = G * NWAVES;
        float* mp = (float*)(ws + WS_MOD);
        for (int it = gw; it < 2 * 96 * 8; it += NGW) {
            const int ks = it & 7, jg = (it >> 3) % 96, L = it / 768, j0 = 64 * jg;
            float sil[5][2];
#pragma unroll
            for (int s = 0; s < 5; ++s)
#pragma unroll
                for (int hf = 0; hf < 2; ++hf) { const int k = 128 * ks + 64 * hf + lane; sil[s][hf] = silu_f(s < 4 ? a.in[I_C][s * 1024 + k] : a.in[I_CCTX][k]); }
            float acc[5] = {0.f, 0.f, 0.f, 0.f, 0.f};
            const float* wp = a.in[I_WADA] + (size_t)L * 1024 * 6144 + (size_t)(128 * ks) * 6144 + j0 + lane;
#pragma unroll
            for (int hf = 0; hf < 2; ++hf)
#pragma unroll 16
                for (int kk = 0; kk < 64; ++kk) { const float w = wp[(size_t)(64 * hf + kk) * 6144];
#pragma unroll
                    for (int s = 0; s < 5; ++s) acc[s] += __builtin_bit_cast(float, __builtin_amdgcn_readlane(__builtin_bit_cast(int, sil[s][hf]), kk)) * w; }
#pragma unroll
            for (int s = 0; s < 5; ++s) mp[((size_t)(L * 8 + ks) * 5 + s) * 6144 + j0 + lane] = acc[s];
        }
    }
    for (int it = bx; it < 256; it += G) {
        const int L = it >> 7, g = (it >> 5) & 3, kblk = it & 31;
        LAS float* Mt = (LAS float*)lds; LAS float* Wl = (LAS float*)(lds + 32768);
        __syncthreads();
        const float* wf = a.in[I_WF] + (size_t)(L * 4 + g) * 4096;
        LAS float* trg = (LAS float*)(lds + 49152); LAS float* wfl = (LAS float*)(lds + 49152 + 512);
        if (tid < 128) { const float fr = (float)(tid & 63) * (1.0f / 64.0f); trg[tid] = tid < 64 ? __builtin_amdgcn_cosf(fr) : __builtin_amdgcn_sinf(fr); }
        { float t8[8];
#pragma unroll
          for (int k = 0; k < 8; ++k) t8[k] = wf[tid + k * NTHR];
#pragma unroll
          for (int k = 0; k < 8; ++k) wfl[tid + k * NTHR] = t8[k]; }
        const float* wi = a.in[I_WIN] + (size_t)L * 1024 * 1536;
        { float t4[4];
#pragma unroll
          for (int k = 0; k < 4; ++k) { const int idx = tid + k * NTHR, kl = idx >> 6, d = idx & 63; t4[k] = wi[(size_t)(32 * kblk + kl) * 1536 + 512 + 64 * g + d]; }
#pragma unroll
          for (int k = 0; k < 4; ++k) { const int idx = tid + k * NTHR, kl = idx >> 6, d = idx & 63; Wl[kl * 65 + d] = t4[k]; } }
        __syncthreads();
        { const int rg = tid >> 4, cg = tid & 15, pq = rg >> 4, d0 = 4 * (rg & 15);
          f32x4 acc4[4];
#pragma unroll
          for (int i = 0; i < 4; ++i) acc4[i] = (f32x4){0.f, 0.f, 0.f, 0.f};
#pragma unroll 4
          for (int e = 0; e < 64; ++e) { const f32x4 w4 = *(const LAS f32x4*)(wfl + e * 64 + 4 * cg);
#pragma unroll
              for (int i = 0; i < 4; ++i) { const float tv = trg[64 * pq + (((d0 + i) * e) & 63)]; acc4[i] = acc4[i] + w4 * tv; } }
#pragma unroll
          for (int i = 0; i < 4; ++i) *(LAS f32x4*)(Mt + (pq * 64 + d0 + i) * 64 + 4 * cg) = acc4[i]; }
        __syncthreads();
        { const int klp = tid & 15, cgrp = tid >> 4, pq = cgrp >> 4, e20 = 4 * (cgrp & 15);
          bf16* WIN = (bf16*)(ws + WS_W + W_IN) + (size_t)L * NZ * 1024;
          f32x4 s0 = (f32x4){0.f, 0.f, 0.f, 0.f}, s1 = (f32x4){0.f, 0.f, 0.f, 0.f};
#pragma unroll 8
          for (int d = 0; d < 64; ++d) { const f32x4 m4 = *(const LAS f32x4*)(Mt + (pq * 64 + d) * 64 + e20); const float w0 = Wl[(2 * klp) * 65 + d], w1 = Wl[(2 * klp + 1) * 65 + d];
              s0 = s0 + m4 * w0; s1 = s1 + m4 * w1; }
#pragma unroll
          for (int i = 0; i < 4; ++i) *(unsigned*)(WIN + (size_t)(512 + 256 * pq + 64 * g + e20 + i) * 1024 + 32 * kblk + 2 * klp) = cvt_pk_bf16(s0[i], s1[i]); }
    }
    __syncthreads();
    {
        const int gt = bx * NTHR + tid, GT = G * NTHR;
        bf16* G1 = (bf16*)(ws + WS_TAB + T_G1); bf16* G3 = (bf16*)(ws + WS_TAB + T_G3); bf16* GC = (bf16*)(ws + WS_TAB + T_GC); bf16* WSB = (bf16*)(ws + WS_TAB + T_WS);
        float* RC = (float*)(ws + WS_TAB + T_ROPE); float* RS = RC + 2048;
        for (int idx = gt; idx < 128 * 128; idx += GT) { const int m = idx >> 7, kk = idx & 127; const int w = m >> 4, x = m & 15, k1 = 8 * w + 2 * (x >> 2) + ((x & 3) >> 1), ri = x & 1, pq = kk >> 6, n1 = kk & 63;
            const float fr = (float)((k1 * n1) & 63) * (1.0f / 64.0f), c = __builtin_amdgcn_cosf(fr), s = __builtin_amdgcn_sinf(fr);
            G1[idx] = f2bf(ri == 0 ? (pq == 0 ? c : -s) : (pq == 0 ? s : c)); }
        for (int idx = gt; idx < 128 * 256; idx += GT) { const int k2 = idx >> 8, kk = idx & 255, ri = kk >> 7, n2 = kk & 127; const float fr = (float)((k2 * n2) & 127) * (1.0f / 128.0f);
            G3[idx] = f2bf(ri == 0 ? __builtin_amdgcn_cosf(fr) : __builtin_amdgcn_sinf(fr)); }
        for (int idx = gt; idx < 256 * 512; idx += GT) { const int k = idx >> 9, kk = idx & 511, pq = kk >> 8, n = kk & 255; const float fr = (float)((k * n) & 255) * (1.0f / 256.0f);
            GC[idx] = f2bf(pq == 0 ? __builtin_amdgcn_cosf(fr) : -__builtin_amdgcn_sinf(fr)); }
        for (int idx = gt; idx < 2 * 4 * 128 * 128; idx += GT) WSB[idx] = f2bf(a.in[I_WS][idx]);
        { int* t0 = (int*)(ws + WS_RT + RT_TOK); int* d0 = (int*)(ws + WS_RT + RT_DST); float* g0 = (float*)(ws + WS_RT + RT_GATE);
          for (int idx = gt; idx < MALL; idx += GT) { t0[idx] = idx; d0[idx] = idx; g0[idx] = 1.0f; }
          int* t1 = (int*)(ws + WS_RT1 + RT1_TOK); int* d1 = (int*)(ws + WS_RT1 + RT1_DST); float* g1 = (float*)(ws + WS_RT1 + RT1_GATE);
          for (int idx = gt; idx < NE * CAP; idx += GT) { t1[idx] = 0; d1[idx] = -1; g1[idx] = 0.f; } }
        for (int idx = gt; idx < 2048; idx += GT) { const int pos = idx >> 4, f = idx & 15; const float inv = powf(10000.0f, -(float)f / 16.0f); const float ang = (float)pos * inv; RC[idx] = cosf(ang); RS[idx] = sinf(ang); }
    }
    {
        LAS float* scr = (LAS float*)(lds + wave * 16384);
        bf16* WB = (bf16*)(ws + WS_W);
        const int gw = bx * NWAVES + wave, NGW = G * NWAVES;
        f32x4 va[16], vb[16]; TJob Ja, Jb;
        int ia = gw;
        if (ia < TJ_NOW) { Ja = tj_decode(a, WB, ia); tj_load(Ja, lane, va); }
        for (;;) {
            if (ia >= TJ_NOW) break;
            const int ib = ia + NGW;
            if (ib < TJ_NOW) { Jb = tj_decode(a, WB, ib); tj_load(Jb, lane, vb); }
            tj_store(Ja, scr, lane, va);
            if (ib >= TJ_NOW) break;
            ia = ib + NGW;
            if (ia < TJ_NOW) { Ja = tj_decode(a, WB, ia); tj_load(Ja, lane, va); }
            tj_store(Jb, scr, lane, vb);
        }
    }
}

DI void cvt_filler(const Args& a, unsigned char* ws, LAS unsigned char* lds, int tid, int wave, int lane, int* done, int need) {
    LAS int* sh = (LAS int*)(lds + LDSCTL_OFF + LC_FILL);
    int* cur = (int*)(ws + WS_CTL) + CW_CVT;
    LAS float* scr = (LAS float*)(lds + wave * 16384);
    bf16* WB = (bf16*)(ws + WS_W);
    __syncthreads();
    for (int it = 0;; ++it) {
        if (tid == 0) { int b = -1;
            const bool stop = done && __hip_atomic_load(done, __ATOMIC_RELAXED, __HIP_MEMORY_SCOPE_AGENT) >= need;
            if (!stop) { b = __hip_atomic_fetch_add(cur, done ? TJ_BATCH / 2 : TJ_BATCH, __ATOMIC_RELAXED, __HIP_MEMORY_SCOPE_AGENT); if (b >= TJ_DEF) b = -1; }
            sh[it & 1] = b; }
        __syncthreads();
        const int b = __builtin_amdgcn_readfirstlane(sh[it & 1]);
        if (b < 0) break;
        f32x4 va[16], vb[16];
        const int ia = b + (done ? wave : 2 * wave), ib = done ? TJ_DEF : ia + 1;
        if (ia < TJ_DEF) { const TJob Ja = tj_decode(a, WB, TJ_NOW + ia); tj_load(Ja, lane, va);
            if (ib < TJ_DEF) { const TJob Jb = tj_decode(a, WB, TJ_NOW + ib); tj_load(Jb, lane, vb); tj_store(Ja, scr, lane, va); tj_store(Jb, scr, lane, vb); }
            else tj_store(Ja, scr, lane, va); }
    }
    __syncthreads();
}

DI void ld_row_f32(const float* row, int lane, f32x4 (&v)[4]) { const f32x4* p = (const f32x4*)row + lane;
#pragma unroll
    for (int j = 0; j < 4; ++j) v[j] = p[64 * j]; }
DI void st_row_f32(float* row, int lane, const f32x4 (&v)[4]) { f32x4* p = (f32x4*)row + lane;
#pragma unroll
    for (int j = 0; j < 4; ++j) p[64 * j] = v[j]; }
DI void ld_row_bf16(const bf16* row, int lane, f32x4 (&v)[4]) { const u32x2* p = (const u32x2*)row + lane;
#pragma unroll
    for (int j = 0; j < 4; ++j) { const u32x2 w = p[64 * j]; v[j] = (f32x4){bflo(w.x), bfhi(w.x), bflo(w.y), bfhi(w.y)}; } }
DI void st_row_bf16(bf16* row, int lane, const f32x4 (&v)[4]) { u32x2* p = (u32x2*)row + lane;
#pragma unroll
    for (int j = 0; j < 4; ++j) { u32x2 w; w.x = cvt_pk_bf16(v[j][0], v[j][1]); w.y = cvt_pk_bf16(v[j][2], v[j][3]); p[64 * j] = w; } }
DI float row_rstd(const f32x4 (&v)[4], int lane) { float s = 0.f;
#pragma unroll
    for (int j = 0; j < 4; ++j) s += (v[j][0] * v[j][0] + v[j][1] * v[j][1]) + (v[j][2] * v[j][2] + v[j][3] * v[j][3]);
    return 1.0f / sqrtf(wave_sum(s, lane) * (1.0f / 1024.0f) + EPS); }
DI void modulate_row(const f32x4 (&h)[4], float rstd, const float* g, const float* sh, const float* sc, int lane, f32x4 (&y)[4]) {
#pragma unroll
    for (int j = 0; j < 4; ++j) { const f32x4 gv = ((const f32x4*)g + lane)[64 * j], shv = ((const f32x4*)sh + lane)[64 * j], scv = ((const f32x4*)sc + lane)[64 * j];
        y[j] = h[j] * rstd * gv * (1.0f + scv) + shv; } }
DI int mod_set(int r) { return r < MLAT ? (r >> 13) : 4; }

DI void ldraw_f32(const float* row, int lane, f32x4 (&v)[4]) { const f32x4* p = (const f32x4*)row + lane;
#pragma unroll
    for (int j = 0; j < 4; ++j) v[j] = p[64 * j]; }
DI void ldraw_bf16(const bf16* row, int lane, u32x2 (&v)[4]) { const u32x2* p = (const u32x2*)row + lane;
#pragma unroll
    for (int j = 0; j < 4; ++j) v[j] = p[64 * j]; }
DI void unpack_bf16(const u32x2 (&w)[4], f32x4 (&v)[4]) {
#pragma unroll
    for (int j = 0; j < 4; ++j) v[j] = (f32x4){bflo(w[j].x), bfhi(w[j].x), bflo(w[j].y), bfhi(w[j].y)}; }
DI void ldvec(const float* p, int lane, f32x4 (&v)[4]) { ldraw_f32(p, lane, v); }
DI void ldmod(const Args& a, const unsigned char* ws, int L, int s, int j, int lane, f32x4 (&v)[4]) {
    ldraw_f32(a.in[I_BADA] + L * 6144 + j * 1024, lane, v);
#pragma unroll 1
    for (int ks = 0; ks < 8; ++ks) { f32x4 t[4]; ldraw_f32((const float*)(ws + WS_MOD) + ((size_t)(L * 8 + ks) * 5 + s) * 6144 + j * 1024, lane, t);
#pragma unroll
        for (int q = 0; q < 4; ++q) v[q] = v[q] + t[q]; }
}

DI void norm0_phase(const Args& a, unsigned char* ws, int wave, int lane) {
    constexpr int RPW = MALL / 256; const int bx = blockIdx.x;
    bf16* Y = (bf16*)(ws + WS_Y);
    if (bx >= 256) return;
    f32x4 g[4], sh[4], sc[4], hn[4]; int cs = -1;
    ldvec(a.in[I_GMPRE], lane, g);
    { const int r = bx * RPW + wave; ldraw_f32(r < MLAT ? a.in[I_X] + (size_t)r * DM : a.in[I_CTX] + (size_t)(r - MLAT) * DM, lane, hn); }
    for (int rr = wave; rr < RPW; rr += NWAVES) {
        const int r = bx * RPW + rr, s = mod_set(r);
        f32x4 h[4], y[4];
#pragma unroll
        for (int j = 0; j < 4; ++j) h[j] = hn[j];
        if (rr + NWAVES < RPW) { const int rn = r + NWAVES; ldraw_f32(rn < MLAT ? a.in[I_X] + (size_t)rn * DM : a.in[I_CTX] + (size_t)(rn - MLAT) * DM, lane, hn); }
        if (s != cs) { ldmod(a, ws, 0, s, 0, lane, sh); ldmod(a, ws, 0, s, 1, lane, sc); cs = s; }
        const float rs = row_rstd(h, lane);
#pragma unroll
        for (int j = 0; j < 4; ++j) y[j] = h[j] * rs * g[j] * (1.0f + sc[j]) + sh[j];
        st_row_bf16(Y + (size_t)r * DM, lane, y);
    }
}

DI void norm_mid_phase(const Args& a, unsigned char* ws, LAS unsigned char* lds, int L, int tid, int wave, int lane) {
    const int M = L == 0 ? MALL : MLAT, RPW = M / 256, bx = blockIdx.x;
    const bool moe = (L == 1);
    LAS int* cnt = (LAS int*)(lds + LDSCTL_OFF + LC_CNT);
    __syncthreads();
    if (tid < 8) cnt[tid] = 0;
    LAS float* wrl = (LAS float*)(lds + 4096);
    if (moe) { f32x4 w4[2048 / NTHR];
#pragma unroll
        for (int k = 0; k < 2048 / NTHR; ++k) w4[k] = ((const f32x4*)a.in[I_WR])[tid + k * NTHR];
#pragma unroll
        for (int k = 0; k < 2048 / NTHR; ++k) { const int i = tid + k * NTHR, c = i >> 1, e0 = 4 * (i & 1);
#pragma unroll
            for (int q = 0; q < 4; ++q) wrl[(e0 + q) * 1024 + c] = w4[k][q]; } }
    __syncthreads();
    const bf16* O = (const bf16*)(ws + WS_R + R_O); bf16* Y = (bf16*)(ws + WS_Y);
    bf16* hctx1 = (bf16*)(ws + WS_HCTX); const bf16* h2lat = (const bf16*)a.out + (size_t)MLAT * DM; bf16* h3 = (bf16*)(ws + WS_H3);
    LAS int* rec = (LAS int*)lds;
    if (bx < 256) {
        f32x4 gpost[4], gpre[4], gtm[4], shf[4], scf[4]; u32x4 hr[4], hr2[4]; u32x2 hb[4], hb2[4]; u32x2 on[4], on2[4]; int cs = -1;
        ldvec(a.in[I_GMPOST] + L * DM, lane, gpost); ldvec(a.in[I_GFPRE] + L * DM, lane, gpre);
#define NM_LOAD(rq_, o_, h_, hb_) do { const int rq = (rq_); ldraw_bf16(O + (size_t)rq * DM, lane, o_); \
            if (L == 0) { const u32x4* p_ = (const u32x4*)(rq < MLAT ? a.in[I_X] + (size_t)rq * DM : a.in[I_CTX] + (size_t)(rq - MLAT) * DM) + lane; _Pragma("unroll") for (int j = 0; j < 4; ++j) h_[j] = p_[64 * j]; } \
            else ldraw_bf16(h2lat + (size_t)rq * DM, lane, hb_); } while (0)
#define NM_ROW(rr_) ((L == 0 && SPLITK) ? ((rr_) < 4 ? MLAT + 4 * bx + (rr_) : 128 * bx + ((rr_) - 4)) : bx * RPW + (rr_))
        NM_LOAD(NM_ROW(wave), on, hr, hb);
        if (wave + NWAVES < RPW) NM_LOAD(NM_ROW(wave + NWAVES), on2, hr2, hb2);
        for (int rr = wave; rr < RPW; rr += NWAVES) {
            const int r = NM_ROW(rr), s = mod_set(r);
            bf16* hout = L == 0 ? (r < MLAT ? (bf16*)a.out + (size_t)r * DM : hctx1 + (size_t)(r - MLAT) * DM) : h3 + (size_t)r * DM;
            f32x4 o[4], h[4], y[4]; unpack_bf16(on, o);
#pragma unroll
            for (int j = 0; j < 4; ++j) h[j] = L == 0 ? __builtin_bit_cast(f32x4, hr[j]) : (f32x4){bflo(hb[j].x), bfhi(hb[j].x), bflo(hb[j].y), bfhi(hb[j].y)};
#pragma unroll
            for (int j = 0; j < 4; ++j) { on[j] = on2[j]; hr[j] = hr2[j]; hb[j] = hb2[j]; }
            if (rr + 2 * NWAVES < RPW) NM_LOAD(NM_ROW(rr + 2 * NWAVES), on2, hr2, hb2);
            if (SPLITK && L == 0 && r >= MLAT) {
#pragma unroll
                for (int j = 0; j < 4; ++j) o[j] = (f32x4){0.f, 0.f, 0.f, 0.f};
#pragma unroll 2
                for (int ks = 0; ks < 4; ++ks) { f32x4 t4[4]; ldraw_f32((const float*)(ws + WS_R + R_T) + ((size_t)ks * MCTX + (r - MLAT)) * DM, lane, t4);
#pragma unroll
                    for (int j = 0; j < 4; ++j) o[j] = o[j] + t4[j]; }
            }
            if (s != cs) { ldmod(a, ws, L, s, 2, lane, gtm); ldmod(a, ws, L, s, 3, lane, shf); ldmod(a, ws, L, s, 4, lane, scf); cs = s; }
            const float ro = row_rstd(o, lane);
#pragma unroll
            for (int j = 0; j < 4; ++j) h[j] = h[j] + gtm[j] * (o[j] * ro * gpost[j]);
            st_row_bf16(hout, lane, h);
            const float rh = row_rstd(h, lane);
#pragma unroll
            for (int j = 0; j < 4; ++j) y[j] = h[j] * rh * gpre[j] * (1.0f + scf[j]) + shf[j];
            if (moe || FP8_DGU) { unsigned* y8 = (unsigned*)((unsigned char*)Y + (size_t)r * DM) + lane;
#pragma unroll
                for (int j = 0; j < 4; ++j) y8[64 * j] = pg8::pk_fp8x4(y[j][0] * pg8::S8_Y, y[j][1] * pg8::S8_Y, y[j][2] * pg8::S8_Y, y[j][3] * pg8::S8_Y); }
            else st_row_bf16(Y + (size_t)r * DM, lane, y);
            if (moe) {
                float lg[8];
#pragma unroll
                for (int e = 0; e < 8; ++e) { float acc = 0.f;
#pragma unroll
                    for (int j = 0; j < 4; ++j) { const f32x4 w4 = *(const LAS f32x4*)(wrl + e * 1024 + 4 * lane + 256 * j); acc += (y[j][0] * w4[0] + y[j][1] * w4[1]) + (y[j][2] * w4[2] + y[j][3] * w4[3]); }
                    lg[e] = acc; }
#pragma unroll
                for (int e = 0; e < 8; ++e) lg[e] = wave_sum(lg[e], lane) + a.in[I_BR][e];
                int i0 = 0; float v0 = lg[0];
#pragma unroll
                for (int e = 1; e < 8; ++e) if (lg[e] > v0) { v0 = lg[e]; i0 = e; }
                int i1 = -1; float v1 = -3.0e38f;
#pragma unroll
                for (int e = 0; e < 8; ++e) if (e != i0 && lg[e] > v1) { v1 = lg[e]; i1 = e; }
                const float g0 = 1.0f / (1.0f + expf(v1 - v0)), g1 = 1.0f - g0;
                if (lane == 0) { const int p0 = __hip_atomic_fetch_add(&cnt[i0], 1, __ATOMIC_RELAXED, __HIP_MEMORY_SCOPE_WORKGROUP), p1 = __hip_atomic_fetch_add(&cnt[i1], 1, __ATOMIC_RELAXED, __HIP_MEMORY_SCOPE_WORKGROUP);
                    rec[rr * 4 + 0] = (i0 << 16) | p0; rec[rr * 4 + 1] = __float_as_int(g0); rec[rr * 4 + 2] = (i1 << 16) | p1; rec[rr * 4 + 3] = __float_as_int(g1); }
            }
        }
    }
    if (moe) {
        __syncthreads();
        if (bx < 256 && tid < 8) cnt[8 + tid] = __hip_atomic_fetch_add((int*)(ws + WS_CTL) + CW_GCNT + tid, cnt[tid], __ATOMIC_RELAXED, __HIP_MEMORY_SCOPE_AGENT);
        __syncthreads();
        if (bx < 256 && tid < 2 * RPW) { const int rr = tid >> 1, k = tid & 1, r = bx * RPW + rr; const int info = rec[rr * 4 + 2 * k], e = info >> 16, slot = e * CAP + cnt[8 + e] + (info & 0xffff);
            ((int*)(ws + WS_RT1 + RT1_TOK))[slot] = r; ((int*)(ws + WS_RT1 + RT1_DST))[slot] = k * MALL + r; ((int*)(ws + WS_RT1 + RT1_GATE))[slot] = rec[rr * 4 + 2 * k + 1]; }
    }
}

#undef NM_LOAD
#undef NM_ROW
DI void norm_end_phase(const Args& a, unsigned char* ws, int L, int wave, int lane) {
    const int M = L == 0 ? MALL : MLAT, RPW = M / 256, bx = blockIdx.x; const bool moe = (L == 1);
    const bf16* F = (const bf16*)(ws + WS_R + R_F); bf16* Y = (bf16*)(ws + WS_Y);
    const bf16* hctx1 = (const bf16*)(ws + WS_HCTX); bf16* hctx2 = (bf16*)(ws + WS_HCTX) + (size_t)MCTX * DM; bf16* h2lat = (bf16*)a.out + (size_t)MLAT * DM; const bf16* h3 = (const bf16*)(ws + WS_H3);
    if (bx >= 256) return;
    f32x4 gpost[4], gnx[4], gtf[4], shn[4], scn[4]; u32x2 f0n[4], hbn[4]; unsigned q0[4], q1[4], q02[4], q12[4]; int cs = -1;
    ldvec(a.in[I_GFPOST] + L * DM, lane, gpost); ldvec(a.in[I_GMPRE] + DM, lane, gnx);
#define NE_HIN(r_) (L == 0 ? ((r_) < MLAT ? (const bf16*)a.out + (size_t)(r_) * DM : hctx1 + (size_t)((r_) - MLAT) * DM) : h3 + (size_t)(r_) * DM)
#define NE_ROW(rr_) (L == 0 ? ((rr_) < 4 ? MLAT + 4 * bx + (rr_) : 128 * bx + ((rr_) - 4)) : bx * RPW + (rr_))
    u32x2 f0n2[4], hbn2[4];
#define NE_LOAD(rq_, f0_, q0_, q1_, hb_) do { const int rq = (rq_); \
        if (moe) { const unsigned* p0_ = (const unsigned*)((const unsigned char*)F + (size_t)rq * DM) + lane; const unsigned* p1_ = (const unsigned*)((const unsigned char*)F + (size_t)(MALL + rq) * DM) + lane; \
            _Pragma("unroll") for (int j = 0; j < 4; ++j) { q0_[j] = p0_[64 * j]; q1_[j] = p1_[64 * j]; } } \
        else ldraw_bf16(F + (size_t)rq * DM, lane, f0_); \
        ldraw_bf16(NE_HIN(rq), lane, hb_); } while (0)
    NE_LOAD(NE_ROW(wave), f0n, q0, q1, hbn);
    if (wave + NWAVES < RPW) NE_LOAD(NE_ROW(wave + NWAVES), f0n2, q02, q12, hbn2);
    for (int rr = wave; rr < RPW; rr += NWAVES) {
        const int r = NE_ROW(rr), s = mod_set(r);
        f32x4 f[4], h[4]; unpack_bf16(hbn, h);
        if (moe) {
#pragma unroll
            for (int j = 0; j < 4; ++j) { const int a0 = (int)q0[j], a1 = (int)q1[j];
                f[j] = (f32x4){__builtin_amdgcn_cvt_f32_fp8(a0, 0) + __builtin_amdgcn_cvt_f32_fp8(a1, 0), __builtin_amdgcn_cvt_f32_fp8(a0, 1) + __builtin_amdgcn_cvt_f32_fp8(a1, 1),
                               __builtin_amdgcn_cvt_f32_fp8(a0, 2) + __builtin_amdgcn_cvt_f32_fp8(a1, 2), __builtin_amdgcn_cvt_f32_fp8(a0, 3) + __builtin_amdgcn_cvt_f32_fp8(a1, 3)} * (1.0f / pg8::S8_F); }
        } else unpack_bf16(f0n, f);
#pragma unroll
        for (int j = 0; j < 4; ++j) { f0n[j] = f0n2[j]; q0[j] = q02[j]; q1[j] = q12[j]; hbn[j] = hbn2[j]; }
        if (rr + 2 * NWAVES < RPW) NE_LOAD(NE_ROW(rr + 2 * NWAVES), f0n2, q02, q12, hbn2);
        if (SPLITK && L == 0 && r >= MLAT) {
#pragma unroll
            for (int j = 0; j < 4; ++j) f[j] = (f32x4){0.f, 0.f, 0.f, 0.f};
#pragma unroll 2
            for (int ks = 0; ks < (FP8_DDN ? 7 : 14); ++ks) { f32x4 t[4]; ldraw_f32((const float*)(ws + WS_R + (FP8_DDN ? R_PART : R_PART0)) + ((size_t)ks * MCTX + (r - MLAT)) * DM, lane, t);
#pragma unroll
                for (int j = 0; j < 4; ++j) f[j] = f[j] + t[j]; }
            if (FP8_DDN) {
#pragma unroll
                for (int j = 0; j < 4; ++j) f[j] = f[j] * (1.0f / (pg8::S8_ACT * pg8::S8_W)); }
        }
        if (s != cs) { ldmod(a, ws, L, s, 5, lane, gtf); if (L == 0) { ldmod(a, ws, 1, s, 0, lane, shn); ldmod(a, ws, 1, s, 1, lane, scn); } cs = s; }
        const float rf = row_rstd(f, lane);
#pragma unroll
        for (int j = 0; j < 4; ++j) h[j] = h[j] + gtf[j] * (f[j] * rf * gpost[j]);
        if (L == 0) st_row_bf16(r < MLAT ? h2lat + (size_t)r * DM : hctx2 + (size_t)(r - MLAT) * DM, lane, h);
        else st_row_f32(a.out + (size_t)r * DM, lane, h);
        if (L == 0) { f32x4 y[4]; const float rh = row_rstd(h, lane);
#pragma unroll
            for (int j = 0; j < 4; ++j) y[j] = h[j] * rh * gnx[j] * (1.0f + scn[j]) + shn[j];
            st_row_bf16(Y + (size_t)r * DM, lane, y); }
    }
#undef NE_HIN
#undef NE_ROW
#undef NE_LOAD
}

constexpr int AT_KS = 0, AT_VT = 9216, AT_BUF = 19456;
DI void attn_unit(LAS unsigned char* lds, const bf16* Z, bf16* OC, const float* sinkL, int u, int tid, int wave, int lane) {
    int b, blk, kh; bool isctx;
    if (u < 512) { kh = u & 1; blk = (u >> 1) & 63; b = u >> 7; isctx = false; } else { const int j = u - 512; kh = j & 1; blk = (j >> 1) & 1; b = j >> 2; isctx = true; }
    const int qrowbase = isctx ? (MLAT + b * NCTX + 128 * blk) : (b * NLAT + 128 * blk);
    const int hq = 4 * kh + (wave & 3), qrow0 = (wave >> 2) * 64, i16 = lane & 15, h4 = lane >> 4;
    bf16x8 Qf[4][2];
#pragma unroll
    for (int qt = 0; qt < 4; ++qt)
#pragma unroll
        for (int ks = 0; ks < 2; ++ks) Qf[qt][ks] = *(const bf16x8*)(Z + (size_t)(qrowbase + qrow0 + 16 * qt + i16) * NZ + ZQ + 64 * hq + 32 * ks + 8 * h4);
    float mrun[4], lrun[4]; f32x4 o[4][4];
    const float sk = sinkL[hq] * LOG2E;
#pragma unroll
    for (int qt = 0; qt < 4; ++qt) { mrun[qt] = sk; lrun[qt] = (h4 == 0) ? 1.f : 0.f;
#pragma unroll
        for (int dt = 0; dt < 4; ++dt) o[dt][qt] = (f32x4){0.f, 0.f, 0.f, 0.f}; }
    const int ntl = isctx ? 0 : 6, ntt = ntl + 4;
#define AT_TILE(t, kr, mt, k0) (((t) < ntl) ? ((kr) = b * NLAT + 128 * (blk - 1 + ((t) >> 1)) + 64 * ((t) & 1), (mt) = ((t) >> 1) == 0 ? 1 : (((t) >> 1) == 2 ? 2 : 0), (k0) = 64 * ((t) & 1), (blk - 1 + ((t) >> 1)) >= 0 && (blk - 1 + ((t) >> 1)) <= 63) \
                                            : ((kr) = MLAT + b * NCTX + 64 * ((t) - ntl), (mt) = 0, (k0) = 0, true))
    const int skey = tid >> 3, sch = tid & 7;
#define AT_LOAD(kr) do { const bf16* src = Z + (size_t)((kr) + skey) * NZ; kvr = *(const u32x4*)(src + ZK + 64 * kh + 8 * sch); vvr = *(const u32x4*)(src + ZVV + 64 * kh + 8 * sch); } while (0)
#define AT_STORE(pb_) do { *(LAS u32x4*)(lds + (pb_) * AT_BUF + AT_KS + skey * 144 + sch * 16) = kvr; *(LAS u32x4*)(lds + (pb_) * AT_BUF + AT_VT + skey * 160 + sch * 16) = vvr; } while (0)
    u32x4 kvr, vvr;
    int tix = 0, krow0 = 0, cmtype = 0, ckb0 = 0, nmtype = 0, nkb0 = 0, pb = 0;
    while (tix < ntt && !AT_TILE(tix, krow0, cmtype, ckb0)) ++tix;
    AT_LOAD(krow0);
    __syncthreads();
    AT_STORE(0);
#pragma unroll
    for (int qt = 0; qt < 4; ++qt)
#pragma unroll
        for (int ks = 0; ks < 2; ++ks) asm volatile("" : "+v"(Qf[qt][ks]));
    ++tix; while (tix < ntt && !AT_TILE(tix, krow0, nmtype, nkb0)) ++tix;
    bool nvalid = tix < ntt;
    if (nvalid) AT_LOAD(krow0);
    __syncthreads();
    for (;;) {
        int n2mtype = 0, n2kb0 = 0; bool n2valid = false;
        if (nvalid) { AT_STORE(pb ^ 1);
            ++tix; while (tix < ntt && !AT_TILE(tix, krow0, n2mtype, n2kb0)) ++tix;
            n2valid = tix < ntt; if (n2valid) AT_LOAD(krow0); }
        const LAS unsigned char* ldt = lds + pb * AT_BUF;
        const bool skipw = (cmtype == 1 && ckb0 < qrow0) || (cmtype == 2 && ckb0 > qrow0);
        if (!skipw) {
        f32x4 sa[4][4];
#pragma unroll
        for (int kt = 0; kt < 4; ++kt)
#pragma unroll
            for (int qt = 0; qt < 4; ++qt) { const float nm = -mrun[qt]; sa[kt][qt] = (f32x4){nm, nm, nm, nm}; }
#pragma unroll
        for (int ks = 0; ks < 2; ++ks)
#pragma unroll
            for (int kt = 0; kt < 4; ++kt) { const bf16x8 ak = *(const LAS bf16x8*)(ldt + AT_KS + (16 * kt + i16) * 144 + (32 * ks + 8 * h4) * 2);
#pragma unroll
                for (int qt = 0; qt < 4; ++qt) sa[kt][qt] = mfma16(ak, Qf[qt][ks], sa[kt][qt]); }
        if (cmtype && ckb0 == qrow0) {
            int ln; asm volatile("v_mbcnt_lo_u32_b32 %0, -1, 0\n\tv_mbcnt_hi_u32_b32 %0, -1, %0" : "=v"(ln));
            const int dl = 4 * (ln >> 4) - (ln & 15);
            if (cmtype == 1) {
#pragma unroll
                for (int kt = 0; kt < 4; ++kt)
#pragma unroll
                    for (int qt = 0; qt < 4; ++qt) {
                        if (kt < qt) sa[kt][qt] = (f32x4){-1.0e30f, -1.0e30f, -1.0e30f, -1.0e30f};
                        else if (kt == qt) {
#pragma unroll
                            for (int r = 0; r < 4; ++r) if (dl + r < 0) sa[kt][qt][r] = -1.0e30f; } }
            } else {
#pragma unroll
                for (int kt = 0; kt < 4; ++kt)
#pragma unroll
                    for (int qt = 0; qt < 4; ++qt) {
                        if (kt > qt) sa[kt][qt] = (f32x4){-1.0e30f, -1.0e30f, -1.0e30f, -1.0e30f};
                        else if (kt == qt) {
#pragma unroll
                            for (int r = 0; r < 4; ++r) if (dl + r > 0) sa[kt][qt][r] = -1.0e30f; } }
            }
        }
#pragma unroll
        for (int qt = 0; qt < 4; ++qt) {
            float mx = vmax3(vmax3(vmax3(sa[0][qt][0], sa[0][qt][1], sa[0][qt][2]), vmax3(sa[0][qt][3], sa[1][qt][0], sa[1][qt][1]), sa[1][qt][2]),
                             vmax3(sa[1][qt][3], sa[2][qt][0], sa[2][qt][1]), vmax3(vmax3(sa[2][qt][2], sa[2][qt][3], sa[3][qt][0]), vmax3(sa[3][qt][1], sa[3][qt][2], sa[3][qt][3]), sa[3][qt][3]));
            if (__builtin_amdgcn_ballot_w64(mx > 6.0f) != 0ull) {
                mx = xrow16_max(mx);
                const float dl = fmaxf(mx, 0.f), alpha = fexp2(-dl); mrun[qt] += dl; lrun[qt] *= alpha;
#pragma unroll
                for (int kt = 0; kt < 4; ++kt) sa[kt][qt] = sa[kt][qt] - dl;
#pragma unroll
                for (int dt = 0; dt < 4; ++dt) o[dt][qt] = o[dt][qt] * alpha;
            }
            f32x2 ps = (f32x2){0.f, 0.f};
#pragma unroll
            for (int kt = 0; kt < 4; ++kt) { f32x4 p; p[0] = fexp2(sa[kt][qt][0]); p[1] = fexp2(sa[kt][qt][1]); p[2] = fexp2(sa[kt][qt][2]); p[3] = fexp2(sa[kt][qt][3]); sa[kt][qt] = p;
                ps = ps + (f32x2){p[0], p[1]} + (f32x2){p[2], p[3]}; }
            lrun[qt] += ps.x + ps.y;
        }
#pragma unroll
        for (int s = 0; s < 2; ++s) {
            bf16x8 pf[4];
#pragma unroll
            for (int qt = 0; qt < 4; ++qt) { u32x4 w; const f32x4 p0 = sa[2 * s][qt], p1 = sa[2 * s + 1][qt];
                w.x = cvt_pk_bf16(p0[0], p0[1]); w.y = cvt_pk_bf16(p0[2], p0[3]); w.z = cvt_pk_bf16(p1[0], p1[1]); w.w = cvt_pk_bf16(p1[2], p1[3]); pf[qt] = __builtin_bit_cast(bf16x8, w); }
#pragma unroll
            for (int dt = 0; dt < 4; ++dt) {
                const LAS unsigned char* vp = ldt + AT_VT + (32 * s + 4 * h4 + (i16 >> 2)) * 160 + (16 * dt + 4 * (i16 & 3)) * 2;
                const v4i16_t lo = __builtin_amdgcn_ds_read_tr16_b64_v4i16((LAS v4i16_t*)vp), hi = __builtin_amdgcn_ds_read_tr16_b64_v4i16((LAS v4i16_t*)(vp + 16 * 160)); const bf16x8 av = __builtin_shufflevector(lo, hi, 0, 1, 2, 3, 4, 5, 6, 7);
#pragma unroll
                for (int qt = 0; qt < 4; ++qt) o[dt][qt] = mfma16(av, pf[qt], o[dt][qt]); }
        }
        }
        if (!nvalid) break;
        __syncthreads();
        pb ^= 1; cmtype = nmtype; ckb0 = nkb0; nvalid = n2valid; nmtype = n2mtype; nkb0 = n2kb0;
    }
#undef AT_LOAD
#undef AT_STORE
    const int trs = (((lane & 3) << 4) | (lane >> 2)) << 2;
#pragma unroll
    for (int qt = 0; qt < 4; ++qt) { const float lt = xrow16_sum(lrun[qt]); const float inv = 1.0f / lt;
        bf16* orow = OC + (size_t)(qrowbase + qrow0 + 16 * qt + (lane >> 2)) * DM + 512 + 64 * hq + 4 * (lane & 3);
#pragma unroll
        for (int dt = 0; dt < 4; ++dt) { const f32x4 v = o[dt][qt] * inv; u32x2 w; w.x = (unsigned)__builtin_amdgcn_ds_bpermute(trs, (int)cvt_pk_bf16(v[0], v[1])); w.y = (unsigned)__builtin_amdgcn_ds_bpermute(trs, (int)cvt_pk_bf16(v[2], v[3])); *(u32x2*)(orow + 16 * dt) = w; } }
#undef AT_TILE
}

DI void sgu_unit(LAS unsigned char* lds, const bf16* Z, bf16* OC, const bf16* wsb, const float* bs, const float* gv, int c, int tid, int wave, int lane) {
    const int rowbase = 128 * c, i16 = lane & 15, h4 = lane >> 4, p = 16 * wave + i16;
    __syncthreads();
    const int pc = tid & 31, sh = pc >> 3;
    u32x4 v[8];
#pragma unroll
    for (int k = 0; k < 8; ++k) v[k] = *(const u32x4*)(Z + (size_t)(rowbase + (tid >> 5) + 16 * k) * NZ + ZV + 8 * pc);
    const f32x4 ga = *(const f32x4*)(gv + 8 * pc), gb = *(const f32x4*)(gv + 8 * pc + 4);
    const int lr = lane >> 2, lp = lane & 3;
    const int mfl = ((i16 << 2) | h4) << 2, trs = ((lp << 4) | lr) << 2;
    u32x4 bwn[4]; u32x2 uun[4]; float bn;
#define SG_LDH(hh_) do { _Pragma("unroll") for (int ks = 0; ks < 4; ++ks) bwn[ks] = *(const u32x4*)(wsb + ((size_t)(hh_) * 128 + 16 * wave + lr) * 128 + 32 * ks + 8 * lp); \
        _Pragma("unroll") for (int ct = 0; ct < 4; ++ct) uun[ct] = *(const u32x2*)(Z + (size_t)(rowbase + 16 * wave + lr) * NZ + ZU + 64 * (hh_) + 16 * ct + 4 * lp); \
        bn = bs[(hh_) * 128 + p]; } while (0)
    SG_LDH(0);
#pragma unroll
    for (int k = 0; k < 8; ++k) { float ss = 0.f;
#pragma unroll
        for (int q2 = 0; q2 < 4; ++q2) { const float x0 = bflo(v[k][q2]), x1 = bfhi(v[k][q2]); ss += x0 * x0 + x1 * x1; }
        ss += dppx<0xB1>(ss); ss += dppx<0x4E>(ss); ss += dppx<0x141>(ss);
        const float rstd = 1.0f / sqrtf(ss * (1.0f / 64.0f) + EPS);
        u32x4 w;
        w.x = cvt_pk_bf16(bflo(v[k].x) * rstd * ga[0], bfhi(v[k].x) * rstd * ga[1]); w.y = cvt_pk_bf16(bflo(v[k].y) * rstd * ga[2], bfhi(v[k].y) * rstd * ga[3]);
        w.z = cvt_pk_bf16(bflo(v[k].z) * rstd * gb[0], bfhi(v[k].z) * rstd * gb[1]); w.w = cvt_pk_bf16(bflo(v[k].w) * rstd * gb[2], bfhi(v[k].w) * rstd * gb[3]);
        *(LAS u32x4*)(lds + ((tid >> 5) + 16 * k) * 544 + pc * 16) = w; }
    __syncthreads();
#pragma unroll
    for (int hh = 0; hh < 4; ++hh) {
        u32x4 bw[4]; u32x2 uu[4]; const float bias = bn;
#pragma unroll
        for (int k = 0; k < 4; ++k) { bw[k] = bwn[k]; uu[k] = uun[k]; }
        if (hh < 3) SG_LDH(hh + 1);
        f32x4 acc[4];
#pragma unroll
        for (int ct = 0; ct < 4; ++ct) acc[ct] = (f32x4){0.f, 0.f, 0.f, 0.f};
#pragma unroll
        for (int ks = 0; ks < 4; ++ks) { u32x4 t;
            t.x = (unsigned)__builtin_amdgcn_ds_bpermute(mfl, (int)bw[ks].x); t.y = (unsigned)__builtin_amdgcn_ds_bpermute(mfl, (int)bw[ks].y); t.z = (unsigned)__builtin_amdgcn_ds_bpermute(mfl, (int)bw[ks].z); t.w = (unsigned)__builtin_amdgcn_ds_bpermute(mfl, (int)bw[ks].w);
            const bf16x8 bwf = __builtin_bit_cast(bf16x8, t);
#pragma unroll
            for (int ct = 0; ct < 4; ++ct) { const bf16x8 av = trfrag(lds + 32 * ks * 544 + (hh * 64 + 16 * ct) * 2, 544, lane); acc[ct] = mfma16(av, bwf, acc[ct]); } }
#pragma unroll
        for (int ct = 0; ct < 4; ++ct) { f32x4 t;
#pragma unroll
            for (int r = 0; r < 4; ++r) t[r] = __builtin_bit_cast(float, __builtin_amdgcn_ds_bpermute(trs, __builtin_bit_cast(int, acc[ct][r] + bias)));
            u32x2 w; w.x = cvt_pk_bf16(bflo(uu[ct].x) * t[0], bfhi(uu[ct].x) * t[1]); w.y = cvt_pk_bf16(bflo(uu[ct].y) * t[2], bfhi(uu[ct].y) * t[3]);
            *(u32x2*)(OC + (size_t)(rowbase + 16 * wave + lr) * DM + 64 * hh + 16 * ct + 4 * lp) = w; }
    }
#undef SG_LDH
}

DI void fft1_unit(LAS unsigned char* lds, const bf16* Z, bf16* T, const bf16* G1, int u, int tid, int wave, int lane) {
    const int n2g = u & 31, g = (u >> 5) & 3, b = u >> 7, i16 = lane & 15, h4 = lane >> 4;
    __syncthreads();
    constexpr int PB = 544;
    { const int ch = tid & 7, n2l = (tid >> 3) & 3, k0 = tid >> 5;
      u32x4 v[8];
#pragma unroll
      for (int it = 0; it < 8; ++it) { const int k = k0 + 16 * it, pq = k >> 6, n1 = k & 63;
          v[it] = *(const u32x4*)(Z + (size_t)(b * NLAT + 128 * n1 + 4 * n2g + n2l) * NZ + ZP + 256 * pq + 64 * g + 8 * ch); }
#pragma unroll
      for (int it = 0; it < 8; ++it) { const int k = k0 + 16 * it;
          *(LAS u32x4*)(lds + k * PB + (n2l * 64 + 8 * ch) * 2) = v[it]; } }
    __syncthreads();
    bf16x8 ga[4];
#pragma unroll
    for (int ks = 0; ks < 4; ++ks) ga[ks] = *(const bf16x8*)(G1 + (16 * wave + i16) * 128 + 32 * ks + 8 * h4);
    const int k1a = 8 * wave + 2 * h4;
#pragma unroll 4
    for (int ct = 0; ct < 16; ++ct) {
        f32x4 acc = (f32x4){0.f, 0.f, 0.f, 0.f};
#pragma unroll
        for (int ks = 0; ks < 4; ++ks) { const bf16x8 bd = trfrag(lds + 32 * ks * PB + 32 * ct, PB, lane); acc = mfma16(ga[ks], bd, acc); }
        const int n2 = 4 * n2g + (ct >> 2), e2 = 16 * (ct & 3) + i16;
#pragma unroll
        for (int hf = 0; hf < 2; ++hf) { const int k1 = k1a + hf; const float ar = acc[2 * hf], mai = acc[2 * hf + 1];
            const float fr = (float)((k1 * n2) & 8191) * (1.0f / 8192.0f), c = __builtin_amdgcn_cosf(fr), s = __builtin_amdgcn_sinf(fr);
            const float apr = ar * c - mai * s, api = -mai * c - ar * s;
            const size_t base = ((((size_t)(b * 4 + g) * 64 + k1) * 2) * 128 + n2) * 64 + e2;
            T[base] = f2bf(apr); T[base + 128 * 64] = f2bf(api); }
    }
}

template <int KD> DI void dft_unit(LAS unsigned char* lds, const bf16* Gt, const bf16* P0, const bf16* P1, int pitch, bf16* outp, int rstride, float scale, int tid, int wave, int lane) {
    constexpr int PB = 160; const int i16 = lane & 15, h4 = lane >> 4;
    __syncthreads();
    { const int ch = tid & 7, r0 = tid >> 3;
      u32x4 v[KD / 64];
#pragma unroll
      for (int it = 0; it < KD / 64; ++it) { const int k = r0 + 64 * it, pl = k / (KD / 2), rr = k % (KD / 2);
          v[it] = *(const u32x4*)((pl ? P1 : P0) + (size_t)rr * pitch + 8 * ch); }
#pragma unroll
      for (int it = 0; it < KD / 64; ++it) { const int k = r0 + 64 * it;
          *(LAS u32x4*)(lds + k * PB + 16 * ch) = v[it]; } }
    __syncthreads();
    f32x4 acc[4];
#pragma unroll
    for (int ct = 0; ct < 4; ++ct) acc[ct] = (f32x4){0.f, 0.f, 0.f, 0.f};
#pragma unroll 4
    for (int ks = 0; ks < KD / 32; ++ks) { const bf16x8 gb = *(const bf16x8*)(Gt + (size_t)(16 * wave + i16) * KD + 32 * ks + 8 * h4);
#pragma unroll
        for (int ct = 0; ct < 4; ++ct) { const bf16x8 ad = trfrag(lds + 32 * ks * PB + 32 * ct, PB, lane); acc[ct] = mfma16(ad, gb, acc[ct]); } }
    bf16* orow = outp + (size_t)rstride * (16 * wave + i16) * DM + 4 * h4;
#pragma unroll
    for (int ct = 0; ct < 4; ++ct) { const f32x4 v = acc[ct] * scale; u32x2 w; w.x = cvt_pk_bf16(v[0], v[1]); w.y = cvt_pk_bf16(v[2], v[3]); *(u32x2*)(orow + 16 * ct) = w; }
}

DI void fft3_phase(LAS unsigned char* lds, const bf16* T, const bf16* G3, bf16* OC, int bx, int G, int tid, int wave, int lane) {
    constexpr int PB = 160, BUF = 256 * PB; const int i16 = lane & 15, h4 = lane >> 4, ch = tid & 7, r0 = tid >> 3;
    int u = bx; if (u >= 1024) return;
    bf16x8 gb[8];
#pragma unroll
    for (int ks = 0; ks < 8; ++ks) gb[ks] = *(const bf16x8*)(G3 + (size_t)(16 * wave + i16) * 256 + 32 * ks + 8 * h4);
    if (G == 256) {
        u32x4 va[4][4];
#pragma unroll
        for (int i = 0; i < 4; ++i) { const bf16* p_ = T + (size_t)(bx + 256 * i) * 2 * 8192 + (size_t)r0 * 64 + 8 * ch;
#pragma unroll
            for (int it = 0; it < 4; ++it) va[i][it] = *(const u32x4*)(p_ + (size_t)it * 64 * 64); }
        __syncthreads();
#pragma unroll
        for (int it = 0; it < 4; ++it) *(LAS u32x4*)(lds + (r0 + 64 * it) * PB + 16 * ch) = va[0][it];
        __syncthreads();
        const int trs = (((lane & 3) << 4) | (lane >> 2)) << 2;
#pragma unroll
        for (int i = 0; i < 4; ++i) { const int uu = bx + 256 * i;
            if (i < 3) {
#pragma unroll
                for (int it = 0; it < 4; ++it) *(LAS u32x4*)(lds + ((i + 1) & 1) * BUF + (r0 + 64 * it) * PB + 16 * ch) = va[i + 1][it]; }
            const LAS unsigned char* ldt = lds + (i & 1) * BUF;
            f32x4 acc[4];
#pragma unroll
            for (int ct = 0; ct < 4; ++ct) acc[ct] = (f32x4){0.f, 0.f, 0.f, 0.f};
#pragma unroll
            for (int ks = 0; ks < 8; ++ks)
#pragma unroll
                for (int ct = 0; ct < 4; ++ct) { const bf16x8 ad = trfrag(ldt + 32 * ks * PB + 32 * ct, PB, lane); acc[ct] = mfma16(ad, gb[ks], acc[ct]); }
            const int k1 = uu & 63, g = (uu >> 6) & 3, b = uu >> 8;
            bf16* orow = OC + (size_t)(b * NLAT + k1 + 64 * (16 * wave + (lane >> 2))) * DM + 256 + 64 * g + 4 * (lane & 3);
#pragma unroll
            for (int ct = 0; ct < 4; ++ct) { const f32x4 w4 = acc[ct] * (1.0f / 724.0773439350247f); u32x2 w; w.x = (unsigned)__builtin_amdgcn_ds_bpermute(trs, (int)cvt_pk_bf16(w4[0], w4[1])); w.y = (unsigned)__builtin_amdgcn_ds_bpermute(trs, (int)cvt_pk_bf16(w4[2], w4[3])); *(u32x2*)(orow + 16 * ct) = w; }
            if (i < 3) __syncthreads(); }
        return;
    }
    u32x4 v[4];
#define F3_LOAD(uu) do { const bf16* p_ = T + (size_t)(uu) * 2 * 8192 + (size_t)r0 * 64 + 8 * ch; _Pragma("unroll") for (int it = 0; it < 4; ++it) v[it] = *(const u32x4*)(p_ + (size_t)it * 64 * 64); } while (0)
#define F3_STORE(pb_) do { _Pragma("unroll") for (int it = 0; it < 4; ++it) *(LAS u32x4*)(lds + (pb_) * BUF + (r0 + 64 * it) * PB + 16 * ch) = v[it]; } while (0)
    F3_LOAD(u);
    __syncthreads();
    F3_STORE(0);
    int un = u + G; bool nvalid = un < 1024;
    if (nvalid) F3_LOAD(un);
    __syncthreads();
    int pb = 0;
    for (;;) {
        int u2 = un + G; bool n2valid = false;
        if (nvalid) { F3_STORE(pb ^ 1); n2valid = u2 < 1024; if (n2valid) F3_LOAD(u2); }
        const LAS unsigned char* ldt = lds + pb * BUF;
        f32x4 acc[4];
#pragma unroll
        for (int ct = 0; ct < 4; ++ct) acc[ct] = (f32x4){0.f, 0.f, 0.f, 0.f};
#pragma unroll
        for (int ks = 0; ks < 8; ++ks)
#pragma unroll
            for (int ct = 0; ct < 4; ++ct) { const bf16x8 ad = trfrag(ldt + 32 * ks * PB + 32 * ct, PB, lane); acc[ct] = mfma16(ad, gb[ks], acc[ct]); }
        const int k1 = u & 63, g = (u >> 6) & 3, b = u >> 8;
        bf16* orow = OC + (size_t)(b * NLAT + k1 + 64 * (16 * wave + (lane >> 2))) * DM + 256 + 64 * g + 4 * (lane & 3);
        const int trs = (((lane & 3) << 4) | (lane >> 2)) << 2;
#pragma unroll
        for (int ct = 0; ct < 4; ++ct) { const f32x4 w4 = acc[ct] * (1.0f / 724.0773439350247f); u32x2 w; w.x = (unsigned)__builtin_amdgcn_ds_bpermute(trs, (int)cvt_pk_bf16(w4[0], w4[1])); w.y = (unsigned)__builtin_amdgcn_ds_bpermute(trs, (int)cvt_pk_bf16(w4[2], w4[3])); *(u32x2*)(orow + 16 * ct) = w; }
        if (!nvalid) break;
        __syncthreads();
        pb ^= 1; u = un; un = u2; nvalid = n2valid;
    }
#undef F3_LOAD
#undef F3_STORE
}

constexpr int PH_L = 20, PH_END = 2 + 2 * PH_L;
__global__ void __launch_bounds__(NTHR, 2) fwd_kernel(Args args) {
    extern __shared__ __attribute__((aligned(16))) unsigned char lds_raw[];
    LAS unsigned char* const lds0 = (LAS unsigned char*)lds_raw;
    const int tid0 = threadIdx.x; const int wave0 = __builtin_amdgcn_readfirstlane(tid0 >> 6);
    const int G0 = gridDim.x, bx0 = blockIdx.x;
    unsigned char* ws0 = args.ws;
#define PHASE_REGS() int bx = bx0, G = G0; asm volatile("" : "+s"(bx), "+s"(G)); LAS unsigned char* lds = lds0; asm volatile("" : "+s"(lds)); int tid; asm volatile("v_mbcnt_lo_u32_b32 %0, -1, 0\n\tv_mbcnt_hi_u32_b32 %0, -1, %0" : "=v"(tid)); tid += wave0 * 64; GAS unsigned char* wsg_ = (GAS unsigned char*)ws0; asm volatile("" : "+s"(wsg_)); unsigned char* ws = (unsigned char*)wsg_; const int lane = tid & 63, wave = __builtin_amdgcn_readfirstlane(tid >> 6); (void)lane; (void)wave; \
    bf16* Z = (bf16*)(ws + WS_R + R_Z); bf16* OC = (bf16*)(ws + WS_R + R_OC); bf16* TT = (bf16*)(ws + WS_R + R_T); bf16* Y = (bf16*)(ws + WS_Y); (void)Z; (void)OC; (void)TT; (void)Y
    for (int u = tid0; u < (LDS_BYTES - LDSCTL_OFF) / 4; u += NTHR) ((LAS unsigned*)(lds0 + LDSCTL_OFF))[u] = 0u;
    __syncthreads();
#if MK_MULTI
#define GRID_BAR() do { } while (0)
#else
    XcdBarrier bar = xcd_barrier_post((unsigned*)(ws0 + WS_CTL) + CW_BAR, (volatile LAS unsigned*)(lds0 + LDSCTL_OFF + LC_BAR));
#define GRID_BAR() do { XcdBarrier b_ = bar; { GAS unsigned* bp_ = (GAS unsigned*)bar.bar; asm volatile("" : "+s"(bp_)); b_.bar = (unsigned*)bp_; } int l_; asm volatile("v_mbcnt_lo_u32_b32 %0, -1, 0\n\tv_mbcnt_hi_u32_b32 %0, -1, %0" : "=v"(l_)); xcd_barrier(b_, wave0 == 0 && l_ == 0); if (MK_PROBE == 40) xcd_barrier(b_, wave0 == 0 && l_ == 0); } while (0)
#endif
    const int lo = args.ph_lo, hi = args.ph_hi;
#define IN(k) (lo <= (k) && (k) < hi)
#define TAIL_FILL(id, nunits) do { if (FILL) { PHASE_REGS(); const int nu_ = (nunits), last_ = nu_ - ((nu_ + G - 1) / G - 1) * G; int* dn_ = (int*)(ws + WS_CTL) + CW_DONE + 64 * (L * 16 + (id)); \
        if (last_ < G) { if (bx < last_) { if (tid == 0) __hip_atomic_fetch_add(dn_, 1, __ATOMIC_RELAXED, __HIP_MEMORY_SCOPE_AGENT); } else cvt_filler(args, ws, lds, tid, wave, lane, dn_, 1); } } } while (0)
#define SEAM(k) do { if (IN(k) && IN((k) + 1)) GRID_BAR(); } while (0)

    if (EN(0) && IN(0)) { PHASE_REGS(); for (int rep = 0; rep < REP(1); ++rep) prologue_a(args, ws, lds, tid, wave, lane); }
    SEAM(0);
    if (EN(1) && IN(1)) { PHASE_REGS(); for (int rep = 0; rep < REP(2); ++rep) norm0_phase(args, ws, wave, lane); }
    SEAM(1);

#pragma unroll 1
    for (int L = 0; L < 2; ++L) {
        const int pb = 2 + PH_L * L;
        if (EN(2) && IN(pb + 0)) { PHASE_REGS();
            pg8::SchedIn S{G, bx, L == 0 ? 28 : 4, L == 0, (const char*)(ws + WS_W + W_IN) + (size_t)L * NZ * 1024 * 2, 2048};
            { LAS f32x4* rl = (LAS f32x4*)(lds + LDSCTL_OFF + LC_ROPE); const f32x4* src = (const f32x4*)(ws + WS_TAB + T_ROPE); const f32x4 r0_ = src[tid], r1_ = src[tid + NTHR]; rl[tid] = r0_; rl[tid + NTHR] = r1_; __syncthreads(); }
            pg8::EpiZ E{Z, (const LAS float*)(lds + LDSCTL_OFF + LC_ROPE), (const LAS float*)(lds + LDSCTL_OFF + LC_ROPE) + 2048};
            pg8::gemm_phase<pg8::EpiZ, pg8::SchedIn, false, false>(lds, (const unsigned char*)Y, 2048, S, E, tid);
        }
        if (IN(pb + 0)) TAIL_FILL(0, 896 + (L == 0 ? 28 : 4));
        SEAM(pb + 0);
        if (IN(pb + 1)) {
            const int nattn = L == 0 ? 528 : 512, nsgu = L == 0 ? 264 : 256;
            if (EN(3)) { PHASE_REGS(); for (int rep = 0; rep < REP(3); ++rep) { for (int u = bx; u < 512; u += G) attn_unit(lds, Z, OC, args.in[I_SINK] + L * 8, u, tid, wave, lane);
                { PHASE_REGS(); for (int u = 512 + ((bx + 16) % G); u < nattn; u += G) attn_unit(lds, Z, OC, args.in[I_SINK] + L * 8, u, tid, wave, lane); } } }
            if (EN(4)) { PHASE_REGS(); for (int rep = 0; rep < REP(4); ++rep) { for (int u = bx; u < 256; u += G) sgu_unit(lds, Z, OC, (const bf16*)(ws + WS_TAB + T_WS) + (size_t)L * 4 * 128 * 128, args.in[I_BS] + L * 512, args.in[I_GV] + L * 256, u, tid, wave, lane);
                for (int u = 256 + ((bx + 32) % G); u < nsgu; u += G) sgu_unit(lds, Z, OC, (const bf16*)(ws + WS_TAB + T_WS) + (size_t)L * 4 * 128 * 128, args.in[I_BS] + L * 512, args.in[I_GV] + L * 256, u, tid, wave, lane); } }
            if (EN(5)) { PHASE_REGS(); for (int rep = 0; rep < REP(5); ++rep) for (int u = bx; u < 512; u += G) fft1_unit(lds, Z, TT, (const bf16*)(ws + WS_TAB + T_G1), u, tid, wave, lane); }
            if (L == 0) { PHASE_REGS(); for (int u = (bx + 96) % G; u < 32; u += G) {     const int mh = u & 1, g = (u >> 1) & 3, b = u >> 3; const bf16* zr = Z + (size_t)(MLAT + b * NCTX) * NZ;
                dft_unit<512>(lds, (const bf16*)(ws + WS_TAB + T_GC) + (size_t)128 * mh * 512, zr + ZP + 64 * g, zr + ZQI + 64 * g, NZ, OC + (size_t)(MLAT + b * NCTX + 128 * mh) * DM + 256 + 64 * g, 1, 1.0f / 128.0f, tid, wave, lane); } }
            __syncthreads();
            if (FILL && L == 0 && G0 == 256) { PHASE_REGS();
                const bool extra = bx >= 240 || (bx >= 224 && bx < 232) || (bx >= 160 && bx < 192);
                int* dn_ = (int*)(ws + WS_CTL) + CW_DONE + 64 * 15;
                if (extra) { if (tid == 0) __hip_atomic_fetch_add(dn_, 1, __ATOMIC_RELAXED, __HIP_MEMORY_SCOPE_AGENT); } else cvt_filler(args, ws, lds, tid, wave, lane, dn_, 1); }
        }
        SEAM(pb + 1);
        if (EN(6) && IN(pb + 2)) { PHASE_REGS();
            for (int rep = 0; rep < REP(6); ++rep) fft3_phase(lds, TT, (const bf16*)(ws + WS_TAB + T_G3), OC, bx, G, tid, wave, lane);
            __syncthreads();
        }
        SEAM(pb + 2);
        if (EN(7) && IN(pb + 3)) { PHASE_REGS();
            pg8::SchedPlain S{G, bx, (L == 0 && !SPLITK) ? 132 : 128, 4, (const char*)(ws + WS_W + W_OUT) + (size_t)L * 1024 * 1024 * 2, 2048};
            pg8::EpiO E{(bf16*)(ws + WS_R + R_O), DM};
            pg8::gemm_phase<pg8::EpiO, pg8::SchedPlain, false, false>(lds, (const unsigned char*)OC, 2048, S, E, tid);
        }
        if (EN(7) && IN(pb + 3) && L == 0 && SPLITK) { PHASE_REGS();
            pg8::SchedSplit S{G, bx, 4, 4, 4, 4, (const char*)(ws + WS_W + W_OUT), 2048};
            pg8::EpiPart E{(float*)(ws + WS_R + R_T), MCTX, DM};
            pg8::gemm_phase<pg8::EpiPart, pg8::SchedSplit, false, false>(lds, (const unsigned char*)(OC + (size_t)MLAT * DM), 2048, S, E, tid, 4);
        }
        if (IN(pb + 3)) TAIL_FILL(3, (L == 0 && SPLITK) ? 512 + 64 : (L == 0 ? 132 : 128) * 4);
        SEAM(pb + 3);
        if (EN(8) && IN(pb + 4)) { PHASE_REGS(); for (int rep = 0; rep < (L == 0 ? REP(7) : 1); ++rep) norm_mid_phase(args, ws, lds, L, tid, wave, lane); }
        if (IN(pb + 4) && L == 1) { PHASE_REGS(); cvt_filler(args, ws, lds, tid, wave, lane, nullptr, 0); }
        SEAM(pb + 4);
#pragma unroll 1
        for (int c = 0; c < 5; ++c) {
            const bool any = IN(pb + 6 + 2 * c) || IN(pb + 7 + 2 * c);
            int ntiles = 0;
            PHASE_REGS();
            if (any) {
                LAS int* tlw = (LAS int*)(lds + LDSCTL_OFF + LC_TILE);
                int pre[9]; pre[0] = 0;
#pragma unroll
                for (int e = 0; e < 8; ++e) { const int ce = L == 0 ? (e == 0 ? MALL : 0) : __builtin_amdgcn_readfirstlane(__hip_atomic_load((int*)(ws + WS_CTL) + CW_GCNT + e, RLX_AGENT)); pre[e + 1] = pre[e] + ((ce + 255) >> 8); }
                ntiles = pre[8];
                __syncthreads();
                for (int t = tid; t < ntiles && t < 512; t += NTHR) { int e = 0;
#pragma unroll
                    for (int q = 1; q < 8; ++q) if (pre[q] <= t) e = q;
                    int pe = 0;
#pragma unroll
                    for (int q = 0; q < 8; ++q) if (q == e) pe = pre[q];
                    tlw[t] = (e << 24) | ((L == 0 ? 0 : e * CAP) + 256 * (t - pe)); }
                __syncthreads(); }
            const int CT = L == 0 ? CHUNK_TILES : 128;
            const int t0 = c * CT; int nM = ntiles - t0;
            if (L == 0 && SPLITK && !FP8_DDN) { if (c == 0) nM = nM > CT ? CT : nM; else if (c > 1) nM = 0; }
            else if (L == 1 && !MK_MULTI) { if (c == 0) nM = nM > CT ? CT : nM; else if (c > 1) nM = 0; }
            else nM = nM > CT ? CT : nM;
            unsigned char* const actb = (L == 0 && SPLITK && !FP8_DDN) ? ws + WS_R - ACT0_BACK : (L == 1 && !MK_MULTI) ? ws + WS_R - ACT1_BACK : ws + WS_R + R_ACT;
            if (!MK_MULTI && nM <= 0) break;
            const LAS int* tl = (const LAS int*)(lds + LDSCTL_OFF + LC_TILE);
            const int* tokmap = L == 0 ? (const int*)(ws + WS_RT + RT_TOK) : (const int*)(ws + WS_RT1 + RT1_TOK);
            const int* dstmap = L == 0 ? (const int*)(ws + WS_RT + RT_DST) : (const int*)(ws + WS_RT1 + RT1_DST);
            const float* gatemap = L == 0 ? (const float*)(ws + WS_RT + RT_GATE) : (const float*)(ws + WS_RT1 + RT1_GATE);
            if (EN(10) && IN(pb + 6 + 2 * c) && nM > 0) {
                if (L == 0 && FP8_DGU && !FP8_DDN) { PHASE_REGS();
                    pg8::SchedGrp S{G, bx, t0, nM, 28, (const char*)(ws + WS_W + W_GUD), (size_t)0, 1024, tl, tokmap, true, MK_PROBE == 21};
                    pg8::EpiGUm E{(bf16*)actb, t0};
                    pg8::gemm_phase<pg8::EpiGUm, pg8::SchedGrp, true, true>(lds, (const unsigned char*)Y, 1024, S, E, tid);
                    TAIL_FILL(4 + 2 * c, nM * 28);
                } else if (L == 0 && !FP8_DGU) { PHASE_REGS();
                    pg8::SchedGrp S{G, bx, t0, nM, 28, (const char*)(ws + WS_W + W_GUD), (size_t)0, 2048, tl, tokmap, true, MK_PROBE == 21};
                    pg8::EpiGU E{(bf16*)(ws + WS_R + R_ACT), t0};
                    pg8::gemm_phase<pg8::EpiGU, pg8::SchedGrp, true, false>(lds, (const unsigned char*)Y, 2048, S, E, tid);
                    TAIL_FILL(4 + 2 * c, nM * 28);
                } else { PHASE_REGS();
                    pg8::SchedGrp S{G, bx, t0, nM, 28, (const char*)(ws + WS_W + (L == 0 ? W_GUD : W_GUE)), L == 0 ? (size_t)0 : (size_t)7168 * 1024, 1024, tl, tokmap, true, MK_PROBE == 23};
                    pg8::EpiGU8 E{(unsigned char*)actb, t0};
                    pg8::gemm_phase<pg8::EpiGU8, pg8::SchedGrp, true, true>(lds, (const unsigned char*)Y, 1024, S, E, tid);
                }
            }
            SEAM(pb + 6 + 2 * c);
            if (EN(11) && IN(pb + 7 + 2 * c) && nM > 0) {
                if (L == 0 && SPLITK && c == 2 && FP8_DDN) { PHASE_REGS();
                    pg8::SchedSplit S{G, bx, nM, 4, 7, 4, (const char*)(ws + WS_W + W_DD), DFF};
                    pg8::EpiPart E{(float*)(ws + WS_R + R_PART), nM * 256, DM};
                    pg8::gemm_phase<pg8::EpiPart, pg8::SchedSplit, false, true>(lds, (const unsigned char*)(ws + WS_R + R_ACT), DFF, S, E, tid, 4);
                } else if (L == 0 && !FP8_DDN) {
                    const int ng = (SPLITK && nM > CHUNK_TILES) ? CHUNK_TILES : nM;
                    { PHASE_REGS();
                      pg8::SchedGrp S{G, bx, t0, ng, 4, (const char*)(ws + WS_W + W_DD), (size_t)0, 2 * DFF, tl, tokmap, false, MK_PROBE == 22};
                      pg8::EpiDown E{(bf16*)(ws + WS_R + R_F), dstmap, gatemap};
                      pg8::gemm_phase<pg8::EpiDown, pg8::SchedGrp, false, false>(lds, (const unsigned char*)actb, 2 * DFF, S, E, tid); }
                    if (nM > ng) { PHASE_REGS();
                      pg8::SchedSplit S{G, bx, nM - ng, 4, 14, 4, (const char*)(ws + WS_W + W_DD), 2 * DFF};
                      pg8::EpiPart E{(float*)(ws + WS_R + R_PART0), (nM - ng) * 256, DM};
                      pg8::gemm_phase<pg8::EpiPart, pg8::SchedSplit, false, false>(lds, (const unsigned char*)actb + (size_t)ng * 256 * 2 * DFF, 2 * DFF, S, E, tid, 4); }
                } else { PHASE_REGS();
                    pg8::SchedGrp S{G, bx, t0, nM, 4, (const char*)(ws + WS_W + (L == 0 ? W_DD : W_DE)), L == 0 ? (size_t)0 : (size_t)1024 * DFF, DFF, tl, tokmap, false, MK_PROBE == 24};
                    pg8::EpiDown8 E{(bf16*)(ws + WS_R + R_F), dstmap, gatemap};
                    pg8::gemm_phase<pg8::EpiDown8, pg8::SchedGrp, false, true>(lds, (const unsigned char*)actb, DFF, S, E, tid);
                }
            }
            SEAM(pb + 7 + 2 * c);
        }
        if (EN(12) && IN(pb + 16)) { PHASE_REGS(); norm_end_phase(args, ws, L, wave, lane); }
        if (L == 0) SEAM(pb + 16);
    }
#undef IN
#undef SEAM
}

extern "C" void kernel_launch(void* const* d_in, const int* in_sizes, int n_in, void* d_out, int out_size, void* d_ws, size_t ws_size, hipStream_t stream) {
    static int grid = 0;
    if (grid == 0) {
        if (n_in != 25 || out_size != MLAT * DM || ws_size < WS_END) { fprintf(stderr, "kernel_launch: unexpected shapes (n_in %d out %d ws %zu, need %zu)\n", n_in, out_size, ws_size, (size_t)WS_END); grid = -1; return; }
        int dev = 0, cus = 0, per_cu = 0;
        if (hipGetDevice(&dev) != hipSuccess || hipDeviceGetAttribute(&cus, hipDeviceAttributeMultiprocessorCount, dev) != hipSuccess) { grid = -1; return; }
        if (hipFuncSetAttribute((const void*)fwd_kernel, hipFuncAttributeMaxDynamicSharedMemorySize, LDS_BYTES) != hipSuccess) { fprintf(stderr, "kernel_launch: hipFuncSetAttribute failed\n"); grid = -1; return; }
        if (hipOccupancyMaxActiveBlocksPerMultiprocessor(&per_cu, (const void*)fwd_kernel, NTHR, LDS_BYTES) != hipSuccess || per_cu < 1) fprintf(stderr, "kernel_launch: occupancy query says %d\n", per_cu);
        (void)hipGetLastError();
        grid = cus > 256 ? 256 : cus;
    }
    if (grid < 0) return;
    (void)hipMemsetAsync((char*)d_ws + WS_CTL, 0, CTL_ZERO_BYTES, stream);
    Args a{};
    for (int i = 0; i < 25; ++i) a.in[i] = (const float*)d_in[i];
    a.out = (float*)d_out; a.ws = (unsigned char*)d_ws;
#if MK_MULTI
    for (int p = 0; p < PH_END; ++p) {
        const int k = p < 2 ? -1 : (p - 2) % PH_L;
        if (k > 16 || k == 5) continue;
        a.ph_lo = p; a.ph_hi = p + 1;
        hipLaunchKernelGGL(fwd_kernel, dim3(grid), dim3(NTHR), LDS_BYTES, stream, a);
    }
#else
    a.ph_lo = 0; a.ph_hi = PH_END;
    hipLaunchKernelGGL(fwd_kernel, dim3(grid), dim3(NTHR), LDS_BYTES, stream, a);
#endif
}
```

```cpp
#include <hip/hip_runtime.h>
#include <cstdio>
#include <cstdint>

#ifndef MK_MULTI
#define MK_MULTI 0
#endif
#define SPLITK (!MK_MULTI)
#ifndef MK_EN
#define MK_EN 0xFFFF
#endif
#define EN(b) (((MK_EN) >> (b)) & 1)
#ifndef MK_PROBE
#define MK_PROBE 0
#endif
#define KDUP_IN (MK_PROBE == 20)
#define KDUP_GRP (MK_PROBE >= 21 && MK_PROBE <= 24)
#define REP(k) ((MK_PROBE == (k)) ? 2 : 1)
#ifndef FILL
#define FILL 1
#endif

#define GAS __attribute__((address_space(1)))
#define LAS __attribute__((address_space(3)))
typedef unsigned short bf16;
typedef short bf16x8 __attribute__((ext_vector_type(8)));
typedef float f32x4 __attribute__((ext_vector_type(4)));
typedef float f32x2 __attribute__((ext_vector_type(2)));
typedef unsigned u32x4 __attribute__((ext_vector_type(4)));
typedef unsigned u32x2 __attribute__((ext_vector_type(2)));
typedef int i32x8 __attribute__((ext_vector_type(8)));
typedef GAS unsigned gu32;
#define RLX_AGENT __ATOMIC_RELAXED, __HIP_MEMORY_SCOPE_AGENT
#define LDS_WAIT() asm volatile("s_waitcnt lgkmcnt(0)" ::: "memory")
#define VM_WAIT() asm volatile("s_waitcnt vmcnt(0)" ::: "memory")
#define DI __device__ __forceinline__

constexpr int NB = 4, NLAT = 8192, NCTX = 256, DM = 1024;
constexpr int MLAT = NB * NLAT, MCTX = NB * NCTX, MALL = MLAT + MCTX;
constexpr int NZ = 1792;
constexpr int ZU = 0, ZV = 256, ZP = 512, ZQI = 768, ZQ = 1024, ZK = 1536, ZVV = 1664;
constexpr int DFF = 3584, NE = 8;
constexpr float EPS = 1e-6f, LOG2E = 1.4426950408889634f, QSCALE = 0.125f * 1.4426950408889634f;
constexpr int NWAVES = 8, NTHR = 512;
#ifndef FP8_DGU
#define FP8_DGU 1
#endif
#ifndef FP8_DDN
#define FP8_DDN 0
#endif
constexpr int CHUNK_TILES = 64;

constexpr size_t MiB = 1u << 20;
constexpr size_t WS_CTL = 0, CTL_ZERO_BYTES = 1 * MiB;
constexpr size_t WS_MOD = 6 * MiB;
constexpr size_t WS_TAB = 2 * MiB;
constexpr size_t T_G1 = 0, T_G3 = 32768, T_GC = 98304, T_WS = 360448, T_ROPE = 622592;
constexpr size_t WS_RT = 3 * MiB;
constexpr size_t RT_TOK = 0, RT_DST = 327680, RT_GATE = 655360, RT_TILE = 983040, RT_WGCNT = 985088, RT_ROW = 1 * MiB;
constexpr size_t WS_W = 8 * MiB;
constexpr size_t W_IN = 0, W_OUT = 7 * MiB, W_GUD = 11 * MiB, W_DD = 25 * MiB, W_GUE = 32 * MiB, W_DE = 88 * MiB;
constexpr size_t WS_H3 = 8 * MiB + 120 * MiB;
constexpr size_t WS_HCTX = 208 * MiB;
constexpr size_t WS_Y = 212 * MiB;
constexpr size_t WS_R = 278 * MiB;
constexpr size_t R_Z = 0, R_O = 0, R_OC = 116 * MiB, R_T = 182 * MiB, R_ACT = 0, R_F = 116 * MiB;
constexpr size_t ACT0_BACK = 8 * MiB;
constexpr size_t ACT1_BACK = 16 * MiB;
constexpr size_t R_PART0 = 182 * MiB;
constexpr size_t R_PART = 8 * MiB;
static_assert((size_t)MCTX * DFF * 2 <= 8 * MiB && R_PART + (size_t)14 * MCTX * DM * 4 <= 116 * MiB, "partials fit the activation region");
constexpr size_t WS_RT1 = 278 * MiB + 248 * MiB;
constexpr int CAP = 32768;
constexpr size_t RT1_TOK = 0, RT1_DST = 1 * MiB, RT1_GATE = 2 * MiB;
constexpr size_t WS_END = WS_RT1 + 3 * MiB;
static_assert((size_t)MALL * NZ * 2 <= 116 * MiB && (size_t)(CHUNK_TILES * 256) * DFF * 2 <= 116 * MiB && (size_t)(132 * 256) * DFF <= 116 * MiB && (size_t)2 * MALL * DM * 2 <= 132 * MiB, "ws map");
constexpr int CW_TMO = 0, CW_NTILES = 16, CW_CVT = 32, CW_GCNT = 48, CW_DONE = 64, CW_BAR = 4096;

constexpr int RING_BYTES = 131072, LDSCTL_OFF = RING_BYTES, LDS_BYTES = 163840;
constexpr int LC_ROPE = 16384;
constexpr int LC_BAR = 0;
constexpr int LC_TILE = 64;
constexpr int LC_CNT = 64 + 2048;
constexpr int LC_FILL = 64 + 2048 + 128;

DI unsigned cvt_pk_bf16(float lo, float hi) { unsigned r; asm volatile("v_cvt_pk_bf16_f32 %0, %1, %2" : "=v"(r) : "v"(lo), "v"(hi)); return r; }
DI unsigned short f2bf(float f) { return (unsigned short)(cvt_pk_bf16(f, 0.f) & 0xffffu); }
DI float bflo(unsigned w) { return __uint_as_float(w << 16); }
DI float bfhi(unsigned w) { return __uint_as_float(w & 0xffff0000u); }
DI float shx(float v, int mask, int lane) { return __builtin_bit_cast(float, __builtin_amdgcn_ds_bpermute((lane ^ mask) << 2, __builtin_bit_cast(int, v))); }
template <int CTRL> DI float dppx(float x) { return __builtin_bit_cast(float, __builtin_amdgcn_mov_dpp(__builtin_bit_cast(int, x), CTRL, 0xf, 0xf, true)); }
DI float xrow16_sum(float x) {
    auto s = __builtin_amdgcn_permlane16_swap(__float_as_uint(x), __float_as_uint(x), false, false);
    x = __uint_as_float(s[0]) + __uint_as_float(s[1]);
    auto t = __builtin_amdgcn_permlane32_swap(__float_as_uint(x), __float_as_uint(x), false, false);
    return __uint_as_float(t[0]) + __uint_as_float(t[1]);
}
DI float xrow16_max(float x) {
    auto s = __builtin_amdgcn_permlane16_swap(__float_as_uint(x), __float_as_uint(x), false, false);
    x = fmaxf(__uint_as_float(s[0]), __uint_as_float(s[1]));
    auto t = __builtin_amdgcn_permlane32_swap(__float_as_uint(x), __float_as_uint(x), false, false);
    return fmaxf(__uint_as_float(t[0]), __uint_as_float(t[1]));
}
DI float wave_sum(float v, int) {
    v += dppx<0xB1>(v);
    v += dppx<0x4E>(v);
    v += dppx<0x141>(v);
    v += dppx<0x128>(v);
    return xrow16_sum(v);
}
DI float fexp2(float x) { return __builtin_amdgcn_exp2f(x); }
DI float vmax3(float a, float b, float c) { float r; asm("v_max3_f32 %0, %1, %2, %3" : "=v"(r) : "v"(a), "v"(b), "v"(c)); return r; }
DI float frcp(float x) { return __builtin_amdgcn_rcpf(x); }
DI float gelu_tanh(float x) { const float u = 0.7978845608028654f * (x + 0.044715f * x * x * x); return x * frcp(1.0f + fexp2(-2.0f * LOG2E * u)); }
DI float silu_f(float x) { return x * frcp(1.0f + fexp2(-LOG2E * x)); }
DI f32x4 mfma16(bf16x8 a, bf16x8 b, f32x4 c) { return __builtin_amdgcn_mfma_f32_16x16x32_bf16(a, b, c, 0, 0, 0); }
typedef short v4i16_t __attribute__((ext_vector_type(4)));
DI bf16x8 trfrag(const LAS unsigned char* p, int pitch, int lane) {
    const LAS unsigned char* q = p + (8 * (lane >> 4) + ((lane & 15) >> 2)) * pitch + 8 * (lane & 3);
    const v4i16_t lo = __builtin_amdgcn_ds_read_tr16_b64_v4i16((LAS v4i16_t*)q), hi = __builtin_amdgcn_ds_read_tr16_b64_v4i16((LAS v4i16_t*)(q + 4 * pitch));
    return __builtin_shufflevector(lo, hi, 0, 1, 2, 3, 4, 5, 6, 7);
}

#define XB_TMO      128
#define XB_XCNT(j)  (256  + 64 * (j))
#define XB_XSUB(j)  (1280 + 64 * (j))
#define XB_XGEN(j)  (2304 + 64 * (j))
#define XB_TOP      3328
#define XB_TOPGEN   3392
#define XCD_BAR_WORDS 3456
#define XB_SPIN_CAP (1u << 18)
DI unsigned xb_ld(unsigned* p)              { return __hip_atomic_load(p, __ATOMIC_RELAXED, __HIP_MEMORY_SCOPE_AGENT); }
DI unsigned xb_add(unsigned* p, unsigned v) { return __hip_atomic_fetch_add(p, v, __ATOMIC_RELAXED, __HIP_MEMORY_SCOPE_AGENT); }
DI unsigned xb_xcc_id() { return (unsigned)__builtin_amdgcn_s_getreg((3 << 11) | 20) & 0xFu; }
#define XB_SPIN(cond, bar) do { unsigned _sp = 0; while (cond) { __builtin_amdgcn_s_sleep(1); \
    if ((++_sp & 255u) == 0u) { if (xb_ld(&(bar)[XB_TMO])) break; if (_sp > XB_SPIN_CAP) { atomicAdd(&(bar)[XB_TMO], 1u); break; } } } } while (0)
struct XcdBarrier { unsigned* bar; unsigned x; volatile LAS unsigned* st; };
DI XcdBarrier xcd_barrier_post(unsigned* bar, volatile LAS unsigned* st) {
    XcdBarrier b; b.bar = bar; b.x = xb_xcc_id(); b.st = st;
    if (threadIdx.x == 0) (void)xb_add(&bar[XB_XCNT(b.x)], 1u);
    return b;
}
DI void xcd_barrier_complete(unsigned* bar, unsigned x, unsigned& nloc, unsigned& nx) {
    const unsigned G = gridDim.x * gridDim.y * gridDim.z;
    unsigned sum, cnt, mine, sp = 0u;
    for (;;) {
        sum = 0u; cnt = 0u; mine = 0u;
#pragma unroll
        for (unsigned j = 0; j < 16; ++j) { const unsigned c = xb_ld(&bar[XB_XCNT(j)]); sum += c; cnt += (c > 0u) ? 1u : 0u; mine = (j == x) ? c : mine; }
        if (sum == G) break;
        __builtin_amdgcn_s_sleep(1);
        if ((++sp & 255u) == 0u) { if (xb_ld(&bar[XB_TMO])) break; if (sp > XB_SPIN_CAP) { atomicAdd(&bar[XB_TMO], 1u); break; } }
    }
    nloc = mine > 0u ? mine : 1u; nx = cnt > 0u ? cnt : 1u;
}
DI void xcd_barrier(const XcdBarrier& b, const bool leader) {
    asm volatile("s_waitcnt vmcnt(0)" ::: "memory");
    __syncthreads();
    if (leader) {
        unsigned* bar = b.bar;
        __builtin_amdgcn_s_waitcnt(0);
        unsigned nloc = b.st[0], nx = b.st[1];
        if (nloc == 0u) { xcd_barrier_complete(bar, b.x, nloc, nx); b.st[0] = nloc; b.st[1] = nx; }
        const unsigned old = xb_add(&bar[XB_XSUB(b.x)], 1u);
        const unsigned gen = old / nloc;
        if (old + 1u == (gen + 1u) * nloc) {
            __builtin_amdgcn_fence(__ATOMIC_RELEASE, "agent");
            asm volatile("s_waitcnt vmcnt(0)" ::: "memory");
            const unsigned og = xb_add(&bar[XB_TOP], 1u);
            const unsigned tg = og / nx;
            if (og + 1u == (tg + 1u) * nx) xb_add(&bar[XB_TOPGEN], 1u);
            else XB_SPIN(xb_ld(&bar[XB_TOPGEN]) == tg, bar);
            __builtin_amdgcn_fence(__ATOMIC_ACQUIRE, "agent");
            xb_add(&bar[XB_XGEN(b.x)], 1u);
            asm volatile("s_waitcnt vmcnt(0)" ::: "memory");
        } else {
            XB_SPIN(xb_ld(&bar[XB_XGEN(b.x)]) == gen, bar);
            __builtin_amdgcn_fence(__ATOMIC_ACQUIRE, "agent");
            asm volatile("s_waitcnt vmcnt(0)" ::: "memory");
        }
    }
    __syncthreads();
}

namespace pg8 {
typedef unsigned short bf16_t;
constexpr int BM = 256, BK = 64, HALF = 128, HTB = HALF * BK * 2, STAGE_BYTES = 8 * HTB;
DI int lds_byte(int r, int c) { const int st = (r >> 4) * 2 + (c >> 5), rr = r & 15, cc = c & 31, ob = rr * 64 + cc * 2; return st * 1024 + (ob ^ (((ob >> 9) & 1) << 5)); }
DI void stage_rc(int b, int& R, int& C) { const int st = b / 1024, sb = b % 1024, swz = sb ^ (((sb >> 9) & 1) << 5); R = (st >> 1) * 16 + swz / 64; C = (st & 1) * 32 + (swz % 64) / 2; }
DI int perm32(int rho) { const int n = rho >> 4, i = rho & 15; return 8 * (i >> 2) + 4 * n + (i & 3); }

struct Unit { int pm, pn; int arow; unsigned boff; int dup; int slot0; unsigned kofs; int ks; };

DI void static_map(int wgid, int nM, int nN, int& pm, int& pn) {
    const int nwg = nM * nN; const int q = nwg / 8, r = nwg % 8, xcd = wgid % 8, off = wgid / 8;
    wgid = (xcd < r ? xcd * (q + 1) : r * (q + 1) + (xcd - r) * q) + off;
    const int nig = 8 * nN, gid = wgid / nig, fm = gid * 8, gsz = (nM - fm) < 8 ? (nM - fm) : 8;
    pm = fm + ((wgid % nig) % gsz); pn = (wgid % nig) / gsz;
}

template <class Epi, class Sched, bool GATHER, bool FP8>
DI void gemm_phase(LAS unsigned char* lds, const unsigned char* Abase, const int rowbytes, const Sched& S, const Epi& E, const int tid, const int ntk = 0) {
    const int wid = __builtin_amdgcn_readfirstlane(tid >> 6), lane = tid & 63, wr = wid >> 2, wc = wid & 3, fr = lane & 15, fq = lane >> 4;
    const int nt = ntk ? ntk : rowbytes / 128;
    unsigned voffA, voffB, cofs; int Rr[2];
    { int R, C; stage_rc(tid * 16, R, C); const int Rb = (R & ~31) + perm32(R & 31);
      voffA = (unsigned)(R * rowbytes + C * 2); voffB = (unsigned)(Rb * rowbytes + C * 2); cofs = (unsigned)C * 2u; Rr[0] = R; Rr[1] = R + 64; }
    const unsigned kstep = (unsigned)(BK * 2);
    const unsigned hstep = (unsigned)HALF * (unsigned)rowbytes;
    const unsigned istep = 64u * (unsigned)rowbytes;
    const unsigned rowb = (unsigned)rowbytes;
    const unsigned ldsw = (unsigned)wid * 1024u;
    const int aoff = lds_byte(wr * 64 + fr, fq * 8), boff = lds_byte(wc * 32 + fr, fq * 8);
    const __amdgpu_buffer_rsrc_t rA = __builtin_amdgcn_make_buffer_rsrc((void*)Abase, (short)0, 0x7fffffff, 0x00020000);
    const __amdgpu_buffer_rsrc_t rB = __builtin_amdgcn_make_buffer_rsrc((void*)S.wbase(), (short)0, 0x7fffffff, 0x00020000);
#define PG8_SA(b, h) (((b) * 2 + (h)) * HTB)
#define PG8_SB(b, h) ((4 + (b) * 2 + (h)) * HTB)
#define PG8_DMA(rs, ldsoff, vo, so) __builtin_amdgcn_raw_ptr_buffer_load_lds(rs, (LAS void*)(lds + (ldsoff)), 16, (int)(vo), (int)(so), 0, 0)
#define PG8_STAGE(bufoff, so) do { PG8_DMA(rB, (bufoff) + ldsw, voffB, (so)); PG8_DMA(rB, (bufoff) + ldsw + 8192, voffB, (so) + istep); } while (0)
#define PG8_STAGE_A(bufoff, h, kb, nx) do { if constexpr (GATHER) { PG8_DMA(rA, (bufoff) + ldsw, aoC[h][0], (kb)); PG8_DMA(rA, (bufoff) + ldsw + 8192, aoC[h][1], (kb)); } \
        else { const unsigned so_ = ((nx) ? nA : cA) + (unsigned)(h) * hstep + (kb); PG8_DMA(rA, (bufoff) + ldsw, voffA, so_); PG8_DMA(rA, (bufoff) + ldsw + 8192, voffA, so_ + istep); } } while (0)
#define PG8_LDA(dst, b, h) do { _Pragma("unroll") for (int m = 0; m < 4; ++m) { const u32x4 lo_ = *(const LAS u32x4*)(lds + PG8_SA(b, h) + aoff + m * 2048), hi_ = *(const LAS u32x4*)(lds + PG8_SA(b, h) + aoff + m * 2048 + 1024); \
        dst[m] = (i32x8){(int)lo_.x, (int)lo_.y, (int)lo_.z, (int)lo_.w, (int)hi_.x, (int)hi_.y, (int)hi_.z, (int)hi_.w}; } } while (0)
#define PG8_LDB(dst, b, h) do { _Pragma("unroll") for (int n = 0; n < 2; ++n) { const u32x4 lo_ = *(const LAS u32x4*)(lds + PG8_SB(b, h) + boff + n * 2048), hi_ = *(const LAS u32x4*)(lds + PG8_SB(b, h) + boff + n * 2048 + 1024); \
        dst[n] = (i32x8){(int)lo_.x, (int)lo_.y, (int)lo_.z, (int)lo_.w, (int)hi_.x, (int)hi_.y, (int)hi_.z, (int)hi_.w}; } } while (0)
#define PG8_HALF(v, k) __builtin_bit_cast(bf16x8, __builtin_shufflevector(v, v, 4 * (k), 4 * (k) + 1, 4 * (k) + 2, 4 * (k) + 3))
#define PG8_MMA(ai, bj, At, Bt) do { __builtin_amdgcn_s_setprio(1); if constexpr (FP8) { _Pragma("unroll") for (int m = 0; m < 4; ++m) _Pragma("unroll") for (int n = 0; n < 2; ++n) \
        acc[ai][bj][m][n] = __builtin_amdgcn_mfma_scale_f32_16x16x128_f8f6f4(Bt[n], At[m], acc[ai][bj][m][n], 0, 0, 0, 0, 0, 0); } \
    else { _Pragma("unroll") for (int m = 0; m < 4; ++m) _Pragma("unroll") for (int n = 0; n < 2; ++n) { \
        acc[ai][bj][m][n] = __builtin_amdgcn_mfma_f32_16x16x32_bf16(PG8_HALF(Bt[n], 0), PG8_HALF(At[m], 0), acc[ai][bj][m][n], 0, 0, 0); \
        acc[ai][bj][m][n] = __builtin_amdgcn_mfma_f32_16x16x32_bf16(PG8_HALF(Bt[n], 1), PG8_HALF(At[m], 1), acc[ai][bj][m][n], 0, 0, 0); } } __builtin_amdgcn_s_setprio(0); } while (0)
#define PG8_WAIT_V(n) asm volatile("s_waitcnt vmcnt(" #n ")" ::: "memory")
#define PG8_WAIT_L(n) asm volatile("s_waitcnt lgkmcnt(" #n ")" ::: "memory")
#define PG8_BAR __builtin_amdgcn_s_barrier()
#define PG8_SCHED __builtin_amdgcn_sched_barrier(0)
    Unit cur, nxt; int ui = 0;
    if (!S.next(0, cur)) return;
    f32x4 acc[2][2][4][2];
#pragma unroll
    for (int a = 0; a < 2; ++a)
#pragma unroll
        for (int b = 0; b < 2; ++b)
#pragma unroll
            for (int m = 0; m < 4; ++m)
#pragma unroll
                for (int n = 0; n < 2; ++n) acc[a][b][m][n] = (f32x4){0.f, 0.f, 0.f, 0.f};
    i32x8 At[4], B0[2], B1[2];
    unsigned aoC[2][2];
    LAS unsigned short* gidx = (LAS unsigned short*)(lds + 131072 + 4096);
    unsigned cA = (unsigned)cur.arow * rowb + cur.kofs, cB = cur.boff + cur.kofs;
    if constexpr (GATHER) {
        Unit pu;
        for (int i = 0; i < 16 && S.next(i, pu); ++i) if (tid < 256) gidx[i * 256 + tid] = (unsigned short)S.rowidx(pu.arow + tid);
        __syncthreads();
    }
#pragma unroll
    for (int h = 0; h < 2; ++h)
#pragma unroll
        for (int i = 0; i < 2; ++i) aoC[h][i] = GATHER ? (unsigned)gidx[128 * h + Rr[i]] * rowb + cofs : 0u;
    unsigned nA = cA, nB = cB;
    PG8_STAGE(PG8_SB(0, 0), cB); PG8_STAGE(PG8_SB(0, 1), cB + hstep); PG8_STAGE_A(PG8_SA(0, 0), 0, 0u, false); PG8_STAGE_A(PG8_SA(0, 1), 1, 0u, false);
    if (wr == 1) PG8_BAR;
    PG8_WAIT_V(2); PG8_BAR;
    PG8_STAGE(PG8_SB(1, 0), cB + kstep); PG8_STAGE_A(PG8_SA(1, 0), 0, kstep, false); PG8_STAGE(PG8_SB(1, 1), cB + hstep + kstep);
    PG8_WAIT_V(6); PG8_BAR;
    for (;;) {
        const bool has_next = S.next(ui + 1, nxt);
        nA = has_next ? (unsigned)nxt.arow * rowb + nxt.kofs : cA; nB = has_next ? nxt.boff + nxt.kofs : cB;
#pragma unroll 1
        for (int t = 0; t < nt; t += 2) {
            const bool last = (t == nt - 2);
            const unsigned kb1 = (unsigned)(t + 1) * kstep, kb2 = last ? 0u : (unsigned)(t + 2) * kstep, kb3 = kb2 + kstep;
            const unsigned b2 = (last ? nB : cB) + kb2, b3 = b2 + kstep;
            PG8_LDB(B0, 0, 0); PG8_LDB(B1, 0, 1); PG8_SCHED; PG8_LDA(At, 0, 0); PG8_STAGE_A(PG8_SA(1, 1), 1, kb1, false);
            PG8_WAIT_V(8); PG8_WAIT_L(0); PG8_BAR; PG8_MMA(0, 0, At, B0); PG8_MMA(0, 1, At, B1); PG8_BAR; PG8_SCHED;
            if constexpr (GATHER) { if (last && has_next) { const LAS unsigned short* gi = gidx + (ui + 1) * 256;
                aoC[0][0] = (unsigned)gi[Rr[0]] * rowb + cofs; aoC[0][1] = (unsigned)gi[Rr[1]] * rowb + cofs; aoC[1][0] = (unsigned)gi[128 + Rr[0]] * rowb + cofs; aoC[1][1] = (unsigned)gi[128 + Rr[1]] * rowb + cofs; } }
            PG8_LDA(At, 0, 1); PG8_STAGE(PG8_SB(0, 0), b2); PG8_STAGE(PG8_SB(0, 1), b2 + hstep); PG8_STAGE_A(PG8_SA(0, 0), 0, kb2, last);
            PG8_WAIT_V(8); PG8_WAIT_L(0); PG8_BAR; PG8_MMA(1, 0, At, B0); PG8_MMA(1, 1, At, B1); PG8_BAR; PG8_SCHED;
            PG8_LDB(B0, 1, 0); PG8_LDB(B1, 1, 1); PG8_SCHED; PG8_LDA(At, 1, 0); PG8_STAGE_A(PG8_SA(0, 1), 1, kb2, last);
            PG8_WAIT_V(8); PG8_WAIT_L(0); PG8_BAR; PG8_MMA(0, 0, At, B0); PG8_MMA(0, 1, At, B1); PG8_BAR; PG8_SCHED;
            PG8_LDA(At, 1, 1); PG8_STAGE(PG8_SB(1, 0), b3); PG8_STAGE(PG8_SB(1, 1), b3 + hstep); PG8_STAGE_A(PG8_SA(1, 0), 0, kb3, last);
            PG8_WAIT_V(8); PG8_WAIT_L(0); PG8_BAR; PG8_MMA(1, 0, At, B0); PG8_MMA(1, 1, At, B1); PG8_BAR; PG8_SCHED;
        }
        if (wr == 0) PG8_BAR;
        if (!cur.dup) { int te; asm volatile("v_mbcnt_lo_u32_b32 %0, -1, 0\n\tv_mbcnt_hi_u32_b32 %0, -1, %0" : "=v"(te));
          for (int rep = 0; rep < REP(30); ++rep) E(acc, cur, wr, wc, te & 15, (te & 63) >> 4); }
        if (!has_next) break;
#pragma unroll
        for (int a = 0; a < 2; ++a)
#pragma unroll
            for (int b = 0; b < 2; ++b)
#pragma unroll
                for (int m = 0; m < 4; ++m)
#pragma unroll
                    for (int n = 0; n < 2; ++n) acc[a][b][m][n] = (f32x4){0.f, 0.f, 0.f, 0.f};
        cur = nxt; cA = nA; cB = nB; ++ui;
        if (wr == 1) PG8_BAR;
    }
    PG8_WAIT_V(0);
    PG8_BAR;
#undef PG8_SA
#undef PG8_SB
#undef PG8_STAGE
#undef PG8_DMA
#undef PG8_STAGE_A
#undef PG8_LDA
#undef PG8_LDB
#undef PG8_MMA
#undef PG8_HALF
#undef PG8_WAIT_V
#undef PG8_WAIT_L
#undef PG8_BAR
#undef PG8_SCHED
}

struct SchedIn {
    int G, c, nctx; bool ctx_all; const char* Bt; int rb;
    DI bool next(int i0, Unit& u) const {
        const int i = KDUP_IN ? (i0 >> 1) : i0; u.dup = KDUP_IN ? !(i0 & 1) : 0;
        const long Lx = (long)i * G + c; int pm, pn;
        if (Lx < 896) static_map((int)Lx, 128, 7, pm, pn);
        else { const int j = (int)(Lx - 896); if (j >= nctx) return false; if (ctx_all) { pm = 128 + j / 7; pn = j % 7; } else { pm = 128 + j; pn = 6; } }
        u.pm = pm; u.pn = pn; u.arow = pm * 256; u.boff = (unsigned)(pn * 256 * rb); u.kofs = 0u; u.ks = 0; return true;
    }
    DI int rowidx(int) const { return 0; }
    DI const void* wbase() const { return Bt; }
};
struct SchedPlain {
    int G, c, nM, nN; const char* Bt; int rb;
    DI bool next(int i, Unit& u) const {
        u.dup = 0; const long Lx = (long)i * G + c; if (Lx >= (long)nM * nN) return false; int pm, pn; static_map((int)Lx, nM, nN, pm, pn);
        u.pm = pm; u.pn = pn; u.arow = pm * 256; u.boff = (unsigned)(pn * 256 * rb); u.kofs = 0u; u.ks = 0; return true;
    }
    DI int rowidx(int) const { return 0; }
    DI const void* wbase() const { return Bt; }
};
struct SchedGrp {
    int G, c, t0, nM, nN; const char* W; size_t wstride; int rb; const LAS int* tile_e; const int* tokmap; bool gather; bool kdup;
    DI bool next(int i0, Unit& u) const {
        const int i = (KDUP_GRP && kdup) ? (i0 >> 1) : i0; u.dup = (KDUP_GRP && kdup) ? !(i0 & 1) : 0;
        const long Lx = (long)i * G + c; if (Lx >= (long)nM * nN) return false; int pm, pn; static_map((int)Lx, nM, nN, pm, pn);
        const int te = __builtin_amdgcn_readfirstlane(tile_e[t0 + pm]);
        const int e = te >> 24; u.slot0 = te & 0xffffff;
        u.pm = t0 + pm; u.pn = pn; u.arow = gather ? u.slot0 : pm * 256; u.boff = (unsigned)e * (unsigned)wstride + (unsigned)(pn * 256 * rb); u.kofs = 0u; u.ks = 0; return true;
    }
    DI int rowidx(int slot) const { return tokmap[slot]; }
    DI const void* wbase() const { return W; }
};

struct SchedSplit {
    int G, c, nM, nN, S, ntk; const char* Bt; int rb;
    DI bool next(int i, Unit& u) const {
        const long Lx = (long)i * G + c; if (Lx >= (long)nM * nN * S) return false;
        const int ks = (int)(Lx % S), rest = (int)(Lx / S), pn = rest % nN, pm = rest / nN;
        u.pm = pm; u.pn = pn; u.arow = pm * 256; u.boff = (unsigned)(pn * 256 * rb); u.kofs = (unsigned)(ks * ntk * 128); u.ks = ks; u.dup = 0; u.slot0 = 0; return true;
    }
    DI int rowidx(int) const { return 0; }
    DI const void* wbase() const { return Bt; }
};
#ifndef EPI_NT
#define EPI_NT 0
#endif
#if EPI_NT
#define EPI_ST(p, v) __builtin_nontemporal_store((v), (p))
#else
#define EPI_ST(p, v) (*(p) = (v))
#endif
typedef f32x4 Acc[2][2][4][2];
DI u32x4 tr4(u32x4 w, int te) { const int src = (((te & 3) << 4) | (te >> 2)) << 2; u32x4 r;
    r.x = (unsigned)__builtin_amdgcn_ds_bpermute(src, (int)w.x); r.y = (unsigned)__builtin_amdgcn_ds_bpermute(src, (int)w.y); r.z = (unsigned)__builtin_amdgcn_ds_bpermute(src, (int)w.z); r.w = (unsigned)__builtin_amdgcn_ds_bpermute(src, (int)w.w); return r; }
struct EpiZ {
    bf16_t* Z; const LAS float* rc; const LAS float* rs;
    DI void operator()(const Acc& acc, const Unit& u, int wr, int wc, int fr, int fq) const {
        const int pn = u.pn, row0 = u.pm * 256 + wr * 64 + fr, te = fq * 16 + fr;
        const bool lat = u.pm < 128;
        bf16_t* rowp0 = Z + (size_t)(u.pm * 256 + wr * 64 + (te >> 2)) * NZ + pn * 256 + wc * 32 + 8 * (te & 3);
#pragma unroll
        for (int ai = 0; ai < 2; ++ai)
#pragma unroll
            for (int m = 0; m < 4; ++m) {
                const int row = row0 + ai * 128 + m * 16; bf16_t* rowp = rowp0 + (size_t)(ai * 128 + m * 16) * NZ;
#pragma unroll
                for (int bj = 0; bj < 2; ++bj) {
                    f32x4 v0 = acc[ai][bj][m][0], v1 = acc[ai][bj][m][1];
                    if (pn < 2) {
#pragma unroll
                        for (int j = 0; j < 4; ++j) { v0[j] = gelu_tanh(v0[j]); v1[j] = gelu_tanh(v1[j]); }
                    } else if (pn >= 4 && !(pn == 6 && bj == 1)) {
                        if (lat) {
                            const int n = row & (NLAT - 1); const int pos = (wc & 1) ? (n & 63) : (n >> 6); const int fb = 8 * (fq & 1);
                            const f32x4 c0 = *(const LAS f32x4*)(rc + pos * 16 + fb), c1 = *(const LAS f32x4*)(rc + pos * 16 + fb + 4);
                            const f32x4 s0 = *(const LAS f32x4*)(rs + pos * 16 + fb), s1 = *(const LAS f32x4*)(rs + pos * 16 + fb + 4);
                            const float sg = (fq >> 1) ? 1.f : -1.f;
                            f32x4 p0, p1;
#pragma unroll
                            for (int j = 0; j < 4; ++j) { p0[j] = shx(v0[j], 32, fq * 16 + fr); p1[j] = shx(v1[j], 32, fq * 16 + fr); }
                            v0 = v0 * c0 + sg * p0 * s0; v1 = v1 * c1 + sg * p1 * s1;
                        }
                        if (pn < 6) { v0 = v0 * QSCALE; v1 = v1 * QSCALE; }
                    }
                    u32x4 w; w.x = cvt_pk_bf16(v0[0], v0[1]); w.y = cvt_pk_bf16(v0[2], v0[3]); w.z = cvt_pk_bf16(v1[0], v1[1]); w.w = cvt_pk_bf16(v1[2], v1[3]);
                    EPI_ST((u32x4*)(rowp + bj * 128), tr4(w, te));
                }
            }
    }
};
struct EpiO {
    bf16_t* O; int ldc;
    DI void operator()(const Acc& acc, const Unit& u, int wr, int wc, int fr, int fq) const {
        const int te = fq * 16 + fr, row0 = u.pm * 256 + wr * 64 + (te >> 2), colb = u.pn * 256 + wc * 32 + 8 * (te & 3);
#pragma unroll
        for (int ai = 0; ai < 2; ++ai)
#pragma unroll
            for (int m = 0; m < 4; ++m) { bf16_t* rowp = O + (size_t)(row0 + ai * 128 + m * 16) * ldc + colb;
#pragma unroll
                for (int bj = 0; bj < 2; ++bj) { const f32x4 v0 = acc[ai][bj][m][0], v1 = acc[ai][bj][m][1];
                    u32x4 w; w.x = cvt_pk_bf16(v0[0], v0[1]); w.y = cvt_pk_bf16(v0[2], v0[3]); w.z = cvt_pk_bf16(v1[0], v1[1]); w.w = cvt_pk_bf16(v1[2], v1[3]);
                    EPI_ST((u32x4*)(rowp + bj * 128), tr4(w, te)); } }
    }
};
DI f32x2 swiglu2(f32x2 g, f32x2 u, float c1, float c0, float k0) {
    const f32x2 t = g * c1 + c0; f32x2 e; e.x = fexp2(t.x); e.y = fexp2(t.y);
    const f32x2 d = e + k0; f32x2 r; r.x = frcp(d.x); r.y = frcp(d.y);
    return (g * u) * r;
}
DI f32x2 swiglu2d(f32x2 g, f32x2 u) {
    f32x2 e; e.x = fexp2(-g.x); e.y = fexp2(-g.y);
    const f32x2 d = e * LOG2E + LOG2E; f32x2 r; r.x = frcp(d.x); r.y = frcp(d.y);
    return (g * u) * r;
}
struct EpiGU {
    bf16_t* ACT; int t0;
    DI void operator()(const Acc& acc, const Unit& u, int wr, int wc, int fr, int fq) const {
        const int row0 = (u.pm - t0) * 256 + wr * 64 + fr, colb = u.pn * 128 + wc * 32 + 8 * fq;
#pragma unroll
        for (int ai = 0; ai < 2; ++ai)
#pragma unroll
            for (int m = 0; m < 4; ++m) { bf16_t* rowp = ACT + (size_t)(row0 + ai * 128 + m * 16) * DFF + colb;
                const f32x4 g0 = acc[ai][0][m][0], g1 = acc[ai][0][m][1], u0 = acc[ai][1][m][0], u1 = acc[ai][1][m][1];
                const f32x2 a = swiglu2d((f32x2){g0[0], g0[1]}, (f32x2){u0[0], u0[1]}), b = swiglu2d((f32x2){g0[2], g0[3]}, (f32x2){u0[2], u0[3]});
                const f32x2 c = swiglu2d((f32x2){g1[0], g1[1]}, (f32x2){u1[0], u1[1]}), d = swiglu2d((f32x2){g1[2], g1[3]}, (f32x2){u1[2], u1[3]});
                u32x4 w; w.x = cvt_pk_bf16(a.x, a.y); w.y = cvt_pk_bf16(b.x, b.y); w.z = cvt_pk_bf16(c.x, c.y); w.w = cvt_pk_bf16(d.x, d.y);
                EPI_ST((u32x4*)rowp, w); }
    }
};
struct EpiPart {
    float* P; int rows, ldc;
    DI void operator()(const Acc& acc, const Unit& u, int wr, int wc, int fr, int fq) const {
        const int te = fq * 16 + fr, row0 = u.pm * 256 + wr * 64 + (te >> 2), colb = u.pn * 256 + wc * 32 + 8 * (te & 3);
        float* base = P + (size_t)u.ks * rows * ldc;
#pragma unroll
        for (int ai = 0; ai < 2; ++ai)
#pragma unroll
            for (int m = 0; m < 4; ++m) { float* rowp = base + (size_t)(row0 + ai * 128 + m * 16) * ldc + colb;
#pragma unroll
                for (int bj = 0; bj < 2; ++bj) { *(u32x4*)(rowp + bj * 128) = tr4(__builtin_bit_cast(u32x4, acc[ai][bj][m][0]), te); *(u32x4*)(rowp + bj * 128 + 4) = tr4(__builtin_bit_cast(u32x4, acc[ai][bj][m][1]), te); } }
    }
};
struct EpiDown {
    bf16_t* F; const int* dstmap; const float* gate;
    DI void operator()(const Acc& acc, const Unit& u, int wr, int wc, int fr, int fq) const {
        const int te = fq * 16 + fr, slot0 = u.slot0 + wr * 64 + fr, slot0s = u.slot0 + wr * 64 + (te >> 2), colb = u.pn * 256 + wc * 32 + 8 * (te & 3);
        int dstv[2][4]; float gtv[2][4];
#pragma unroll
        for (int ai = 0; ai < 2; ++ai)
#pragma unroll
            for (int m = 0; m < 4; ++m) { dstv[ai][m] = dstmap[slot0s + ai * 128 + m * 16]; gtv[ai][m] = gate[slot0 + ai * 128 + m * 16]; }
#pragma unroll
        for (int ai = 0; ai < 2; ++ai)
#pragma unroll
            for (int m = 0; m < 4; ++m) { const int dst = dstv[ai][m]; const float gt = gtv[ai][m];
                bf16_t* rowp = F + (size_t)dst * DM + colb;
#pragma unroll
                for (int bj = 0; bj < 2; ++bj) { const f32x4 v0 = acc[ai][bj][m][0] * gt, v1 = acc[ai][bj][m][1] * gt;
                    u32x4 w; w.x = cvt_pk_bf16(v0[0], v0[1]); w.y = cvt_pk_bf16(v0[2], v0[3]); w.z = cvt_pk_bf16(v1[0], v1[1]); w.w = cvt_pk_bf16(v1[2], v1[3]);
                    const u32x4 wt = tr4(w, te);
                    if (dst >= 0) EPI_ST((u32x4*)(rowp + bj * 128), wt); } }
    }
};

constexpr float S8_Y = 16.0f, S8_W = 256.0f, S8_ACT = 8.0f, S8_F = 16.0f;
DI float clamp8(float v) { return __builtin_amdgcn_fmed3f(v, -448.0f, 448.0f); }
DI unsigned pk_fp8x4(float a, float b, float c, float d) { int w0; asm volatile("" : "=v"(w0));
    int w = __builtin_amdgcn_cvt_pk_fp8_f32(clamp8(a), clamp8(b), w0, false); w = __builtin_amdgcn_cvt_pk_fp8_f32(clamp8(c), clamp8(d), w, true); return (unsigned)w; }
struct EpiGU8 {
    unsigned char* ACT; int t0;
    DI void operator()(const Acc& acc, const Unit& u, int wr, int wc, int fr, int fq) const {
        constexpr float us = 1.0f / (S8_Y * S8_W), c1 = -us * LOG2E, c0 = 21.0f, k0 = 2097152.0f;
        static_assert(us * us * S8_ACT * k0 == 1.0f, "k0 = 1 / c2, c0 = log2 k0");
        const int te = fq * 16 + fr, rho = te >> 1, hf = te & 1, srcl = (((2 * hf + (rho >> 4)) << 4) | (rho & 15)) << 2;
        unsigned char* base = ACT + (size_t)((u.pm - t0) * 256 + wr * 64 + rho) * DFF + u.pn * 128 + wc * 32 + 16 * hf;
#pragma unroll
        for (int ai = 0; ai < 2; ++ai)
#pragma unroll
            for (int mp = 0; mp < 4; mp += 2) { u32x2 w[2];
#pragma unroll
                for (int k = 0; k < 2; ++k) { const int m = mp + k;
                    const f32x4 g0 = acc[ai][0][m][0], g1 = acc[ai][0][m][1], u0 = acc[ai][1][m][0], u1 = acc[ai][1][m][1];
                    const f32x2 a = swiglu2((f32x2){g0[0], g0[1]}, (f32x2){u0[0], u0[1]}, c1, c0, k0), b = swiglu2((f32x2){g0[2], g0[3]}, (f32x2){u0[2], u0[3]}, c1, c0, k0);
                    const f32x2 c = swiglu2((f32x2){g1[0], g1[1]}, (f32x2){u1[0], u1[1]}, c1, c0, k0), d = swiglu2((f32x2){g1[2], g1[3]}, (f32x2){u1[2], u1[3]}, c1, c0, k0);
                    w[k].x = pk_fp8x4(a.x, a.y, b.x, b.y); w[k].y = pk_fp8x4(c.x, c.y, d.x, d.y); }
                const auto rx = __builtin_amdgcn_permlane16_swap(w[0].x, w[1].x, false, false), ry = __builtin_amdgcn_permlane16_swap(w[0].y, w[1].y, false, false);
                u32x4 o; o.x = (unsigned)__builtin_amdgcn_ds_bpermute(srcl, (int)rx[0]); o.y = (unsigned)__builtin_amdgcn_ds_bpermute(srcl, (int)ry[0]); o.z = (unsigned)__builtin_amdgcn_ds_bpermute(srcl, (int)rx[1]); o.w = (unsigned)__builtin_amdgcn_ds_bpermute(srcl, (int)ry[1]);
                EPI_ST((u32x4*)(base + (size_t)(ai * 128 + mp * 16) * DFF), o); }
    }
};
struct EpiGUm {
    bf16_t* ACT; int t0;
    DI void operator()(const Acc& acc, const Unit& u, int wr, int wc, int fr, int fq) const {
        const int te = fq * 16 + fr, row0 = (u.pm - t0) * 256 + wr * 64 + (te >> 2), colb = u.pn * 128 + wc * 32 + 8 * (te & 3);
        constexpr float us = 1.0f / (S8_Y * S8_W), c1 = -us * LOG2E, c0 = 24.0f, k0 = 16777216.0f;
        static_assert(us * us * k0 == 1.0f, "k0 = 1 / us^2, c0 = log2 k0");
#pragma unroll
        for (int ai = 0; ai < 2; ++ai)
#pragma unroll
            for (int m = 0; m < 4; ++m) { bf16_t* rowp = ACT + (size_t)(row0 + ai * 128 + m * 16) * DFF + colb;
                const f32x4 g0 = acc[ai][0][m][0], g1 = acc[ai][0][m][1], u0 = acc[ai][1][m][0], u1 = acc[ai][1][m][1];
                const f32x2 a = swiglu2((f32x2){g0[0], g0[1]}, (f32x2){u0[0], u0[1]}, c1, c0, k0), b = swiglu2((f32x2){g0[2], g0[3]}, (f32x2){u0[2], u0[3]}, c1, c0, k0);
                const f32x2 c = swiglu2((f32x2){g1[0], g1[1]}, (f32x2){u1[0], u1[1]}, c1, c0, k0), d = swiglu2((f32x2){g1[2], g1[3]}, (f32x2){u1[2], u1[3]}, c1, c0, k0);
                u32x4 w; w.x = cvt_pk_bf16(a.x, a.y); w.y = cvt_pk_bf16(b.x, b.y); w.z = cvt_pk_bf16(c.x, c.y); w.w = cvt_pk_bf16(d.x, d.y);
                EPI_ST((u32x4*)rowp, tr4(w, te)); }
    }
};
struct EpiDown8 {
    bf16_t* F; const int* dstmap; const float* gate;
    DI void operator()(const Acc& acc, const Unit& u, int wr, int wc, int fr, int fq) const {
        static_assert(!FP8_DDN, "the dense layer's norm_end reads bf16 F rows");
        const int te = fq * 16 + fr, slot0 = u.slot0 + wr * 64 + fr, slot0s = u.slot0 + wr * 64 + (te >> 2), colb = u.pn * 256 + wc * 32 + 8 * (te & 3);
        constexpr float us = S8_F / (S8_ACT * S8_W);
        const int trs = (((te & 3) << 4) | (te >> 2)) << 2;
        int dstv[2][4]; float gtv[2][4];
#pragma unroll
        for (int ai = 0; ai < 2; ++ai)
#pragma unroll
            for (int m = 0; m < 4; ++m) { dstv[ai][m] = dstmap[slot0s + ai * 128 + m * 16]; gtv[ai][m] = gate[slot0 + ai * 128 + m * 16] * us; }
#pragma unroll
        for (int ai = 0; ai < 2; ++ai)
#pragma unroll
            for (int m = 0; m < 4; ++m) { const int dst = dstv[ai][m]; const float gt = gtv[ai][m];
                unsigned char* rowp = (unsigned char*)F + (size_t)dst * DM + colb;
#pragma unroll
                for (int bj = 0; bj < 2; ++bj) { const f32x4 v0 = acc[ai][bj][m][0] * gt, v1 = acc[ai][bj][m][1] * gt;
                    u32x2 w; w.x = (unsigned)__builtin_amdgcn_ds_bpermute(trs, (int)pk_fp8x4(v0[0], v0[1], v0[2], v0[3])); w.y = (unsigned)__builtin_amdgcn_ds_bpermute(trs, (int)pk_fp8x4(v1[0], v1[1], v1[2], v1[3]));
                    if (dst >= 0) *(u32x2*)(rowp + bj * 128) = w; } }
    }
};
}

struct Args { const float* in[25]; float* out; unsigned char* ws; int ph_lo, ph_hi; };
enum { I_X = 0, I_C, I_CTX, I_CCTX, I_WADA, I_BADA, I_GMPRE, I_GMPOST, I_GFPRE, I_GFPOST, I_WIN, I_WS, I_BS, I_GV, I_WF, I_SINK, I_WOUT, I_WGD, I_WUD, I_WDD, I_WR, I_BR, I_WGE, I_WUE, I_WDE };

struct TJob { const float* src; bf16* dst; int K, Nsrc, ncol0, drow0, kb, f8; float sc; };
constexpr int TJ_IN_A = 256, TJ_IN_B = 384, TJ_OUT = 512, TJ_D = 896, TJ_E = 7168;
constexpr int TJ_TOTAL = TJ_IN_A + TJ_IN_B + TJ_OUT + 3 * TJ_D + 3 * TJ_E;
constexpr int TJ_NOW = TJ_IN_A + TJ_IN_B + TJ_OUT + 3 * TJ_D;
constexpr int TJ_DEF = TJ_TOTAL - TJ_NOW, TJ_BATCH = 16;
static_assert(TJ_DEF % TJ_BATCH == 0, "deferred queue is dealt in whole batches");
DI TJob tj_decode(const Args& a, bf16* WB, int it) {
    TJob J; J.f8 = 0; J.sc = 1.0f;
    if (it < TJ_IN_A) { const int L = it / 128, r = it % 128; J.kb = r / 8; const int nb = r % 8;
        J.src = a.in[I_WIN] + (size_t)L * 1024 * 1536; J.K = 1024; J.Nsrc = 1536; J.ncol0 = 64 * nb; J.dst = WB + W_IN / 2 + (size_t)L * NZ * 1024; J.drow0 = 64 * nb; return J; }
    it -= TJ_IN_A;
    if (it < TJ_IN_B) { const int L = it / 192, r = it % 192; J.kb = r / 12; const int nb = r % 12;
        J.src = a.in[I_WIN] + (size_t)L * 1024 * 1536; J.K = 1024; J.Nsrc = 1536; J.ncol0 = 768 + 64 * nb; J.dst = WB + W_IN / 2 + (size_t)L * NZ * 1024; J.drow0 = 1024 + 64 * nb; return J; }
    it -= TJ_IN_B;
    if (it < TJ_OUT) { const int L = it / 256, r = it % 256; J.kb = r / 16; const int nb = r % 16;
        J.src = a.in[I_WOUT] + (size_t)L * 1024 * 1024; J.K = 1024; J.Nsrc = 1024; J.ncol0 = 64 * nb; J.dst = WB + W_OUT / 2 + (size_t)L * 1024 * 1024; J.drow0 = 64 * nb; return J; }
    it -= TJ_OUT;
    if (it < 2 * TJ_D) { const int up = it / TJ_D, r = it % TJ_D; J.kb = r / 56; const int nb = r % 56, f0 = 64 * nb;
        J.src = a.in[up ? I_WUD : I_WGD]; J.K = 1024; J.Nsrc = DFF; J.ncol0 = f0; J.dst = WB + W_GUD / 2; J.drow0 = (f0 / 128) * 256 + (f0 % 128) + 128 * up; J.sc = FP8_DGU ? pg8::S8_W : (up ? 1.0f : LOG2E); J.f8 = FP8_DGU; return J; }
    it -= 2 * TJ_D;
    if (it < TJ_D) { J.kb = it / 16; const int nb = it % 16;
        J.src = a.in[I_WDD]; J.K = DFF; J.Nsrc = 1024; J.ncol0 = 64 * nb; J.dst = WB + W_DD / 2; J.drow0 = 64 * nb; if (FP8_DDN) { J.f8 = 1; J.sc = pg8::S8_W; } return J; }
    it -= TJ_D;
    if (it < 2 * TJ_E) { const int up = it / TJ_E, r0 = it % TJ_E, e = r0 / TJ_D, r = r0 % TJ_D; J.kb = r / 56; const int nb = r % 56, f0 = 64 * nb;
        J.src = a.in[up ? I_WUE : I_WGE] + (size_t)e * 1024 * DFF; J.K = 1024; J.Nsrc = DFF; J.ncol0 = f0; J.dst = (bf16*)((unsigned char*)WB + W_GUE + (size_t)e * 7168 * 1024); J.drow0 = (f0 / 128) * 256 + (f0 % 128) + 128 * up; J.f8 = 1; J.sc = pg8::S8_W; return J; }
    it -= 2 * TJ_E;
    { const int e = it / TJ_D, r = it % TJ_D; J.kb = r / 16; const int nb = r % 16;
        J.src = a.in[I_WDE] + (size_t)e * DFF * 1024; J.K = DFF; J.Nsrc = 1024; J.ncol0 = 64 * nb; J.dst = (bf16*)((unsigned char*)WB + W_DE + (size_t)e * 1024 * DFF); J.drow0 = 64 * nb; J.f8 = 1; J.sc = pg8::S8_W; return J; }
}
DI void tj_load(const TJob& J, int lane, f32x4 (&v)[16]) {
    const float* p = J.src + (size_t)(64 * J.kb + (lane >> 4)) * J.Nsrc + J.ncol0 + 4 * (lane & 15);
#pragma unroll
    for (int i = 0; i < 16; ++i) v[i] = *(const f32x4*)(p + (size_t)(4 * i) * J.Nsrc);
}
DI void tj_store(const TJob& J, LAS float* scr, int lane, const f32x4 (&v)[16]) {
#pragma unroll
    for (int i = 0; i < 16; ++i) { const int k = 4 * i + (lane >> 4); *(LAS f32x4*)(scr + k * 64 + ((4 * (lane & 15)) ^ (4 * ((k >> 3) & 7)))) = v[i]; }
    LDS_WAIT();
    const int c = lane & 7, k0 = 64 * J.kb;
#pragma unroll
    for (int j = 0; j < 8; ++j) { const int n = (lane >> 3) + 8 * j; const LAS float* s = scr + (8 * c) * 64 + (((n & ~3) ^ (4 * c)) + (n & 3));
        const float x0 = s[0 * 64], x1 = s[1 * 64], x2 = s[2 * 64], x3 = s[3 * 64], x4 = s[4 * 64], x5 = s[5 * 64], x6 = s[6 * 64], x7 = s[7 * 64];
        const float sw = J.sc;
        if (J.f8) { u32x2 o; o.x = pg8::pk_fp8x4(x0 * sw, x1 * sw, x2 * sw, x3 * sw); o.y = pg8::pk_fp8x4(x4 * sw, x5 * sw, x6 * sw, x7 * sw);
            *(u32x2*)((unsigned char*)J.dst + (size_t)(J.drow0 + n) * J.K + k0 + 8 * c) = o; }
        else { u32x4 o; o.x = cvt_pk_bf16(x0 * sw, x1 * sw); o.y = cvt_pk_bf16(x2 * sw, x3 * sw); o.z = cvt_pk_bf16(x4 * sw, x5 * sw); o.w = cvt_pk_bf16(x6 * sw, x7 * sw);
            *(u32x4*)(J.dst + (size_t)(J.drow0 + n) * J.K + k0 + 8 * c) = o; } }
    LDS_WAIT();
}

DI void prologue_a(const Args& a, unsigned char* ws, LAS unsigned char* lds, int tid, int wave, int lane) {
    const int G = gridDim.x, bx = blockIdx.x;
    {
        const int gw = bx * NWAVES + wave, NGW = G * NWAVES;
        float* mp = (float*)(ws + WS_MOD);
        for (int it = gw; it < 2 * 96 * 8; it += NGW) {
            const int ks = it & 7, jg = (it >> 3) % 96, L = it / 768, j0 = 64 * jg;
            float sil[5][2];
#pragma unroll
            for (int s = 0; s < 5; ++s)
#pragma unroll
                for (int hf = 0; hf < 2; ++hf) { const int k = 128 * ks + 64 * hf + lane; sil[s][hf] = silu_f(s < 4 ? a.in[I_C][s * 1024 + k] : a.in[I_CCTX][k]); }
            float acc[5] = {0.f, 0.f, 0.f, 0.f, 0.f};
            const float* wp = a.in[I_WADA] + (size_t)L * 1024 * 6144 + (size_t)(128 * ks) * 6144 + j0 + lane;
#pragma unroll
            for (int hf = 0; hf < 2; ++hf)
#pragma unroll 16
                for (int kk = 0; kk < 64; ++kk) { const float w = wp[(size_t)(64 * hf + kk) * 6144];
#pragma unroll
                    for (int s = 0; s < 5; ++s) acc[s] += __builtin_bit_cast(float, __builtin_amdgcn_readlane(__builtin_bit_cast(int, sil[s][hf]), kk)) * w; }
#pragma unroll
            for (int s = 0; s < 5; ++s) mp[((size_t)(L * 8 + ks) * 5 + s) * 6144 + j0 + lane] = acc[s];
        }
    }
    for (int it = bx; it < 256; it += G) {
        const int L = it >> 7, g = (it >> 5) & 3, kblk = it & 31;
        LAS float* Mt = (LAS float*)lds; LAS float* Wl = (LAS float*)(lds + 32768);
        __syncthreads();
        const float* wf = a.in[I_WF] + (size_t)(L * 4 + g) * 4096;
        LAS float* trg = (LAS float*)(lds + 49152); LAS float* wfl = (LAS float*)(lds + 49152 + 512);
        if (tid < 128) { const float fr = (float)(tid & 63) * (1.0f / 64.0f); trg[tid] = tid < 64 ? __builtin_amdgcn_cosf(fr) : __builtin_amdgcn_sinf(fr); }
        { float t8[8];
#pragma unroll
          for (int k = 0; k < 8; ++k) t8[k] = wf[tid + k * NTHR];
#pragma unroll
          for (int k = 0; k < 8; ++k) wfl[tid + k * NTHR] = t8[k]; }
        const float* wi = a.in[I_WIN] + (size_t)L * 1024 * 1536;
        { float t4[4];
#pragma unroll
          for (int k = 0; k < 4; ++k) { const int idx = tid + k * NTHR, kl = idx >> 6, d = idx & 63; t4[k] = wi[(size_t)(32 * kblk + kl) * 1536 + 512 + 64 * g + d]; }
#pragma unroll
          for (int k = 0; k < 4; ++k) { const int idx = tid + k * NTHR, kl = idx >> 6, d = idx & 63; Wl[kl * 65 + d] = t4[k]; } }
        __syncthreads();
        { const int rg = tid >> 4, cg = tid & 15, pq = rg >> 4, d0 = 4 * (rg & 15);
          f32x4 acc4[4];
#pragma unroll
          for (int i = 0; i < 4; ++i) acc4[i] = (f32x4){0.f, 0.f, 0.f, 0.f};
#pragma unroll 4
          for (int e = 0; e < 64; ++e) { const f32x4 w4 = *(const LAS f32x4*)(wfl + e * 64 + 4 * cg);
#pragma unroll
              for (int i = 0; i < 4; ++i) { const float tv = trg[64 * pq + (((d0 + i) * e) & 63)]; acc4[i] = acc4[i] + w4 * tv; } }
#pragma unroll
          for (int i = 0; i < 4; ++i) *(LAS f32x4*)(Mt + (pq * 64 + d0 + i) * 64 + 4 * cg) = acc4[i]; }
        __syncthreads();
        { const int klp = tid & 15, cgrp = tid >> 4, pq = cgrp >> 4, e20 = 4 * (cgrp & 15);
          bf16* WIN = (bf16*)(ws + WS_W + W_IN) + (size_t)L * NZ * 1024;
          f32x4 s0 = (f32x4){0.f, 0.f, 0.f, 0.f}, s1 = (f32x4){0.f, 0.f, 0.f, 0.f};
#pragma unroll 8
          for (int d = 0; d < 64; ++d) { const f32x4 m4 = *(const LAS f32x4*)(Mt + (pq * 64 + d) * 64 + e20); const float w0 = Wl[(2 * klp) * 65 + d], w1 = Wl[(2 * klp + 1) * 65 + d];
              s0 = s0 + m4 * w0; s1 = s1 + m4 * w1; }
#pragma unroll
          for (int i = 0; i < 4; ++i) *(unsigned*)(WIN + (size_t)(512 + 256 * pq + 64 * g + e20 + i) * 1024 + 32 * kblk + 2 * klp) = cvt_pk_bf16(s0[i], s1[i]); }
    }
    __syncthreads();
    {
        const int gt = bx * NTHR + tid, GT = G * NTHR;
        bf16* G1 = (bf16*)(ws + WS_TAB + T_G1); bf16* G3 = (bf16*)(ws + WS_TAB + T_G3); bf16* GC = (bf16*)(ws + WS_TAB + T_GC); bf16* WSB = (bf16*)(ws + WS_TAB + T_WS);
        float* RC = (float*)(ws + WS_TAB + T_ROPE); float* RS = RC + 2048;
        for (int idx = gt; idx < 128 * 128; idx += GT) { const int m = idx >> 7, kk = idx & 127; const int w = m >> 4, x = m & 15, k1 = 8 * w + 2 * (x >> 2) + ((x & 3) >> 1), ri = x & 1, pq = kk >> 6, n1 = kk & 63;
            const float fr = (float)((k1 * n1) & 63) * (1.0f / 64.0f), c = __builtin_amdgcn_cosf(fr), s = __builtin_amdgcn_sinf(fr);
            G1[idx] = f2bf(ri == 0 ? (pq == 0 ? c : -s) : (pq == 0 ? s : c)); }
        for (int idx = gt; idx < 128 * 256; idx += GT) { const int k2 = idx >> 8, kk = idx & 255, ri = kk >> 7, n2 = kk & 127; const float fr = (float)((k2 * n2) & 127) * (1.0f / 128.0f);
            G3[idx] = f2bf(ri == 0 ? __builtin_amdgcn_cosf(fr) : __builtin_amdgcn_sinf(fr)); }
        for (int idx = gt; idx < 256 * 512; idx += GT) { const int k = idx >> 9, kk = idx & 511, pq = kk >> 8, n = kk & 255; const float fr = (float)((k * n) & 255) * (1.0f / 256.0f);
            GC[idx] = f2bf(pq == 0 ? __builtin_amdgcn_cosf(fr) : -__builtin_amdgcn_sinf(fr)); }
        for (int idx = gt; idx < 2 * 4 * 128 * 128; idx += GT) WSB[idx] = f2bf(a.in[I_WS][idx]);
        { int* t0 = (int*)(ws + WS_RT + RT_TOK); int* d0 = (int*)(ws + WS_RT + RT_DST); float* g0 = (float*)(ws + WS_RT + RT_GATE);
          for (int idx = gt; idx < MALL; idx += GT) { t0[idx] = idx; d0[idx] = idx; g0[idx] = 1.0f; }
          int* t1 = (int*)(ws + WS_RT1 + RT1_TOK); int* d1 = (int*)(ws + WS_RT1 + RT1_DST); float* g1 = (float*)(ws + WS_RT1 + RT1_GATE);
          for (int idx = gt; idx < NE * CAP; idx += GT) { t1[idx] = 0; d1[idx] = -1; g1[idx] = 0.f; } }
        for (int idx = gt; idx < 2048; idx += GT) { const int pos = idx >> 4, f = idx & 15; const float inv = powf(10000.0f, -(float)f / 16.0f); const float ang = (float)pos * inv; RC[idx] = cosf(ang); RS[idx] = sinf(ang); }
    }
    {
        LAS float* scr = (LAS float*)(lds + wave * 16384);
        bf16* WB = (bf16*)(ws + WS_W);
        const int gw = bx * NWAVES + wave, NGW = G * NWAVES;
        f32x4 va[16], vb[16]; TJob Ja, Jb;
        int ia = gw;
        if (ia < TJ_NOW) { Ja = tj_decode(a, WB, ia); tj_load(Ja, lane, va); }
        for (;;) {
            if (ia >= TJ_NOW) break;
            const int ib = ia + NGW;
            if (ib < TJ_NOW) { Jb = tj_decode(a, WB, ib); tj_load(Jb, lane, vb); }
            tj_store(Ja, scr, lane, va);
            if (ib >= TJ_NOW) break;
            ia = ib + NGW;
            if (ia < TJ_NOW) { Ja = tj_decode(a, WB, ia); tj_load(Ja, lane, va); }
            tj_store(Jb, scr, lane, vb);
        }
    }
}

DI void cvt_filler(const Args& a, unsigned char* ws, LAS unsigned char* lds, int tid, int wave, int lane, int* done, int need) {
    LAS int* sh = (LAS int*)(lds + LDSCTL_OFF + LC_FILL);
    int* cur = (int*)(ws + WS_CTL) + CW_CVT;
    LAS float* scr = (LAS float*)(lds + wave * 16384);
    bf16* WB = (bf16*)(ws + WS_W);
    __syncthreads();
    for (int it = 0;; ++it) {
        if (tid == 0) { int b = -1;
            const bool stop = done && __hip_atomic_load(done, __ATOMIC_RELAXED, __HIP_MEMORY_SCOPE_AGENT) >= need;
            if (!stop) { b = __hip_atomic_fetch_add(cur, done ? TJ_BATCH / 2 : TJ_BATCH, __ATOMIC_RELAXED, __HIP_MEMORY_SCOPE_AGENT); if (b >= TJ_DEF) b = -1; }
            sh[it & 1] = b; }
        __syncthreads();
        const int b = __builtin_amdgcn_readfirstlane(sh[it & 1]);
        if (b < 0) break;
        f32x4 va[16], vb[16];
        const int ia = b + (done ? wave : 2 * wave), ib = done ? TJ_DEF : ia + 1;
        if (ia < TJ_DEF) { const TJob Ja = tj_decode(a, WB, TJ_NOW + ia); tj_load(Ja, lane, va);
            if (ib < TJ_DEF) { const TJob Jb = tj_decode(a, WB, TJ_NOW + ib); tj_load(Jb, lane, vb); tj_store(Ja, scr, lane, va); tj_store(Jb, scr, lane, vb); }
            else tj_store(Ja, scr, lane, va); }
    }
    __syncthreads();
}

DI void ld_row_f32(const float* row, int lane, f32x4 (&v)[4]) { const f32x4* p = (const f32x4*)row + lane;
#pragma unroll
    for (int j = 0; j < 4; ++j) v[j] = p[64 * j]; }
DI void st_row_f32(float* row, int lane, const f32x4 (&v)[4]) { f32x4* p = (f32x4*)row + lane;
#pragma unroll
    for (int j = 0; j < 4; ++j) p[64 * j] = v[j]; }
DI void ld_row_bf16(const bf16* row, int lane, f32x4 (&v)[4]) { const u32x2* p = (const u32x2*)row + lane;
#pragma unroll
    for (int j = 0; j < 4; ++j) { const u32x2 w = p[64 * j]; v[j] = (f32x4){bflo(w.x), bfhi(w.x), bflo(w.y), bfhi(w.y)}; } }
DI void st_row_bf16(bf16* row, int lane, const f32x4 (&v)[4]) { u32x2* p = (u32x2*)row + lane;
#pragma unroll
    for (int j = 0; j < 4; ++j) { u32x2 w; w.x = cvt_pk_bf16(v[j][0], v[j][1]); w.y = cvt_pk_bf16(v[j][2], v[j][3]); p[64 * j] = w; } }
DI float row_rstd(const f32x4 (&v)[4], int lane) { float s = 0.f;
#pragma unroll
    for (int j = 0; j < 4; ++j) s += (v[j][0] * v[j][0] + v[j][1] * v[j][1]) + (v[j][2] * v[j][2] + v[j][3] * v[j][3]);
    return 1.0f / sqrtf(wave_sum(s, lane) * (1.0f / 1024.0f) + EPS); }
DI void modulate_row(const f32x4 (&h)[4], float rstd, const float* g, const float* sh, const float* sc, int lane, f32x4 (&y)[4]) {
#pragma unroll
    for (int j = 0; j < 4; ++j) { const f32x4 gv = ((const f32x4*)g + lane)[64 * j], shv = ((const f32x4*)sh + lane)[64 * j], scv = ((const f32x4*)sc + lane)[64 * j];
        y[j] = h[j] * rstd * gv * (1.0f + scv) + shv; } }
DI int mod_set(int r) { return r < MLAT ? (r >> 13) : 4; }

DI void ldraw_f32(const float* row, int lane, f32x4 (&v)[4]) { const f32x4* p = (const f32x4*)row + lane;
#pragma unroll
    for (int j = 0; j < 4; ++j) v[j] = p[64 * j]; }
DI void ldraw_bf16(const bf16* row, int lane, u32x2 (&v)[4]) { const u32x2* p = (const u32x2*)row + lane;
#pragma unroll
    for (int j = 0; j < 4; ++j) v[j] = p[64 * j]; }
DI void unpack_bf16(const u32x2 (&w)[4], f32x4 (&v)[4]) {
#pragma unroll
    for (int j = 0; j < 4; ++j) v[j] = (f32x4){bflo(w[j].x), bfhi(w[j].x), bflo(w[j].y), bfhi(w[j].y)}; }
DI void ldvec(const float* p, int lane, f32x4 (&v)[4]) { ldraw_f32(p, lane, v); }
DI void ldmod(const Args& a, const unsigned char* ws, int L, int s, int j, int lane, f32x4 (&v)[4]) {
    ldraw_f32(a.in[I_BADA] + L * 6144 + j * 1024, lane, v);
#pragma unroll 1
    for (int ks = 0; ks < 8; ++ks) { f32x4 t[4]; ldraw_f32((const float*)(ws + WS_MOD) + ((size_t)(L * 8 + ks) * 5 + s) * 6144 + j * 1024, lane, t);
#pragma unroll
        for (int q = 0; q < 4; ++q) v[q] = v[q] + t[q]; }
}

DI void norm0_phase(const Args& a, unsigned char* ws, int wave, int lane) {
    constexpr int RPW = MALL / 256; const int bx = blockIdx.x;
    bf16* Y = (bf16*)(ws + WS_Y);
    if (bx >= 256) return;
    f32x4 g[4], sh[4], sc[4], hn[4]; int cs = -1;
    ldvec(a.in[I_GMPRE], lane, g);
    { const int r = bx * RPW + wave; ldraw_f32(r < MLAT ? a.in[I_X] + (size_t)r * DM : a.in[I_CTX] + (size_t)(r - MLAT) * DM, lane, hn); }
    for (int rr = wave; rr < RPW; rr += NWAVES) {
        const int r = bx * RPW + rr, s = mod_set(r);
        f32x4 h[4], y[4];
#pragma unroll
        for (int j = 0; j < 4; ++j) h[j] = hn[j];
        if (rr + NWAVES < RPW) { const int rn = r + NWAVES; ldraw_f32(rn < MLAT ? a.in[I_X] + (size_t)rn * DM : a.in[I_CTX] + (size_t)(rn - MLAT) * DM, lane, hn); }
        if (s != cs) { ldmod(a, ws, 0, s, 0, lane, sh); ldmod(a, ws, 0, s, 1, lane, sc); cs = s; }
        const float rs = row_rstd(h, lane);
#pragma unroll
        for (int j = 0; j < 4; ++j) y[j] = h[j] * rs * g[j] * (1.0f + sc[j]) + sh[j];
        st_row_bf16(Y + (size_t)r * DM, lane, y);
    }
}

DI void norm_mid_phase(const Args& a, unsigned char* ws, LAS unsigned char* lds, int L, int tid, int wave, int lane) {
    const int M = L == 0 ? MALL : MLAT, RPW = M / 256, bx = blockIdx.x;
    const bool moe = (L == 1);
    LAS int* cnt = (LAS int*)(lds + LDSCTL_OFF + LC_CNT);
    __syncthreads();
    if (tid < 8) cnt[tid] = 0;
    LAS float* wrl = (LAS float*)(lds + 4096);
    if (moe) { f32x4 w4[2048 / NTHR];
#pragma unroll
        for (int k = 0; k < 2048 / NTHR; ++k) w4[k] = ((const f32x4*)a.in[I_WR])[tid + k * NTHR];
#pragma unroll
        for (int k = 0; k < 2048 / NTHR; ++k) { const int i = tid + k * NTHR, c = i >> 1, e0 = 4 * (i & 1);
#pragma unroll
            for (int q = 0; q < 4; ++q) wrl[(e0 + q) * 1024 + c] = w4[k][q]; } }
    __syncthreads();
    const bf16* O = (const bf16*)(ws + WS_R + R_O); bf16* Y = (bf16*)(ws + WS_Y);
    bf16* hctx1 = (bf16*)(ws + WS_HCTX); const bf16* h2lat = (const bf16*)a.out + (size_t)MLAT * DM; bf16* h3 = (bf16*)(ws + WS_H3);
    LAS int* rec = (LAS int*)lds;
    if (bx < 256) {
        f32x4 gpost[4], gpre[4], gtm[4], shf[4], scf[4]; u32x4 hr[4], hr2[4]; u32x2 hb[4], hb2[4]; u32x2 on[4], on2[4]; int cs = -1;
        ldvec(a.in[I_GMPOST] + L * DM, lane, gpost); ldvec(a.in[I_GFPRE] + L * DM, lane, gpre);
#define NM_LOAD(rq_, o_, h_, hb_) do { const int rq = (rq_); ldraw_bf16(O + (size_t)rq * DM, lane, o_); \
            if (L == 0) { const u32x4* p_ = (const u32x4*)(rq < MLAT ? a.in[I_X] + (size_t)rq * DM : a.in[I_CTX] + (size_t)(rq - MLAT) * DM) + lane; _Pragma("unroll") for (int j = 0; j < 4; ++j) h_[j] = p_[64 * j]; } \
            else ldraw_bf16(h2lat + (size_t)rq * DM, lane, hb_); } while (0)
#define NM_ROW(rr_) ((L == 0 && SPLITK) ? ((rr_) < 4 ? MLAT + 4 * bx + (rr_) : 128 * bx + ((rr_) - 4)) : bx * RPW + (rr_))
        NM_LOAD(NM_ROW(wave), on, hr, hb);
        if (wave + NWAVES < RPW) NM_LOAD(NM_ROW(wave + NWAVES), on2, hr2, hb2);
        for (int rr = wave; rr < RPW; rr += NWAVES) {
            const int r = NM_ROW(rr), s = mod_set(r);
            bf16* hout = L == 0 ? (r < MLAT ? (bf16*)a.out + (size_t)r * DM : hctx1 + (size_t)(r - MLAT) * DM) : h3 + (size_t)r * DM;
            f32x4 o[4], h[4], y[4]; unpack_bf16(on, o);
#pragma unroll
            for (int j = 0; j < 4; ++j) h[j] = L == 0 ? __builtin_bit_cast(f32x4, hr[j]) : (f32x4){bflo(hb[j].x), bfhi(hb[j].x), bflo(hb[j].y), bfhi(hb[j].y)};
#pragma unroll
            for (int j = 0; j < 4; ++j) { on[j] = on2[j]; hr[j] = hr2[j]; hb[j] = hb2[j]; }
            if (rr + 2 * NWAVES < RPW) NM_LOAD(NM_ROW(rr + 2 * NWAVES), on2, hr2, hb2);
            if (SPLITK && L == 0 && r >= MLAT) {
#pragma unroll
                for (int j = 0; j < 4; ++j) o[j] = (f32x4){0.f, 0.f, 0.f, 0.f};
#pragma unroll 2
                for (int ks = 0; ks < 4; ++ks) { f32x4 t4[4]; ldraw_f32((const float*)(ws + WS_R + R_T) + ((size_t)ks * MCTX + (r - MLAT)) * DM, lane, t4);
#pragma unroll
                    for (int j = 0; j < 4; ++j) o[j] = o[j] + t4[j]; }
            }
            if (s != cs) { ldmod(a, ws, L, s, 2, lane, gtm); ldmod(a, ws, L, s, 3, lane, shf); ldmod(a, ws, L, s, 4, lane, scf); cs = s; }
            const float ro = row_rstd(o, lane);
#pragma unroll
            for (int j = 0; j < 4; ++j) h[j] = h[j] + gtm[j] * (o[j] * ro * gpost[j]);
            st_row_bf16(hout, lane, h);
            const float rh = row_rstd(h, lane);
#pragma unroll
            for (int j = 0; j < 4; ++j) y[j] = h[j] * rh * gpre[j] * (1.0f + scf[j]) + shf[j];
            if (moe || FP8_DGU) { unsigned* y8 = (unsigned*)((unsigned char*)Y + (size_t)r * DM) + lane;
#pragma unroll
                for (int j = 0; j < 4; ++j) y8[64 * j] = pg8::pk_fp8x4(y[j][0] * pg8::S8_Y, y[j][1] * pg8::S8_Y, y[j][2] * pg8::S8_Y, y[j][3] * pg8::S8_Y); }
            else st_row_bf16(Y + (size_t)r * DM, lane, y);
            if (moe) {
                float lg[8];
#pragma unroll
                for (int e = 0; e < 8; ++e) { float acc = 0.f;
#pragma unroll
                    for (int j = 0; j < 4; ++j) { const f32x4 w4 = *(const LAS f32x4*)(wrl + e * 1024 + 4 * lane + 256 * j); acc += (y[j][0] * w4[0] + y[j][1] * w4[1]) + (y[j][2] * w4[2] + y[j][3] * w4[3]); }
                    lg[e] = acc; }
#pragma unroll
                for (int e = 0; e < 8; ++e) lg[e] = wave_sum(lg[e], lane) + a.in[I_BR][e];
                int i0 = 0; float v0 = lg[0];
#pragma unroll
                for (int e = 1; e < 8; ++e) if (lg[e] > v0) { v0 = lg[e]; i0 = e; }
                int i1 = -1; float v1 = -3.0e38f;
#pragma unroll
                for (int e = 0; e < 8; ++e) if (e != i0 && lg[e] > v1) { v1 = lg[e]; i1 = e; }
                const float g0 = 1.0f / (1.0f + expf(v1 - v0)), g1 = 1.0f - g0;
                if (lane == 0) { const int p0 = __hip_atomic_fetch_add(&cnt[i0], 1, __ATOMIC_RELAXED, __HIP_MEMORY_SCOPE_WORKGROUP), p1 = __hip_atomic_fetch_add(&cnt[i1], 1, __ATOMIC_RELAXED, __HIP_MEMORY_SCOPE_WORKGROUP);
                    rec[rr * 4 + 0] = (i0 << 16) | p0; rec[rr * 4 + 1] = __float_as_int(g0); rec[rr * 4 + 2] = (i1 << 16) | p1; rec[rr * 4 + 3] = __float_as_int(g1); }
            }
        }
    }
    if (moe) {
        __syncthreads();
        if (bx < 256 && tid < 8) cnt[8 + tid] = __hip_atomic_fetch_add((int*)(ws + WS_CTL) + CW_GCNT + tid, cnt[tid], __ATOMIC_RELAXED, __HIP_MEMORY_SCOPE_AGENT);
        __syncthreads();
        if (bx < 256 && tid < 2 * RPW) { const int rr = tid >> 1, k = tid & 1, r = bx * RPW + rr; const int info = rec[rr * 4 + 2 * k], e = info >> 16, slot = e * CAP + cnt[8 + e] + (info & 0xffff);
            ((int*)(ws + WS_RT1 + RT1_TOK))[slot] = r; ((int*)(ws + WS_RT1 + RT1_DST))[slot] = k * MALL + r; ((int*)(ws + WS_RT1 + RT1_GATE))[slot] = rec[rr * 4 + 2 * k + 1]; }
    }
}

#undef NM_LOAD
#undef NM_ROW
DI void norm_end_phase(const Args& a, unsigned char* ws, int L, int wave, int lane) {
    const int M = L == 0 ? MALL : MLAT, RPW = M / 256, bx = blockIdx.x; const bool moe = (L == 1);
    const bf16* F = (const bf16*)(ws + WS_R + R_F); bf16* Y = (bf16*)(ws + WS_Y);
    const bf16* hctx1 = (const bf16*)(ws + WS_HCTX); bf16* hctx2 = (bf16*)(ws + WS_HCTX) + (size_t)MCTX * DM; bf16* h2lat = (bf16*)a.out + (size_t)MLAT * DM; const bf16* h3 = (const bf16*)(ws + WS_H3);
    if (bx >= 256) return;
    f32x4 gpost[4], gnx[4], gtf[4], shn[4], scn[4]; u32x2 f0n[4], hbn[4]; unsigned q0[4], q1[4], q02[4], q12[4]; int cs = -1;
    ldvec(a.in[I_GFPOST] + L * DM, lane, gpost); ldvec(a.in[I_GMPRE] + DM, lane, gnx);
#define NE_HIN(r_) (L == 0 ? ((r_) < MLAT ? (const bf16*)a.out + (size_t)(r_) * DM : hctx1 + (size_t)((r_) - MLAT) * DM) : h3 + (size_t)(r_) * DM)
#define NE_ROW(rr_) (L == 0 ? ((rr_) < 4 ? MLAT + 4 * bx + (rr_) : 128 * bx + ((rr_) - 4)) : bx * RPW + (rr_))
    u32x2 f0n2[4], hbn2[4];
#define NE_LOAD(rq_, f0_, q0_, q1_, hb_) do { const int rq = (rq_); \
        if (moe) { const unsigned* p0_ = (const unsigned*)((const unsigned char*)F + (size_t)rq * DM) + lane; const unsigned* p1_ = (const unsigned*)((const unsigned char*)F + (size_t)(MALL + rq) * DM) + lane; \
            _Pragma("unroll") for (int j = 0; j < 4; ++j) { q0_[j] = p0_[64 * j]; q1_[j] = p1_[64 * j]; } } \
        else ldraw_bf16(F + (size_t)rq * DM, lane, f0_); \
        ldraw_bf16(NE_HIN(rq), lane, hb_); } while (0)
    NE_LOAD(NE_ROW(wave), f0n, q0, q1, hbn);
    if (wave + NWAVES < RPW) NE_LOAD(NE_ROW(wave + NWAVES), f0n2, q02, q12, hbn2);
    for (int rr = wave; rr < RPW; rr += NWAVES) {
        const int r = NE_ROW(rr), s = mod_set(r);
        f32x4 f[4], h[4]; unpack_bf16(hbn, h);
        if (moe) {
#pragma unroll
            for (int j = 0; j < 4; ++j) { const int a0 = (int)q0[j], a1 = (int)q1[j];
                f[j] = (f32x4){__builtin_amdgcn_cvt_f32_fp8(a0, 0) + __builtin_amdgcn_cvt_f32_fp8(a1, 0), __builtin_amdgcn_cvt_f32_fp8(a0, 1) + __builtin_amdgcn_cvt_f32_fp8(a1, 1),
                               __builtin_amdgcn_cvt_f32_fp8(a0, 2) + __builtin_amdgcn_cvt_f32_fp8(a1, 2), __builtin_amdgcn_cvt_f32_fp8(a0, 3) + __builtin_amdgcn_cvt_f32_fp8(a1, 3)} * (1.0f / pg8::S8_F); }
        } else unpack_bf16(f0n, f);
#pragma unroll
        for (int j = 0; j < 4; ++j) { f0n[j] = f0n2[j]; q0[j] = q02[j]; q1[j] = q12[j]; hbn[j] = hbn2[j]; }
        if (rr + 2 * NWAVES < RPW) NE_LOAD(NE_ROW(rr + 2 * NWAVES), f0n2, q02, q12, hbn2);
        if (SPLITK && L == 0 && r >= MLAT) {
#pragma unroll
            for (int j = 0; j < 4; ++j) f[j] = (f32x4){0.f, 0.f, 0.f, 0.f};
#pragma unroll 2
            for (int ks = 0; ks < (FP8_DDN ? 7 : 14); ++ks) { f32x4 t[4]; ldraw_f32((const float*)(ws + WS_R + (FP8_DDN ? R_PART : R_PART0)) + ((size_t)ks * MCTX + (r - MLAT)) * DM, lane, t);
#pragma unroll
                for (int j = 0; j < 4; ++j) f[j] = f[j] + t[j]; }
            if (FP8_DDN) {
#pragma unroll
                for (int j = 0; j < 4; ++j) f[j] = f[j] * (1.0f / (pg8::S8_ACT * pg8::S8_W)); }
        }
        if (s != cs) { ldmod(a, ws, L, s, 5, lane, gtf); if (L == 0) { ldmod(a, ws, 1, s, 0, lane, shn); ldmod(a, ws, 1, s, 1, lane, scn); } cs = s; }
        const float rf = row_rstd(f, lane);
#pragma unroll
        for (int j = 0; j < 4; ++j) h[j] = h[j] + gtf[j] * (f[j] * rf * gpost[j]);
        if (L == 0) st_row_bf16(r < MLAT ? h2lat + (size_t)r * DM : hctx2 + (size_t)(r - MLAT) * DM, lane, h);
        else st_row_f32(a.out + (size_t)r * DM, lane, h);
        if (L == 0) { f32x4 y[4]; const float rh = row_rstd(h, lane);
#pragma unroll
            for (int j = 0; j < 4; ++j) y[j] = h[j] * rh * gnx[j] * (1.0f + scn[j]) + shn[j];
            st_row_bf16(Y + (size_t)r * DM, lane, y); }
    }
#undef NE_HIN
#undef NE_ROW
#undef NE_LOAD
}

constexpr int AT_KS = 0, AT_VT = 9216, AT_BUF = 19456;
DI void attn_unit(LAS unsigned char* lds, const bf16* Z, bf16* OC, const float* sinkL, int u, int tid, int wave, int lane) {
    int b, blk, kh; bool isctx;
    if (u < 512) { kh = u & 1; blk = (u >> 1) & 63; b = u >> 7; isctx = false; } else { const int j = u - 512; kh = j & 1; blk = (j >> 1) & 1; b = j >> 2; isctx = true; }
    const int qrowbase = isctx ? (MLAT + b * NCTX + 128 * blk) : (b * NLAT + 128 * blk);
    const int hq = 4 * kh + (wave & 3), qrow0 = (wave >> 2) * 64, i16 = lane & 15, h4 = lane >> 4;
    bf16x8 Qf[4][2];
#pragma unroll
    for (int qt = 0; qt < 4; ++qt)
#pragma unroll
        for (int ks = 0; ks < 2; ++ks) Qf[qt][ks] = *(const bf16x8*)(Z + (size_t)(qrowbase + qrow0 + 16 * qt + i16) * NZ + ZQ + 64 * hq + 32 * ks + 8 * h4);
    float mrun[4], lrun[4]; f32x4 o[4][4];
    const float sk = sinkL[hq] * LOG2E;
#pragma unroll
    for (int qt = 0; qt < 4; ++qt) { mrun[qt] = sk; lrun[qt] = (h4 == 0) ? 1.f : 0.f;
#pragma unroll
        for (int dt = 0; dt < 4; ++dt) o[dt][qt] = (f32x4){0.f, 0.f, 0.f, 0.f}; }
    const int ntl = isctx ? 0 : 6, ntt = ntl + 4;
#define AT_TILE(t, kr, mt, k0) (((t) < ntl) ? ((kr) = b * NLAT + 128 * (blk - 1 + ((t) >> 1)) + 64 * ((t) & 1), (mt) = ((t) >> 1) == 0 ? 1 : (((t) >> 1) == 2 ? 2 : 0), (k0) = 64 * ((t) & 1), (blk - 1 + ((t) >> 1)) >= 0 && (blk - 1 + ((t) >> 1)) <= 63) \
                                            : ((kr) = MLAT + b * NCTX + 64 * ((t) - ntl), (mt) = 0, (k0) = 0, true))
    const int skey = tid >> 3, sch = tid & 7;
#define AT_LOAD(kr) do { const bf16* src = Z + (size_t)((kr) + skey) * NZ; kvr = *(const u32x4*)(src + ZK + 64 * kh + 8 * sch); vvr = *(const u32x4*)(src + ZVV + 64 * kh + 8 * sch); } while (0)
#define AT_STORE(pb_) do { *(LAS u32x4*)(lds + (pb_) * AT_BUF + AT_KS + skey * 144 + sch * 16) = kvr; *(LAS u32x4*)(lds + (pb_) * AT_BUF + AT_VT + skey * 160 + sch * 16) = vvr; } while (0)
    u32x4 kvr, vvr;
    int tix = 0, krow0 = 0, cmtype = 0, ckb0 = 0, nmtype = 0, nkb0 = 0, pb = 0;
    while (tix < ntt && !AT_TILE(tix, krow0, cmtype, ckb0)) ++tix;
    AT_LOAD(krow0);
    __syncthreads();
    AT_STORE(0);
#pragma unroll
    for (int qt = 0; qt < 4; ++qt)
#pragma unroll
        for (int ks = 0; ks < 2; ++ks) asm volatile("" : "+v"(Qf[qt][ks]));
    ++tix; while (tix < ntt && !AT_TILE(tix, krow0, nmtype, nkb0)) ++tix;
    bool nvalid = tix < ntt;
    if (nvalid) AT_LOAD(krow0);
    __syncthreads();
    for (;;) {
        int n2mtype = 0, n2kb0 = 0; bool n2valid = false;
        if (nvalid) { AT_STORE(pb ^ 1);
            ++tix; while (tix < ntt && !AT_TILE(tix, krow0, n2mtype, n2kb0)) ++tix;
            n2valid = tix < ntt; if (n2valid) AT_LOAD(krow0); }
        const LAS unsigned char* ldt = lds + pb * AT_BUF;
        const bool skipw = (cmtype == 1 && ckb0 < qrow0) || (cmtype == 2 && ckb0 > qrow0);
        if (!skipw) {
        f32x4 sa[4][4];
#pragma unroll
        for (int kt = 0; kt < 4; ++kt)
#pragma unroll
            for (int qt = 0; qt < 4; ++qt) { const float nm = -mrun[qt]; sa[kt][qt] = (f32x4){nm, nm, nm, nm}; }
#pragma unroll
        for (int ks = 0; ks < 2; ++ks)
#pragma unroll
            for (int kt = 0; kt < 4; ++kt) { const bf16x8 ak = *(const LAS bf16x8*)(ldt + AT_KS + (16 * kt + i16) * 144 + (32 * ks + 8 * h4) * 2);
#pragma unroll
                for (int qt = 0; qt < 4; ++qt) sa[kt][qt] = mfma16(ak, Qf[qt][ks], sa[kt][qt]); }
        if (cmtype && ckb0 == qrow0) {
            int ln; asm volatile("v_mbcnt_lo_u32_b32 %0, -1, 0\n\tv_mbcnt_hi_u32_b32 %0, -1, %0" : "=v"(ln));
            const int dl = 4 * (ln >> 4) - (ln & 15);
            if (cmtype == 1) {
#pragma unroll
                for (int kt = 0; kt < 4; ++kt)
#pragma unroll
                    for (int qt = 0; qt < 4; ++qt) {
                        if (kt < qt) sa[kt][qt] = (f32x4){-1.0e30f, -1.0e30f, -1.0e30f, -1.0e30f};
                        else if (kt == qt) {
#pragma unroll
                            for (int r = 0; r < 4; ++r) if (dl + r < 0) sa[kt][qt][r] = -1.0e30f; } }
            } else {
#pragma unroll
                for (int kt = 0; kt < 4; ++kt)
#pragma unroll
                    for (int qt = 0; qt < 4; ++qt) {
                        if (kt > qt) sa[kt][qt] = (f32x4){-1.0e30f, -1.0e30f, -1.0e30f, -1.0e30f};
                        else if (kt == qt) {
#pragma unroll
                            for (int r = 0; r < 4; ++r) if (dl + r > 0) sa[kt][qt][r] = -1.0e30f; } }
            }
        }
#pragma unroll
        for (int qt = 0; qt < 4; ++qt) {
            float mx = vmax3(vmax3(vmax3(sa[0][qt][0], sa[0][qt][1], sa[0][qt][2]), vmax3(sa[0][qt][3], sa[1][qt][0], sa[1][qt][1]), sa[1][qt][2]),
                             vmax3(sa[1][qt][3], sa[2][qt][0], sa[2][qt][1]), vmax3(vmax3(sa[2][qt][2], sa[2][qt][3], sa[3][qt][0]), vmax3(sa[3][qt][1], sa[3][qt][2], sa[3][qt][3]), sa[3][qt][3]));
            if (__builtin_amdgcn_ballot_w64(mx > 6.0f) != 0ull) {
                mx = xrow16_max(mx);
                const float dl = fmaxf(mx, 0.f), alpha = fexp2(-dl); mrun[qt] += dl; lrun[qt] *= alpha;
#pragma unroll
                for (int kt = 0; kt < 4; ++kt) sa[kt][qt] = sa[kt][qt] - dl;
#pragma unroll
                for (int dt = 0; dt < 4; ++dt) o[dt][qt] = o[dt][qt] * alpha;
            }
            f32x2 ps = (f32x2){0.f, 0.f};
#pragma unroll
            for (int kt = 0; kt < 4; ++kt) { f32x4 p; p[0] = fexp2(sa[kt][qt][0]); p[1] = fexp2(sa[kt][qt][1]); p[2] = fexp2(sa[kt][qt][2]); p[3] = fexp2(sa[kt][qt][3]); sa[kt][qt] = p;
                ps = ps + (f32x2){p[0], p[1]} + (f32x2){p[2], p[3]}; }
            lrun[qt] += ps.x + ps.y;
        }
#pragma unroll
        for (int s = 0; s < 2; ++s) {
            bf16x8 pf[4];
#pragma unroll
            for (int qt = 0; qt < 4; ++qt) { u32x4 w; const f32x4 p0 = sa[2 * s][qt], p1 = sa[2 * s + 1][qt];
                w.x = cvt_pk_bf16(p0[0], p0[1]); w.y = cvt_pk_bf16(p0[2], p0[3]); w.z = cvt_pk_bf16(p1[0], p1[1]); w.w = cvt_pk_bf16(p1[2], p1[3]); pf[qt] = __builtin_bit_cast(bf16x8, w); }
#pragma unroll
            for (int dt = 0; dt < 4; ++dt) {
                const LAS unsigned char* vp = ldt + AT_VT + (32 * s + 4 * h4 + (i16 >> 2)) * 160 + (16 * dt + 4 * (i16 & 3)) * 2;
                const v4i16_t lo = __builtin_amdgcn_ds_read_tr16_b64_v4i16((LAS v4i16_t*)vp), hi = __builtin_amdgcn_ds_read_tr16_b64_v4i16((LAS v4i16_t*)(vp + 16 * 160)); const bf16x8 av = __builtin_shufflevector(lo, hi, 0, 1, 2, 3, 4, 5, 6, 7);
#pragma unroll
                for (int qt = 0; qt < 4; ++qt) o[dt][qt] = mfma16(av, pf[qt], o[dt][qt]); }
        }
        }
        if (!nvalid) break;
        __syncthreads();
        pb ^= 1; cmtype = nmtype; ckb0 = nkb0; nvalid = n2valid; nmtype = n2mtype; nkb0 = n2kb0;
    }
#undef AT_LOAD
#undef AT_STORE
    const int trs = (((lane & 3) << 4) | (lane >> 2)) << 2;
#pragma unroll
    for (int qt = 0; qt < 4; ++qt) { const float lt = xrow16_sum(lrun[qt]); const float inv = 1.0f / lt;
        bf16* orow = OC + (size_t)(qrowbase + qrow0 + 16 * qt + (lane >> 2)) * DM + 512 + 64 * hq + 4 * (lane & 3);
#pragma unroll
        for (int dt = 0; dt < 4; ++dt) { const f32x4 v = o[dt][qt] * inv; u32x2 w; w.x = (unsigned)__builtin_amdgcn_ds_bpermute(trs, (int)cvt_pk_bf16(v[0], v[1])); w.y = (unsigned)__builtin_amdgcn_ds_bpermute(trs, (int)cvt_pk_bf16(v[2], v[3])); *(u32x2*)(orow + 16 * dt) = w; } }
#undef AT_TILE
}

DI void sgu_unit(LAS unsigned char* lds, const bf16* Z, bf16* OC, const bf16* wsb, const float* bs, const float* gv, int c, int tid, int wave, int lane) {
    const int rowbase = 128 * c, i16 = lane & 15, h4 = lane >> 4, p = 16 * wave + i16;
    __syncthreads();
    const int pc = tid & 31, sh = pc >> 3;
    u32x4 v[8];
#pragma unroll
    for (int k = 0; k < 8; ++k) v[k] = *(const u32x4*)(Z + (size_t)(rowbase + (tid >> 5) + 16 * k) * NZ + ZV + 8 * pc);
    const f32x4 ga = *(const f32x4*)(gv + 8 * pc), gb = *(const f32x4*)(gv + 8 * pc + 4);
    const int lr = lane >> 2, lp = lane & 3;
    const int mfl = ((i16 << 2) | h4) << 2, trs = ((lp << 4) | lr) << 2;
    u32x4 bwn[4]; u32x2 uun[4]; float bn;
#define SG_LDH(hh_) do { _Pragma("unroll") for (int ks = 0; ks < 4; ++ks) bwn[ks] = *(const u32x4*)(wsb + ((size_t)(hh_) * 128 + 16 * wave + lr) * 128 + 32 * ks + 8 * lp); \
        _Pragma("unroll") for (int ct = 0; ct < 4; ++ct) uun[ct] = *(const u32x2*)(Z + (size_t)(rowbase + 16 * wave + lr) * NZ + ZU + 64 * (hh_) + 16 * ct + 4 * lp); \
        bn = bs[(hh_) * 128 + p]; } while (0)
    SG_LDH(0);
#pragma unroll
    for (int k = 0; k < 8; ++k) { float ss = 0.f;
#pragma unroll
        for (int q2 = 0; q2 < 4; ++q2) { const float x0 = bflo(v[k][q2]), x1 = bfhi(v[k][q2]); ss += x0 * x0 + x1 * x1; }
        ss += dppx<0xB1>(ss); ss += dppx<0x4E>(ss); ss += dppx<0x141>(ss);
        const float rstd = 1.0f / sqrtf(ss * (1.0f / 64.0f) + EPS);
        u32x4 w;
        w.x = cvt_pk_bf16(bflo(v[k].x) * rstd * ga[0], bfhi(v[k].x) * rstd * ga[1]); w.y = cvt_pk_bf16(bflo(v[k].y) * rstd * ga[2], bfhi(v[k].y) * rstd * ga[3]);
        w.z = cvt_pk_bf16(bflo(v[k].z) * rstd * gb[0], bfhi(v[k].z) * rstd * gb[1]); w.w = cvt_pk_bf16(bflo(v[k].w) * rstd * gb[2], bfhi(v[k].w) * rstd * gb[3]);
        *(LAS u32x4*)(lds + ((tid >> 5) + 16 * k) * 544 + pc * 16) = w; }
    __syncthreads();
#pragma unroll
    for (int hh = 0; hh < 4; ++hh) {
        u32x4 bw[4]; u32x2 uu[4]; const float bias = bn;
#pragma unroll
        for (int k = 0; k < 4; ++k) { bw[k] = bwn[k]; uu[k] = uun[k]; }
        if (hh < 3) SG_LDH(hh + 1);
        f32x4 acc[4];
#pragma unroll
        for (int ct = 0; ct < 4; ++ct) acc[ct] = (f32x4){0.f, 0.f, 0.f, 0.f};
#pragma unroll
        for (int ks = 0; ks < 4; ++ks) { u32x4 t;
            t.x = (unsigned)__builtin_amdgcn_ds_bpermute(mfl, (int)bw[ks].x); t.y = (unsigned)__builtin_amdgcn_ds_bpermute(mfl, (int)bw[ks].y); t.z = (unsigned)__builtin_amdgcn_ds_bpermute(mfl, (int)bw[ks].z); t.w = (unsigned)__builtin_amdgcn_ds_bpermute(mfl, (int)bw[ks].w);
            const bf16x8 bwf = __builtin_bit_cast(bf16x8, t);
#pragma unroll
            for (int ct = 0; ct < 4; ++ct) { const bf16x8 av = trfrag(lds + 32 * ks * 544 + (hh * 64 + 16 * ct) * 2, 544, lane); acc[ct] = mfma16(av, bwf, acc[ct]); } }
#pragma unroll
        for (int ct = 0; ct < 4; ++ct) { f32x4 t;
#pragma unroll
            for (int r = 0; r < 4; ++r) t[r] = __builtin_bit_cast(float, __builtin_amdgcn_ds_bpermute(trs, __builtin_bit_cast(int, acc[ct][r] + bias)));
            u32x2 w; w.x = cvt_pk_bf16(bflo(uu[ct].x) * t[0], bfhi(uu[ct].x) * t[1]); w.y = cvt_pk_bf16(bflo(uu[ct].y) * t[2], bfhi(uu[ct].y) * t[3]);
            *(u32x2*)(OC + (size_t)(rowbase + 16 * wave + lr) * DM + 64 * hh + 16 * ct + 4 * lp) = w; }
    }
#undef SG_LDH
}

DI void fft1_compute(LAS unsigned char* lds, bf16* T, const bf16x8 (&ga)[4], int u, int wave, int lane) {
    constexpr int PB = 544;
    const int n2g = u & 31, g = (u >> 5) & 3, b = u >> 7, i16 = lane & 15, h4 = lane >> 4;
    const int k1a = 8 * wave + 2 * h4;
    LAS unsigned short* wbuf = (LAS unsigned short*)(lds + 128 * PB + wave * 4096);
#pragma unroll
    for (int H = 0; H < 2; ++H) {
#pragma unroll 4
        for (int c8 = 0; c8 < 8; ++c8) { const int ct = 8 * H + c8;
            f32x4 acc = (f32x4){0.f, 0.f, 0.f, 0.f};
#pragma unroll
            for (int ks = 0; ks < 4; ++ks) { const bf16x8 bd = trfrag(lds + 32 * ks * PB + 32 * ct, PB, lane); acc = mfma16(ga[ks], bd, acc); }
            const int n2 = 4 * n2g + (ct >> 2), e2 = 16 * (ct & 3) + i16;
#pragma unroll
            for (int hf = 0; hf < 2; ++hf) { const int k1 = k1a + hf; const float ar = acc[2 * hf], mai = acc[2 * hf + 1];
                const float fr = (float)((k1 * n2) & 8191) * (1.0f / 8192.0f), c = __builtin_amdgcn_cosf(fr), s = __builtin_amdgcn_sinf(fr);
                const float apr = ar * c - mai * s, api = -mai * c - ar * s;
                const int wi = (((2 * h4 + hf) * 2) * 2 + (c8 >> 2)) * 64 + e2;
                wbuf[wi] = f2bf(apr); wbuf[wi + 128] = f2bf(api); } }
        asm volatile("s_waitcnt lgkmcnt(0)" ::: "memory");
#pragma unroll
        for (int j = 0; j < 4; ++j) { const int seg = 4 * j + (lane >> 4), k1 = 8 * wave + (seg >> 1), pl = seg & 1;
            const u32x4 o = *(const LAS u32x4*)((const LAS unsigned char*)wbuf + seg * 256 + (lane & 15) * 16);
            *(u32x4*)(T + ((((size_t)(b * 4 + g) * 64 + k1) * 2 + pl) * 128 + 4 * n2g + 2 * H) * 64 + (lane & 15) * 8) = o; }
        asm volatile("s_waitcnt lgkmcnt(0)" ::: "memory");
    }
}
DI void fft1_phase(LAS unsigned char* lds, const bf16* Z, bf16* T, const bf16* G1, int bx, int G, int tid, int wave, int lane) {
    constexpr int PB = 544;
    const int i16 = lane & 15, h4 = lane >> 4, ch = tid & 7, n2l = (tid >> 3) & 3, k0 = tid >> 5;
    bf16x8 ga[4];
#pragma unroll
    for (int ks = 0; ks < 4; ++ks) ga[ks] = *(const bf16x8*)(G1 + (16 * wave + i16) * 128 + 32 * ks + 8 * h4);
#define F1_LD(vv, uu) do { const int n2g_ = (uu) & 31, g_ = ((uu) >> 5) & 3, b_ = (uu) >> 7; _Pragma("unroll") for (int it = 0; it < 8; ++it) { const int k = k0 + 16 * it, pq = k >> 6, n1 = k & 63; \
        vv[it] = *(const u32x4*)(Z + (size_t)(b_ * NLAT + 128 * n1 + 4 * n2g_ + n2l) * NZ + ZP + 256 * pq + 64 * g_ + 8 * ch); } } while (0)
#define F1_ST(vv) do { _Pragma("unroll") for (int it = 0; it < 8; ++it) { const int k = k0 + 16 * it; *(LAS u32x4*)(lds + k * PB + (n2l * 64 + 8 * ch) * 2) = vv[it]; } } while (0)
    if (G == 256) {
        u32x4 va[8], vb[8];
        F1_LD(va, bx); F1_LD(vb, bx + 256);
        __syncthreads(); F1_ST(va); __syncthreads();
        fft1_compute(lds, T, ga, bx, wave, lane);
        __syncthreads(); F1_ST(vb); __syncthreads();
        fft1_compute(lds, T, ga, bx + 256, wave, lane);
        return;
    }
    for (int u = bx; u < 512; u += G) {
        u32x4 v[8];
        F1_LD(v, u);
        __syncthreads(); F1_ST(v); __syncthreads();
        fft1_compute(lds, T, ga, u, wave, lane);
    }
#undef F1_LD
#undef F1_ST
}

template <int KD> DI void dft_unit(LAS unsigned char* lds, const bf16* Gt, const bf16* P0, const bf16* P1, int pitch, bf16* outp, int rstride, float scale, int tid, int wave, int lane) {
    constexpr int PB = 160; const int i16 = lane & 15, h4 = lane >> 4;
    __syncthreads();
    { const int ch = tid & 7, r0 = tid >> 3;
      u32x4 v[KD / 64];
#pragma unroll
      for (int it = 0; it < KD / 64; ++it) { const int k = r0 + 64 * it, pl = k / (KD / 2), rr = k % (KD / 2);
          v[it] = *(const u32x4*)((pl ? P1 : P0) + (size_t)rr * pitch + 8 * ch); }
#pragma unroll
      for (int it = 0; it < KD / 64; ++it) { const int k = r0 + 64 * it;
          *(LAS u32x4*)(lds + k * PB + 16 * ch) = v[it]; } }
    __syncthreads();
    f32x4 acc[4];
#pragma unroll
    for (int ct = 0; ct < 4; ++ct) acc[ct] = (f32x4){0.f, 0.f, 0.f, 0.f};
#pragma unroll 4
    for (int ks = 0; ks < KD / 32; ++ks) { const bf16x8 gb = *(const bf16x8*)(Gt + (size_t)(16 * wave + i16) * KD + 32 * ks + 8 * h4);
#pragma unroll
        for (int ct = 0; ct < 4; ++ct) { const bf16x8 ad = trfrag(lds + 32 * ks * PB + 32 * ct, PB, lane); acc[ct] = mfma16(ad, gb, acc[ct]); } }
    bf16* orow = outp + (size_t)rstride * (16 * wave + i16) * DM + 4 * h4;
#pragma unroll
    for (int ct = 0; ct < 4; ++ct) { const f32x4 v = acc[ct] * scale; u32x2 w; w.x = cvt_pk_bf16(v[0], v[1]); w.y = cvt_pk_bf16(v[2], v[3]); *(u32x2*)(orow + 16 * ct) = w; }
}

DI void fft3_phase(LAS unsigned char* lds, const bf16* T, const bf16* G3, bf16* OC, int bx, int G, int tid, int wave, int lane) {
    constexpr int PB = 160, BUF = 256 * PB; const int i16 = lane & 15, h4 = lane >> 4, ch = tid & 7, r0 = tid >> 3;
    int u = bx; if (u >= 1024) return;
    bf16x8 gb[8];
#pragma unroll
    for (int ks = 0; ks < 8; ++ks) gb[ks] = *(const bf16x8*)(G3 + (size_t)(16 * wave + i16) * 256 + 32 * ks + 8 * h4);
    if (G == 256) {
        u32x4 va[4][4];
#pragma unroll
        for (int i = 0; i < 4; ++i) { const bf16* p_ = T + (size_t)(bx + 256 * i) * 2 * 8192 + (size_t)r0 * 64 + 8 * ch;
#pragma unroll
            for (int it = 0; it < 4; ++it) va[i][it] = *(const u32x4*)(p_ + (size_t)it * 64 * 64); }
        __syncthreads();
#pragma unroll
        for (int it = 0; it < 4; ++it) *(LAS u32x4*)(lds + (r0 + 64 * it) * PB + 16 * ch) = va[0][it];
        __syncthreads();
        const int trs = (((lane & 3) << 4) | (lane >> 2)) << 2;
#pragma unroll
        for (int i = 0; i < 4; ++i) { const int uu = bx + 256 * i;
            if (i < 3) {
#pragma unroll
                for (int it = 0; it < 4; ++it) *(LAS u32x4*)(lds + ((i + 1) & 1) * BUF + (r0 + 64 * it) * PB + 16 * ch) = va[i + 1][it]; }
            const LAS unsigned char* ldt = lds + (i & 1) * BUF;
            f32x4 acc[4];
#pragma unroll
            for (int ct = 0; ct < 4; ++ct) acc[ct] = (f32x4){0.f, 0.f, 0.f, 0.f};
#pragma unroll
            for (int ks = 0; ks < 8; ++ks)
#pragma unroll
                for (int ct = 0; ct < 4; ++ct) { const bf16x8 ad = trfrag(ldt + 32 * ks * PB + 32 * ct, PB, lane); acc[ct] = mfma16(ad, gb[ks], acc[ct]); }
            const int k1 = uu & 63, g = (uu >> 6) & 3, b = uu >> 8;
            bf16* orow = OC + (size_t)(b * NLAT + k1 + 64 * (16 * wave + (lane >> 2))) * DM + 256 + 64 * g + 4 * (lane & 3);
#pragma unroll
            for (int ct = 0; ct < 4; ++ct) { const f32x4 w4 = acc[ct] * (1.0f / 724.0773439350247f); u32x2 w; w.x = (unsigned)__builtin_amdgcn_ds_bpermute(trs, (int)cvt_pk_bf16(w4[0], w4[1])); w.y = (unsigned)__builtin_amdgcn_ds_bpermute(trs, (int)cvt_pk_bf16(w4[2], w4[3])); *(u32x2*)(orow + 16 * ct) = w; }
            if (i < 3) __syncthreads(); }
        return;
    }
    u32x4 v[4];
#define F3_LOAD(uu) do { const bf16* p_ = T + (size_t)(uu) * 2 * 8192 + (size_t)r0 * 64 + 8 * ch; _Pragma("unroll") for (int it = 0; it < 4; ++it) v[it] = *(const u32x4*)(p_ + (size_t)it * 64 * 64); } while (0)
#define F3_STORE(pb_) do { _Pragma("unroll") for (int it = 0; it < 4; ++it) *(LAS u32x4*)(lds + (pb_) * BUF + (r0 + 64 * it) * PB + 16 * ch) = v[it]; } while (0)
    F3_LOAD(u);
    __syncthreads();
    F3_STORE(0);
    int un = u + G; bool nvalid = un < 1024;
    if (nvalid) F3_LOAD(un);
    __syncthreads();
    int pb = 0;
    for (;;) {
        int u2 = un + G; bool n2valid = false;
        if (nvalid) { F3_STORE(pb ^ 1); n2valid = u2 < 1024; if (n2valid) F3_LOAD(u2); }
        const LAS unsigned char* ldt = lds + pb * BUF;
        f32x4 acc[4];
#pragma unroll
        for (int ct = 0; ct < 4; ++ct) acc[ct] = (f32x4){0.f, 0.f, 0.f, 0.f};
#pragma unroll
        for (int ks = 0; ks < 8; ++ks)
#pragma unroll
            for (int ct = 0; ct < 4; ++ct) { const bf16x8 ad = trfrag(ldt + 32 * ks * PB + 32 * ct, PB, lane); acc[ct] = mfma16(ad, gb[ks], acc[ct]); }
        const int k1 = u & 63, g = (u >> 6) & 3, b = u >> 8;
        bf16* orow = OC + (size_t)(b * NLAT + k1 + 64 * (16 * wave + (lane >> 2))) * DM + 256 + 64 * g + 4 * (lane & 3);
        const int trs = (((lane & 3) << 4) | (lane >> 2)) << 2;
#pragma unroll
        for (int ct = 0; ct < 4; ++ct) { const f32x4 w4 = acc[ct] * (1.0f / 724.0773439350247f); u32x2 w; w.x = (unsigned)__builtin_amdgcn_ds_bpermute(trs, (int)cvt_pk_bf16(w4[0], w4[1])); w.y = (unsigned)__builtin_amdgcn_ds_bpermute(trs, (int)cvt_pk_bf16(w4[2], w4[3])); *(u32x2*)(orow + 16 * ct) = w; }
        if (!nvalid) break;
        __syncthreads();
        pb ^= 1; u = un; un = u2; nvalid = n2valid;
    }
#undef F3_LOAD
#undef F3_STORE
}

constexpr int PH_L = 20, PH_END = 2 + 2 * PH_L;
__global__ void __launch_bounds__(NTHR, 2) fwd_kernel(Args args) {
    extern __shared__ __attribute__((aligned(16))) unsigned char lds_raw[];
    LAS unsigned char* const lds0 = (LAS unsigned char*)lds_raw;
    const int tid0 = threadIdx.x; const int wave0 = __builtin_amdgcn_readfirstlane(tid0 >> 6);
    const int G0 = gridDim.x, bx0 = blockIdx.x;
    unsigned char* ws0 = args.ws;
#define PHASE_REGS() int bx = bx0, G = G0; asm volatile("" : "+s"(bx), "+s"(G)); LAS unsigned char* lds = lds0; asm volatile("" : "+s"(lds)); int tid; asm volatile("v_mbcnt_lo_u32_b32 %0, -1, 0\n\tv_mbcnt_hi_u32_b32 %0, -1, %0" : "=v"(tid)); tid += wave0 * 64; GAS unsigned char* wsg_ = (GAS unsigned char*)ws0; asm volatile("" : "+s"(wsg_)); unsigned char* ws = (unsigned char*)wsg_; const int lane = tid & 63, wave = __builtin_amdgcn_readfirstlane(tid >> 6); (void)lane; (void)wave; \
    bf16* Z = (bf16*)(ws + WS_R + R_Z); bf16* OC = (bf16*)(ws + WS_R + R_OC); bf16* TT = (bf16*)(ws + WS_R + R_T); bf16* Y = (bf16*)(ws + WS_Y); (void)Z; (void)OC; (void)TT; (void)Y
    for (int u = tid0; u < (LDS_BYTES - LDSCTL_OFF) / 4; u += NTHR) ((LAS unsigned*)(lds0 + LDSCTL_OFF))[u] = 0u;
    __syncthreads();
#if MK_MULTI
#define GRID_BAR() do { } while (0)
#else
    XcdBarrier bar = xcd_barrier_post((unsigned*)(ws0 + WS_CTL) + CW_BAR, (volatile LAS unsigned*)(lds0 + LDSCTL_OFF + LC_BAR));
#define GRID_BAR() do { XcdBarrier b_ = bar; { GAS unsigned* bp_ = (GAS unsigned*)bar.bar; asm volatile("" : "+s"(bp_)); b_.bar = (unsigned*)bp_; } int l_; asm volatile("v_mbcnt_lo_u32_b32 %0, -1, 0\n\tv_mbcnt_hi_u32_b32 %0, -1, %0" : "=v"(l_)); xcd_barrier(b_, wave0 == 0 && l_ == 0); if (MK_PROBE == 40) xcd_barrier(b_, wave0 == 0 && l_ == 0); } while (0)
#endif
    const int lo = args.ph_lo, hi = args.ph_hi;
#define IN(k) (lo <= (k) && (k) < hi)
#define TAIL_FILL(id, nunits) do { if (FILL) { PHASE_REGS(); const int nu_ = (nunits), last_ = nu_ - ((nu_ + G - 1) / G - 1) * G; int* dn_ = (int*)(ws + WS_CTL) + CW_DONE + 64 * (L * 16 + (id)); \
        if (last_ < G) { if (bx < last_) { if (tid == 0) __hip_atomic_fetch_add(dn_, 1, __ATOMIC_RELAXED, __HIP_MEMORY_SCOPE_AGENT); } else cvt_filler(args, ws, lds, tid, wave, lane, dn_, 1); } } } while (0)
#define SEAM(k) do { if (IN(k) && IN((k) + 1)) GRID_BAR(); } while (0)

    if (EN(0) && IN(0)) { PHASE_REGS(); for (int rep = 0; rep < REP(1); ++rep) prologue_a(args, ws, lds, tid, wave, lane); }
    SEAM(0);
    if (EN(1) && IN(1)) { PHASE_REGS(); for (int rep = 0; rep < REP(2); ++rep) norm0_phase(args, ws, wave, lane); }
    SEAM(1);

#pragma unroll 1
    for (int L = 0; L < 2; ++L) {
        const int pb = 2 + PH_L * L;
        if (EN(2) && IN(pb + 0)) { PHASE_REGS();
            pg8::SchedIn S{G, bx, L == 0 ? 28 : 4, L == 0, (const char*)(ws + WS_W + W_IN) + (size_t)L * NZ * 1024 * 2, 2048};
            { LAS f32x4* rl = (LAS f32x4*)(lds + LDSCTL_OFF + LC_ROPE); const f32x4* src = (const f32x4*)(ws + WS_TAB + T_ROPE); const f32x4 r0_ = src[tid], r1_ = src[tid + NTHR]; rl[tid] = r0_; rl[tid + NTHR] = r1_; __syncthreads(); }
            pg8::EpiZ E{Z, (const LAS float*)(lds + LDSCTL_OFF + LC_ROPE), (const LAS float*)(lds + LDSCTL_OFF + LC_ROPE) + 2048};
            pg8::gemm_phase<pg8::EpiZ, pg8::SchedIn, false, false>(lds, (const unsigned char*)Y, 2048, S, E, tid);
        }
        if (IN(pb + 0)) TAIL_FILL(0, 896 + (L == 0 ? 28 : 4));
        SEAM(pb + 0);
        if (IN(pb + 1)) {
            const int nattn = L == 0 ? 528 : 512, nsgu = L == 0 ? 264 : 256;
            if (EN(3)) { PHASE_REGS(); for (int rep = 0; rep < REP(3); ++rep) { for (int u = bx; u < 512; u += G) attn_unit(lds, Z, OC, args.in[I_SINK] + L * 8, u, tid, wave, lane);
                { PHASE_REGS(); for (int u = 512 + ((bx + 16) % G); u < nattn; u += G) attn_unit(lds, Z, OC, args.in[I_SINK] + L * 8, u, tid, wave, lane); } } }
            if (EN(4)) { PHASE_REGS(); for (int rep = 0; rep < REP(4); ++rep) { for (int u = bx; u < 256; u += G) sgu_unit(lds, Z, OC, (const bf16*)(ws + WS_TAB + T_WS) + (size_t)L * 4 * 128 * 128, args.in[I_BS] + L * 512, args.in[I_GV] + L * 256, u, tid, wave, lane);
                for (int u = 256 + ((bx + 32) % G); u < nsgu; u += G) sgu_unit(lds, Z, OC, (const bf16*)(ws + WS_TAB + T_WS) + (size_t)L * 4 * 128 * 128, args.in[I_BS] + L * 512, args.in[I_GV] + L * 256, u, tid, wave, lane); } }
            if (EN(5)) { PHASE_REGS(); for (int rep = 0; rep < REP(5); ++rep) fft1_phase(lds, Z, TT, (const bf16*)(ws + WS_TAB + T_G1), bx, G, tid, wave, lane); }
            if (L == 0) { PHASE_REGS(); for (int u = (bx + 96) % G; u < 32; u += G) {     const int mh = u & 1, g = (u >> 1) & 3, b = u >> 3; const bf16* zr = Z + (size_t)(MLAT + b * NCTX) * NZ;
                dft_unit<512>(lds, (const bf16*)(ws + WS_TAB + T_GC) + (size_t)128 * mh * 512, zr + ZP + 64 * g, zr + ZQI + 64 * g, NZ, OC + (size_t)(MLAT + b * NCTX + 128 * mh) * DM + 256 + 64 * g, 1, 1.0f / 128.0f, tid, wave, lane); } }
            __syncthreads();
            if (FILL && L == 0 && G0 == 256) { PHASE_REGS();
                const bool extra = bx >= 240 || (bx >= 224 && bx < 232) || (bx >= 160 && bx < 192);
                int* dn_ = (int*)(ws + WS_CTL) + CW_DONE + 64 * 15;
                if (extra) { if (tid == 0) __hip_atomic_fetch_add(dn_, 1, __ATOMIC_RELAXED, __HIP_MEMORY_SCOPE_AGENT); } else cvt_filler(args, ws, lds, tid, wave, lane, dn_, 1); }
        }
        SEAM(pb + 1);
        if (EN(6) && IN(pb + 2)) { PHASE_REGS();
            for (int rep = 0; rep < REP(6); ++rep) fft3_phase(lds, TT, (const bf16*)(ws + WS_TAB + T_G3), OC, bx, G, tid, wave, lane);
            __syncthreads();
        }
        SEAM(pb + 2);
        if (EN(7) && IN(pb + 3)) { PHASE_REGS();
            pg8::SchedPlain S{G, bx, (L == 0 && !SPLITK) ? 132 : 128, 4, (const char*)(ws + WS_W + W_OUT) + (size_t)L * 1024 * 1024 * 2, 2048};
            pg8::EpiO E{(bf16*)(ws + WS_R + R_O), DM};
            pg8::gemm_phase<pg8::EpiO, pg8::SchedPlain, false, false>(lds, (const unsigned char*)OC, 2048, S, E, tid);
        }
        if (EN(7) && IN(pb + 3) && L == 0 && SPLITK) { PHASE_REGS();
            pg8::SchedSplit S{G, bx, 4, 4, 4, 4, (const char*)(ws + WS_W + W_OUT), 2048};
            pg8::EpiPart E{(float*)(ws + WS_R + R_T), MCTX, DM};
            pg8::gemm_phase<pg8::EpiPart, pg8::SchedSplit, false, false>(lds, (const unsigned char*)(OC + (size_t)MLAT * DM), 2048, S, E, tid, 4);
        }
        if (IN(pb + 3)) TAIL_FILL(3, (L == 0 && SPLITK) ? 512 + 64 : (L == 0 ? 132 : 128) * 4);
        SEAM(pb + 3);
        if (EN(8) && IN(pb + 4)) { PHASE_REGS(); for (int rep = 0; rep < (L == 0 ? REP(7) : 1); ++rep) norm_mid_phase(args, ws, lds, L, tid, wave, lane); }
        if (IN(pb + 4) && L == 1) { PHASE_REGS(); cvt_filler(args, ws, lds, tid, wave, lane, nullptr, 0); }
        SEAM(pb + 4);
#pragma unroll 1
        for (int c = 0; c < 5; ++c) {
            const bool any = IN(pb + 6 + 2 * c) || IN(pb + 7 + 2 * c);
            int ntiles = 0;
            PHASE_REGS();
            if (any) {
                LAS int* tlw = (LAS int*)(lds + LDSCTL_OFF + LC_TILE);
                int pre[9]; pre[0] = 0;
#pragma unroll
                for (int e = 0; e < 8; ++e) { const int ce = L == 0 ? (e == 0 ? MALL : 0) : __builtin_amdgcn_readfirstlane(__hip_atomic_load((int*)(ws + WS_CTL) + CW_GCNT + e, RLX_AGENT)); pre[e + 1] = pre[e] + ((ce + 255) >> 8); }
                ntiles = pre[8];
                __syncthreads();
                for (int t = tid; t < ntiles && t < 512; t += NTHR) { int e = 0;
#pragma unroll
                    for (int q = 1; q < 8; ++q) if (pre[q] <= t) e = q;
                    int pe = 0;
#pragma unroll
                    for (int q = 0; q < 8; ++q) if (q == e) pe = pre[q];
                    tlw[t] = (e << 24) | ((L == 0 ? 0 : e * CAP) + 256 * (t - pe)); }
                __syncthreads(); }
            const int CT = L == 0 ? CHUNK_TILES : 128;
            int t0 = c * CT; int nM = ntiles - t0, ndf = 0;
            if (L == 0 && SPLITK && !FP8_DDN) { if (c == 0) nM = nM > CT ? CT : nM; else if (c > 1) nM = 0; }
            else if (L == 1 && !MK_MULTI) {
                const int x = (ntiles > 2 * CT && ntiles <= 2 * CT + 16) ? ntiles - 2 * CT : 0;
                if (c == 0) nM = nM > CT ? CT + x : nM; else if (c == 1) { t0 = CT + x; nM = ntiles - t0; ndf = x; } else nM = 0; }
            else nM = nM > CT ? CT : nM;
            unsigned char* const actb = (L == 0 && SPLITK && !FP8_DDN) ? ws + WS_R - ACT0_BACK : (L == 1 && !MK_MULTI) ? ws + WS_R - ACT1_BACK : ws + WS_R + R_ACT;
            if (!MK_MULTI && nM <= 0) break;
            const LAS int* tl = (const LAS int*)(lds + LDSCTL_OFF + LC_TILE);
            const int* tokmap = L == 0 ? (const int*)(ws + WS_RT + RT_TOK) : (const int*)(ws + WS_RT1 + RT1_TOK);
            const int* dstmap = L == 0 ? (const int*)(ws + WS_RT + RT_DST) : (const int*)(ws + WS_RT1 + RT1_DST);
            const float* gatemap = L == 0 ? (const float*)(ws + WS_RT + RT_GATE) : (const float*)(ws + WS_RT1 + RT1_GATE);
            if (EN(10) && IN(pb + 6 + 2 * c) && nM > 0) {
                if (L == 0 && FP8_DGU && !FP8_DDN) { PHASE_REGS();
                    pg8::SchedGrp S{G, bx, t0, nM, 28, (const char*)(ws + WS_W + W_GUD), (size_t)0, 1024, tl, tokmap, true, MK_PROBE == 21};
                    pg8::EpiGUm E{(bf16*)actb, t0};
                    pg8::gemm_phase<pg8::EpiGUm, pg8::SchedGrp, true, true>(lds, (const unsigned char*)Y, 1024, S, E, tid);
                    TAIL_FILL(4 + 2 * c, nM * 28);
                } else if (L == 0 && !FP8_DGU) { PHASE_REGS();
                    pg8::SchedGrp S{G, bx, t0, nM, 28, (const char*)(ws + WS_W + W_GUD), (size_t)0, 2048, tl, tokmap, true, MK_PROBE == 21};
                    pg8::EpiGU E{(bf16*)(ws + WS_R + R_ACT), t0};
                    pg8::gemm_phase<pg8::EpiGU, pg8::SchedGrp, true, false>(lds, (const unsigned char*)Y, 2048, S, E, tid);
                    TAIL_FILL(4 + 2 * c, nM * 28);
                } else if (bx < 4 * ndf) { PHASE_REGS();
                    pg8::SchedGrp S{4 * ndf, bx, CT, ndf, 4, (const char*)(ws + WS_W + W_DE), (size_t)1024 * DFF, DFF, tl, tokmap, false, false};
                    pg8::EpiDown8 E{(bf16*)(ws + WS_R + R_F), dstmap, gatemap};
                    pg8::gemm_phase<pg8::EpiDown8, pg8::SchedGrp, false, true>(lds, (const unsigned char*)actb + (size_t)CT * 256 * DFF, DFF, S, E, tid);
                } else { PHASE_REGS();
                    pg8::SchedGrp S{G - 4 * ndf, bx - 4 * ndf, t0, nM, 28, (const char*)(ws + WS_W + (L == 0 ? W_GUD : W_GUE)), L == 0 ? (size_t)0 : (size_t)7168 * 1024, 1024, tl, tokmap, true, MK_PROBE == 23};
                    pg8::EpiGU8 E{(unsigned char*)actb, t0};
                    pg8::gemm_phase<pg8::EpiGU8, pg8::SchedGrp, true, true>(lds, (const unsigned char*)Y, 1024, S, E, tid);
                }
            }
            SEAM(pb + 6 + 2 * c);
            if (EN(11) && IN(pb + 7 + 2 * c) && nM > 0) {
                if (L == 0 && SPLITK && c == 2 && FP8_DDN) { PHASE_REGS();
                    pg8::SchedSplit S{G, bx, nM, 4, 7, 4, (const char*)(ws + WS_W + W_DD), DFF};
                    pg8::EpiPart E{(float*)(ws + WS_R + R_PART), nM * 256, DM};
                    pg8::gemm_phase<pg8::EpiPart, pg8::SchedSplit, false, true>(lds, (const unsigned char*)(ws + WS_R + R_ACT), DFF, S, E, tid, 4);
                } else if (L == 0 && !FP8_DDN) {
                    const int ng = (SPLITK && nM > CHUNK_TILES) ? CHUNK_TILES : nM;
                    { PHASE_REGS();
                      pg8::SchedGrp S{G, bx, t0, ng, 4, (const char*)(ws + WS_W + W_DD), (size_t)0, 2 * DFF, tl, tokmap, false, MK_PROBE == 22};
                      pg8::EpiDown E{(bf16*)(ws + WS_R + R_F), dstmap, gatemap};
                      pg8::gemm_phase<pg8::EpiDown, pg8::SchedGrp, false, false>(lds, (const unsigned char*)actb, 2 * DFF, S, E, tid); }
                    if (nM > ng) { PHASE_REGS();
                      pg8::SchedSplit S{G, bx, nM - ng, 4, 14, 4, (const char*)(ws + WS_W + W_DD), 2 * DFF};
                      pg8::EpiPart E{(float*)(ws + WS_R + R_PART0), (nM - ng) * 256, DM};
                      pg8::gemm_phase<pg8::EpiPart, pg8::SchedSplit, false, false>(lds, (const unsigned char*)actb + (size_t)ng * 256 * 2 * DFF, 2 * DFF, S, E, tid, 4); }
                } else { PHASE_REGS();
                    const int nMd = (L == 1 && !MK_MULTI && c == 0 && nM > CT) ? CT : nM;
                    pg8::SchedGrp S{G, bx, t0, nMd, 4, (const char*)(ws + WS_W + (L == 0 ? W_DD : W_DE)), L == 0 ? (size_t)0 : (size_t)1024 * DFF, DFF, tl, tokmap, false, MK_PROBE == 24};
                    pg8::EpiDown8 E{(bf16*)(ws + WS_R + R_F), dstmap, gatemap};
                    pg8::gemm_phase<pg8::EpiDown8, pg8::SchedGrp, false, true>(lds, (const unsigned char*)actb, DFF, S, E, tid);
                }
            }
            SEAM(pb + 7 + 2 * c);
        }
        if (EN(12) && IN(pb + 16)) { PHASE_REGS(); norm_end_phase(args, ws, L, wave, lane); }
        if (L == 0) SEAM(pb + 16);
    }
#undef IN
#undef SEAM
}

extern "C" void kernel_launch(void* const* d_in, const int* in_sizes, int n_in, void* d_out, int out_size, void* d_ws, size_t ws_size, hipStream_t stream) {
    static int grid = 0;
    if (grid == 0) {
        if (n_in != 25 || out_size != MLAT * DM || ws_size < WS_END) { fprintf(stderr, "kernel_launch: unexpected shapes (n_in %d out %d ws %zu, need %zu)\n", n_in, out_size, ws_size, (size_t)WS_END); grid = -1; return; }
        int dev = 0, cus = 0, per_cu = 0;
        if (hipGetDevice(&dev) != hipSuccess || hipDeviceGetAttribute(&cus, hipDeviceAttributeMultiprocessorCount, dev) != hipSuccess) { grid = -1; return; }
        if (hipFuncSetAttribute((const void*)fwd_kernel, hipFuncAttributeMaxDynamicSharedMemorySize, LDS_BYTES) != hipSuccess) { fprintf(stderr, "kernel_launch: hipFuncSetAttribute failed\n"); grid = -1; return; }
        if (hipOccupancyMaxActiveBlocksPerMultiprocessor(&per_cu, (const void*)fwd_kernel, NTHR, LDS_BYTES) != hipSuccess || per_cu < 1) fprintf(stderr, "kernel_launch: occupancy query says %d\n", per_cu);
        (void)hipGetLastError();
        grid = cus > 256 ? 256 : cus;
    }
    if (grid < 0) return;
    (void)hipMemsetAsync((char*)d_ws + WS_CTL, 0, CTL_ZERO_BYTES, stream);
    Args a{};
    for (int i = 0; i < 25; ++i) a.in[i] = (const float*)d_in[i];
    a.out = (float*)d_out; a.ws = (unsigned char*)d_ws;
#if MK_MULTI
    for (int p = 0; p < PH_END; ++p) {
        const int k = p < 2 ? -1 : (p - 2) % PH_L;
        if (k > 16 || k == 5) continue;
        a.ph_lo = p; a.ph_hi = p + 1;
        hipLaunchKernelGGL(fwd_kernel, dim3(grid), dim3(NTHR), LDS_BYTES, stream, a);
    }
#else
    a.ph_lo = 0; a.ph_hi = PH_END;
    hipLaunchKernelGGL(fwd_kernel, dim3(grid), dim3(NTHR), LDS_BYTES, stream, a);
#endif
}
```
